# Optimizing an MI355X kernel written in HIP

```python
import jax, jax.numpy as jnp
from jax import lax
import numpy as np

D_MODEL = 1024
BATCH = 8
SEQ = 4096
DEPTH = 1

CTX_LEN = 256
GRID_W = 64
EPS = 1e-6
N_MOD = 6

A_WIDTH = D_MODEL
A_GROUPS = 8
A_GROUP_DIM = A_WIDTH // A_GROUPS
A_CHUNK = 128

B_HEADS = 4
B_DK = D_MODEL // 2 // B_HEADS
B_DV = D_MODEL // B_HEADS
B_QK_WIDTH = B_HEADS * B_DK
B_V_WIDTH = B_HEADS * B_DV
GATE_RANK = 16
GATE_TEMP = 16.0
GLA_CHUNK = 64

D_FF = ((8 * D_MODEL // 3 + 255) // 256) * 256

IN_SIZES = (A_WIDTH, A_WIDTH, B_QK_WIDTH, B_QK_WIDTH, B_V_WIDTH, B_V_WIDTH,
            GATE_RANK, GATE_RANK, D_MODEL, D_MODEL)

kernel_name = "hybrid_gmlp_gla_diffusion_block"


def _split_offsets():
    offs, acc = [], 0
    for s in IN_SIZES[:-1]:
        acc += s
        offs.append(acc)
    return offs


def _rmsnorm(x, g):
    xf = x.astype(jnp.float32)
    y = xf * lax.rsqrt(jnp.mean(xf * xf, axis=-1, keepdims=True) + EPS)
    return (y * g.astype(jnp.float32)).astype(x.dtype)


def _layernorm(x, g, b):
    xf = x.astype(jnp.float32)
    mu = jnp.mean(xf, axis=-1, keepdims=True)
    xc = xf - mu
    y = xc * lax.rsqrt(jnp.mean(xc * xc, axis=-1, keepdims=True) + EPS)
    return (y * g.astype(jnp.float32) + b.astype(jnp.float32)).astype(x.dtype)


def _modulate(xn, shift, scale):
    return xn * (1 + scale) + shift


def _chunk_mlp(u, v, n_chunks, ln_v_g, ln_v_b, w_spatial, b_spatial):
    B, T, _ = u.shape
    u = jax.nn.gelu(u, approximate=False)
    v = _layernorm(jax.nn.gelu(v, approximate=False), ln_v_g, ln_v_b)
    vc = v.reshape(B, n_chunks, A_CHUNK, A_GROUPS, A_GROUP_DIM)
    mixed = jnp.einsum('gpq,bnqgc->bnpgc', w_spatial, vc) + jnp.transpose(b_spatial)[:, :, None]
    return u * mixed.reshape(B, T, A_WIDTH)


def _gla_heads(q, k, v, af, ab, w_af, b_af, w_ab, b_ab):
    B, T, _ = q.shape
    f32 = jnp.float32
    q = q.astype(f32).reshape(B, T, B_HEADS, B_DK) * (B_DK ** -0.5)
    k = k.astype(f32).reshape(B, T, B_HEADS, B_DK)
    v = v.astype(f32).reshape(B, T, B_HEADS, B_DV)
    lf = (jax.nn.log_sigmoid((af @ w_af + b_af).astype(f32)) / GATE_TEMP).reshape(B, T, B_HEADS, B_DK)
    lb = (jax.nn.log_sigmoid((ab @ w_ab + b_ab).astype(f32)) / GATE_TEMP).reshape(B, T, B_HEADS, B_DK)
    return q, k, v, lf, lb


def _gla_scan(q, k, v, log_a, s0):
    B, T, H, DK = q.shape
    DV = v.shape[-1]
    n = T // GLA_CHUNK

    def to_chunks(t):
        return jnp.moveaxis(t.reshape(B, n, GLA_CHUNK, H, t.shape[-1]), 1, 0)

    mask = jnp.tril(jnp.ones((GLA_CHUNK, GLA_CHUNK), dtype=bool))

    def step(s, xs):
        qc, kc, vc, gc = xs
        b = jnp.cumsum(gc, axis=1)
        b_last = b[:, -1]
        q_dec = qc * jnp.exp(b)
        k_inv = kc * jnp.exp(-b)
        k_state = kc * jnp.exp(b_last[:, None] - b)
        o_inter = jnp.einsum('bchk,bhkv->bchv', q_dec, s)
        att = jnp.where(mask, jnp.einsum('bihk,bjhk->bhij', q_dec, k_inv), 0.0)
        o_intra = jnp.einsum('bhij,bjhv->bihv', att, vc)
        s_new = jnp.exp(b_last)[..., None] * s + jnp.einsum('bchk,bchv->bhkv', k_state, vc)
        return s_new, o_inter + o_intra

    s_fin, o = lax.scan(step, s0, (to_chunks(q), to_chunks(k), to_chunks(v), to_chunks(log_a)))
    o = jnp.moveaxis(o, 0, 1).reshape(B, T, H, DV)
    return o, s_fin


def _gla_out(o, r, gla_norm_g, dtype):
    B, T = o.shape[0], o.shape[1]
    o = o * lax.rsqrt(jnp.mean(o * o, axis=-1, keepdims=True) + EPS)
    o = o.reshape(B, T, B_V_WIDTH) * gla_norm_g.astype(jnp.float32)
    return o.astype(dtype) * jax.nn.silu(r)


def _token_mixer(h_lat, h_ctx, w_in, ln_v_g, ln_v_b, w_spatial, b_spatial,
                 w_alpha_f, b_alpha_f, w_alpha_b, b_alpha_b, gla_norm_g,
                 w_branch_a, w_branch_b, w_out, with_ctx_out):
    offs = _split_offsets()
    u_l, v_l, q_l, k_l, vv_l, r_l, af_l, ab_l, ga_l, gb_l = jnp.split(h_lat @ w_in, offs, axis=-1)
    u_c, v_c, q_c, k_c, vv_c, r_c, af_c, ab_c, ga_c, gb_c = jnp.split(h_ctx @ w_in, offs, axis=-1)
    B = h_lat.shape[0]

    ql, kl, vl, lfl, lbl = _gla_heads(q_l, k_l, vv_l, af_l, ab_l, w_alpha_f, b_alpha_f, w_alpha_b, b_alpha_b)
    qc, kc, vc, lfc, lbc = _gla_heads(q_c, k_c, vv_c, af_c, ab_c, w_alpha_f, b_alpha_f, w_alpha_b, b_alpha_b)
    s0 = jnp.zeros((B, B_HEADS, B_DK, B_DV), jnp.float32)
    fl = lambda t: jnp.flip(t, axis=1)
    o_cf, s_cf = _gla_scan(qc, kc, vc, lfc, s0)
    o_lf, _ = _gla_scan(ql, kl, vl, lfl, s_cf)
    o_cb, s_cb = _gla_scan(fl(qc), fl(kc), fl(vc), fl(lbc), s0)
    o_lb, _ = _gla_scan(fl(ql), fl(kl), fl(vl), fl(lbl), s_cb)
    b_lat = _gla_out(o_lf + fl(o_lb), r_l, gla_norm_g, h_lat.dtype)

    rows = h_lat.shape[1] // GRID_W
    a_lat = _chunk_mlp(u_l, v_l, rows // (A_CHUNK // GRID_W), ln_v_g, ln_v_b, w_spatial, b_spatial)

    def merge(a_out, b_out, ga, gb):
        y = jax.nn.sigmoid(ga) * (a_out @ w_branch_a) + jax.nn.sigmoid(gb) * (b_out @ w_branch_b)
        return y @ w_out

    out_lat = merge(a_lat, b_lat, ga_l, gb_l)
    if not with_ctx_out:
        return out_lat, None
    b_ctx = _gla_out(o_cf + fl(o_cb), r_c, gla_norm_g, h_ctx.dtype)
    a_ctx = _chunk_mlp(u_c, v_c, h_ctx.shape[1] // A_CHUNK, ln_v_g, ln_v_b, w_spatial, b_spatial)
    return out_lat, merge(a_ctx, b_ctx, ga_c, gb_c)


def _swiglu(h, w_ffn_in, w_ffn_out):
    a, g = jnp.split(h @ w_ffn_in, 2, axis=-1)
    return (jax.nn.silu(g) * a) @ w_ffn_out


def setup_inputs(seed: int = 0) -> dict:
    key = jax.random.key(seed)
    ks = jax.random.split(key, 24)
    f32 = jnp.float32
    nrm = lambda k, shape, s: jax.random.normal(k, shape, f32) * s
    L, D = DEPTH, D_MODEL
    return {
        "x": nrm(ks[0], (BATCH, SEQ, D), 1.0),
        "c": nrm(ks[1], (BATCH, D), 1.0),
        "ctx": nrm(ks[2], (BATCH, CTX_LEN, D), 1.0),
        "c_ctx": nrm(ks[3], (D,), 1.0),
        "w_ada": nrm(ks[4], (L, D, N_MOD * D), 0.5 * D ** -0.5),
        "b_ada": nrm(ks[5], (L, N_MOD * D), 0.02),
        "norm1_g": 1.0 + nrm(ks[6], (L, D), 0.02),
        "w_in": nrm(ks[7], (L, D, sum(IN_SIZES)), D ** -0.5),
        "ln_v_g": 1.0 + nrm(ks[8], (L, A_WIDTH), 0.02),
        "ln_v_b": nrm(ks[9], (L, A_WIDTH), 0.02),
        "w_spatial": nrm(ks[10], (L, A_GROUPS, A_CHUNK, A_CHUNK), A_CHUNK ** -0.5),
        "b_spatial": 1.0 + nrm(ks[11], (L, A_GROUPS, A_CHUNK), 0.02),
        "w_alpha_f": nrm(ks[12], (L, GATE_RANK, B_QK_WIDTH), GATE_RANK ** -0.5),
        "b_alpha_f": nrm(ks[13], (L, B_QK_WIDTH), 0.02),
        "w_alpha_b": nrm(ks[14], (L, GATE_RANK, B_QK_WIDTH), GATE_RANK ** -0.5),
        "b_alpha_b": nrm(ks[15], (L, B_QK_WIDTH), 0.02),
        "gla_norm_g": 1.0 + nrm(ks[16], (L, B_V_WIDTH), 0.02),
        "w_branch_a": nrm(ks[17], (L, A_WIDTH, D), A_WIDTH ** -0.5),
        "w_branch_b": nrm(ks[18], (L, B_V_WIDTH, D), B_V_WIDTH ** -0.5),
        "w_out": nrm(ks[19], (L, D, D), D ** -0.5),
        "norm2_g": 1.0 + nrm(ks[20], (L, D), 0.02),
        "w_ffn_in": nrm(ks[21], (L, D, 2 * D_FF), D ** -0.5),
        "w_ffn_out": nrm(ks[22], (L, D_FF, D), D_FF ** -0.5),
        "final_norm_g": 1.0 + nrm(ks[23], (D,), 0.02),
    }


def reference(x, c, ctx, c_ctx, w_ada, b_ada, norm1_g, w_in, ln_v_g, ln_v_b, w_spatial, b_spatial,
              w_alpha_f, b_alpha_f, w_alpha_b, b_alpha_b, gla_norm_g, w_branch_a, w_branch_b,
              w_out, norm2_g, w_ffn_in, w_ffn_out, final_norm_g):
    for l in range(DEPTH):
        update_ctx = l < DEPTH - 1
        mod = jnp.split((jax.nn.silu(c) @ w_ada[l] + b_ada[l])[:, None, :], N_MOD, axis=-1)
        mod_c = jnp.split(jax.nn.silu(c_ctx) @ w_ada[l] + b_ada[l], N_MOD, axis=-1)
        sh1, sc1, g1, sh2, sc2, g2 = mod
        sh1c, sc1c, g1c, sh2c, sc2c, g2c = mod_c

        h_lat = _modulate(_rmsnorm(x, norm1_g[l]), sh1, sc1)
        h_ctx = _modulate(_rmsnorm(ctx, norm1_g[l]), sh1c, sc1c)
        mix_l, mix_c = _token_mixer(h_lat, h_ctx, w_in[l], ln_v_g[l], ln_v_b[l], w_spatial[l], b_spatial[l],
                                    w_alpha_f[l], b_alpha_f[l], w_alpha_b[l], b_alpha_b[l], gla_norm_g[l],
                                    w_branch_a[l], w_branch_b[l], w_out[l], update_ctx)
        x = x + g1 * mix_l
        x = x + g2 * _swiglu(_modulate(_rmsnorm(x, norm2_g[l]), sh2, sc2), w_ffn_in[l], w_ffn_out[l])
        if update_ctx:
            ctx = ctx + g1c * mix_c
            ctx = ctx + g2c * _swiglu(_modulate(_rmsnorm(ctx, norm2_g[l]), sh2c, sc2c), w_ffn_in[l], w_ffn_out[l])
    return _rmsnorm(x, final_norm_g)
```

```cpp
#include <hip/hip_runtime.h>
#include <stdint.h>
#include <cstdio>

typedef unsigned short bf16;
__device__ __forceinline__ float bf2f(bf16 v) { return __uint_as_float(((unsigned)v) << 16); }
__device__ __forceinline__ bf16 f2bf(float f) { unsigned u = __float_as_uint(f); u += 0x7fffu + ((u >> 16) & 1u); return (bf16)(u >> 16); }

constexpr int NB = 8, T = 4096, D = 1024, TC = 256;
constexpr int ML = NB * T;
constexpr int MC = NB * TC;
constexpr int M = ML + MC;
constexpr int NH = 4, DK = 128, DV = 256, QKW = 512, VW = 1024, RANK = 16;
constexpr int DFF = 2816, NIN = 7200;
constexpr float EPS = 1e-6f;
constexpr int C_U = 0, C_VA = 1024, C_Q = 2048, C_K = 2560, C_VV = 3072, C_R = 4096, C_AF = 5120, C_GA = 5152, C_GB = 6176;

constexpr size_t MiB = 1u << 20;
constexpr size_t WS_CTL = 0;
constexpr size_t WS_ROWSS = 256 * 1024, WS_ROWSS2 = 512 * 1024;
constexpr size_t WS_MOD = 1 * MiB;
constexpr size_t WS_CV = WS_MOD + 256 * 1024;
constexpr size_t WS_LNST = 2 * MiB;
constexpr size_t WS_WT1A = 4 * MiB;
constexpr size_t WS_WTVV = WS_WT1A + 1280 * 1024 * 2;
constexpr size_t WS_WT1B = WS_WTVV + 2 * MiB;
constexpr size_t WS_WTVA = WS_WT1B + 8 * MiB;
constexpr size_t WS_WTA = WS_WTVA + 2 * MiB, WS_WTB = WS_WTA + 2 * MiB, WS_WTO = WS_WTB + 2 * MiB;
constexpr size_t WS_WTF1 = WS_WTO + 2 * MiB;
constexpr size_t WS_WTF2 = WS_WTF1 + 11 * MiB;
static_assert(WS_WTF2 + (size_t)1024 * 2816 * 2 <= 48 * MiB, "weights region");
constexpr size_t WS_H = 48 * MiB;
constexpr size_t WS_Q = 116 * MiB;
constexpr size_t WS_K = 148 * MiB;
constexpr size_t WS_AF = 182 * MiB;
constexpr size_t WS_VVT = 188 * MiB;
constexpr size_t WS_PKG = 256 * MiB;
constexpr size_t WS_OF = 423 * MiB;
constexpr size_t WS_OB = 116 * MiB;
constexpr size_t WS_U = 188 * MiB;
constexpr size_t WS_GVT = 256 * MiB;
constexpr size_t WS_R = 320 * MiB;
constexpr size_t WS_Y1 = 256 * MiB;
constexpr size_t WS_Y = 48 * MiB;
constexpr size_t WS_X1 = 384 * MiB;
constexpr size_t WS_A2 = 116 * MiB;
constexpr size_t WS_HB = 180 * MiB;
constexpr size_t WS_END = 512 * MiB;

__global__ void nv_transpose(const float* __restrict__ W, int K, int ldw, int col0, int ncols, bf16* __restrict__ WT) {
    __shared__ float tile[32][33];
    const int k0 = blockIdx.y * 32, n0 = blockIdx.x * 32, tx = threadIdx.x & 31, ty = threadIdx.x >> 5;
    for (int i = ty; i < 32; i += 8) tile[i][tx] = W[(size_t)(k0 + i) * ldw + col0 + n0 + tx];
    __syncthreads();
    for (int i = ty; i < 32; i += 8) WT[(size_t)(n0 + i) * K + k0 + tx] = f2bf(tile[tx][i]);
}
__global__ void nv_zero_bf16(bf16* p, size_t n) { for (size_t i = (size_t)blockIdx.x * blockDim.x + threadIdx.x; i < n; i += (size_t)gridDim.x * blockDim.x) p[i] = 0; }

__global__ void nv_ada(const float* __restrict__ c, const float* __restrict__ cctx, const float* __restrict__ w_ada, const float* __restrict__ b_ada, float* __restrict__ MOD) {
    __shared__ float s[9][1024];
    for (int i = threadIdx.x; i < 9 * 1024; i += blockDim.x) { const int r = i >> 10, k = i & 1023; const float v = r < 8 ? c[r * 1024 + k] : cctx[k]; s[r][k] = v / (1.f + expf(-v)); }
    __syncthreads();
    const int n = blockIdx.x * blockDim.x + threadIdx.x;
    float acc[9];
    for (int r = 0; r < 9; ++r) acc[r] = 0.f;
    for (int k = 0; k < 1024; ++k) { const float w = w_ada[(size_t)k * 6144 + n];
#pragma unroll
        for (int r = 0; r < 9; ++r) acc[r] += s[r][k] * w; }
    for (int r = 0; r < 9; ++r) MOD[r * 6144 + n] = acc[r] + b_ada[n];
}

__device__ __forceinline__ float wave_sum(float v) {
#pragma unroll
    for (int o = 1; o < 64; o <<= 1) v += __shfl_xor(v, o);
    return v;
}
__global__ void nv_modnorm(const float* __restrict__ xl, const float* __restrict__ xc, const float* __restrict__ g, const float* __restrict__ MOD, int shoff, int scoff, bf16* __restrict__ out, int nrows, int pad_) {
    const int row = blockIdx.x * (blockDim.x >> 6) + (threadIdx.x >> 6), lane = threadIdx.x & 63;
    if (row >= nrows) return;
    const float* xr = row < ML ? xl + (size_t)row * D : xc + (size_t)(row - ML) * D;
    const int mr = row < ML ? row / T : 8;
    float v[16]; float ss = 0.f;
#pragma unroll
    for (int j = 0; j < 16; ++j) { v[j] = xr[lane + 64 * j]; ss += v[j] * v[j]; }
    const float rstd = rsqrtf(wave_sum(ss) * (1.f / D) + EPS);
#pragma unroll
    for (int j = 0; j < 16; ++j) { const int cidx = lane + 64 * j; const float y = v[j] * rstd * g[cidx];
        out[(size_t)row * D + cidx] = f2bf(y * (1.f + MOD[mr * 6144 + scoff + cidx]) + MOD[mr * 6144 + shoff + cidx]); }
}

template <class Epi, bool DUAL>
__global__ void __launch_bounds__(256) nv_gemm(const bf16* __restrict__ A, const bf16* __restrict__ Bt, int Mrows, int N, int K, int pad_, Epi epi) {
    __shared__ float As[32][65], Bs[32][65], Bs2[DUAL ? 32 : 1][65];
    const int tid = threadIdx.x, tx = tid & 15, ty = tid >> 4;
    const int m0 = blockIdx.y * 64, n0 = blockIdx.x * 64;
    float acc[4][4], acc2[4][4];
#pragma unroll
    for (int i = 0; i < 4; ++i)
#pragma unroll
        for (int j = 0; j < 4; ++j) { acc[i][j] = 0.f; acc2[i][j] = 0.f; }
    const int lr = tid >> 2, lk = (tid & 3) * 8;
    const int am = m0 + lr, bn = n0 + lr < N ? n0 + lr : N - 1;
    const bf16* ap = A + (size_t)am * K + lk;
    const bf16* bp = Bt + (size_t)epi.brow(bn) * K + lk;
    const bf16* bp2 = DUAL ? Bt + (size_t)epi.brow2(bn) * K + lk : bp;
    for (int k0 = 0; k0 < K; k0 += 32) {
        const uint4 av = *(const uint4*)(ap + k0), bv = *(const uint4*)(bp + k0);
        const unsigned aw[4] = {av.x, av.y, av.z, av.w}, bw[4] = {bv.x, bv.y, bv.z, bv.w};
#pragma unroll
        for (int j = 0; j < 4; ++j) { As[lk + 2 * j][lr] = __uint_as_float(aw[j] << 16); As[lk + 2 * j + 1][lr] = __uint_as_float(aw[j] & 0xffff0000u);
                                      Bs[lk + 2 * j][lr] = __uint_as_float(bw[j] << 16); Bs[lk + 2 * j + 1][lr] = __uint_as_float(bw[j] & 0xffff0000u); }
        if (DUAL) { const uint4 cv = *(const uint4*)(bp2 + k0); const unsigned cw[4] = {cv.x, cv.y, cv.z, cv.w};
#pragma unroll
            for (int j = 0; j < 4; ++j) { Bs2[lk + 2 * j][lr] = __uint_as_float(cw[j] << 16); Bs2[lk + 2 * j + 1][lr] = __uint_as_float(cw[j] & 0xffff0000u); } }
        __syncthreads();
#pragma unroll 8
        for (int k = 0; k < 32; ++k) {
            float a[4], b[4], b2[4];
#pragma unroll
            for (int i = 0; i < 4; ++i) { a[i] = As[k][ty * 4 + i]; b[i] = Bs[k][tx * 4 + i]; b2[i] = DUAL ? Bs2[k][tx * 4 + i] : 0.f; }
#pragma unroll
            for (int i = 0; i < 4; ++i)
#pragma unroll
                for (int j = 0; j < 4; ++j) { acc[i][j] += a[i] * b[j]; if (DUAL) acc2[i][j] += a[i] * b2[j]; }
        }
        __syncthreads();
    }
#pragma unroll
    for (int i = 0; i < 4; ++i)
#pragma unroll
        for (int j = 0; j < 4; ++j) { const int m = m0 + ty * 4 + i, n = n0 + tx * 4 + j; if (m < Mrows && n < N) epi(m, n, acc[i][j], acc2[i][j]); }
}
__device__ __forceinline__ float gelu_erf(float v) { return 0.5f * v * (1.f + erff(v * 0.70710678118654752f)); }
__device__ __forceinline__ float sigmoidf_(float v) { return 1.f / (1.f + expf(-v)); }
struct EpBase { __device__ int brow(int n) const { return n; } __device__ int brow2(int n) const { return n; } };
struct EpQ : EpBase { bf16* O; int ld; float sc; __device__ void operator()(int m, int n, float a, float) const { O[(size_t)m * ld + n] = f2bf(a * sc); } };
struct EpF32 : EpBase { float* O; int ld; int pad; __device__ void operator()(int m, int n, float a, float) const { O[(size_t)m * ld + n] = a; } };
struct EpT : EpBase { bf16* O; int ld; int act; __device__ void operator()(int m, int n, float a, float) const { O[(size_t)n * ld + m] = f2bf(act ? gelu_erf(a) : a); } };
struct EpAct : EpBase { bf16* O; int ld; int act; __device__ void operator()(int m, int n, float a, float) const { float v = act == 1 ? gelu_erf(a) : act == 2 ? a * sigmoidf_(a) : sigmoidf_(a); O[(size_t)m * ld + n] = f2bf(v); } };
struct EpY1 : EpBase { const bf16* G; float* Y1; __device__ void operator()(int m, int n, float a, float) const { Y1[(size_t)m * D + n] = bf2f(G[(size_t)m * D + n]) * a; } };
struct EpY : EpBase { const bf16* G; const float* Y1; bf16* Y; __device__ void operator()(int m, int n, float a, float) const { Y[(size_t)m * D + n] = f2bf(Y1[(size_t)m * D + n] + bf2f(G[(size_t)m * D + n]) * a); } };
struct EpRes : EpBase { const float* X; const float* MOD; float* O; int goff; int pad; __device__ void operator()(int m, int n, float a, float) const { O[(size_t)m * D + n] = X[(size_t)m * D + n] + MOD[(m / T) * 6144 + goff + n] * a; } };
struct EpSwi { bf16* O; __device__ int brow(int n) const { return 256 * (n >> 7) + (n & 127); } __device__ int brow2(int n) const { return 256 * (n >> 7) + 128 + (n & 127); }
    __device__ void operator()(int m, int n, float a, float g) const { O[(size_t)m * DFF + n] = f2bf(a * (g * sigmoidf_(g))); } };

__global__ void __launch_bounds__(256) nv_gla(const bf16* __restrict__ Q, const bf16* __restrict__ Kb, const float* __restrict__ AF, const bf16* __restrict__ VVT,
                                              const float* __restrict__ w_af, const float* __restrict__ b_af, const float* __restrict__ w_ab, const float* __restrict__ b_ab,
                                              bf16* __restrict__ OF, bf16* __restrict__ OB) {
    const int dir = blockIdx.x & 1, h = (blockIdx.x >> 1) & 3, b = blockIdx.x >> 3, tid = threadIdx.x;
    __shared__ float sa[128], sk[128], sq[128], wl[16][128], bl[128];
    const float* wsrc = dir ? w_ab : w_af; const float* bsrc = dir ? b_ab : b_af;
    for (int i = tid; i < 16 * 128; i += 256) wl[i >> 7][i & 127] = wsrc[(i >> 7) * QKW + h * DK + (i & 127)];
    if (tid < 128) bl[tid] = bsrc[h * DK + tid];
    float S[128];
#pragma unroll
    for (int i = 0; i < 128; ++i) S[i] = 0.f;
    bf16* O = dir ? OB : OF;
    const bf16* vrow = VVT + (size_t)(h * DV + tid) * M;
    __syncthreads();
    for (int step = 0; step < TC + T; ++step) {
        const bool isctx = step < TC;
        int row;
        if (isctx) row = ML + b * TC + (dir ? TC - 1 - step : step);
        else { const int t = step - TC; row = b * T + (dir ? T - 1 - t : t); }
        if (tid < 128) {
            float z = bl[tid];
#pragma unroll
            for (int r = 0; r < 16; ++r) z += AF[(size_t)row * 32 + dir * 16 + r] * wl[r][tid];
            const float ls = fminf(z, 0.f) - log1pf(expf(-fabsf(z)));
            sa[tid] = expf(ls * (1.f / 16.f));
            sk[tid] = bf2f(Kb[(size_t)row * QKW + h * DK + tid]);
            sq[tid] = isctx ? 0.f : bf2f(Q[(size_t)row * QKW + h * DK + tid]);
        }
        const float v = bf2f(vrow[row]);
        __syncthreads();
        float o = 0.f;
#pragma unroll
        for (int i = 0; i < 128; ++i) { S[i] = sa[i] * S[i] + sk[i] * v; o += sq[i] * S[i]; }
        if (!isctx) O[(size_t)row * VW + h * DV + tid] = f2bf(o);
        __syncthreads();
    }
}

__global__ void nv_lnstat(const bf16* __restrict__ GVT, float* __restrict__ ST) {
    const int t = blockIdx.x * blockDim.x + threadIdx.x;
    float s = 0.f, s2 = 0.f;
    for (int c = 0; c < 1024; ++c) { const float v = bf2f(GVT[(size_t)c * ML + t]); s += v; }
    const float mean = s * (1.f / 1024.f);
    for (int c = 0; c < 1024; ++c) { const float d = bf2f(GVT[(size_t)c * ML + t]) - mean; s2 += d * d; }
    ST[2 * t] = mean; ST[2 * t + 1] = rsqrtf(s2 * (1.f / 1024.f) + EPS);
}
__global__ void __launch_bounds__(256) nv_chunkmlp(bf16* __restrict__ U, const bf16* __restrict__ GVT, const float* __restrict__ ST, const float* __restrict__ lng, const float* __restrict__ lnb,
                                                   const float* __restrict__ wsp, const float* __restrict__ bsp) {
    extern __shared__ float vt[];
    const int ch = blockIdx.x, g = blockIdx.y, tok0 = ch * 128, tid = threadIdx.x;
    for (int i = tid; i < 128 * 128; i += 256) { const int c = i >> 7, q = i & 127; const int cc = g * 128 + c;
        const float v = bf2f(GVT[(size_t)cc * ML + tok0 + q]);
        vt[q * 128 + c] = (v - ST[2 * (tok0 + q)]) * ST[2 * (tok0 + q) + 1] * lng[cc] + lnb[cc]; }
    __syncthreads();
    const int c = tid & 127;
    for (int p = tid >> 7; p < 128; p += 2) {
        float acc = 0.f;
        const float* wr = wsp + ((size_t)g * 128 + p) * 128;
        for (int q = 0; q < 128; ++q) acc += wr[q] * vt[q * 128 + c];
        acc += bsp[g * 128 + p];
        const size_t o = (size_t)(tok0 + p) * D + g * 128 + c;
        U[o] = f2bf(bf2f(U[o]) * acc);
    }
}
__global__ void nv_glaout(bf16* __restrict__ OF, const bf16* __restrict__ OB, const bf16* __restrict__ R, const float* __restrict__ gain) {
    const int w = blockIdx.x * (blockDim.x >> 6) + (threadIdx.x >> 6), lane = threadIdx.x & 63;
    const int row = w >> 2, h = w & 3;
    float v[4]; float ss = 0.f;
#pragma unroll
    for (int j = 0; j < 4; ++j) { const size_t o = (size_t)row * VW + h * DV + lane + 64 * j; v[j] = bf2f(OF[o]) + bf2f(OB[o]); ss += v[j] * v[j]; }
    const float rstd = rsqrtf(wave_sum(ss) * (1.f / DV) + EPS);
#pragma unroll
    for (int j = 0; j < 4; ++j) { const int cidx = h * DV + lane + 64 * j; const size_t o = (size_t)row * VW + cidx; OF[o] = f2bf(v[j] * rstd * gain[cidx] * bf2f(R[o])); }
}
__global__ void nv_finalnorm(float* __restrict__ X, const float* __restrict__ g) {
    const int row = blockIdx.x * (blockDim.x >> 6) + (threadIdx.x >> 6), lane = threadIdx.x & 63;
    float v[16]; float ss = 0.f;
#pragma unroll
    for (int j = 0; j < 16; ++j) { v[j] = X[(size_t)row * D + lane + 64 * j]; ss += v[j] * v[j]; }
    const float rstd = rsqrtf(wave_sum(ss) * (1.f / D) + EPS);
#pragma unroll
    for (int j = 0; j < 16; ++j) X[(size_t)row * D + lane + 64 * j] = v[j] * rstd * g[lane + 64 * j];
}

template <class Epi, bool DUAL = false>
static void run_gemm(hipStream_t s, const bf16* A, const bf16* Bt, int Mrows, int N, int K, const Epi& e) {
    hipLaunchKernelGGL((nv_gemm<Epi, DUAL>), dim3((N + 63) / 64, Mrows / 64), dim3(256), 0, s, A, Bt, Mrows, N, K, 0, e);
}
static void run_tr(hipStream_t s, const float* W, int K, int ldw, int col0, int ncols, bf16* WT) {
    hipLaunchKernelGGL(nv_transpose, dim3(ncols / 32, K / 32), dim3(256), 0, s, W, K, ldw, col0, ncols, WT);
}

extern "C" void kernel_launch(void* const* d_in, const int* in_sizes, int n_in, void* d_out, int out_size, void* d_ws, size_t ws_size, hipStream_t stream) {
    if (n_in != 24 || out_size != ML * D || ws_size < WS_END) { fprintf(stderr, "kernel_launch: unexpected sizes n_in %d out %d ws %zu\n", n_in, out_size, ws_size); return; }
    const float* x = (const float*)d_in[0]; const float* c = (const float*)d_in[1]; const float* ctx = (const float*)d_in[2]; const float* cctx = (const float*)d_in[3];
    const float* w_ada = (const float*)d_in[4]; const float* b_ada = (const float*)d_in[5]; const float* norm1_g = (const float*)d_in[6]; const float* w_in = (const float*)d_in[7];
    const float* ln_v_g = (const float*)d_in[8]; const float* ln_v_b = (const float*)d_in[9]; const float* w_sp = (const float*)d_in[10]; const float* b_sp = (const float*)d_in[11];
    const float* w_af = (const float*)d_in[12]; const float* b_af = (const float*)d_in[13]; const float* w_ab = (const float*)d_in[14]; const float* b_ab = (const float*)d_in[15];
    const float* gla_g = (const float*)d_in[16]; const float* w_ba = (const float*)d_in[17]; const float* w_bb = (const float*)d_in[18]; const float* w_out = (const float*)d_in[19];
    const float* norm2_g = (const float*)d_in[20]; const float* w_f1 = (const float*)d_in[21]; const float* w_f2 = (const float*)d_in[22]; const float* fin_g = (const float*)d_in[23];
    unsigned char* ws = (unsigned char*)d_ws; float* out = (float*)d_out;
    bf16 *WT1A = (bf16*)(ws + WS_WT1A), *WTVV = (bf16*)(ws + WS_WTVV), *WT1B = (bf16*)(ws + WS_WT1B), *WTVA = (bf16*)(ws + WS_WTVA), *WTA = (bf16*)(ws + WS_WTA), *WTB = (bf16*)(ws + WS_WTB),
         *WTO = (bf16*)(ws + WS_WTO), *WTF1 = (bf16*)(ws + WS_WTF1), *WTF2 = (bf16*)(ws + WS_WTF2);
    float* MOD = (float*)(ws + WS_MOD); float* LNST = (float*)(ws + WS_LNST);
    bf16 *H = (bf16*)(ws + WS_H), *Q = (bf16*)(ws + WS_Q), *Kb = (bf16*)(ws + WS_K), *VVT = (bf16*)(ws + WS_VVT), *OF = (bf16*)(ws + WS_OF), *OB = (bf16*)(ws + WS_OB), *U = (bf16*)(ws + WS_U),
         *GVT = (bf16*)(ws + WS_GVT), *R = (bf16*)(ws + WS_R), *Y = (bf16*)(ws + WS_Y), *A2 = (bf16*)(ws + WS_A2), *HB = (bf16*)(ws + WS_HB);
    float *AF = (float*)(ws + WS_AF), *Y1 = (float*)(ws + WS_Y1), *X1 = (float*)(ws + WS_X1);
    bf16 *GA = (bf16*)d_out, *GB = (bf16*)d_out + (size_t)ML * D;
    hipMemsetAsync(ws + WS_CTL, 0, 1 * MiB, stream);
    run_tr(stream, w_in, D, NIN, C_Q, 512, WT1A); run_tr(stream, w_in, D, NIN, C_K, 512, WT1A + 512 * 1024); run_tr(stream, w_in, D, NIN, C_AF, 32, WT1A + 1024 * 1024);
    hipLaunchKernelGGL(nv_zero_bf16, dim3(224), dim3(256), 0, stream, WT1A + 1056 * 1024, (size_t)224 * 1024);
    run_tr(stream, w_in, D, NIN, C_VV, 1024, WTVV); run_tr(stream, w_in, D, NIN, C_VA, 1024, WTVA);
    run_tr(stream, w_in, D, NIN, C_U, 1024, WT1B); run_tr(stream, w_in, D, NIN, C_R, 1024, WT1B + 1024 * 1024); run_tr(stream, w_in, D, NIN, C_GA, 1024, WT1B + 2048 * 1024); run_tr(stream, w_in, D, NIN, C_GB, 1024, WT1B + 3072 * 1024);
    run_tr(stream, w_ba, D, D, 0, 1024, WTA); run_tr(stream, w_bb, D, D, 0, 1024, WTB); run_tr(stream, w_out, D, D, 0, 1024, WTO);
    for (int t = 0; t < 22; ++t) { run_tr(stream, w_f1, D, 2 * DFF, 128 * t, 128, WTF1 + (size_t)(256 * t) * 1024); run_tr(stream, w_f1, D, 2 * DFF, DFF + 128 * t, 128, WTF1 + (size_t)(256 * t + 128) * 1024); }
    run_tr(stream, w_f2, DFF, D, 0, 1024, WTF2);
    hipLaunchKernelGGL(nv_ada, dim3(24), dim3(256), 0, stream, c, cctx, w_ada, b_ada, MOD);
    hipLaunchKernelGGL(nv_modnorm, dim3(M / 4), dim3(256), 0, stream, x, ctx, norm1_g, MOD, 0, 1024, H, M, 0);
    run_gemm(stream, H, WT1A, ML, 512, D, EpQ{{}, Q, QKW, 0.08838834764831845f});
    run_gemm(stream, H, WT1A + 512 * 1024, M, 512, D, EpQ{{}, Kb, QKW, 1.f});
    run_gemm(stream, H, WT1A + 1024 * 1024, M, 32, D, EpF32{{}, AF, 32, 0});
    run_gemm(stream, H, WTVV, M, 1024, D, EpT{{}, VVT, M, 0});
    {
        bf16* OBtmp = (bf16*)(ws + WS_PKG);
        hipLaunchKernelGGL(nv_gla, dim3(NB * NH * 2), dim3(256), 0, stream, Q, Kb, AF, VVT, w_af, b_af, w_ab, b_ab, OF, OBtmp);
        hipMemcpyAsync(OB, OBtmp, (size_t)ML * VW * 2, hipMemcpyDeviceToDevice, stream);
    }
    run_gemm(stream, H, WT1B, ML, 1024, D, EpAct{{}, U, D, 1});
    run_gemm(stream, H, WT1B + 1024 * 1024, ML, 1024, D, EpAct{{}, R, D, 2});
    run_gemm(stream, H, WT1B + 2048 * 1024, ML, 1024, D, EpAct{{}, GA, D, 3});
    run_gemm(stream, H, WT1B + 3072 * 1024, ML, 1024, D, EpAct{{}, GB, D, 3});
    run_gemm(stream, H, WTVA, ML, 1024, D, EpT{{}, GVT, ML, 1});
    hipLaunchKernelGGL(nv_lnstat, dim3(ML / 256), dim3(256), 0, stream, GVT, LNST);
    hipLaunchKernelGGL(nv_chunkmlp, dim3(ML / 128, 8), dim3(256), 128 * 128 * 4, stream, U, GVT, LNST, ln_v_g, ln_v_b, w_sp, b_sp);
    hipLaunchKernelGGL(nv_glaout, dim3(ML * NH / 4), dim3(256), 0, stream, OF, OB, R, gla_g);
    run_gemm(stream, U, WTA, ML, 1024, D, EpY1{{}, GA, Y1});
    run_gemm(stream, OF, WTB, ML, 1024, D, EpY{{}, GB, Y1, Y});
    run_gemm(stream, Y, WTO, ML, 1024, D, EpRes{{}, x, MOD, X1, 2048, 0});
    hipLaunchKernelGGL(nv_modnorm, dim3(ML / 4), dim3(256), 0, stream, X1, X1, norm2_g, MOD, 3072, 4096, A2, ML, 0);
    run_gemm<EpSwi, true>(stream, A2, WTF1, ML, DFF, D, EpSwi{HB});
    run_gemm(stream, HB, WTF2, ML, 1024, DFF, EpRes{{}, X1, MOD, out, 5120, 0});
    hipLaunchKernelGGL(nv_finalnorm, dim3(ML / 4), dim3(256), 0, stream, out, fin_g);
}
```

```cpp
#include <hip/hip_runtime.h>
#include <stdint.h>
#include <cstdio>

typedef unsigned short bf16;
__device__ __forceinline__ float bf2f(bf16 v) { return __uint_as_float(((unsigned)v) << 16); }
__device__ __forceinline__ bf16 f2bf(float f) { unsigned u = __float_as_uint(f); u += 0x7fffu + ((u >> 16) & 1u); return (bf16)(u >> 16); }

constexpr int NB = 8, T = 4096, D = 1024, TC = 256;
constexpr int ML = NB * T;
constexpr int MC = NB * TC;
constexpr int M = ML + MC;
constexpr int NH = 4, DK = 128, DV = 256, QKW = 512, VW = 1024, RANK = 16;
constexpr int DFF = 2816, NIN = 7200;
constexpr float EPS = 1e-6f;
constexpr int C_U = 0, C_VA = 1024, C_Q = 2048, C_K = 2560, C_VV = 3072, C_R = 4096, C_AF = 5120, C_GA = 5152, C_GB = 6176;

constexpr size_t MiB = 1u << 20;
constexpr size_t WS_CTL = 0;
constexpr size_t WS_ROWSS = 256 * 1024, WS_ROWSS2 = 512 * 1024;
constexpr size_t WS_MOD = 1 * MiB;
constexpr size_t WS_CV = WS_MOD + 256 * 1024;
constexpr size_t WS_LNST = 2 * MiB;
constexpr size_t WS_GV2 = WS_MOD + 512 * 1024;
constexpr size_t WS_WSPF = 3 * MiB;
constexpr size_t WS_WT1A = 4 * MiB;
constexpr size_t WS_WTVV = WS_WT1A + 1280 * 1024 * 2;
constexpr size_t WS_WT1B = WS_WTVV + 2 * MiB;
constexpr size_t WS_WTVA = WS_WT1B + 8 * MiB;
constexpr size_t WS_WTA = WS_WTVA + 2 * MiB, WS_WTB = WS_WTA + 2 * MiB, WS_WTO = WS_WTB + 2 * MiB;
constexpr size_t WS_WTF1 = WS_WTO + 2 * MiB;
constexpr size_t WS_WTF2 = WS_WTF1 + 11 * MiB;
static_assert(WS_WTF2 + (size_t)1024 * 2816 * 2 <= 48 * MiB, "weights region");
constexpr size_t WS_H = 48 * MiB;
constexpr size_t WS_Q = 116 * MiB;
constexpr size_t WS_K = 148 * MiB;
constexpr size_t WS_AF = 182 * MiB;
constexpr size_t WS_VVT = 188 * MiB;
constexpr size_t WS_PKG = 256 * MiB;
constexpr size_t WS_OF = 423 * MiB;
constexpr size_t WS_OB = 116 * MiB;
constexpr size_t WS_U = 188 * MiB;
constexpr size_t WS_GVT = 256 * MiB;
constexpr size_t WS_R = 320 * MiB;
constexpr size_t WS_Y1 = 256 * MiB;
constexpr size_t WS_Y = 48 * MiB;
constexpr size_t WS_X1 = 384 * MiB;
constexpr size_t WS_A2 = 116 * MiB;
constexpr size_t WS_HB = 180 * MiB;
constexpr size_t WS_END = 512 * MiB;

__global__ void nv_transpose(const float* __restrict__ W, int K, int ldw, int col0, int ncols, bf16* __restrict__ WT) {
    __shared__ float tile[32][33];
    const int k0 = blockIdx.y * 32, n0 = blockIdx.x * 32, tx = threadIdx.x & 31, ty = threadIdx.x >> 5;
    for (int i = ty; i < 32; i += 8) tile[i][tx] = W[(size_t)(k0 + i) * ldw + col0 + n0 + tx];
    __syncthreads();
    for (int i = ty; i < 32; i += 8) WT[(size_t)(n0 + i) * K + k0 + tx] = f2bf(tile[tx][i]);
}
__global__ void nv_zero_bf16(bf16* p, size_t n) { for (size_t i = (size_t)blockIdx.x * blockDim.x + threadIdx.x; i < n; i += (size_t)gridDim.x * blockDim.x) p[i] = 0; }

__global__ void nv_ada(const float* __restrict__ c, const float* __restrict__ cctx, const float* __restrict__ w_ada, const float* __restrict__ b_ada, float* __restrict__ MOD) {
    __shared__ float s[9][1024];
    for (int i = threadIdx.x; i < 9 * 1024; i += blockDim.x) { const int r = i >> 10, k = i & 1023; const float v = r < 8 ? c[r * 1024 + k] : cctx[k]; s[r][k] = v / (1.f + expf(-v)); }
    __syncthreads();
    const int n = blockIdx.x * blockDim.x + threadIdx.x;
    float acc[9];
    for (int r = 0; r < 9; ++r) acc[r] = 0.f;
    for (int k = 0; k < 1024; ++k) { const float w = w_ada[(size_t)k * 6144 + n];
#pragma unroll
        for (int r = 0; r < 9; ++r) acc[r] += s[r][k] * w; }
    for (int r = 0; r < 9; ++r) MOD[r * 6144 + n] = acc[r] + b_ada[n];
}

__device__ __forceinline__ float wave_sum(float v) {
#pragma unroll
    for (int o = 1; o < 64; o <<= 1) v += __shfl_xor(v, o);
    return v;
}
__global__ void nv_modnorm(const float* __restrict__ xl, const float* __restrict__ xc, const float* __restrict__ g, const float* __restrict__ MOD, int shoff, int scoff, bf16* __restrict__ out, int nrows, int pad_) {
    const int row = blockIdx.x * (blockDim.x >> 6) + (threadIdx.x >> 6), lane = threadIdx.x & 63;
    if (row >= nrows) return;
    const float* xr = row < ML ? xl + (size_t)row * D : xc + (size_t)(row - ML) * D;
    const int mr = row < ML ? row / T : 8;
    float v[16]; float ss = 0.f;
#pragma unroll
    for (int j = 0; j < 16; ++j) { v[j] = xr[lane + 64 * j]; ss += v[j] * v[j]; }
    const float rstd = rsqrtf(wave_sum(ss) * (1.f / D) + EPS);
#pragma unroll
    for (int j = 0; j < 16; ++j) { const int cidx = lane + 64 * j; const float y = v[j] * rstd * g[cidx];
        out[(size_t)row * D + cidx] = f2bf(y * (1.f + MOD[mr * 6144 + scoff + cidx]) + MOD[mr * 6144 + shoff + cidx]); }
}

template <class Epi, bool DUAL>
__global__ void __launch_bounds__(256) nv_gemm(const bf16* __restrict__ A, const bf16* __restrict__ Bt, int Mrows, int N, int K, int pad_, Epi epi) {
    __shared__ float As[32][65], Bs[32][65], Bs2[DUAL ? 32 : 1][65];
    const int tid = threadIdx.x, tx = tid & 15, ty = tid >> 4;
    const int m0 = blockIdx.y * 64, n0 = blockIdx.x * 64;
    float acc[4][4], acc2[4][4];
#pragma unroll
    for (int i = 0; i < 4; ++i)
#pragma unroll
        for (int j = 0; j < 4; ++j) { acc[i][j] = 0.f; acc2[i][j] = 0.f; }
    const int lr = tid >> 2, lk = (tid & 3) * 8;
    const int am = m0 + lr, bn = n0 + lr < N ? n0 + lr : N - 1;
    const bf16* ap = A + (size_t)am * K + lk;
    const bf16* bp = Bt + (size_t)epi.brow(bn) * K + lk;
    const bf16* bp2 = DUAL ? Bt + (size_t)epi.brow2(bn) * K + lk : bp;
    for (int k0 = 0; k0 < K; k0 += 32) {
        const uint4 av = *(const uint4*)(ap + k0), bv = *(const uint4*)(bp + k0);
        const unsigned aw[4] = {av.x, av.y, av.z, av.w}, bw[4] = {bv.x, bv.y, bv.z, bv.w};
#pragma unroll
        for (int j = 0; j < 4; ++j) { As[lk + 2 * j][lr] = __uint_as_float(aw[j] << 16); As[lk + 2 * j + 1][lr] = __uint_as_float(aw[j] & 0xffff0000u);
                                      Bs[lk + 2 * j][lr] = __uint_as_float(bw[j] << 16); Bs[lk + 2 * j + 1][lr] = __uint_as_float(bw[j] & 0xffff0000u); }
        if (DUAL) { const uint4 cv = *(const uint4*)(bp2 + k0); const unsigned cw[4] = {cv.x, cv.y, cv.z, cv.w};
#pragma unroll
            for (int j = 0; j < 4; ++j) { Bs2[lk + 2 * j][lr] = __uint_as_float(cw[j] << 16); Bs2[lk + 2 * j + 1][lr] = __uint_as_float(cw[j] & 0xffff0000u); } }
        __syncthreads();
#pragma unroll 8
        for (int k = 0; k < 32; ++k) {
            float a[4], b[4], b2[4];
#pragma unroll
            for (int i = 0; i < 4; ++i) { a[i] = As[k][ty * 4 + i]; b[i] = Bs[k][tx * 4 + i]; b2[i] = DUAL ? Bs2[k][tx * 4 + i] : 0.f; }
#pragma unroll
            for (int i = 0; i < 4; ++i)
#pragma unroll
                for (int j = 0; j < 4; ++j) { acc[i][j] += a[i] * b[j]; if (DUAL) acc2[i][j] += a[i] * b2[j]; }
        }
        __syncthreads();
    }
#pragma unroll
    for (int i = 0; i < 4; ++i)
#pragma unroll
        for (int j = 0; j < 4; ++j) { const int m = m0 + ty * 4 + i, n = n0 + tx * 4 + j; if (m < Mrows && n < N) epi(m, n, acc[i][j], acc2[i][j]); }
}
__device__ __forceinline__ float gelu_erf(float v) { return 0.5f * v * (1.f + erff(v * 0.70710678118654752f)); }
__device__ __forceinline__ float sigmoidf_(float v) { return 1.f / (1.f + expf(-v)); }
struct EpBase { __device__ int brow(int n) const { return n; } __device__ int brow2(int n) const { return n; } };
struct EpQ : EpBase { bf16* O; int ld; float sc; __device__ void operator()(int m, int n, float a, float) const { O[(size_t)m * ld + n] = f2bf(a * sc); } };
struct EpF32 : EpBase { float* O; int ld; int pad; __device__ void operator()(int m, int n, float a, float) const { O[(size_t)m * ld + n] = a; } };
struct EpT : EpBase { bf16* O; int ld; int act; __device__ void operator()(int m, int n, float a, float) const { O[(size_t)n * ld + m] = f2bf(act ? gelu_erf(a) : a); } };
struct EpAct : EpBase { bf16* O; int ld; int act; __device__ void operator()(int m, int n, float a, float) const { float v = act == 1 ? gelu_erf(a) : act == 2 ? a * sigmoidf_(a) : sigmoidf_(a); O[(size_t)m * ld + n] = f2bf(v); } };
struct EpY1 : EpBase { const bf16* G; float* Y1; __device__ void operator()(int m, int n, float a, float) const { Y1[(size_t)m * D + n] = bf2f(G[(size_t)m * D + n]) * a; } };
struct EpY : EpBase { const bf16* G; const float* Y1; bf16* Y; __device__ void operator()(int m, int n, float a, float) const { Y[(size_t)m * D + n] = f2bf(Y1[(size_t)m * D + n] + bf2f(G[(size_t)m * D + n]) * a); } };
struct EpRes : EpBase { const float* X; const float* MOD; float* O; int goff; int pad; __device__ void operator()(int m, int n, float a, float) const { O[(size_t)m * D + n] = X[(size_t)m * D + n] + MOD[(m / T) * 6144 + goff + n] * a; } };
struct EpSwi { bf16* O; __device__ int brow(int n) const { return 256 * (n >> 7) + (n & 127); } __device__ int brow2(int n) const { return 256 * (n >> 7) + 128 + (n & 127); }
    __device__ void operator()(int m, int n, float a, float g) const { O[(size_t)m * DFF + n] = f2bf(a * (g * sigmoidf_(g))); } };

__global__ void __launch_bounds__(256) nv_gla(const bf16* __restrict__ Q, const bf16* __restrict__ Kb, const float* __restrict__ AF, const bf16* __restrict__ VVT,
                                              const float* __restrict__ w_af, const float* __restrict__ b_af, const float* __restrict__ w_ab, const float* __restrict__ b_ab,
                                              bf16* __restrict__ OF, bf16* __restrict__ OB) {
    const int dir = blockIdx.x & 1, h = (blockIdx.x >> 1) & 3, b = blockIdx.x >> 3, tid = threadIdx.x;
    __shared__ float sa[128], sk[128], sq[128], wl[16][128], bl[128];
    const float* wsrc = dir ? w_ab : w_af; const float* bsrc = dir ? b_ab : b_af;
    for (int i = tid; i < 16 * 128; i += 256) wl[i >> 7][i & 127] = wsrc[(i >> 7) * QKW + h * DK + (i & 127)];
    if (tid < 128) bl[tid] = bsrc[h * DK + tid];
    float S[128];
#pragma unroll
    for (int i = 0; i < 128; ++i) S[i] = 0.f;
    bf16* O = dir ? OB : OF;
    const bf16* vrow = VVT + (size_t)(h * DV + tid) * M;
    __syncthreads();
    for (int step = 0; step < TC + T; ++step) {
        const bool isctx = step < TC;
        int row;
        if (isctx) row = ML + b * TC + (dir ? TC - 1 - step : step);
        else { const int t = step - TC; row = b * T + (dir ? T - 1 - t : t); }
        if (tid < 128) {
            float z = bl[tid];
#pragma unroll
            for (int r = 0; r < 16; ++r) z += AF[(size_t)row * 32 + dir * 16 + r] * wl[r][tid];
            const float ls = fminf(z, 0.f) - log1pf(expf(-fabsf(z)));
            sa[tid] = expf(ls * (1.f / 16.f));
            sk[tid] = bf2f(Kb[(size_t)row * QKW + h * DK + tid]);
            sq[tid] = isctx ? 0.f : bf2f(Q[(size_t)row * QKW + h * DK + tid]);
        }
        const float v = bf2f(vrow[row]);
        __syncthreads();
        float o = 0.f;
#pragma unroll
        for (int i = 0; i < 128; ++i) { S[i] = sa[i] * S[i] + sk[i] * v; o += sq[i] * S[i]; }
        if (!isctx) O[(size_t)row * VW + h * DV + tid] = f2bf(o);
        __syncthreads();
    }
}

__global__ void nv_lnstat(const bf16* __restrict__ GVT, float* __restrict__ ST) {
    const int t = blockIdx.x * blockDim.x + threadIdx.x;
    float s = 0.f, s2 = 0.f;
    for (int c = 0; c < 1024; ++c) { const float v = bf2f(GVT[(size_t)c * ML + t]); s += v; }
    const float mean = s * (1.f / 1024.f);
    for (int c = 0; c < 1024; ++c) { const float d = bf2f(GVT[(size_t)c * ML + t]) - mean; s2 += d * d; }
    ST[2 * t] = mean; ST[2 * t + 1] = rsqrtf(s2 * (1.f / 1024.f) + EPS);
}
__global__ void __launch_bounds__(256) nv_chunkmlp(bf16* __restrict__ U, const bf16* __restrict__ GVT, const float* __restrict__ ST, const float* __restrict__ lng, const float* __restrict__ lnb,
                                                   const float* __restrict__ wsp, const float* __restrict__ bsp) {
    extern __shared__ float vt[];
    const int ch = blockIdx.x, g = blockIdx.y, tok0 = ch * 128, tid = threadIdx.x;
    for (int i = tid; i < 128 * 128; i += 256) { const int c = i >> 7, q = i & 127; const int cc = g * 128 + c;
        const float v = bf2f(GVT[(size_t)cc * ML + tok0 + q]);
        vt[q * 128 + c] = (v - ST[2 * (tok0 + q)]) * ST[2 * (tok0 + q) + 1] * lng[cc] + lnb[cc]; }
    __syncthreads();
    const int c = tid & 127;
    for (int p = tid >> 7; p < 128; p += 2) {
        float acc = 0.f;
        const float* wr = wsp + ((size_t)g * 128 + p) * 128;
        for (int q = 0; q < 128; ++q) acc += wr[q] * vt[q * 128 + c];
        acc += bsp[g * 128 + p];
        const size_t o = (size_t)(tok0 + p) * D + g * 128 + c;
        U[o] = f2bf(bf2f(U[o]) * acc);
    }
}
__global__ void nv_glaout(bf16* __restrict__ OF, const bf16* __restrict__ OB, const bf16* __restrict__ R, const float* __restrict__ gain) {
    const int w = blockIdx.x * (blockDim.x >> 6) + (threadIdx.x >> 6), lane = threadIdx.x & 63;
    const int row = w >> 2, h = w & 3;
    float v[4]; float ss = 0.f;
#pragma unroll
    for (int j = 0; j < 4; ++j) { const size_t o = (size_t)row * VW + h * DV + lane + 64 * j; v[j] = bf2f(OF[o]) + bf2f(OB[o]); ss += v[j] * v[j]; }
    const float rstd = rsqrtf(wave_sum(ss) * (1.f / DV) + EPS);
#pragma unroll
    for (int j = 0; j < 4; ++j) { const int cidx = h * DV + lane + 64 * j; const size_t o = (size_t)row * VW + cidx; OF[o] = f2bf(v[j] * rstd * gain[cidx] * bf2f(R[o])); }
}
__global__ void nv_finalnorm(float* __restrict__ X, const float* __restrict__ g) {
    const int row = blockIdx.x * (blockDim.x >> 6) + (threadIdx.x >> 6), lane = threadIdx.x & 63;
    float v[16]; float ss = 0.f;
#pragma unroll
    for (int j = 0; j < 16; ++j) { v[j] = X[(size_t)row * D + lane + 64 * j]; ss += v[j] * v[j]; }
    const float rstd = rsqrtf(wave_sum(ss) * (1.f / D) + EPS);
#pragma unroll
    for (int j = 0; j < 16; ++j) X[(size_t)row * D + lane + 64 * j] = v[j] * rstd * g[lane + 64 * j];
}


namespace pg8 {
#define PG8_LAS __attribute__((address_space(3)))
typedef unsigned short bf16_t;
typedef short bf16x8 __attribute__((ext_vector_type(8)));
typedef float f32x4 __attribute__((ext_vector_type(4)));
typedef float f32x2 __attribute__((ext_vector_type(2)));
typedef unsigned u32x4 __attribute__((ext_vector_type(4)));
constexpr int BM = 256, BK = 64, HALF = 128, HTB = HALF * BK * 2, STAGE_BYTES = 8 * HTB;
__host__ __device__ __forceinline__ int lds_byte(int r, int c) { const int st = (r >> 4) * 2 + (c >> 5), rr = r & 15, cc = c & 31, ob = rr * 64 + cc * 2; return st * 1024 + (ob ^ (((ob >> 9) & 1) << 5)); }
__host__ __device__ __forceinline__ void stage_rc(int b, int& R, int& C) { const int st = b / 1024, sb = b % 1024, swz = sb ^ (((sb >> 9) & 1) << 5); R = (st >> 1) * 16 + swz / 64; C = (st & 1) * 32 + (swz % 64) / 2; }
__host__ __device__ __forceinline__ int perm32(int rho) { const int n = rho >> 4, i = rho & 15; return 8 * (i >> 2) + 4 * n + (i & 3); }
struct Unit { const char* pA; const char* pB; char* pO; int ldc, act, aux, pm, pn; };
__device__ __forceinline__ unsigned cvt_pk_bf16(float lo, float hi) { typedef __bf16 v2bf __attribute__((ext_vector_type(2))); typedef float v2f __attribute__((ext_vector_type(2)));
    const v2f x = {lo, hi}; const v2bf y = __builtin_convertvector(x, v2bf); return __builtin_bit_cast(unsigned, y); }
__device__ __forceinline__ f32x2 gelu_pk(f32x2 v) {
    const f32x2 av = __builtin_elementwise_abs(v), d = av * 0.2316418882f + 1.0f;
    f32x2 t; t.x = __builtin_amdgcn_rcpf(d.x); t.y = __builtin_amdgcn_rcpf(d.y);
    f32x2 q = t * 0.5307027145f + (-0.7265760135f); q = q * t + 0.7107068705f; q = q * t + (-0.142248368f); q = q * t + 0.127414796f; q = q * t;
    const f32x2 s = (v * v) * (-0.72134752044f);
    f32x2 e; e.x = __builtin_amdgcn_exp2f(s.x); e.y = __builtin_amdgcn_exp2f(s.y);
    const f32x2 m = v * (q * e), r = v - m;
    f32x2 o; o.x = v.x < 0.f ? m.x : r.x; o.y = v.y < 0.f ? m.y : r.y; return o;
}
__device__ __forceinline__ float sigm(float x) { return __builtin_amdgcn_rcpf(1.0f + __builtin_amdgcn_exp2f(x * -1.44269504089f)); }
__device__ __forceinline__ int xcd_remap(int L, int nwg) { const int q = nwg / 8, r = nwg % 8, xcd = L % 8, off = L / 8; return (xcd < r ? xcd * (q + 1) : r * (q + 1) + (xcd - r) * q) + off; }

template <class Epi, class Sched, bool ALIGN_EPI, bool SP2>
__device__ __forceinline__ void gemm_phase(PG8_LAS unsigned char* lds, const int K, const Sched& S, const Epi& E) {
    const int tid = threadIdx.x, wid = __builtin_amdgcn_readfirstlane(tid >> 6), lane = tid & 63, wr = wid >> 2, wc = wid & 3, fr = lane & 15, fq = lane >> 4;
    const int nt = K / BK;
    unsigned voffA[2], voffB[2];
#pragma unroll
    for (int i = 0; i < 2; ++i) { int R, C; stage_rc(tid * 16 + i * 8192, R, C); const int Rb = (R & ~31) + perm32(R & 31);
        voffA[i] = (unsigned)(R * K + C) * 2u; voffB[i] = (unsigned)(Rb * K + C) * 2u; }
    const size_t kstep = (size_t)(BK * 2);
    const size_t hstep = (size_t)HALF * K * 2;
    const unsigned ldsw = (unsigned)wid * 1024u;
    const int aoff = lds_byte(wr * 64 + fr, fq * 8), boff = lds_byte(wc * 32 + fr, fq * 8);
#define PG8_SA(b, h) (((b) * 2 + (h)) * HTB)
#define PG8_SB(b, h) ((4 + (b) * 2 + (h)) * HTB)
#define PG8_STAGE(bufoff, gbase, voff) do { _Pragma("unroll") for (int _i = 0; _i < 2; ++_i) \
        __builtin_amdgcn_global_load_lds((const unsigned*)((const char*)(gbase) + (voff)[_i]), (PG8_LAS unsigned*)(lds + (bufoff) + ldsw + _i * 8192), 16, 0, 0); } while (0)
#define PG8_LDA(dst, b, h) do { _Pragma("unroll") for (int m = 0; m < 4; ++m) _Pragma("unroll") for (int k = 0; k < 2; ++k) dst[m][k] = *(const PG8_LAS bf16x8*)(lds + PG8_SA(b, h) + aoff + m * 2048 + k * 1024); } while (0)
#define PG8_LDB(dst, b, h) do { _Pragma("unroll") for (int n = 0; n < 2; ++n) _Pragma("unroll") for (int k = 0; k < 2; ++k) dst[n][k] = *(const PG8_LAS bf16x8*)(lds + PG8_SB(b, h) + boff + n * 2048 + k * 1024); } while (0)
#define PG8_MMA(ai, bj, At, Bt) do { __builtin_amdgcn_s_setprio(1); _Pragma("unroll") for (int m = 0; m < 4; ++m) _Pragma("unroll") for (int n = 0; n < 2; ++n) _Pragma("unroll") for (int k = 0; k < 2; ++k) \
        acc[ai][bj][m][n] = __builtin_amdgcn_mfma_f32_16x16x32_bf16(Bt[n][k], At[m][k], acc[ai][bj][m][n], 0, 0, 0); __builtin_amdgcn_s_setprio(0); } while (0)
#define PG8_WAIT_V(n) asm volatile("s_waitcnt vmcnt(" #n ")" ::: "memory")
#define PG8_WAIT_L(n) asm volatile("s_waitcnt lgkmcnt(" #n ")" ::: "memory")
#define PG8_BAR __builtin_amdgcn_s_barrier()
#define PG8_SCHED __builtin_amdgcn_sched_barrier(0)
    Unit cur, nxt; int ui = 0;
    if (!S.next(0, cur)) return;
    f32x4 acc[2][2][4][2];
#pragma unroll
    for (int a = 0; a < 2; ++a)
#pragma unroll
        for (int b = 0; b < 2; ++b)
#pragma unroll
            for (int m = 0; m < 4; ++m)
#pragma unroll
                for (int n = 0; n < 2; ++n) acc[a][b][m][n] = (f32x4){0.f, 0.f, 0.f, 0.f};
    bf16x8 At[4][2], B0[2][2], B1[2][2];
    const char* cA = cur.pA; const char* cB = cur.pB;
    if constexpr (SP2) {
        PG8_STAGE(PG8_SB(0, 0), cB, voffB); PG8_STAGE(PG8_SB(0, 1), cB + hstep, voffB); PG8_STAGE(PG8_SA(0, 0), cA, voffA); PG8_STAGE(PG8_SA(0, 1), cA + hstep, voffA);
        if (wr == 1) PG8_BAR;
        PG8_WAIT_V(2); PG8_BAR;
        PG8_STAGE(PG8_SB(1, 0), cB + kstep, voffB); PG8_STAGE(PG8_SA(1, 0), cA + kstep, voffA); PG8_STAGE(PG8_SB(1, 1), cB + hstep + kstep, voffB);
        PG8_WAIT_V(6); PG8_BAR;
    } else {
        PG8_STAGE(PG8_SB(0, 0), cB, voffB); PG8_STAGE(PG8_SA(0, 0), cA, voffA); PG8_STAGE(PG8_SB(0, 1), cB + hstep, voffB); PG8_STAGE(PG8_SA(0, 1), cA + hstep, voffA);
        if (wr == 1) PG8_BAR;
        PG8_WAIT_V(4); PG8_BAR;
        PG8_STAGE(PG8_SB(1, 0), cB + kstep, voffB); PG8_STAGE(PG8_SA(1, 0), cA + kstep, voffA); PG8_STAGE(PG8_SB(1, 1), cB + hstep + kstep, voffB);
        PG8_WAIT_V(6); PG8_BAR;
    }
    for (;;) {
        const bool has_next = S.next(ui + 1, nxt);
        const char* nA = has_next ? nxt.pA : cA; const char* nB = has_next ? nxt.pB : cB;
        for (int t = 0; t < nt; t += 2) {
            const bool last = (t == nt - 2);
            const char* a1 = cA + (size_t)(t + 1) * kstep;
            const char* a2 = last ? nA : cA + (size_t)(t + 2) * kstep; const char* b2 = last ? nB : cB + (size_t)(t + 2) * kstep;
            const char* a3 = a2 + kstep; const char* b3 = b2 + kstep;
            if constexpr (SP2) {
            PG8_LDB(B0, 0, 0); PG8_LDB(B1, 0, 1); PG8_SCHED; PG8_LDA(At, 0, 0); PG8_STAGE(PG8_SA(1, 1), a1 + hstep, voffA);
            PG8_WAIT_V(8); PG8_WAIT_L(0); PG8_BAR; PG8_MMA(0, 0, At, B0); PG8_MMA(0, 1, At, B1); PG8_BAR; PG8_SCHED;
            PG8_LDA(At, 0, 1); PG8_STAGE(PG8_SB(0, 0), b2, voffB); PG8_STAGE(PG8_SB(0, 1), b2 + hstep, voffB); PG8_STAGE(PG8_SA(0, 0), a2, voffA);
            PG8_WAIT_V(8); PG8_WAIT_L(0); PG8_BAR; PG8_MMA(1, 0, At, B0); PG8_MMA(1, 1, At, B1); PG8_BAR; PG8_SCHED;
            PG8_LDB(B0, 1, 0); PG8_LDB(B1, 1, 1); PG8_SCHED; PG8_LDA(At, 1, 0); PG8_STAGE(PG8_SA(0, 1), a2 + hstep, voffA);
            PG8_WAIT_V(8); PG8_WAIT_L(0); PG8_BAR; PG8_MMA(0, 0, At, B0); PG8_MMA(0, 1, At, B1); PG8_BAR; PG8_SCHED;
            PG8_LDA(At, 1, 1); PG8_STAGE(PG8_SB(1, 0), b3, voffB); PG8_STAGE(PG8_SB(1, 1), b3 + hstep, voffB); PG8_STAGE(PG8_SA(1, 0), a3, voffA);
            PG8_WAIT_V(8); PG8_WAIT_L(0); PG8_BAR; PG8_MMA(1, 0, At, B0); PG8_MMA(1, 1, At, B1); PG8_BAR; PG8_SCHED;
            } else {
            PG8_LDB(B0, 0, 0); PG8_SCHED; PG8_LDA(At, 0, 0); PG8_STAGE(PG8_SA(1, 1), a1 + hstep, voffA);
            PG8_WAIT_L(8); PG8_BAR; PG8_WAIT_L(0); PG8_MMA(0, 0, At, B0); PG8_BAR; PG8_SCHED;
            PG8_LDB(B1, 0, 1); PG8_STAGE(PG8_SB(0, 0), b2, voffB);
            PG8_BAR; PG8_WAIT_L(0); PG8_MMA(0, 1, At, B1); PG8_BAR;
            PG8_LDA(At, 0, 1); PG8_STAGE(PG8_SA(0, 0), a2, voffA);
            PG8_BAR; PG8_WAIT_L(0); PG8_MMA(1, 0, At, B0); PG8_BAR; PG8_SCHED;
            PG8_STAGE(PG8_SB(0, 1), b2 + hstep, voffB);
            PG8_WAIT_V(6); PG8_BAR; PG8_MMA(1, 1, At, B1); PG8_BAR;
            PG8_LDB(B0, 1, 0); PG8_SCHED; PG8_LDA(At, 1, 0); PG8_STAGE(PG8_SA(0, 1), a2 + hstep, voffA);
            PG8_WAIT_L(8); PG8_BAR; PG8_WAIT_L(0); PG8_MMA(0, 0, At, B0); PG8_BAR; PG8_SCHED;
            PG8_LDB(B1, 1, 1); PG8_STAGE(PG8_SB(1, 0), b3, voffB);
            PG8_BAR; PG8_WAIT_L(0); PG8_MMA(0, 1, At, B1); PG8_BAR;
            PG8_LDA(At, 1, 1); PG8_STAGE(PG8_SA(1, 0), a3, voffA);
            PG8_BAR; PG8_WAIT_L(0); PG8_MMA(1, 0, At, B0); PG8_BAR; PG8_SCHED;
            PG8_STAGE(PG8_SB(1, 1), b3 + hstep, voffB);
            PG8_WAIT_V(6); PG8_BAR; PG8_MMA(1, 1, At, B1); PG8_BAR;
            }
        }
        if constexpr (ALIGN_EPI) { if (wr == 0) PG8_BAR; }
        E(acc, cur, wr, wc, fr, fq);
        if (!has_next) break;
#pragma unroll
        for (int a = 0; a < 2; ++a)
#pragma unroll
            for (int b = 0; b < 2; ++b)
#pragma unroll
                for (int m = 0; m < 4; ++m)
#pragma unroll
                    for (int n = 0; n < 2; ++n) acc[a][b][m][n] = (f32x4){0.f, 0.f, 0.f, 0.f};
        cur = nxt; cA = nA; cB = nB; ++ui;
        if constexpr (ALIGN_EPI) { if (wr == 1) PG8_BAR; }
    }
    PG8_WAIT_V(0);
    if constexpr (!ALIGN_EPI) { if (wr == 0) PG8_BAR; }
    PG8_BAR;
#undef PG8_SA
#undef PG8_SB
#undef PG8_STAGE
#undef PG8_LDA
#undef PG8_LDB
#undef PG8_MMA
#undef PG8_WAIT_V
#undef PG8_WAIT_L
#undef PG8_BAR
#undef PG8_SCHED
}

enum Act { ACT_NONE = 0, ACT_GELU = 1, ACT_SILU = 2, ACT_SIGM = 3, ACT_QSC = 4, ACT_AF32 = 5 };
struct EpiAct {
    template <int ACT> __device__ __forceinline__ void run(const f32x4 (&acc)[2][2][4][2], const Unit& u, int r0, int c0) const {
        bf16_t* O = (bf16_t*)u.pO;
#pragma unroll
        for (int ai = 0; ai < 2; ++ai)
#pragma unroll
            for (int m = 0; m < 4; ++m) { bf16_t* rowp = O + (size_t)(r0 + ai * HALF + m * 16) * u.ldc + c0;
#pragma unroll
                for (int bj = 0; bj < 2; ++bj) { f32x4 v0 = acc[ai][bj][m][0], v1 = acc[ai][bj][m][1];
                    if (ACT == ACT_GELU) { f32x2 a = gelu_pk((f32x2){v0[0], v0[1]}), b = gelu_pk((f32x2){v0[2], v0[3]}), c = gelu_pk((f32x2){v1[0], v1[1]}), d = gelu_pk((f32x2){v1[2], v1[3]});
                        v0 = (f32x4){a.x, a.y, b.x, b.y}; v1 = (f32x4){c.x, c.y, d.x, d.y}; }
                    if (ACT == ACT_SILU) {
#pragma unroll
                        for (int j = 0; j < 4; ++j) { v0[j] = v0[j] * sigm(v0[j]); v1[j] = v1[j] * sigm(v1[j]); } }
                    if (ACT == ACT_SIGM) {
#pragma unroll
                        for (int j = 0; j < 4; ++j) { v0[j] = sigm(v0[j]); v1[j] = sigm(v1[j]); } }
                    if (ACT == ACT_QSC) { v0 = v0 * 0.08838834764831845f; v1 = v1 * 0.08838834764831845f; }
                    u32x4 w; w.x = cvt_pk_bf16(v0[0], v0[1]); w.y = cvt_pk_bf16(v0[2], v0[3]); w.z = cvt_pk_bf16(v1[0], v1[1]); w.w = cvt_pk_bf16(v1[2], v1[3]);
                    *(u32x4*)(rowp + bj * HALF) = w; } }
    }
    __device__ __forceinline__ void operator()(const f32x4 (&acc)[2][2][4][2], const Unit& u, int wr, int wc, int fr, int fq) const {
        const int r0 = wr * 64 + fr, c0 = wc * 32 + 8 * fq;
        switch (u.act) {
        case ACT_NONE: run<ACT_NONE>(acc, u, r0, c0); break;
        case ACT_GELU: run<ACT_GELU>(acc, u, r0, c0); break;
        case ACT_SILU: run<ACT_SILU>(acc, u, r0, c0); break;
        case ACT_SIGM: run<ACT_SIGM>(acc, u, r0, c0); break;
        case ACT_QSC:  run<ACT_QSC>(acc, u, r0, c0); break;
        default:
            if (wc == 0) { float* O = (float*)u.pO;
#pragma unroll
                for (int ai = 0; ai < 2; ++ai)
#pragma unroll
                    for (int m = 0; m < 4; ++m) { float* rowp = O + (size_t)(r0 + ai * HALF + m * 16) * u.ldc + 8 * fq;
                        *(f32x4*)rowp = acc[ai][0][m][0]; *(f32x4*)(rowp + 4) = acc[ai][0][m][1]; } }
            break;
        }
    }
};
struct EpiY1 { const bf16_t* G; float* Y1;
    __device__ __forceinline__ void operator()(const f32x4 (&acc)[2][2][4][2], const Unit& u, int wr, int wc, int fr, int fq) const {
        const size_t o0 = (size_t)(u.pm * BM + wr * 64 + fr) * 1024 + u.pn * BM + wc * 32 + 8 * fq;
#pragma unroll
        for (int ai = 0; ai < 2; ++ai)
#pragma unroll
            for (int m = 0; m < 4; ++m)
#pragma unroll
                for (int bj = 0; bj < 2; ++bj) { const size_t o = o0 + (size_t)(ai * HALF + m * 16) * 1024 + bj * HALF;
                    const u32x4 g = *(const u32x4*)(G + o);
                    f32x4 v0 = acc[ai][bj][m][0], v1 = acc[ai][bj][m][1];
                    v0[0] *= __uint_as_float(g.x << 16); v0[1] *= __uint_as_float(g.x & 0xffff0000u); v0[2] *= __uint_as_float(g.y << 16); v0[3] *= __uint_as_float(g.y & 0xffff0000u);
                    v1[0] *= __uint_as_float(g.z << 16); v1[1] *= __uint_as_float(g.z & 0xffff0000u); v1[2] *= __uint_as_float(g.w << 16); v1[3] *= __uint_as_float(g.w & 0xffff0000u);
                    *(f32x4*)(Y1 + o) = v0; *(f32x4*)(Y1 + o + 4) = v1; }
    }
};
struct EpiY { const bf16_t* G; const float* Y1; bf16_t* Y;
    __device__ __forceinline__ void operator()(const f32x4 (&acc)[2][2][4][2], const Unit& u, int wr, int wc, int fr, int fq) const {
        const size_t o0 = (size_t)(u.pm * BM + wr * 64 + fr) * 1024 + u.pn * BM + wc * 32 + 8 * fq;
#pragma unroll
        for (int ai = 0; ai < 2; ++ai)
#pragma unroll
            for (int m = 0; m < 4; ++m)
#pragma unroll
                for (int bj = 0; bj < 2; ++bj) { const size_t o = o0 + (size_t)(ai * HALF + m * 16) * 1024 + bj * HALF;
                    const u32x4 g = *(const u32x4*)(G + o); const f32x4 y0 = *(const f32x4*)(Y1 + o), y1 = *(const f32x4*)(Y1 + o + 4);
                    f32x4 v0 = acc[ai][bj][m][0], v1 = acc[ai][bj][m][1];
                    v0[0] = y0[0] + v0[0] * __uint_as_float(g.x << 16); v0[1] = y0[1] + v0[1] * __uint_as_float(g.x & 0xffff0000u); v0[2] = y0[2] + v0[2] * __uint_as_float(g.y << 16); v0[3] = y0[3] + v0[3] * __uint_as_float(g.y & 0xffff0000u);
                    v1[0] = y1[0] + v1[0] * __uint_as_float(g.z << 16); v1[1] = y1[1] + v1[1] * __uint_as_float(g.z & 0xffff0000u); v1[2] = y1[2] + v1[2] * __uint_as_float(g.w << 16); v1[3] = y1[3] + v1[3] * __uint_as_float(g.w & 0xffff0000u);
                    u32x4 w; w.x = cvt_pk_bf16(v0[0], v0[1]); w.y = cvt_pk_bf16(v0[2], v0[3]); w.z = cvt_pk_bf16(v1[0], v1[1]); w.w = cvt_pk_bf16(v1[2], v1[3]);
                    *(u32x4*)(Y + o) = w; }
    }
};
struct EpiRes { const float* X; const float* MOD; float* O; int goff;
    __device__ __forceinline__ void operator()(const f32x4 (&acc)[2][2][4][2], const Unit& u, int wr, int wc, int fr, int fq) const {
        const int cb = u.pn * BM + wc * 32 + 8 * fq; const size_t o0 = (size_t)(u.pm * BM + wr * 64 + fr) * 1024 + cb;
        const float* gp = MOD + ((u.pm * BM) / T) * 6144 + goff + cb;
        f32x4 g[2][2];
#pragma unroll
        for (int bj = 0; bj < 2; ++bj) { g[bj][0] = *(const f32x4*)(gp + bj * HALF); g[bj][1] = *(const f32x4*)(gp + bj * HALF + 4); }
#pragma unroll
        for (int ai = 0; ai < 2; ++ai)
#pragma unroll
            for (int m = 0; m < 4; ++m)
#pragma unroll
                for (int bj = 0; bj < 2; ++bj) { const size_t o = o0 + (size_t)(ai * HALF + m * 16) * 1024 + bj * HALF;
                    const f32x4 x0 = *(const f32x4*)(X + o), x1 = *(const f32x4*)(X + o + 4);
                    *(f32x4*)(O + o) = x0 + g[bj][0] * acc[ai][bj][m][0]; *(f32x4*)(O + o + 4) = x1 + g[bj][1] * acc[ai][bj][m][1]; }
    }
};
struct EpiSwi { bf16_t* HBp;
    __device__ __forceinline__ void operator()(const f32x4 (&acc)[2][2][4][2], const Unit& u, int wr, int wc, int fr, int fq) const {
        const size_t o0 = (size_t)(u.pm * BM + wr * 64 + fr) * DFF + u.pn * HALF + wc * 32 + 8 * fq;
#pragma unroll
        for (int ai = 0; ai < 2; ++ai)
#pragma unroll
            for (int m = 0; m < 4; ++m) { const f32x4 a0 = acc[ai][0][m][0], a1 = acc[ai][0][m][1], g0 = acc[ai][1][m][0], g1 = acc[ai][1][m][1]; f32x4 v0, v1;
#pragma unroll
                for (int j = 0; j < 4; ++j) { v0[j] = a0[j] * g0[j] * sigm(g0[j]); v1[j] = a1[j] * g1[j] * sigm(g1[j]); }
                u32x4 w; w.x = cvt_pk_bf16(v0[0], v0[1]); w.y = cvt_pk_bf16(v0[2], v0[3]); w.z = cvt_pk_bf16(v1[0], v1[1]); w.w = cvt_pk_bf16(v1[2], v1[3]);
                *(u32x4*)(HBp + o0 + (size_t)(ai * HALF + m * 16) * DFF) = w; }
    }
};

struct EpiRes2 { const float* X; const float* MOD; const float* GV2; float* X1; bf16_t* A2; unsigned long long* ROWSS;
    __device__ __forceinline__ void operator()(const f32x4 (&acc)[2][2][4][2], const Unit& u, int wr, int wc, int fr, int fq) const {
        const int cb = u.pn * BM + wc * 32 + 8 * fq, bidx = (u.pm * BM) / T; const int r0 = u.pm * BM + wr * 64 + fr; const size_t o0 = (size_t)r0 * 1024 + cb;
        const float* gp = MOD + bidx * 6144 + 2048 + cb; const float* vp = GV2 + bidx * 1024 + cb;
        f32x4 g[2][2], gv[2][2];
#pragma unroll
        for (int bj = 0; bj < 2; ++bj) { g[bj][0] = *(const f32x4*)(gp + bj * HALF); g[bj][1] = *(const f32x4*)(gp + bj * HALF + 4); gv[bj][0] = *(const f32x4*)(vp + bj * HALF); gv[bj][1] = *(const f32x4*)(vp + bj * HALF + 4); }
#pragma unroll
        for (int ai = 0; ai < 2; ++ai)
#pragma unroll
            for (int m = 0; m < 4; ++m) { float ss = 0.f;
#pragma unroll
                for (int bj = 0; bj < 2; ++bj) { const size_t o = o0 + (size_t)(ai * HALF + m * 16) * 1024 + bj * HALF;
                    const f32x4 x0 = *(const f32x4*)(X + o) + g[bj][0] * acc[ai][bj][m][0], x1 = *(const f32x4*)(X + o + 4) + g[bj][1] * acc[ai][bj][m][1];
                    *(f32x4*)(X1 + o) = x0; *(f32x4*)(X1 + o + 4) = x1;
                    ss += (x0[0] * x0[0] + x0[1] * x0[1]) + (x0[2] * x0[2] + x0[3] * x0[3]) + (x1[0] * x1[0] + x1[1] * x1[1]) + (x1[2] * x1[2] + x1[3] * x1[3]);
                    const f32x4 a0 = x0 * gv[bj][0], a1 = x1 * gv[bj][1];
                    u32x4 w; w.x = cvt_pk_bf16(a0[0], a0[1]); w.y = cvt_pk_bf16(a0[2], a0[3]); w.z = cvt_pk_bf16(a1[0], a1[1]); w.w = cvt_pk_bf16(a1[2], a1[3]);
                    *(u32x4*)(A2 + o) = w; }
                ss += __shfl_xor(ss, 16); ss += __shfl_xor(ss, 32);
                if (fq == 0) atomicAdd(ROWSS + r0 + ai * HALF + m * 16, (unsigned long long)(ss * 1073741824.0f)); }
    }
};
struct EpiSwi2 { bf16_t* HBp; const unsigned long long* ROWSS; const float* CV;
    __device__ __forceinline__ void operator()(const f32x4 (&acc)[2][2][4][2], const Unit& u, int wr, int wc, int fr, int fq) const {
        const int r0 = u.pm * BM + wr * 64 + fr, cc = u.pn * HALF + wc * 32 + 8 * fq, bidx = (u.pm * BM) / T;
        const size_t o0 = (size_t)r0 * DFF + cc;
        const float* cp = CV + bidx * (2 * DFF) + cc;
        const f32x4 ca0 = *(const f32x4*)cp, ca1 = *(const f32x4*)(cp + 4), cg0 = *(const f32x4*)(cp + DFF), cg1 = *(const f32x4*)(cp + DFF + 4);
#pragma unroll
        for (int ai = 0; ai < 2; ++ai)
#pragma unroll
            for (int m = 0; m < 4; ++m) { const float rs = __builtin_amdgcn_rsqf((float)ROWSS[r0 + ai * HALF + m * 16] * (1.0f / (1073741824.0f * 1024.0f)) + EPS);
                const f32x4 a0 = acc[ai][0][m][0] * rs + ca0, a1 = acc[ai][0][m][1] * rs + ca1, g0 = acc[ai][1][m][0] * rs + cg0, g1 = acc[ai][1][m][1] * rs + cg1; f32x4 v0, v1;
#pragma unroll
                for (int j = 0; j < 4; ++j) { v0[j] = a0[j] * g0[j] * sigm(g0[j]); v1[j] = a1[j] * g1[j] * sigm(g1[j]); }
                u32x4 w; w.x = cvt_pk_bf16(v0[0], v0[1]); w.y = cvt_pk_bf16(v0[2], v0[3]); w.z = cvt_pk_bf16(v1[0], v1[1]); w.w = cvt_pk_bf16(v1[2], v1[3]);
                *(u32x4*)(HBp + o0 + (size_t)(ai * HALF + m * 16) * DFF) = w; }
    }
};
struct OrderGrid { const char* A; const char* Bt; int nM, nN, K, G, c;
    __device__ __forceinline__ bool next(int i, Unit& u) const {
        const int nwg = nM * nN; const long L = (long)i * G + c; if (L >= nwg) return false;
        const int w = xcd_remap((int)L, nwg);
        const int nig = 8 * nN, gid = w / nig, fm = gid * 8, gsz = (nM - fm) < 8 ? (nM - fm) : 8;
        u.pm = fm + ((w % nig) % gsz); u.pn = (w % nig) / gsz;
        u.pA = A + (size_t)u.pm * 256 * K * 2; u.pB = Bt + (size_t)u.pn * 256 * K * 2; u.pO = nullptr; u.ldc = 0; u.act = 0; u.aux = 0; return true;
    }
};
struct Order1A { const char* H; const char* WT1A; const char* WTVV; char* Q; char* Kb; char* AFp; char* VVT; int G, c;
    __device__ __forceinline__ bool next(int i, Unit& u) const {
        constexpr int NWG = 1208; const long L = (long)i * G + c; if (L >= NWG) return false;
        int w = xcd_remap((int)L, NWG);
        int tok, col; bool swapped;
        if (w < 640) { const int gid = w / 40, r = w % 40; tok = gid * 8 + (r & 7); col = r >> 3; swapped = false; }
        else if (w < 1152) { w -= 640; const int gid = w / 32, r = w & 31; tok = gid * 8 + (r & 7); col = r >> 3; swapped = true; }
        else if (w < 1176) { w -= 1152; tok = 128 + (w & 7); col = 2 + (w >> 3); swapped = false; }
        else { w -= 1176; tok = 128 + (w & 7); col = w >> 3; swapped = true; }
        u.pm = tok; u.pn = col; u.aux = 0;
        const char* hp = H + (size_t)tok * 256 * 1024 * 2;
        if (swapped) { u.pA = WTVV + (size_t)col * 256 * 1024 * 2; u.pB = hp; u.pO = VVT + ((size_t)(col * 256) * M + tok * 256) * 2; u.ldc = M; u.act = ACT_NONE; }
        else { u.pA = hp; u.pB = WT1A + (size_t)col * 256 * 1024 * 2;
            if (col < 2) { u.pO = Q + ((size_t)(tok * 256) * QKW + col * 256) * 2; u.ldc = QKW; u.act = ACT_QSC; }
            else if (col < 4) { u.pO = Kb + ((size_t)(tok * 256) * QKW + (col - 2) * 256) * 2; u.ldc = QKW; u.act = ACT_NONE; }
            else { u.pO = AFp + (size_t)(tok * 256) * 32 * 4; u.ldc = 32; u.act = ACT_AF32; } }
        return true;
    }
};
struct Order1B { const char* H; const char* WT1B; const char* WTVA; char* U; char* R; char* GA; char* GB; char* GVT; int G, c;
    __device__ __forceinline__ bool next(int i, Unit& u) const {
        constexpr int NWG = 2560; const long L = (long)i * G + c; if (L >= NWG) return false;
        int w = xcd_remap((int)L, NWG);
        u.aux = 0;
        if (w < 2048) { const int gid = w >> 7, r = w & 127, tok = gid * 8 + (r & 7), col = r >> 3; u.pm = tok; u.pn = col;
            u.pA = H + (size_t)tok * 256 * 1024 * 2; u.pB = WT1B + (size_t)col * 256 * 1024 * 2; u.ldc = 1024;
            const int seg = col >> 2; const long long dR = R - U, dGA = GA - U, dGB = GB - U;
            const long long dsel = (seg == 1 ? dR : 0ll) + (seg == 2 ? dGA : 0ll) + (seg == 3 ? dGB : 0ll);
            u.act = seg == 0 ? ACT_GELU : seg == 1 ? ACT_SILU : ACT_SIGM;
            u.pO = U + dsel + ((size_t)(tok * 256) * 1024 + (col & 3) * 256) * 2; }
        else { w -= 2048; const int gid = w >> 5, r = w & 31, tok = gid * 8 + (r & 7), ch = r >> 3; u.pm = tok; u.pn = ch;
            u.pA = WTVA + (size_t)ch * 256 * 1024 * 2; u.pB = H + (size_t)tok * 256 * 1024 * 2; u.pO = GVT + ((size_t)(ch * 256) * ML + tok * 256) * 2; u.ldc = ML; u.act = ACT_GELU; }
        return true;
    }
};
}

#define LAS __attribute__((address_space(3)))

namespace gla {
typedef short bf16x8 __attribute__((ext_vector_type(8)));
typedef float f32x4 __attribute__((ext_vector_type(4)));
typedef unsigned u32x4 __attribute__((ext_vector_type(4)));
typedef unsigned u32x2 __attribute__((ext_vector_type(2)));
constexpr int PKG_L_BYTES = 41984, PKG_C_BYTES = 17408, OFF_EL = 0, OFF_KS = 1024, OFF_QD = 17408, OFF_AT = 33792;
constexpr size_t WS_PKGC = 487 * MiB;
static_assert(WS_PKG + (size_t)64 * 64 * PKG_L_BYTES <= WS_OF && WS_PKGC + (size_t)64 * 4 * PKG_C_BYTES <= WS_END, "package regions");
constexpr float LOG2E = 1.44269504088896f;
__device__ __forceinline__ unsigned cvt_pk(float lo, float hi) { typedef __bf16 v2bf __attribute__((ext_vector_type(2))); typedef float v2f __attribute__((ext_vector_type(2)));
    const v2f x = {lo, hi}; const v2bf y = __builtin_convertvector(x, v2bf); return __builtin_bit_cast(unsigned, y); }
__device__ __forceinline__ float bfr(float f) { return __uint_as_float((__float_as_uint(f) + 0x7fffu + ((__float_as_uint(f) >> 16) & 1u)) & 0xffff0000u); }
__device__ __forceinline__ char* pkg_ptr(unsigned char* ws, int seq, int ch) {
    return ch < 4 ? (char*)ws + WS_PKGC + (size_t)(seq * 4 + ch) * PKG_C_BYTES : (char*)ws + WS_PKG + (size_t)(seq * 64 + (ch - 4)) * PKG_L_BYTES;
}
#define GLA_BAR() do { asm volatile("s_waitcnt lgkmcnt(0)" ::: "memory"); __builtin_amdgcn_s_barrier(); asm volatile("" ::: "memory"); } while (0)

__device__ __forceinline__ void prepass_phase(LAS unsigned char* lds, unsigned char* ws, const float* w_af, const float* b_af, const float* w_ab, const float* b_ab, int G, int c) {
    const int tid = threadIdx.x, w = __builtin_amdgcn_readfirstlane(tid >> 6), lane = tid & 63, lc = lane & 15, lg = lane >> 4;
    LAS float* B2 = (LAS float*)lds;
    LAS float* BL = (LAS float*)(lds + 33792);
    LAS unsigned char* QD = lds + 34816;
    LAS unsigned char* KI = lds + 51200;
    LAS unsigned short* KST = (LAS unsigned short*)(lds + 67584);
    const bf16* Qg = (const bf16*)(ws + WS_Q); const bf16* Kg = (const bf16*)(ws + WS_K); const float* AF = (const float*)(ws + WS_AF);
    for (int item = c; item < 64 * 68; item += G) {
        const int seq = item / 68, ch = item - seq * 68, dir = seq >> 5, b = (seq >> 2) & 7, h = seq & 3;
        const bool isctx = ch < 4;
        const int row0 = isctx ? ML + b * TC + ch * 64 : b * T + (ch - 4) * 64;
        char* pk = pkg_ptr(ws, seq, ch);
        {
            const int dk = 16 * w + lc;
            const float* wsrc = (dir ? w_ab : w_af) + h * DK + dk;
            bf16x8 bh, bl;
#pragma unroll
            for (int j = 0; j < 8; ++j) { const float wv = wsrc[((8 * lg + j) & 15) * QKW]; const float hi = bfr(wv); const float lo = bfr(wv - hi);
                bh[j] = (short)(__float_as_uint(hi) >> 16); bl[j] = lg < 2 ? (short)(__float_as_uint(lo) >> 16) : (short)0; }
            const float bias = (dir ? b_ab : b_af)[h * DK + dk];
            float g2[4][4];
#pragma unroll
            for (int tt = 0; tt < 4; ++tt) {
                const float* ap = AF + (size_t)(row0 + 16 * tt + lc) * 32 + dir * 16 + 8 * (lg & 1);
                const f32x4 a0 = *(const f32x4*)ap, a1 = *(const f32x4*)(ap + 4);
                bf16x8 af;
#pragma unroll
                for (int j = 0; j < 8; ++j) { const float v = j < 4 ? a0[j] : a1[j - 4]; const float hi = bfr(v); const float lo = bfr(v - hi); af[j] = (short)(__float_as_uint(lg < 2 ? hi : lo) >> 16); }
                f32x4 z = (f32x4){0.f, 0.f, 0.f, 0.f};
                z = __builtin_amdgcn_mfma_f32_16x16x32_bf16(af, bh, z, 0, 0, 0);
                z = __builtin_amdgcn_mfma_f32_16x16x32_bf16(af, bl, z, 0, 0, 0);
#pragma unroll
                for (int r = 0; r < 4; ++r) { const float zz = z[r] + bias;
                    const float ls2 = fminf(zz, 0.f) * LOG2E - __builtin_amdgcn_logf(1.0f + __builtin_amdgcn_exp2f(-fabsf(zz) * LOG2E));
                    g2[tt][r] = ls2 * (1.0f / 16.0f); }
            }
            float pre[4][4], tot[4], all[4][4];
#pragma unroll
            for (int tt = 0; tt < 4; ++tt) { pre[tt][0] = g2[tt][0]; pre[tt][1] = pre[tt][0] + g2[tt][1]; pre[tt][2] = pre[tt][1] + g2[tt][2]; pre[tt][3] = pre[tt][2] + g2[tt][3]; tot[tt] = pre[tt][3]; }
#pragma unroll
            for (int tt = 0; tt < 4; ++tt)
#pragma unroll
                for (int q = 0; q < 4; ++q) all[tt][q] = __shfl(tot[tt], lc + 16 * q);
            float run = 0.f, total;
            float offs[4];
#pragma unroll
            for (int tt = 0; tt < 4; ++tt) { offs[tt] = run + (lg > 0 ? all[tt][0] : 0.f) + (lg > 1 ? all[tt][1] : 0.f) + (lg > 2 ? all[tt][2] : 0.f); run += (all[tt][0] + all[tt][1]) + (all[tt][2] + all[tt][3]); }
            total = run;
#pragma unroll
            for (int tt = 0; tt < 4; ++tt)
#pragma unroll
                for (int r = 0; r < 4; ++r) { const float incl = offs[tt] + pre[tt][r]; const float bb = dir ? (total - incl) + g2[tt][r] : incl; B2[(16 * tt + 4 * lg + r) * 132 + dk] = bb; }
            if (lg == 0) { BL[dk] = total; ((float*)(pk + OFF_EL))[dk] = __builtin_amdgcn_exp2f(total); }
        }
        GLA_BAR();
#pragma unroll
        for (int rep = 0; rep < 2; ++rep) {
            const int f = w + 8 * rep, it = f >> 2, s = f & 3, i = 16 * it + lc, d0 = 32 * s + 4 * lg, d1 = d0 + 16;
            const f32x4 b0 = *(const LAS f32x4*)(B2 + i * 132 + d0), b1 = *(const LAS f32x4*)(B2 + i * 132 + d1), l0 = *(const LAS f32x4*)(BL + d0), l1 = *(const LAS f32x4*)(BL + d1);
            const size_t ro = (size_t)(row0 + i) * QKW + h * DK;
            const u32x2 k0 = *(const u32x2*)(Kg + ro + d0), k1 = *(const u32x2*)(Kg + ro + d1);
            float kv[8] = {__uint_as_float(k0.x << 16), __uint_as_float(k0.x & 0xffff0000u), __uint_as_float(k0.y << 16), __uint_as_float(k0.y & 0xffff0000u),
                           __uint_as_float(k1.x << 16), __uint_as_float(k1.x & 0xffff0000u), __uint_as_float(k1.y << 16), __uint_as_float(k1.y & 0xffff0000u)};
            float bb[8] = {b0[0], b0[1], b0[2], b0[3], b1[0], b1[1], b1[2], b1[3]}, ll[8] = {l0[0], l0[1], l0[2], l0[3], l1[0], l1[1], l1[2], l1[3]};
#pragma unroll
            for (int e = 0; e < 8; ++e) { const int dk = (e < 4 ? d0 : d1) + (e & 3); KST[dk * 64 + i] = (unsigned short)(__float_as_uint(bfr(kv[e] * __builtin_amdgcn_exp2f(ll[e] - bb[e]))) >> 16); }
            if (!isctx) {
                const u32x2 q0 = *(const u32x2*)(Qg + ro + d0), q1 = *(const u32x2*)(Qg + ro + d1);
                float qv[8] = {__uint_as_float(q0.x << 16), __uint_as_float(q0.x & 0xffff0000u), __uint_as_float(q0.y << 16), __uint_as_float(q0.y & 0xffff0000u),
                               __uint_as_float(q1.x << 16), __uint_as_float(q1.x & 0xffff0000u), __uint_as_float(q1.y << 16), __uint_as_float(q1.y & 0xffff0000u)};
                float qd[8], ki[8];
#pragma unroll
                for (int e = 0; e < 8; ++e) { qd[e] = qv[e] * __builtin_amdgcn_exp2f(bb[e]); ki[e] = kv[e] * __builtin_amdgcn_exp2f(-bb[e]); }
                u32x4 qw, kw; qw.x = cvt_pk(qd[0], qd[1]); qw.y = cvt_pk(qd[2], qd[3]); qw.z = cvt_pk(qd[4], qd[5]); qw.w = cvt_pk(qd[6], qd[7]);
                kw.x = cvt_pk(ki[0], ki[1]); kw.y = cvt_pk(ki[2], ki[3]); kw.z = cvt_pk(ki[4], ki[5]); kw.w = cvt_pk(ki[6], ki[7]);
                *(LAS u32x4*)(QD + f * 1024 + lane * 16) = qw; *(LAS u32x4*)(KI + f * 1024 + lane * 16) = kw;
                *(u32x4*)(pk + OFF_QD + f * 1024 + lane * 16) = qw;
            }
        }
        GLA_BAR();
        if (!isctx) {
            const int s2 = w >> 2, it = w & 3;
            f32x4 d0v = (f32x4){0.f, 0.f, 0.f, 0.f}, d1v = (f32x4){0.f, 0.f, 0.f, 0.f};
#pragma unroll
            for (int s = 0; s < 4; ++s) { const bf16x8 qf = *(const LAS bf16x8*)(QD + (it * 4 + s) * 1024 + lane * 16);
                const bf16x8 ka = *(const LAS bf16x8*)(KI + ((2 * s2) * 4 + s) * 1024 + lane * 16), kb = *(const LAS bf16x8*)(KI + ((2 * s2 + 1) * 4 + s) * 1024 + lane * 16);
                d0v = __builtin_amdgcn_mfma_f32_16x16x32_bf16(ka, qf, d0v, 0, 0, 0); d1v = __builtin_amdgcn_mfma_f32_16x16x32_bf16(kb, qf, d1v, 0, 0, 0); }
            const int i = 16 * it + lc; float a[8];
#pragma unroll
            for (int e = 0; e < 8; ++e) { const int j = 32 * s2 + (e < 4 ? 0 : 16) + 4 * lg + (e & 3); const float v = e < 4 ? d0v[e] : d1v[e - 4]; a[e] = (dir ? (i <= j) : (i >= j)) ? v : 0.f; }
            u32x4 aw; aw.x = cvt_pk(a[0], a[1]); aw.y = cvt_pk(a[2], a[3]); aw.z = cvt_pk(a[4], a[5]); aw.w = cvt_pk(a[6], a[7]);
            *(u32x4*)(pk + OFF_AT + (it * 2 + s2) * 1024 + lane * 16) = aw;
        }
#pragma unroll
        for (int rep = 0; rep < 2; ++rep) { const int fi = 2 * w + rep, dkt = fi >> 1, sp = fi & 1, dk = 16 * dkt + lc;
            const u32x2 x0 = *(const LAS u32x2*)(KST + dk * 64 + 32 * sp + 4 * lg), x1 = *(const LAS u32x2*)(KST + dk * 64 + 32 * sp + 16 + 4 * lg);
            u32x4 o; o.x = x0.x; o.y = x0.y; o.z = x1.x; o.w = x1.y;
            *(u32x4*)(pk + OFF_KS + fi * 1024 + lane * 16) = o; }
    }
}

__device__ __forceinline__ void scan_phase(LAS unsigned char* lds, unsigned char* ws, int G, int c) {
    const int tid = threadIdx.x, w = __builtin_amdgcn_readfirstlane(tid >> 6), lane = tid & 63, lc = lane & 15, lg = lane >> 4;
    const bf16* VVT = (const bf16*)(ws + WS_VVT);
    const int vc = (G % 8 == 0) ? (c % 8) * (G / 8) + c / 8 : c;
    for (int item = vc; item < 256; item += G) {
        const int seq = item >> 2, vs = item & 3, dir = seq >> 5, b = (seq >> 2) & 7, h = seq & 3;
        bf16* O = (bf16*)(ws + (dir ? WS_OB : WS_OF));
        auto chunk_of = [&](int st) { return st < 4 ? (dir ? 3 - st : st) : 4 + (dir ? 63 - (st - 4) : st - 4); };
        if (w >= 4) {
            const int lw = w - 4;
            auto issue = [&](int st) { const int ch = chunk_of(st); const char* pk = pkg_ptr(ws, seq, ch); LAS unsigned char* dst = lds + (st % 3) * PKG_L_BYTES;
                const int np = ch < 4 ? 4 : 10;
                for (int p = 0; p < np; ++p) { const int piece = lw + 4 * p; __builtin_amdgcn_global_load_lds((const unsigned*)(pk + piece * 1024 + lane * 16), (LAS unsigned*)(dst + piece * 1024), 16, 0, 0); }
                const int piece = ch < 4 ? 16 : 40; __builtin_amdgcn_global_load_lds((const unsigned*)(pk + piece * 1024 + lane * 16), (LAS unsigned*)(dst + piece * 1024), 16, 0, 0); };
            issue(0); issue(1);
            for (int st = 0; st < 68; ++st) {
                if (st + 1 < 68) { if (chunk_of(st + 1) < 4) asm volatile("s_waitcnt vmcnt(5)" ::: "memory"); else asm volatile("s_waitcnt vmcnt(11)" ::: "memory"); }
                else asm volatile("s_waitcnt vmcnt(0)" ::: "memory");
                __builtin_amdgcn_s_barrier();
                if (st + 2 < 68) issue(st + 2);
            }
            __builtin_amdgcn_s_barrier();
        } else {
            const int dvb = vs * 64 + 16 * w;
            const bf16* vrow = VVT + (size_t)(h * DV + dvb + lc) * M;
            f32x4 S[8];
#pragma unroll
            for (int t = 0; t < 8; ++t) S[t] = (f32x4){0.f, 0.f, 0.f, 0.f};
            auto row_of = [&](int st) { const int ch = chunk_of(st); return ch < 4 ? ML + b * TC + ch * 64 : b * T + (ch - 4) * 64; };
            auto load_v = [&](int st, bf16x8 (&vf)[2]) { const bf16* p = vrow + row_of(st);
#pragma unroll
                for (int sp = 0; sp < 2; ++sp) { const u32x2 x0 = *(const u32x2*)(p + 32 * sp + 4 * lg), x1 = *(const u32x2*)(p + 32 * sp + 16 + 4 * lg);
                    u32x4 t; t.x = x0.x; t.y = x0.y; t.z = x1.x; t.w = x1.y; vf[sp] = __builtin_bit_cast(bf16x8, t); } };
            bf16x8 vf[2], vn[2];
            load_v(0, vf);
            for (int st = 0; st < 68; ++st) {
                if (st + 1 < 68) load_v(st + 1, vn);
                GLA_BAR();
                const LAS unsigned char* base = lds + (st % 3) * PKG_L_BYTES;
                const int ch = chunk_of(st);
                if (ch >= 4) {
                    bf16x8 sa[4];
#pragma unroll
                    for (int s = 0; s < 4; ++s) { u32x4 t; t.x = cvt_pk(S[2 * s][0], S[2 * s][1]); t.y = cvt_pk(S[2 * s][2], S[2 * s][3]); t.z = cvt_pk(S[2 * s + 1][0], S[2 * s + 1][1]); t.w = cvt_pk(S[2 * s + 1][2], S[2 * s + 1][3]); sa[s] = __builtin_bit_cast(bf16x8, t); }
                    const int row0 = b * T + (ch - 4) * 64;
#pragma unroll
                    for (int it = 0; it < 4; ++it) { f32x4 o = (f32x4){0.f, 0.f, 0.f, 0.f};
#pragma unroll
                        for (int s = 0; s < 4; ++s) { const bf16x8 qf = *(const LAS bf16x8*)(base + OFF_QD + (it * 4 + s) * 1024 + lane * 16); o = __builtin_amdgcn_mfma_f32_16x16x32_bf16(sa[s], qf, o, 0, 0, 0); }
#pragma unroll
                        for (int s2 = 0; s2 < 2; ++s2) { const bf16x8 af = *(const LAS bf16x8*)(base + OFF_AT + (it * 2 + s2) * 1024 + lane * 16); o = __builtin_amdgcn_mfma_f32_16x16x32_bf16(vf[s2], af, o, 0, 0, 0); }
                        u32x2 ow; ow.x = cvt_pk(o[0], o[1]); ow.y = cvt_pk(o[2], o[3]);
                        *(u32x2*)(O + (size_t)(row0 + 16 * it + lc) * VW + h * DV + dvb + 4 * lg) = ow; }
                }
#pragma unroll
                for (int t = 0; t < 8; ++t) { const f32x4 el = *(const LAS f32x4*)(base + OFF_EL + (16 * t + 4 * lg) * 4); S[t] = S[t] * el;
#pragma unroll
                    for (int sp = 0; sp < 2; ++sp) { const bf16x8 kf = *(const LAS bf16x8*)(base + OFF_KS + (t * 2 + sp) * 1024 + lane * 16); S[t] = __builtin_amdgcn_mfma_f32_16x16x32_bf16(kf, vf[sp], S[t], 0, 0, 0); } }
                vf[0] = vn[0]; vf[1] = vn[1];
            }
            GLA_BAR();
        }
    }
}
}


#define XB_TMO      128
#define XB_XCNT(j)  (256  + 64 * (j))
#define XB_XSUB(j)  (1280 + 64 * (j))
#define XB_XGEN(j)  (2304 + 64 * (j))
#define XB_TOP      3328
#define XB_TOPGEN   3392
#define XCD_BAR_WORDS 3456
#define XB_SPIN_CAP (1u << 18)
__device__ __forceinline__ unsigned xb_ld(unsigned* p)              { return __hip_atomic_load(p, __ATOMIC_RELAXED, __HIP_MEMORY_SCOPE_AGENT); }
__device__ __forceinline__ unsigned xb_add(unsigned* p, unsigned v) { return __hip_atomic_fetch_add(p, v, __ATOMIC_RELAXED, __HIP_MEMORY_SCOPE_AGENT); }
__device__ __forceinline__ unsigned xb_xcc_id() { return (unsigned)__builtin_amdgcn_s_getreg((3 << 11) | 20) & 0xFu; }
#define XB_SPIN(cond, bar) do { unsigned _sp = 0; while (cond) { __builtin_amdgcn_s_sleep(1); \
    if ((++_sp & 255u) == 0u) { if (xb_ld(&(bar)[XB_TMO])) break; if (_sp > XB_SPIN_CAP) { atomicAdd(&(bar)[XB_TMO], 1u); break; } } } } while (0)
struct XcdBarrier { unsigned* bar; unsigned x; volatile LAS unsigned* st; };
__device__ __forceinline__ XcdBarrier xcd_barrier_post(unsigned* bar, volatile LAS unsigned* st) {
    XcdBarrier b; b.bar = bar; b.x = xb_xcc_id(); b.st = st;
    if (threadIdx.x == 0) (void)xb_add(&bar[XB_XCNT(b.x)], 1u);
    return b;
}
__device__ __forceinline__ void xcd_barrier_complete(unsigned* bar, unsigned x, unsigned& nloc, unsigned& nx) {
    const unsigned G = gridDim.x * gridDim.y * gridDim.z;
    unsigned sum, cnt, mine, sp = 0u;
    for (;;) {
        sum = 0u; cnt = 0u; mine = 0u;
#pragma unroll
        for (unsigned j = 0; j < 16; ++j) { const unsigned c = xb_ld(&bar[XB_XCNT(j)]); sum += c; cnt += (c > 0u) ? 1u : 0u; mine = (j == x) ? c : mine; }
        if (sum == G) break;
        __builtin_amdgcn_s_sleep(1);
        if ((++sp & 255u) == 0u) { if (xb_ld(&bar[XB_TMO])) break; if (sp > XB_SPIN_CAP) { atomicAdd(&bar[XB_TMO], 1u); break; } }
    }
    nloc = mine > 0u ? mine : 1u; nx = cnt > 0u ? cnt : 1u;
}
__device__ __forceinline__ void xcd_barrier(const XcdBarrier& b) {
    asm volatile("s_waitcnt vmcnt(0)" ::: "memory");
    __syncthreads();
    if (threadIdx.x == 0) {
        unsigned* bar = b.bar;
        __builtin_amdgcn_s_waitcnt(0);
        unsigned nloc = b.st[0], nx = b.st[1];
        if (nloc == 0u) { xcd_barrier_complete(bar, b.x, nloc, nx); b.st[0] = nloc; b.st[1] = nx; }
        const unsigned old = xb_add(&bar[XB_XSUB(b.x)], 1u);
        const unsigned gen = old / nloc;
        if (old + 1u == (gen + 1u) * nloc) {
            __builtin_amdgcn_fence(__ATOMIC_RELEASE, "agent");
            asm volatile("s_waitcnt vmcnt(0)" ::: "memory");
            const unsigned og = xb_add(&bar[XB_TOP], 1u);
            const unsigned tg = og / nx;
            if (og + 1u == (tg + 1u) * nx) xb_add(&bar[XB_TOPGEN], 1u);
            else XB_SPIN(xb_ld(&bar[XB_TOPGEN]) == tg, bar);
            __builtin_amdgcn_fence(__ATOMIC_ACQUIRE, "agent");
            xb_add(&bar[XB_XGEN(b.x)], 1u);
            asm volatile("s_waitcnt vmcnt(0)" ::: "memory");
        } else {
            XB_SPIN(xb_ld(&bar[XB_XGEN(b.x)]) == gen, bar);
            __builtin_amdgcn_fence(__ATOMIC_ACQUIRE, "agent");
            asm volatile("s_waitcnt vmcnt(0)" ::: "memory");
        }
    }
    __syncthreads();
}

namespace thin {
typedef float f32x4 __attribute__((ext_vector_type(4)));
typedef unsigned u32x4 __attribute__((ext_vector_type(4)));
typedef unsigned u32x2 __attribute__((ext_vector_type(2)));
typedef short bf16x8 __attribute__((ext_vector_type(8)));
using gla::cvt_pk;
__device__ __forceinline__ float lo16(unsigned w) { return __uint_as_float(w << 16); }
__device__ __forceinline__ float hi16(unsigned w) { return __uint_as_float(w & 0xffff0000u); }
__device__ __forceinline__ void tr_item(const float* W, int K, int ldw, int col0, bf16* WT, int mode, LAS float* scr, int item, int nblk, int lane) {
    const int kb = item / nblk, nb = item % nblk, k0 = 64 * kb, n0 = 32 * nb;
#pragma unroll 8
    for (int i = 0; i < 32; ++i) { const int kk = 2 * i + (lane >> 5); scr[kk * 33 + (lane & 31)] = W[(size_t)(k0 + kk) * ldw + col0 + n0 + (lane & 31)]; }
    asm volatile("s_waitcnt lgkmcnt(0)" ::: "memory");
    int r0 = n0;
    if (mode == 1) { const int col = col0 + n0; r0 = col < DFF ? 256 * (col >> 7) + (col & 127) : 256 * ((col - DFF) >> 7) + 128 + ((col - DFF) & 127); }
    const int cch = lane & 7;
#pragma unroll
    for (int j = 0; j < 4; ++j) { const int n = (lane >> 3) + 8 * j; const LAS float* sp = scr + (8 * cch) * 33 + n;
        u32x4 o; o.x = cvt_pk(sp[0 * 33], sp[1 * 33]); o.y = cvt_pk(sp[2 * 33], sp[3 * 33]); o.z = cvt_pk(sp[4 * 33], sp[5 * 33]); o.w = cvt_pk(sp[6 * 33], sp[7 * 33]);
        *(u32x4*)(WT + (size_t)(r0 + n) * K + k0 + 8 * cch) = o; }
    asm volatile("s_waitcnt lgkmcnt(0)" ::: "memory");
}
template <int NR, int NC>
__device__ __forceinline__ void gemv_block(const LAS float* sv, LAS float* red, const float* W, int ldw, int col0, const float* bias, float* out, int ldo) {
    const int tid = threadIdx.x, w = tid >> 6, lane = tid & 63, col = lane % NC, kk = lane / NC;
    float acc[NR];
#pragma unroll
    for (int r = 0; r < NR; ++r) acc[r] = 0.f;
    if (kk < 2) {
#pragma unroll 4
        for (int j = 0; j < 64; ++j) { const int k = 128 * w + 2 * j + kk; const float wv = W[(size_t)k * ldw + col0 + col];
#pragma unroll
            for (int r = 0; r < NR; ++r) acc[r] += sv[r * 1024 + k] * wv; }
    }
#pragma unroll
    for (int r = 0; r < NR; ++r) { const float o = __shfl(acc[r], (lane + NC) & 63); if (lane < NC) red[(w * NR + r) * 32 + col] = acc[r] + o; }
    __syncthreads();
    if (tid < NR * NC) { const int r = tid / NC, cidx = tid % NC; float t = 0.f;
#pragma unroll
        for (int ww = 0; ww < 8; ++ww) t += red[(ww * NR + r) * 32 + cidx];
        out[(size_t)r * ldo + col0 + cidx] = t + (bias ? bias[col0 + cidx] : 0.f); }
    __syncthreads();
}
struct P0Args { const float *c, *cctx, *w_ada, *b_ada, *w_in, *w_ba, *w_bb, *w_out, *w_f1, *w_f2, *w_sp; };
__device__ __forceinline__ void p0_phase(LAS unsigned char* lds, unsigned char* ws, const P0Args& A, int G, int vcu) {
    const int tid = threadIdx.x, w = __builtin_amdgcn_readfirstlane(tid >> 6), lane = tid & 63;
    LAS float* scr = (LAS float*)(lds + w * 8448);
    LAS float* sv = (LAS float*)(lds + 69632);
    LAS float* red = (LAS float*)(lds + 69632 + 36864);
    for (int i = tid; i < 9 * 1024; i += 512) { const int r = i >> 10, k = i & 1023; const float v = r < 8 ? A.c[r * 1024 + k] : A.cctx[k]; sv[i] = v / (1.f + __expf(-v)); }
    __syncthreads();
    for (int cb = vcu; cb < 256; cb += G) gemv_block<9, 24>(sv, red, A.w_ada, 6144, 24 * cb, A.b_ada, (float*)(ws + WS_MOD), 6144);
    const int gw = vcu * 8 + w, NGW = G * 8; int base = 0;
#define TR_JOB(Wp, K_, ldw_, col0_, ncols_, dst_, mode_) do { const int nblk_ = (ncols_) / 32, items_ = ((K_) / 64) * nblk_; \
        for (int it_ = ((gw - base) % NGW + NGW) % NGW; it_ < items_; it_ += NGW) tr_item(Wp, K_, ldw_, col0_, dst_, mode_, scr, it_, nblk_, lane); base = (base + items_) % NGW; } while (0)
    bf16* WT1A = (bf16*)(ws + WS_WT1A); bf16* WT1B = (bf16*)(ws + WS_WT1B);
    TR_JOB(A.w_in, 1024, NIN, C_Q, 512, WT1A, 0); TR_JOB(A.w_in, 1024, NIN, C_K, 512, WT1A + 512 * 1024, 0); TR_JOB(A.w_in, 1024, NIN, C_AF, 32, WT1A + 1024 * 1024, 0);
    TR_JOB(A.w_in, 1024, NIN, C_VV, 1024, (bf16*)(ws + WS_WTVV), 0); TR_JOB(A.w_in, 1024, NIN, C_VA, 1024, (bf16*)(ws + WS_WTVA), 0);
    TR_JOB(A.w_in, 1024, NIN, C_U, 1024, WT1B, 0); TR_JOB(A.w_in, 1024, NIN, C_R, 1024, WT1B + 1024 * 1024, 0); TR_JOB(A.w_in, 1024, NIN, C_GA, 1024, WT1B + 2048 * 1024, 0); TR_JOB(A.w_in, 1024, NIN, C_GB, 1024, WT1B + 3072 * 1024, 0);
    TR_JOB(A.w_ba, 1024, 1024, 0, 1024, (bf16*)(ws + WS_WTA), 0); TR_JOB(A.w_bb, 1024, 1024, 0, 1024, (bf16*)(ws + WS_WTB), 0); TR_JOB(A.w_out, 1024, 1024, 0, 1024, (bf16*)(ws + WS_WTO), 0);
    TR_JOB(A.w_f1, 1024, 2 * DFF, 0, 2 * DFF, (bf16*)(ws + WS_WTF1), 1);
    TR_JOB(A.w_f2, DFF, 1024, 0, 1024, (bf16*)(ws + WS_WTF2), 0);
#undef TR_JOB
    { u32x4* z = (u32x4*)(WT1A + 1056 * 1024); const u32x4 zero = {0u, 0u, 0u, 0u}; for (int i = vcu * 512 + tid; i < 224 * 1024 / 8; i += G * 512) z[i] = zero; }
    for (int i = vcu * 512 + tid; i < 8 * 8 * 4 * 64; i += G * 512) { const int ln = i & 63, sidx = (i >> 6) & 3, pt = (i >> 8) & 7, g = i >> 11;
        const float* src = A.w_sp + ((size_t)g * 128 + 16 * pt + (ln & 15)) * 128 + 32 * sidx + 8 * (ln >> 4);
        const f32x4 a = *(const f32x4*)src, b = *(const f32x4*)(src + 4);
        u32x4 o; o.x = cvt_pk(a[0], a[1]); o.y = cvt_pk(a[2], a[3]); o.z = cvt_pk(b[0], b[1]); o.w = cvt_pk(b[2], b[3]);
        ((u32x4*)(ws + WS_WSPF))[i] = o; }
    __syncthreads();
}
__device__ __forceinline__ float wsum(float v) {
#pragma unroll
    for (int o = 1; o < 64; o <<= 1) v += __shfl_xor(v, o);
    return v;
}
__device__ __forceinline__ void p1_phase(LAS unsigned char* lds, unsigned char* ws, const float* x, const float* ctx, const float* n1g, const float* n2g, const float* w_f1, int G, int vcu) {
    const int tid = threadIdx.x, w = __builtin_amdgcn_readfirstlane(tid >> 6), lane = tid & 63;
    const float* MOD = (const float*)(ws + WS_MOD); bf16* H = (bf16*)(ws + WS_H);
    const int gw = vcu * 8 + w, NGW = G * 8;
    for (int row = gw; row < M; row += NGW) {
        const float* xr = row < ML ? x + (size_t)row * D : ctx + (size_t)(row - ML) * D; const int mr = row < ML ? row / T : 8;
        f32x4 v[4]; float ss = 0.f;
#pragma unroll
        for (int j = 0; j < 4; ++j) { v[j] = *(const f32x4*)(xr + 4 * lane + 256 * j); ss += (v[j][0] * v[j][0] + v[j][1] * v[j][1]) + (v[j][2] * v[j][2] + v[j][3] * v[j][3]); }
        const float rstd = rsqrtf(wsum(ss) * (1.f / D) + EPS);
#pragma unroll
        for (int j = 0; j < 4; ++j) { const int cidx = 4 * lane + 256 * j; const f32x4 g = *(const f32x4*)(n1g + cidx), sh = *(const f32x4*)(MOD + mr * 6144 + cidx), sc = *(const f32x4*)(MOD + mr * 6144 + 1024 + cidx);
            const f32x4 y = v[j] * rstd * g * (sc + 1.0f) + sh; u32x2 o; o.x = cvt_pk(y[0], y[1]); o.y = cvt_pk(y[2], y[3]); *(u32x2*)(H + (size_t)row * D + cidx) = o; }
    }
    for (int i = vcu * 512 + tid; i < 8 * 1024; i += G * 512) ((float*)(ws + WS_GV2))[i] = n2g[i & 1023] * (1.f + MOD[(i >> 10) * 6144 + 4096 + (i & 1023)]);
    LAS float* sv = (LAS float*)lds; LAS float* red = (LAS float*)(lds + 32768);
    for (int i = tid; i < 8 * 1024; i += 512) sv[i] = MOD[(i >> 10) * 6144 + 3072 + (i & 1023)];
    __syncthreads();
    for (int cb = vcu; cb < 256; cb += G) gemv_block<8, 22>(sv, red, w_f1, 2 * DFF, 22 * cb, nullptr, (float*)(ws + WS_CV), 2 * DFF);
}
__device__ __forceinline__ void mix_phase(LAS unsigned char* lds, unsigned char* ws, const float* lng, const float* lnb, const float* bsp, const float* gain, int G, int vcu) {
    const int tid = threadIdx.x, w = __builtin_amdgcn_readfirstlane(tid >> 6), lane = tid & 63, lc = lane & 15, lg = lane >> 4;
    const bf16* GVT = (const bf16*)(ws + WS_GVT); bf16* U = (bf16*)(ws + WS_U); const u32x4* WSPF = (const u32x4*)(ws + WS_WSPF);
    LAS unsigned char* WB = lds;
    LAS float* RS = (LAS float*)(lds + 32768);
    LAS float* RQ = (LAS float*)(lds + 32768 + 4096);
    LAS float* MR = (LAS float*)(lds + 32768 + 8192);
    for (int ch = vcu; ch < ML / 128; ch += G) {
        const int tok0 = ch * 128;
        {
            const int tp = tid & 63, cs = tid >> 6; float s0 = 0.f, s1 = 0.f, q0 = 0.f, q1 = 0.f;
            const bf16* gp = GVT + (size_t)(cs * 128) * ML + tok0 + 2 * tp;
#pragma unroll 8
            for (int cc = 0; cc < 128; ++cc) { const unsigned v = *(const unsigned*)(gp + (size_t)cc * ML); const float a = lo16(v), b = hi16(v); s0 += a; q0 += a * a; s1 += b; q1 += b * b; }
            RS[cs * 128 + 2 * tp] = s0; RS[cs * 128 + 2 * tp + 1] = s1; RQ[cs * 128 + 2 * tp] = q0; RQ[cs * 128 + 2 * tp + 1] = q1;
        }
        __syncthreads();
        if (tid < 128) { float sx = 0.f, qx = 0.f;
#pragma unroll
            for (int k = 0; k < 8; ++k) { sx += RS[k * 128 + tid]; qx += RQ[k * 128 + tid]; }
            const float mean = sx * (1.f / 1024.f), var = fmaxf(qx * (1.f / 1024.f) - mean * mean, 0.f); MR[2 * tid] = mean; MR[2 * tid + 1] = rsqrtf(var + EPS); }
        for (int g = 0; g < 8; ++g) {
            __syncthreads();
#pragma unroll
            for (int k = 0; k < 4; ++k) *(LAS u32x4*)(WB + (tid + 512 * k) * 16) = WSPF[g * 2048 + tid + 512 * k];
            __syncthreads();
            const int chn = g * 128 + 16 * w + lc; const float gg = lng[chn], bb = lnb[chn];
            bf16x8 af[4];
#pragma unroll
            for (int sidx = 0; sidx < 4; ++sidx) { const int q0 = 32 * sidx + 8 * lg; const u32x4 raw = *(const u32x4*)(GVT + (size_t)chn * ML + tok0 + q0);
                const unsigned rw[4] = {raw.x, raw.y, raw.z, raw.w}; float y[8];
#pragma unroll
                for (int e = 0; e < 4; ++e) { const f32x4 mr = *(const LAS f32x4*)(MR + 2 * (q0 + 2 * e));
                    y[2 * e] = (lo16(rw[e]) - mr[0]) * mr[1] * gg + bb; y[2 * e + 1] = (hi16(rw[e]) - mr[2]) * mr[3] * gg + bb; }
                u32x4 t; t.x = cvt_pk(y[0], y[1]); t.y = cvt_pk(y[2], y[3]); t.z = cvt_pk(y[4], y[5]); t.w = cvt_pk(y[6], y[7]); af[sidx] = __builtin_bit_cast(bf16x8, t); }
#pragma unroll
            for (int pt = 0; pt < 8; ++pt) { f32x4 d = (f32x4){0.f, 0.f, 0.f, 0.f};
#pragma unroll
                for (int sidx = 0; sidx < 4; ++sidx) { const bf16x8 bf = *(const LAS bf16x8*)(WB + ((pt * 4 + sidx) * 64 + lane) * 16); d = __builtin_amdgcn_mfma_f32_16x16x32_bf16(af[sidx], bf, d, 0, 0, 0); }
                const int p = 16 * pt + lc; const float bs = bsp[g * 128 + p];
                bf16* up = U + (size_t)(tok0 + p) * D + g * 128 + 16 * w + 4 * lg; const u32x2 uv = *(const u32x2*)up;
                u32x2 o; o.x = cvt_pk(lo16(uv.x) * (d[0] + bs), hi16(uv.x) * (d[1] + bs)); o.y = cvt_pk(lo16(uv.y) * (d[2] + bs), hi16(uv.y) * (d[3] + bs)); *(u32x2*)up = o; }
        }
        __syncthreads();
    }
    bf16* OF = (bf16*)(ws + WS_OF); const bf16* OB = (const bf16*)(ws + WS_OB); const bf16* R = (const bf16*)(ws + WS_R);
    const int gw = vcu * 8 + w, NGW = G * 8;
    for (int row = gw; row < ML; row += NGW) {
        const size_t o = (size_t)row * VW + 16 * lane; float v[16], r[16]; float ss = 0.f;
#pragma unroll
        for (int hv = 0; hv < 2; ++hv) { const u32x4 a = *(const u32x4*)(OF + o + 8 * hv), b = *(const u32x4*)(OB + o + 8 * hv), rr = *(const u32x4*)(R + o + 8 * hv);
            const unsigned aw[4] = {a.x, a.y, a.z, a.w}, bw[4] = {b.x, b.y, b.z, b.w}, rw[4] = {rr.x, rr.y, rr.z, rr.w};
#pragma unroll
            for (int e = 0; e < 4; ++e) { v[8 * hv + 2 * e] = lo16(aw[e]) + lo16(bw[e]); v[8 * hv + 2 * e + 1] = hi16(aw[e]) + hi16(bw[e]); r[8 * hv + 2 * e] = lo16(rw[e]); r[8 * hv + 2 * e + 1] = hi16(rw[e]); } }
#pragma unroll
        for (int e = 0; e < 16; ++e) ss += v[e] * v[e];
        ss += __shfl_xor(ss, 1); ss += __shfl_xor(ss, 2); ss += __shfl_xor(ss, 4); ss += __shfl_xor(ss, 8);
        const float rstd = rsqrtf(ss * (1.f / DV) + EPS);
#pragma unroll
        for (int hv = 0; hv < 2; ++hv) { const f32x4 g0 = *(const f32x4*)(gain + 16 * lane + 8 * hv), g1 = *(const f32x4*)(gain + 16 * lane + 8 * hv + 4); float y[8];
#pragma unroll
            for (int e = 0; e < 4; ++e) { y[e] = v[8 * hv + e] * rstd * g0[e] * r[8 * hv + e]; y[4 + e] = v[8 * hv + 4 + e] * rstd * g1[e] * r[8 * hv + 4 + e]; }
            u32x4 t; t.x = cvt_pk(y[0], y[1]); t.y = cvt_pk(y[2], y[3]); t.z = cvt_pk(y[4], y[5]); t.w = cvt_pk(y[6], y[7]); *(u32x4*)(OF + o + 8 * hv) = t; }
    }
}
__device__ __forceinline__ void fin_phase(float* X, const float* g, int G, int vcu) {
    const int w = threadIdx.x >> 6, lane = threadIdx.x & 63, gw = vcu * 8 + w, NGW = G * 8;
    for (int row = gw; row < ML; row += NGW) { float* xr = X + (size_t)row * D; f32x4 v[4]; float ss = 0.f;
#pragma unroll
        for (int j = 0; j < 4; ++j) { v[j] = *(const f32x4*)(xr + 4 * lane + 256 * j); ss += (v[j][0] * v[j][0] + v[j][1] * v[j][1]) + (v[j][2] * v[j][2] + v[j][3] * v[j][3]); }
        const float rstd = rsqrtf(wsum(ss) * (1.f / D) + EPS);
#pragma unroll
        for (int j = 0; j < 4; ++j) *(f32x4*)(xr + 4 * lane + 256 * j) = v[j] * rstd * *(const f32x4*)(g + 4 * lane + 256 * j); }
}
}

constexpr int NWAVES = 8, LDS_BYTES = 147456;
#ifndef PG8_SP2
#define PG8_SP2 true
#endif
#ifndef PG8_ALIGN
#define PG8_ALIGN true
#endif
enum Phase { PH_P0 = 0, PH_P1 = 1, PH_G1A = 2, PH_PRE = 3, PH_SCAN = 4, PH_G1B = 5, PH_MIX = 6, PH_MRG = 7, PH_WOUT = 8, PH_FF1 = 9, PH_FF2 = 10, PH_FIN = 11, PH_END = 12 };
constexpr int CW_BAR = 4096;
constexpr int MISC_OFF = LDS_BYTES - 256;
struct Args { const float* in[24]; float* out; unsigned char* ws; int ph_lo, ph_hi; };
__global__ void __launch_bounds__(NWAVES * 64, 2) mega_fwd(Args a) {
    extern __shared__ __attribute__((aligned(16))) unsigned char lds_raw[];
    LAS unsigned char* lds = (LAS unsigned char*)lds_raw;
    unsigned char* ws = a.ws;
    const int G = gridDim.x, c = blockIdx.x;
    const int vcu = (G % 8 == 0) ? (c % 8) * (G / 8) + c / 8 : c;
    const char* Hc = (const char*)(ws + WS_H);
    volatile LAS unsigned* MISC = (volatile LAS unsigned*)(lds + MISC_OFF);
    if (threadIdx.x < 64) MISC[threadIdx.x] = 0u;
    __syncthreads();
    XcdBarrier bar; bar.bar = (unsigned*)(ws + WS_CTL) + CW_BAR; bar.x = 0; bar.st = nullptr;
    const bool multi = a.ph_hi - a.ph_lo > 1;
    if (multi) bar = xcd_barrier_post((unsigned*)(ws + WS_CTL) + CW_BAR, MISC + 8);
#define IN(k) (a.ph_lo <= (k) && (k) < a.ph_hi)
#define SEAM(k) do { if (IN(k) && IN((k) + 1)) xcd_barrier(bar); } while (0)
    if (IN(PH_P0)) { thin::P0Args pa{a.in[1], a.in[3], a.in[4], a.in[5], a.in[7], a.in[17], a.in[18], a.in[19], a.in[21], a.in[22], a.in[10]}; thin::p0_phase(lds, ws, pa, G, vcu); }
    SEAM(PH_P0);
    if (IN(PH_P1)) thin::p1_phase(lds, ws, a.in[0], a.in[2], a.in[6], a.in[20], a.in[21], G, vcu);
    SEAM(PH_P1);
    if (IN(PH_G1A)) {
        pg8::Order1A S{Hc, (const char*)(ws + WS_WT1A), (const char*)(ws + WS_WTVV), (char*)(ws + WS_Q), (char*)(ws + WS_K), (char*)(ws + WS_AF), (char*)(ws + WS_VVT), G, c};
        pg8::EpiAct E;
        pg8::gemm_phase<pg8::EpiAct, pg8::Order1A, PG8_ALIGN, PG8_SP2>(lds, 1024, S, E);
    }
    SEAM(PH_G1A);
    if (IN(PH_PRE)) { gla::prepass_phase(lds, ws, a.in[12], a.in[13], a.in[14], a.in[15], G, c); __syncthreads(); }
    SEAM(PH_PRE);
    if (IN(PH_SCAN)) { gla::scan_phase(lds, ws, G, c); __syncthreads(); }
    SEAM(PH_SCAN);
    if (IN(PH_G1B)) {
        pg8::Order1B S{Hc, (const char*)(ws + WS_WT1B), (const char*)(ws + WS_WTVA), (char*)(ws + WS_U), (char*)(ws + WS_R), (char*)a.out, (char*)a.out + (size_t)ML * D * 2, (char*)(ws + WS_GVT), G, c};
        pg8::EpiAct E;
        pg8::gemm_phase<pg8::EpiAct, pg8::Order1B, PG8_ALIGN, PG8_SP2>(lds, 1024, S, E);
    }
    SEAM(PH_G1B);
    if (IN(PH_MIX)) thin::mix_phase(lds, ws, a.in[8], a.in[9], a.in[11], a.in[16], G, vcu);
    SEAM(PH_MIX);
    if (IN(PH_MRG)) {
        { pg8::OrderGrid S{(const char*)(ws + WS_U), (const char*)(ws + WS_WTA), 128, 4, 1024, G, c};
          pg8::EpiY1 E{(const bf16*)a.out, (float*)(ws + WS_Y1)};
          pg8::gemm_phase<pg8::EpiY1, pg8::OrderGrid, PG8_ALIGN, PG8_SP2>(lds, 1024, S, E); }
        { pg8::OrderGrid S{(const char*)(ws + WS_OF), (const char*)(ws + WS_WTB), 128, 4, 1024, G, c};
          pg8::EpiY E{(const bf16*)a.out + (size_t)ML * D, (const float*)(ws + WS_Y1), (bf16*)(ws + WS_Y)};
          pg8::gemm_phase<pg8::EpiY, pg8::OrderGrid, PG8_ALIGN, PG8_SP2>(lds, 1024, S, E); }
    }
    SEAM(PH_MRG);
    if (IN(PH_WOUT)) {
        pg8::OrderGrid S{(const char*)(ws + WS_Y), (const char*)(ws + WS_WTO), 128, 4, 1024, G, c};
        pg8::EpiRes2 E{a.in[0], (const float*)(ws + WS_MOD), (const float*)(ws + WS_GV2), (float*)(ws + WS_X1), (bf16*)(ws + WS_A2), (unsigned long long*)(ws + WS_ROWSS)};
        pg8::gemm_phase<pg8::EpiRes2, pg8::OrderGrid, PG8_ALIGN, PG8_SP2>(lds, 1024, S, E);
    }
    SEAM(PH_WOUT);
    if (IN(PH_FF1)) {
        pg8::OrderGrid S{(const char*)(ws + WS_A2), (const char*)(ws + WS_WTF1), 128, 22, 1024, G, c};
        pg8::EpiSwi2 E{(bf16*)(ws + WS_HB), (const unsigned long long*)(ws + WS_ROWSS), (const float*)(ws + WS_CV)};
        pg8::gemm_phase<pg8::EpiSwi2, pg8::OrderGrid, PG8_ALIGN, PG8_SP2>(lds, 1024, S, E);
    }
    SEAM(PH_FF1);
    if (IN(PH_FF2)) {
        pg8::OrderGrid S{(const char*)(ws + WS_HB), (const char*)(ws + WS_WTF2), 128, 4, DFF, G, c};
        pg8::EpiRes E{(const float*)(ws + WS_X1), (const float*)(ws + WS_MOD), a.out, 5120};
        pg8::gemm_phase<pg8::EpiRes, pg8::OrderGrid, PG8_ALIGN, PG8_SP2>(lds, DFF, S, E);
    }
    SEAM(PH_FF2);
    if (IN(PH_FIN)) thin::fin_phase(a.out, a.in[23], G, vcu);
#undef IN
#undef SEAM
}
static int g_grid = 0;
static void run_mega(hipStream_t stream, void* const* d_in, void* d_out, void* d_ws, int lo, int hi) {
    Args a{}; for (int i = 0; i < 24; ++i) a.in[i] = (const float*)d_in[i];
    a.out = (float*)d_out; a.ws = (unsigned char*)d_ws; a.ph_lo = lo; a.ph_hi = hi;
    hipLaunchKernelGGL(mega_fwd, dim3(g_grid), dim3(NWAVES * 64), LDS_BYTES, stream, a);
}

template <class Epi, bool DUAL = false>
static void run_gemm(hipStream_t s, const bf16* A, const bf16* Bt, int Mrows, int N, int K, const Epi& e) {
    hipLaunchKernelGGL((nv_gemm<Epi, DUAL>), dim3((N + 63) / 64, Mrows / 64), dim3(256), 0, s, A, Bt, Mrows, N, K, 0, e);
}
static void run_tr(hipStream_t s, const float* W, int K, int ldw, int col0, int ncols, bf16* WT) {
    hipLaunchKernelGGL(nv_transpose, dim3(ncols / 32, K / 32), dim3(256), 0, s, W, K, ldw, col0, ncols, WT);
}

extern "C" void kernel_launch(void* const* d_in, const int* in_sizes, int n_in, void* d_out, int out_size, void* d_ws, size_t ws_size, hipStream_t stream) {
    if (n_in != 24 || out_size != ML * D || ws_size < WS_END) { fprintf(stderr, "kernel_launch: unexpected sizes n_in %d out %d ws %zu\n", n_in, out_size, ws_size); return; }
    const float* x = (const float*)d_in[0]; const float* c = (const float*)d_in[1]; const float* ctx = (const float*)d_in[2]; const float* cctx = (const float*)d_in[3];
    const float* w_ada = (const float*)d_in[4]; const float* b_ada = (const float*)d_in[5]; const float* norm1_g = (const float*)d_in[6]; const float* w_in = (const float*)d_in[7];
    const float* ln_v_g = (const float*)d_in[8]; const float* ln_v_b = (const float*)d_in[9]; const float* w_sp = (const float*)d_in[10]; const float* b_sp = (const float*)d_in[11];
    const float* w_af = (const float*)d_in[12]; const float* b_af = (const float*)d_in[13]; const float* w_ab = (const float*)d_in[14]; const float* b_ab = (const float*)d_in[15];
    const float* gla_g = (const float*)d_in[16]; const float* w_ba = (const float*)d_in[17]; const float* w_bb = (const float*)d_in[18]; const float* w_out = (const float*)d_in[19];
    const float* norm2_g = (const float*)d_in[20]; const float* w_f1 = (const float*)d_in[21]; const float* w_f2 = (const float*)d_in[22]; const float* fin_g = (const float*)d_in[23];
    unsigned char* ws = (unsigned char*)d_ws; float* out = (float*)d_out;
    if (g_grid == 0) {
        int dev = 0, cus = 0, per_cu = 0;
        hipGetDevice(&dev); hipDeviceGetAttribute(&cus, hipDeviceAttributeMultiprocessorCount, dev);
        hipFuncSetAttribute((const void*)mega_fwd, hipFuncAttributeMaxDynamicSharedMemorySize, LDS_BYTES);
        hipOccupancyMaxActiveBlocksPerMultiprocessor(&per_cu, (const void*)mega_fwd, NWAVES * 64, LDS_BYTES);
        (void)hipGetLastError();
        if (per_cu < 1) fprintf(stderr, "kernel_launch: occupancy query says %d blocks/CU\n", per_cu);
        g_grid = cus;
    }
    bf16 *WT1A = (bf16*)(ws + WS_WT1A), *WTVV = (bf16*)(ws + WS_WTVV), *WT1B = (bf16*)(ws + WS_WT1B), *WTVA = (bf16*)(ws + WS_WTVA), *WTA = (bf16*)(ws + WS_WTA), *WTB = (bf16*)(ws + WS_WTB),
         *WTO = (bf16*)(ws + WS_WTO), *WTF1 = (bf16*)(ws + WS_WTF1), *WTF2 = (bf16*)(ws + WS_WTF2);
    float* MOD = (float*)(ws + WS_MOD); float* LNST = (float*)(ws + WS_LNST);
    bf16 *H = (bf16*)(ws + WS_H), *Q = (bf16*)(ws + WS_Q), *Kb = (bf16*)(ws + WS_K), *VVT = (bf16*)(ws + WS_VVT), *OF = (bf16*)(ws + WS_OF), *OB = (bf16*)(ws + WS_OB), *U = (bf16*)(ws + WS_U),
         *GVT = (bf16*)(ws + WS_GVT), *R = (bf16*)(ws + WS_R), *Y = (bf16*)(ws + WS_Y), *A2 = (bf16*)(ws + WS_A2), *HB = (bf16*)(ws + WS_HB);
    float *AF = (float*)(ws + WS_AF), *Y1 = (float*)(ws + WS_Y1), *X1 = (float*)(ws + WS_X1);
    bf16 *GA = (bf16*)d_out, *GB = (bf16*)d_out + (size_t)ML * D;
    hipMemsetAsync(ws + WS_CTL, 0, 1 * MiB, stream);
#ifndef MK_ONE_LAUNCH
#define MK_ONE_LAUNCH 1
#endif
    if (MK_ONE_LAUNCH) run_mega(stream, d_in, d_out, d_ws, 0, PH_END);
    else for (int p = 0; p < PH_END; ++p) run_mega(stream, d_in, d_out, d_ws, p, p + 1);
}
```

```cpp
#include <hip/hip_runtime.h>
#include <stdint.h>
#include <cstdio>

typedef unsigned short bf16;
__device__ __forceinline__ float bf2f(bf16 v) { return __uint_as_float(((unsigned)v) << 16); }
__device__ __forceinline__ bf16 f2bf(float f) { unsigned u = __float_as_uint(f); u += 0x7fffu + ((u >> 16) & 1u); return (bf16)(u >> 16); }

constexpr int NB = 8, T = 4096, D = 1024, TC = 256;
constexpr int ML = NB * T;
constexpr int MC = NB * TC;
constexpr int M = ML + MC;
constexpr int NH = 4, DK = 128, DV = 256, QKW = 512, VW = 1024, RANK = 16;
constexpr int DFF = 2816, NIN = 7200;
constexpr float EPS = 1e-6f;
constexpr int C_U = 0, C_VA = 1024, C_Q = 2048, C_K = 2560, C_VV = 3072, C_R = 4096, C_AF = 5120, C_GA = 5152, C_GB = 6176;

constexpr size_t MiB = 1u << 20;
constexpr size_t WS_CTL = 0;
constexpr size_t WS_ROWSS = 256 * 1024, WS_ROWSS2 = 512 * 1024;
constexpr size_t WS_MOD = 1 * MiB;
constexpr size_t WS_CV = WS_MOD + 256 * 1024;
constexpr size_t WS_LNST = 2 * MiB;
constexpr size_t WS_GV2 = WS_MOD + 512 * 1024;
constexpr size_t WS_WSPF = 3 * MiB;
constexpr size_t WS_WT1A = 4 * MiB;
constexpr size_t WS_WTVV = WS_WT1A + 1280 * 1024 * 2;
constexpr size_t WS_WT1B = WS_WTVV + 2 * MiB;
constexpr size_t WS_WTVA = WS_WT1B + 8 * MiB;
constexpr size_t WS_WTA = WS_WTVA + 2 * MiB, WS_WTB = WS_WTA + 2 * MiB, WS_WTO = WS_WTB + 2 * MiB;
constexpr size_t WS_WTF1 = WS_WTO + 2 * MiB;
constexpr size_t WS_WTF2 = WS_WTF1 + 11 * MiB;
static_assert(WS_WTF2 + (size_t)1024 * 2816 * 2 <= 48 * MiB, "weights region");
constexpr size_t WS_H = 48 * MiB;
constexpr size_t WS_Q = 116 * MiB;
constexpr size_t WS_K = 148 * MiB;
constexpr size_t WS_AF = 182 * MiB;
constexpr size_t WS_VVT = 188 * MiB;
constexpr size_t WS_PKG = 256 * MiB;
constexpr size_t WS_OF = 423 * MiB;
constexpr size_t WS_OB = 116 * MiB;
constexpr size_t WS_U = 188 * MiB;
constexpr size_t WS_GVT = 256 * MiB;
constexpr size_t WS_R = 320 * MiB;
constexpr size_t WS_Y1 = 256 * MiB;
constexpr size_t WS_Y = 48 * MiB;
constexpr size_t WS_X1 = 384 * MiB;
constexpr size_t WS_A2 = 116 * MiB;
constexpr size_t WS_HB = 180 * MiB;
constexpr size_t WS_END = 512 * MiB;

__global__ void nv_transpose(const float* __restrict__ W, int K, int ldw, int col0, int ncols, bf16* __restrict__ WT) {
    __shared__ float tile[32][33];
    const int k0 = blockIdx.y * 32, n0 = blockIdx.x * 32, tx = threadIdx.x & 31, ty = threadIdx.x >> 5;
    for (int i = ty; i < 32; i += 8) tile[i][tx] = W[(size_t)(k0 + i) * ldw + col0 + n0 + tx];
    __syncthreads();
    for (int i = ty; i < 32; i += 8) WT[(size_t)(n0 + i) * K + k0 + tx] = f2bf(tile[tx][i]);
}
__global__ void nv_zero_bf16(bf16* p, size_t n) { for (size_t i = (size_t)blockIdx.x * blockDim.x + threadIdx.x; i < n; i += (size_t)gridDim.x * blockDim.x) p[i] = 0; }

__global__ void nv_ada(const float* __restrict__ c, const float* __restrict__ cctx, const float* __restrict__ w_ada, const float* __restrict__ b_ada, float* __restrict__ MOD) {
    __shared__ float s[9][1024];
    for (int i = threadIdx.x; i < 9 * 1024; i += blockDim.x) { const int r = i >> 10, k = i & 1023; const float v = r < 8 ? c[r * 1024 + k] : cctx[k]; s[r][k] = v / (1.f + expf(-v)); }
    __syncthreads();
    const int n = blockIdx.x * blockDim.x + threadIdx.x;
    float acc[9];
    for (int r = 0; r < 9; ++r) acc[r] = 0.f;
    for (int k = 0; k < 1024; ++k) { const float w = w_ada[(size_t)k * 6144 + n];
#pragma unroll
        for (int r = 0; r < 9; ++r) acc[r] += s[r][k] * w; }
    for (int r = 0; r < 9; ++r) MOD[r * 6144 + n] = acc[r] + b_ada[n];
}

__device__ __forceinline__ float wave_sum(float v) {
#pragma unroll
    for (int o = 1; o < 64; o <<= 1) v += __shfl_xor(v, o);
    return v;
}
__global__ void nv_modnorm(const float* __restrict__ xl, const float* __restrict__ xc, const float* __restrict__ g, const float* __restrict__ MOD, int shoff, int scoff, bf16* __restrict__ out, int nrows, int pad_) {
    const int row = blockIdx.x * (blockDim.x >> 6) + (threadIdx.x >> 6), lane = threadIdx.x & 63;
    if (row >= nrows) return;
    const float* xr = row < ML ? xl + (size_t)row * D : xc + (size_t)(row - ML) * D;
    const int mr = row < ML ? row / T : 8;
    float v[16]; float ss = 0.f;
#pragma unroll
    for (int j = 0; j < 16; ++j) { v[j] = xr[lane + 64 * j]; ss += v[j] * v[j]; }
    const float rstd = rsqrtf(wave_sum(ss) * (1.f / D) + EPS);
#pragma unroll
    for (int j = 0; j < 16; ++j) { const int cidx = lane + 64 * j; const float y = v[j] * rstd * g[cidx];
        out[(size_t)row * D + cidx] = f2bf(y * (1.f + MOD[mr * 6144 + scoff + cidx]) + MOD[mr * 6144 + shoff + cidx]); }
}

template <class Epi, bool DUAL>
__global__ void __launch_bounds__(256) nv_gemm(const bf16* __restrict__ A, const bf16* __restrict__ Bt, int Mrows, int N, int K, int pad_, Epi epi) {
    __shared__ float As[32][65], Bs[32][65], Bs2[DUAL ? 32 : 1][65];
    const int tid = threadIdx.x, tx = tid & 15, ty = tid >> 4;
    const int m0 = blockIdx.y * 64, n0 = blockIdx.x * 64;
    float acc[4][4], acc2[4][4];
#pragma unroll
    for (int i = 0; i < 4; ++i)
#pragma unroll
        for (int j = 0; j < 4; ++j) { acc[i][j] = 0.f; acc2[i][j] = 0.f; }
    const int lr = tid >> 2, lk = (tid & 3) * 8;
    const int am = m0 + lr, bn = n0 + lr < N ? n0 + lr : N - 1;
    const bf16* ap = A + (size_t)am * K + lk;
    const bf16* bp = Bt + (size_t)epi.brow(bn) * K + lk;
    const bf16* bp2 = DUAL ? Bt + (size_t)epi.brow2(bn) * K + lk : bp;
    for (int k0 = 0; k0 < K; k0 += 32) {
        const uint4 av = *(const uint4*)(ap + k0), bv = *(const uint4*)(bp + k0);
        const unsigned aw[4] = {av.x, av.y, av.z, av.w}, bw[4] = {bv.x, bv.y, bv.z, bv.w};
#pragma unroll
        for (int j = 0; j < 4; ++j) { As[lk + 2 * j][lr] = __uint_as_float(aw[j] << 16); As[lk + 2 * j + 1][lr] = __uint_as_float(aw[j] & 0xffff0000u);
                                      Bs[lk + 2 * j][lr] = __uint_as_float(bw[j] << 16); Bs[lk + 2 * j + 1][lr] = __uint_as_float(bw[j] & 0xffff0000u); }
        if (DUAL) { const uint4 cv = *(const uint4*)(bp2 + k0); const unsigned cw[4] = {cv.x, cv.y, cv.z, cv.w};
#pragma unroll
            for (int j = 0; j < 4; ++j) { Bs2[lk + 2 * j][lr] = __uint_as_float(cw[j] << 16); Bs2[lk + 2 * j + 1][lr] = __uint_as_float(cw[j] & 0xffff0000u); } }
        __syncthreads();
#pragma unroll 8
        for (int k = 0; k < 32; ++k) {
            float a[4], b[4], b2[4];
#pragma unroll
            for (int i = 0; i < 4; ++i) { a[i] = As[k][ty * 4 + i]; b[i] = Bs[k][tx * 4 + i]; b2[i] = DUAL ? Bs2[k][tx * 4 + i] : 0.f; }
#pragma unroll
            for (int i = 0; i < 4; ++i)
#pragma unroll
                for (int j = 0; j < 4; ++j) { acc[i][j] += a[i] * b[j]; if (DUAL) acc2[i][j] += a[i] * b2[j]; }
        }
        __syncthreads();
    }
#pragma unroll
    for (int i = 0; i < 4; ++i)
#pragma unroll
        for (int j = 0; j < 4; ++j) { const int m = m0 + ty * 4 + i, n = n0 + tx * 4 + j; if (m < Mrows && n < N) epi(m, n, acc[i][j], acc2[i][j]); }
}
__device__ __forceinline__ float gelu_erf(float v) { return 0.5f * v * (1.f + erff(v * 0.70710678118654752f)); }
__device__ __forceinline__ float sigmoidf_(float v) { return 1.f / (1.f + expf(-v)); }
struct EpBase { __device__ int brow(int n) const { return n; } __device__ int brow2(int n) const { return n; } };
struct EpQ : EpBase { bf16* O; int ld; float sc; __device__ void operator()(int m, int n, float a, float) const { O[(size_t)m * ld + n] = f2bf(a * sc); } };
struct EpF32 : EpBase { float* O; int ld; int pad; __device__ void operator()(int m, int n, float a, float) const { O[(size_t)m * ld + n] = a; } };
struct EpT : EpBase { bf16* O; int ld; int act; __device__ void operator()(int m, int n, float a, float) const { O[(size_t)n * ld + m] = f2bf(act ? gelu_erf(a) : a); } };
struct EpAct : EpBase { bf16* O; int ld; int act; __device__ void operator()(int m, int n, float a, float) const { float v = act == 1 ? gelu_erf(a) : act == 2 ? a * sigmoidf_(a) : sigmoidf_(a); O[(size_t)m * ld + n] = f2bf(v); } };
struct EpY1 : EpBase { const bf16* G; float* Y1; __device__ void operator()(int m, int n, float a, float) const { Y1[(size_t)m * D + n] = bf2f(G[(size_t)m * D + n]) * a; } };
struct EpY : EpBase { const bf16* G; const float* Y1; bf16* Y; __device__ void operator()(int m, int n, float a, float) const { Y[(size_t)m * D + n] = f2bf(Y1[(size_t)m * D + n] + bf2f(G[(size_t)m * D + n]) * a); } };
struct EpRes : EpBase { const float* X; const float* MOD; float* O; int goff; int pad; __device__ void operator()(int m, int n, float a, float) const { O[(size_t)m * D + n] = X[(size_t)m * D + n] + MOD[(m / T) * 6144 + goff + n] * a; } };
struct EpSwi { bf16* O; __device__ int brow(int n) const { return 256 * (n >> 7) + (n & 127); } __device__ int brow2(int n) const { return 256 * (n >> 7) + 128 + (n & 127); }
    __device__ void operator()(int m, int n, float a, float g) const { O[(size_t)m * DFF + n] = f2bf(a * (g * sigmoidf_(g))); } };

__global__ void __launch_bounds__(256) nv_gla(const bf16* __restrict__ Q, const bf16* __restrict__ Kb, const float* __restrict__ AF, const bf16* __restrict__ VVT,
                                              const float* __restrict__ w_af, const float* __restrict__ b_af, const float* __restrict__ w_ab, const float* __restrict__ b_ab,
                                              bf16* __restrict__ OF, bf16* __restrict__ OB) {
    const int dir = blockIdx.x & 1, h = (blockIdx.x >> 1) & 3, b = blockIdx.x >> 3, tid = threadIdx.x;
    __shared__ float sa[128], sk[128], sq[128], wl[16][128], bl[128];
    const float* wsrc = dir ? w_ab : w_af; const float* bsrc = dir ? b_ab : b_af;
    for (int i = tid; i < 16 * 128; i += 256) wl[i >> 7][i & 127] = wsrc[(i >> 7) * QKW + h * DK + (i & 127)];
    if (tid < 128) bl[tid] = bsrc[h * DK + tid];
    float S[128];
#pragma unroll
    for (int i = 0; i < 128; ++i) S[i] = 0.f;
    bf16* O = dir ? OB : OF;
    const bf16* vrow = VVT + (size_t)(h * DV + tid) * M;
    __syncthreads();
    for (int step = 0; step < TC + T; ++step) {
        const bool isctx = step < TC;
        int row;
        if (isctx) row = ML + b * TC + (dir ? TC - 1 - step : step);
        else { const int t = step - TC; row = b * T + (dir ? T - 1 - t : t); }
        if (tid < 128) {
            float z = bl[tid];
#pragma unroll
            for (int r = 0; r < 16; ++r) z += AF[(size_t)row * 32 + dir * 16 + r] * wl[r][tid];
            const float ls = fminf(z, 0.f) - log1pf(expf(-fabsf(z)));
            sa[tid] = expf(ls * (1.f / 16.f));
            sk[tid] = bf2f(Kb[(size_t)row * QKW + h * DK + tid]);
            sq[tid] = isctx ? 0.f : bf2f(Q[(size_t)row * QKW + h * DK + tid]);
        }
        const float v = bf2f(vrow[row]);
        __syncthreads();
        float o = 0.f;
#pragma unroll
        for (int i = 0; i < 128; ++i) { S[i] = sa[i] * S[i] + sk[i] * v; o += sq[i] * S[i]; }
        if (!isctx) O[(size_t)row * VW + h * DV + tid] = f2bf(o);
        __syncthreads();
    }
}

__global__ void nv_lnstat(const bf16* __restrict__ GVT, float* __restrict__ ST) {
    const int t = blockIdx.x * blockDim.x + threadIdx.x;
    float s = 0.f, s2 = 0.f;
    for (int c = 0; c < 1024; ++c) { const float v = bf2f(GVT[(size_t)c * ML + t]); s += v; }
    const float mean = s * (1.f / 1024.f);
    for (int c = 0; c < 1024; ++c) { const float d = bf2f(GVT[(size_t)c * ML + t]) - mean; s2 += d * d; }
    ST[2 * t] = mean; ST[2 * t + 1] = rsqrtf(s2 * (1.f / 1024.f) + EPS);
}
__global__ void __launch_bounds__(256) nv_chunkmlp(bf16* __restrict__ U, const bf16* __restrict__ GVT, const float* __restrict__ ST, const float* __restrict__ lng, const float* __restrict__ lnb,
                                                   const float* __restrict__ wsp, const float* __restrict__ bsp) {
    extern __shared__ float vt[];
    const int ch = blockIdx.x, g = blockIdx.y, tok0 = ch * 128, tid = threadIdx.x;
    for (int i = tid; i < 128 * 128; i += 256) { const int c = i >> 7, q = i & 127; const int cc = g * 128 + c;
        const float v = bf2f(GVT[(size_t)cc * ML + tok0 + q]);
        vt[q * 128 + c] = (v - ST[2 * (tok0 + q)]) * ST[2 * (tok0 + q) + 1] * lng[cc] + lnb[cc]; }
    __syncthreads();
    const int c = tid & 127;
    for (int p = tid >> 7; p < 128; p += 2) {
        float acc = 0.f;
        const float* wr = wsp + ((size_t)g * 128 + p) * 128;
        for (int q = 0; q < 128; ++q) acc += wr[q] * vt[q * 128 + c];
        acc += bsp[g * 128 + p];
        const size_t o = (size_t)(tok0 + p) * D + g * 128 + c;
        U[o] = f2bf(bf2f(U[o]) * acc);
    }
}
__global__ void nv_glaout(bf16* __restrict__ OF, const bf16* __restrict__ OB, const bf16* __restrict__ R, const float* __restrict__ gain) {
    const int w = blockIdx.x * (blockDim.x >> 6) + (threadIdx.x >> 6), lane = threadIdx.x & 63;
    const int row = w >> 2, h = w & 3;
    float v[4]; float ss = 0.f;
#pragma unroll
    for (int j = 0; j < 4; ++j) { const size_t o = (size_t)row * VW + h * DV + lane + 64 * j; v[j] = bf2f(OF[o]) + bf2f(OB[o]); ss += v[j] * v[j]; }
    const float rstd = rsqrtf(wave_sum(ss) * (1.f / DV) + EPS);
#pragma unroll
    for (int j = 0; j < 4; ++j) { const int cidx = h * DV + lane + 64 * j; const size_t o = (size_t)row * VW + cidx; OF[o] = f2bf(v[j] * rstd * gain[cidx] * bf2f(R[o])); }
}
__global__ void nv_finalnorm(float* __restrict__ X, const float* __restrict__ g) {
    const int row = blockIdx.x * (blockDim.x >> 6) + (threadIdx.x >> 6), lane = threadIdx.x & 63;
    float v[16]; float ss = 0.f;
#pragma unroll
    for (int j = 0; j < 16; ++j) { v[j] = X[(size_t)row * D + lane + 64 * j]; ss += v[j] * v[j]; }
    const float rstd = rsqrtf(wave_sum(ss) * (1.f / D) + EPS);
#pragma unroll
    for (int j = 0; j < 16; ++j) X[(size_t)row * D + lane + 64 * j] = v[j] * rstd * g[lane + 64 * j];
}


namespace pg8 {
#define PG8_LAS __attribute__((address_space(3)))
typedef unsigned short bf16_t;
typedef short bf16x8 __attribute__((ext_vector_type(8)));
typedef float f32x4 __attribute__((ext_vector_type(4)));
typedef float f32x2 __attribute__((ext_vector_type(2)));
typedef unsigned u32x4 __attribute__((ext_vector_type(4)));
constexpr int BM = 256, BK = 64, HALF = 128, HTB = HALF * BK * 2, STAGE_BYTES = 8 * HTB;
__host__ __device__ __forceinline__ int lds_byte(int r, int c) { const int st = (r >> 4) * 2 + (c >> 5), rr = r & 15, cc = c & 31, ob = rr * 64 + cc * 2; return st * 1024 + (ob ^ (((ob >> 9) & 1) << 5)); }
__host__ __device__ __forceinline__ void stage_rc(int b, int& R, int& C) { const int st = b / 1024, sb = b % 1024, swz = sb ^ (((sb >> 9) & 1) << 5); R = (st >> 1) * 16 + swz / 64; C = (st & 1) * 32 + (swz % 64) / 2; }
__host__ __device__ __forceinline__ int perm32(int rho) { const int n = rho >> 4, i = rho & 15; return 8 * (i >> 2) + 4 * n + (i & 3); }
struct Unit { const char* pA; const char* pB; char* pO; int ldc, act, aux, pm, pn; };
__device__ __forceinline__ unsigned cvt_pk_bf16(float lo, float hi) { typedef __bf16 v2bf __attribute__((ext_vector_type(2))); typedef float v2f __attribute__((ext_vector_type(2)));
    const v2f x = {lo, hi}; const v2bf y = __builtin_convertvector(x, v2bf); return __builtin_bit_cast(unsigned, y); }
__device__ __forceinline__ f32x2 gelu_pk(f32x2 v) {
    const f32x2 av = __builtin_elementwise_abs(v), d = av * 0.2316418882f + 1.0f;
    f32x2 t; t.x = __builtin_amdgcn_rcpf(d.x); t.y = __builtin_amdgcn_rcpf(d.y);
    f32x2 q = t * 0.5307027145f + (-0.7265760135f); q = q * t + 0.7107068705f; q = q * t + (-0.142248368f); q = q * t + 0.127414796f; q = q * t;
    const f32x2 s = (v * v) * (-0.72134752044f);
    f32x2 e; e.x = __builtin_amdgcn_exp2f(s.x); e.y = __builtin_amdgcn_exp2f(s.y);
    const f32x2 m = v * (q * e), r = v - m;
    f32x2 o; o.x = v.x < 0.f ? m.x : r.x; o.y = v.y < 0.f ? m.y : r.y; return o;
}
__device__ __forceinline__ float sigm(float x) { return __builtin_amdgcn_rcpf(1.0f + __builtin_amdgcn_exp2f(x * -1.44269504089f)); }
__device__ __forceinline__ int xcd_remap(int L, int nwg) { const int q = nwg / 8, r = nwg % 8, xcd = L % 8, off = L / 8; return (xcd < r ? xcd * (q + 1) : r * (q + 1) + (xcd - r) * q) + off; }

template <class Epi, class Sched, bool ALIGN_EPI, bool SP2>
__device__ __forceinline__ void gemm_phase(PG8_LAS unsigned char* lds, const int K, const Sched& S, const Epi& E) {
    const int tid = threadIdx.x, wid = __builtin_amdgcn_readfirstlane(tid >> 6), lane = tid & 63, wr = wid >> 2, wc = wid & 3, fr = lane & 15, fq = lane >> 4;
    const int nt = K / BK;
    unsigned voffA[2], voffB[2];
#pragma unroll
    for (int i = 0; i < 2; ++i) { int R, C; stage_rc(tid * 16 + i * 8192, R, C); const int Rb = (R & ~31) + perm32(R & 31);
        voffA[i] = (unsigned)(R * K + C) * 2u; voffB[i] = (unsigned)(Rb * K + C) * 2u; }
    const size_t kstep = (size_t)(BK * 2);
    const size_t hstep = (size_t)HALF * K * 2;
    const unsigned ldsw = (unsigned)wid * 1024u;
    const int aoff = lds_byte(wr * 64 + fr, fq * 8), boff = lds_byte(wc * 32 + fr, fq * 8);
#define PG8_SA(b, h) (((b) * 2 + (h)) * HTB)
#define PG8_SB(b, h) ((4 + (b) * 2 + (h)) * HTB)
#define PG8_STAGE(bufoff, gbase, voff) do { _Pragma("unroll") for (int _i = 0; _i < 2; ++_i) \
        __builtin_amdgcn_global_load_lds((const unsigned*)((const char*)(gbase) + (voff)[_i]), (PG8_LAS unsigned*)(lds + (bufoff) + ldsw + _i * 8192), 16, 0, 0); } while (0)
#define PG8_LDA(dst, b, h) do { _Pragma("unroll") for (int m = 0; m < 4; ++m) _Pragma("unroll") for (int k = 0; k < 2; ++k) dst[m][k] = *(const PG8_LAS bf16x8*)(lds + PG8_SA(b, h) + aoff + m * 2048 + k * 1024); } while (0)
#define PG8_LDB(dst, b, h) do { _Pragma("unroll") for (int n = 0; n < 2; ++n) _Pragma("unroll") for (int k = 0; k < 2; ++k) dst[n][k] = *(const PG8_LAS bf16x8*)(lds + PG8_SB(b, h) + boff + n * 2048 + k * 1024); } while (0)
#define PG8_MMA(ai, bj, At, Bt) do { __builtin_amdgcn_s_setprio(1); _Pragma("unroll") for (int m = 0; m < 4; ++m) _Pragma("unroll") for (int n = 0; n < 2; ++n) _Pragma("unroll") for (int k = 0; k < 2; ++k) \
        acc[ai][bj][m][n] = __builtin_amdgcn_mfma_f32_16x16x32_bf16(Bt[n][k], At[m][k], acc[ai][bj][m][n], 0, 0, 0); __builtin_amdgcn_s_setprio(0); } while (0)
#define PG8_WAIT_V(n) asm volatile("s_waitcnt vmcnt(" #n ")" ::: "memory")
#define PG8_WAIT_L(n) asm volatile("s_waitcnt lgkmcnt(" #n ")" ::: "memory")
#define PG8_BAR __builtin_amdgcn_s_barrier()
#define PG8_SCHED __builtin_amdgcn_sched_barrier(0)
    Unit cur, nxt; int ui = 0;
    if (!S.next(0, cur)) return;
    f32x4 acc[2][2][4][2];
#pragma unroll
    for (int a = 0; a < 2; ++a)
#pragma unroll
        for (int b = 0; b < 2; ++b)
#pragma unroll
            for (int m = 0; m < 4; ++m)
#pragma unroll
                for (int n = 0; n < 2; ++n) acc[a][b][m][n] = (f32x4){0.f, 0.f, 0.f, 0.f};
    bf16x8 At[4][2], B0[2][2], B1[2][2];
    const char* cA = cur.pA; const char* cB = cur.pB;
    if constexpr (SP2) {
        PG8_STAGE(PG8_SB(0, 0), cB, voffB); PG8_STAGE(PG8_SB(0, 1), cB + hstep, voffB); PG8_STAGE(PG8_SA(0, 0), cA, voffA); PG8_STAGE(PG8_SA(0, 1), cA + hstep, voffA);
        if (wr == 1) PG8_BAR;
        PG8_WAIT_V(2); PG8_BAR;
        PG8_STAGE(PG8_SB(1, 0), cB + kstep, voffB); PG8_STAGE(PG8_SA(1, 0), cA + kstep, voffA); PG8_STAGE(PG8_SB(1, 1), cB + hstep + kstep, voffB);
        PG8_WAIT_V(6); PG8_BAR;
    } else {
        PG8_STAGE(PG8_SB(0, 0), cB, voffB); PG8_STAGE(PG8_SA(0, 0), cA, voffA); PG8_STAGE(PG8_SB(0, 1), cB + hstep, voffB); PG8_STAGE(PG8_SA(0, 1), cA + hstep, voffA);
        if (wr == 1) PG8_BAR;
        PG8_WAIT_V(4); PG8_BAR;
        PG8_STAGE(PG8_SB(1, 0), cB + kstep, voffB); PG8_STAGE(PG8_SA(1, 0), cA + kstep, voffA); PG8_STAGE(PG8_SB(1, 1), cB + hstep + kstep, voffB);
        PG8_WAIT_V(6); PG8_BAR;
    }
    for (;;) {
        const bool has_next = S.next(ui + 1, nxt);
        const char* nA = has_next ? nxt.pA : cA; const char* nB = has_next ? nxt.pB : cB;
        for (int t = 0; t < nt; t += 2) {
            const bool last = (t == nt - 2);
            const char* a1 = cA + (size_t)(t + 1) * kstep;
            const char* a2 = last ? nA : cA + (size_t)(t + 2) * kstep; const char* b2 = last ? nB : cB + (size_t)(t + 2) * kstep;
            const char* a3 = a2 + kstep; const char* b3 = b2 + kstep;
            if constexpr (SP2) {
            PG8_LDB(B0, 0, 0); PG8_LDB(B1, 0, 1); PG8_SCHED; PG8_LDA(At, 0, 0); PG8_STAGE(PG8_SA(1, 1), a1 + hstep, voffA);
            PG8_WAIT_V(8); PG8_WAIT_L(0); PG8_BAR; PG8_MMA(0, 0, At, B0); PG8_MMA(0, 1, At, B1); PG8_BAR; PG8_SCHED;
            PG8_LDA(At, 0, 1); PG8_STAGE(PG8_SB(0, 0), b2, voffB); PG8_STAGE(PG8_SB(0, 1), b2 + hstep, voffB); PG8_STAGE(PG8_SA(0, 0), a2, voffA);
            PG8_WAIT_V(8); PG8_WAIT_L(0); PG8_BAR; PG8_MMA(1, 0, At, B0); PG8_MMA(1, 1, At, B1); PG8_BAR; PG8_SCHED;
            PG8_LDB(B0, 1, 0); PG8_LDB(B1, 1, 1); PG8_SCHED; PG8_LDA(At, 1, 0); PG8_STAGE(PG8_SA(0, 1), a2 + hstep, voffA);
            PG8_WAIT_V(8); PG8_WAIT_L(0); PG8_BAR; PG8_MMA(0, 0, At, B0); PG8_MMA(0, 1, At, B1); PG8_BAR; PG8_SCHED;
            PG8_LDA(At, 1, 1); PG8_STAGE(PG8_SB(1, 0), b3, voffB); PG8_STAGE(PG8_SB(1, 1), b3 + hstep, voffB); PG8_STAGE(PG8_SA(1, 0), a3, voffA);
            PG8_WAIT_V(8); PG8_WAIT_L(0); PG8_BAR; PG8_MMA(1, 0, At, B0); PG8_MMA(1, 1, At, B1); PG8_BAR; PG8_SCHED;
            } else {
            PG8_LDB(B0, 0, 0); PG8_SCHED; PG8_LDA(At, 0, 0); PG8_STAGE(PG8_SA(1, 1), a1 + hstep, voffA);
            PG8_WAIT_L(8); PG8_BAR; PG8_WAIT_L(0); PG8_MMA(0, 0, At, B0); PG8_BAR; PG8_SCHED;
            PG8_LDB(B1, 0, 1); PG8_STAGE(PG8_SB(0, 0), b2, voffB);
            PG8_BAR; PG8_WAIT_L(0); PG8_MMA(0, 1, At, B1); PG8_BAR;
            PG8_LDA(At, 0, 1); PG8_STAGE(PG8_SA(0, 0), a2, voffA);
            PG8_BAR; PG8_WAIT_L(0); PG8_MMA(1, 0, At, B0); PG8_BAR; PG8_SCHED;
            PG8_STAGE(PG8_SB(0, 1), b2 + hstep, voffB);
            PG8_WAIT_V(6); PG8_BAR; PG8_MMA(1, 1, At, B1); PG8_BAR;
            PG8_LDB(B0, 1, 0); PG8_SCHED; PG8_LDA(At, 1, 0); PG8_STAGE(PG8_SA(0, 1), a2 + hstep, voffA);
            PG8_WAIT_L(8); PG8_BAR; PG8_WAIT_L(0); PG8_MMA(0, 0, At, B0); PG8_BAR; PG8_SCHED;
            PG8_LDB(B1, 1, 1); PG8_STAGE(PG8_SB(1, 0), b3, voffB);
            PG8_BAR; PG8_WAIT_L(0); PG8_MMA(0, 1, At, B1); PG8_BAR;
            PG8_LDA(At, 1, 1); PG8_STAGE(PG8_SA(1, 0), a3, voffA);
            PG8_BAR; PG8_WAIT_L(0); PG8_MMA(1, 0, At, B0); PG8_BAR; PG8_SCHED;
            PG8_STAGE(PG8_SB(1, 1), b3 + hstep, voffB);
            PG8_WAIT_V(6); PG8_BAR; PG8_MMA(1, 1, At, B1); PG8_BAR;
            }
        }
        if constexpr (ALIGN_EPI) { if (wr == 0) PG8_BAR; }
        bool keep = false;
        if constexpr (Epi::CHAIN) { E.chain(acc, cur, wr, wc, fr, fq); keep = Epi::KEEP && (cur.aux == 0); } else E(acc, cur, wr, wc, fr, fq);
        if (!has_next) break;
        if (!keep) {
#pragma unroll
        for (int a = 0; a < 2; ++a)
#pragma unroll
            for (int b = 0; b < 2; ++b)
#pragma unroll
                for (int m = 0; m < 4; ++m)
#pragma unroll
                    for (int n = 0; n < 2; ++n) acc[a][b][m][n] = (f32x4){0.f, 0.f, 0.f, 0.f};
        }
        cur = nxt; cA = nA; cB = nB; ++ui;
        if constexpr (ALIGN_EPI) { if (wr == 1) PG8_BAR; }
    }
    PG8_WAIT_V(0);
    if constexpr (!ALIGN_EPI) { if (wr == 0) PG8_BAR; }
    PG8_BAR;
#undef PG8_SA
#undef PG8_SB
#undef PG8_STAGE
#undef PG8_LDA
#undef PG8_LDB
#undef PG8_MMA
#undef PG8_WAIT_V
#undef PG8_WAIT_L
#undef PG8_BAR
#undef PG8_SCHED
}

enum Act { ACT_NONE = 0, ACT_GELU = 1, ACT_SILU = 2, ACT_SIGM = 3, ACT_QSC = 4, ACT_AF32 = 5, ACT_VT = 6 };
struct EpiAct { static constexpr bool CHAIN = false;
    template <int ACT> __device__ __forceinline__ void run(const f32x4 (&acc)[2][2][4][2], const Unit& u, int r0, int c0) const {
        bf16_t* O = (bf16_t*)u.pO; if (ACT == ACT_VT) c0 = (c0 >> 6) * 65536 + (c0 & 63);
#pragma unroll
        for (int ai = 0; ai < 2; ++ai)
#pragma unroll
            for (int m = 0; m < 4; ++m) { bf16_t* rowp = O + (size_t)(r0 + ai * HALF + m * 16) * u.ldc + c0;
#pragma unroll
                for (int bj = 0; bj < 2; ++bj) { f32x4 v0 = acc[ai][bj][m][0], v1 = acc[ai][bj][m][1];
                    if (ACT == ACT_GELU) { f32x2 a = gelu_pk((f32x2){v0[0], v0[1]}), b = gelu_pk((f32x2){v0[2], v0[3]}), c = gelu_pk((f32x2){v1[0], v1[1]}), d = gelu_pk((f32x2){v1[2], v1[3]});
                        v0 = (f32x4){a.x, a.y, b.x, b.y}; v1 = (f32x4){c.x, c.y, d.x, d.y}; }
                    if (ACT == ACT_SILU) {
#pragma unroll
                        for (int j = 0; j < 4; ++j) { v0[j] = v0[j] * sigm(v0[j]); v1[j] = v1[j] * sigm(v1[j]); } }
                    if (ACT == ACT_SIGM) {
#pragma unroll
                        for (int j = 0; j < 4; ++j) { v0[j] = sigm(v0[j]); v1[j] = sigm(v1[j]); } }
                    if (ACT == ACT_QSC) { v0 = v0 * 0.08838834764831845f; v1 = v1 * 0.08838834764831845f; }
                    u32x4 w; w.x = cvt_pk_bf16(v0[0], v0[1]); w.y = cvt_pk_bf16(v0[2], v0[3]); w.z = cvt_pk_bf16(v1[0], v1[1]); w.w = cvt_pk_bf16(v1[2], v1[3]);
                    *(u32x4*)(rowp + (ACT == ACT_VT ? bj * 2 * 65536 : bj * HALF)) = w; } }
    }
    __device__ __forceinline__ void operator()(const f32x4 (&acc)[2][2][4][2], const Unit& u, int wr, int wc, int fr, int fq) const {
        const int r0 = wr * 64 + fr, c0 = wc * 32 + 8 * fq;
        switch (u.act) {
        case ACT_NONE: run<ACT_NONE>(acc, u, r0, c0); break;
        case ACT_GELU: run<ACT_GELU>(acc, u, r0, c0); break;
        case ACT_SILU: run<ACT_SILU>(acc, u, r0, c0); break;
        case ACT_SIGM: run<ACT_SIGM>(acc, u, r0, c0); break;
        case ACT_QSC:  run<ACT_QSC>(acc, u, r0, c0); break;
        case ACT_VT:   run<ACT_VT>(acc, u, r0, c0); break;
        default:
            if (wc == 0) { float* O = (float*)u.pO;
#pragma unroll
                for (int ai = 0; ai < 2; ++ai)
#pragma unroll
                    for (int m = 0; m < 4; ++m) { float* rowp = O + (size_t)(r0 + ai * HALF + m * 16) * u.ldc + 8 * fq;
                        *(f32x4*)rowp = acc[ai][0][m][0]; *(f32x4*)(rowp + 4) = acc[ai][0][m][1]; } }
            break;
        }
    }
};
struct EpiMrg { static constexpr bool CHAIN = true, KEEP = true; const bf16_t* GA; const bf16_t* GB; bf16_t* Y;
    __device__ __forceinline__ void chain(f32x4 (&acc)[2][2][4][2], const Unit& u, int wr, int wc, int fr, int fq) const {
        const size_t o0 = (size_t)(u.pm * BM + wr * 64 + fr) * 1024 + u.pn * BM + wc * 32 + 8 * fq;
        if (u.aux == 0) {
#pragma unroll
            for (int ai = 0; ai < 2; ++ai)
#pragma unroll
                for (int m = 0; m < 4; ++m)
#pragma unroll
                    for (int bj = 0; bj < 2; ++bj) { const size_t o = o0 + (size_t)(ai * HALF + m * 16) * 1024 + bj * HALF;
                        const u32x4 a = *(const u32x4*)(GA + o), b = *(const u32x4*)(GB + o);
                        const unsigned aw[4] = {a.x, a.y, a.z, a.w}, bw[4] = {b.x, b.y, b.z, b.w};
#pragma unroll
                        for (int e = 0; e < 4; ++e) { const float r0 = __uint_as_float(aw[e] << 16) * __builtin_amdgcn_rcpf(__uint_as_float(bw[e] << 16)), r1 = __uint_as_float(aw[e] & 0xffff0000u) * __builtin_amdgcn_rcpf(__uint_as_float(bw[e] & 0xffff0000u));
                            if (e < 2) { acc[ai][bj][m][0][2 * e] *= r0; acc[ai][bj][m][0][2 * e + 1] *= r1; } else { acc[ai][bj][m][1][2 * e - 4] *= r0; acc[ai][bj][m][1][2 * e - 3] *= r1; } } }
        } else {
#pragma unroll
            for (int ai = 0; ai < 2; ++ai)
#pragma unroll
                for (int m = 0; m < 4; ++m)
#pragma unroll
                    for (int bj = 0; bj < 2; ++bj) { const size_t o = o0 + (size_t)(ai * HALF + m * 16) * 1024 + bj * HALF;
                        const u32x4 g = *(const u32x4*)(GB + o);
                        f32x4 v0 = acc[ai][bj][m][0], v1 = acc[ai][bj][m][1];
                        v0[0] *= __uint_as_float(g.x << 16); v0[1] *= __uint_as_float(g.x & 0xffff0000u); v0[2] *= __uint_as_float(g.y << 16); v0[3] *= __uint_as_float(g.y & 0xffff0000u);
                        v1[0] *= __uint_as_float(g.z << 16); v1[1] *= __uint_as_float(g.z & 0xffff0000u); v1[2] *= __uint_as_float(g.w << 16); v1[3] *= __uint_as_float(g.w & 0xffff0000u);
                        u32x4 w; w.x = cvt_pk_bf16(v0[0], v0[1]); w.y = cvt_pk_bf16(v0[2], v0[3]); w.z = cvt_pk_bf16(v1[0], v1[1]); w.w = cvt_pk_bf16(v1[2], v1[3]);
                        *(u32x4*)(Y + o) = w; }
        }
    }
};
struct EpiRes { const float* X; static constexpr bool CHAIN = false; const float* MOD; float* O; int goff;
    __device__ __forceinline__ void operator()(const f32x4 (&acc)[2][2][4][2], const Unit& u, int wr, int wc, int fr, int fq) const {
        const int cb = u.pn * BM + wc * 32 + 8 * fq; const size_t o0 = (size_t)(u.pm * BM + wr * 64 + fr) * 1024 + cb;
        const float* gp = MOD + ((u.pm * BM) / T) * 6144 + goff + cb;
        f32x4 g[2][2];
#pragma unroll
        for (int bj = 0; bj < 2; ++bj) { g[bj][0] = *(const f32x4*)(gp + bj * HALF); g[bj][1] = *(const f32x4*)(gp + bj * HALF + 4); }
#pragma unroll
        for (int ai = 0; ai < 2; ++ai)
#pragma unroll
            for (int m = 0; m < 4; ++m)
#pragma unroll
                for (int bj = 0; bj < 2; ++bj) { const size_t o = o0 + (size_t)(ai * HALF + m * 16) * 1024 + bj * HALF;
                    const f32x4 x0 = *(const f32x4*)(X + o), x1 = *(const f32x4*)(X + o + 4);
                    *(f32x4*)(O + o) = x0 + g[bj][0] * acc[ai][bj][m][0]; *(f32x4*)(O + o + 4) = x1 + g[bj][1] * acc[ai][bj][m][1]; }
    }
};
struct EpiFin { static constexpr bool CHAIN = true, KEEP = false; const float* X1; const float* MOD; const float* FG; float* O; unsigned long long* ROWSS2; unsigned* CNT;
    __device__ __forceinline__ void chain(f32x4 (&acc)[2][2][4][2], const Unit& u, int wr, int wc, int fr, int fq) const {
        const int cb = u.pn * BM + wc * 32 + 8 * fq, r0 = u.pm * BM + wr * 64 + fr; const size_t o0 = (size_t)r0 * 1024 + cb;
        const float* gp = MOD + ((u.pm * BM) / T) * 6144 + 5120 + cb;
        {   f32x4 g[2][2];
#pragma unroll
            for (int bj = 0; bj < 2; ++bj) { g[bj][0] = *(const f32x4*)(gp + bj * HALF); g[bj][1] = *(const f32x4*)(gp + bj * HALF + 4); }
#pragma unroll
            for (int ai = 0; ai < 2; ++ai)
#pragma unroll
                for (int m = 0; m < 4; ++m) { float ss = 0.f;
#pragma unroll
                    for (int bj = 0; bj < 2; ++bj) { const size_t o = o0 + (size_t)(ai * HALF + m * 16) * 1024 + bj * HALF;
                        const f32x4 x0 = *(const f32x4*)(X1 + o) + g[bj][0] * acc[ai][bj][m][0], x1 = *(const f32x4*)(X1 + o + 4) + g[bj][1] * acc[ai][bj][m][1];
                        acc[ai][bj][m][0] = x0; acc[ai][bj][m][1] = x1;
                        ss += (x0[0] * x0[0] + x0[1] * x0[1]) + (x0[2] * x0[2] + x0[3] * x0[3]) + (x1[0] * x1[0] + x1[1] * x1[1]) + (x1[2] * x1[2] + x1[3] * x1[3]); }
                    ss += __shfl_xor(ss, 16); ss += __shfl_xor(ss, 32);
                    if (fq == 0) atomicAdd(ROWSS2 + r0 + ai * HALF + m * 16, (unsigned long long)(ss * 1073741824.0f));
                    asm volatile("" ::: "memory"); }
        }
        asm volatile("s_waitcnt vmcnt(0)" ::: "memory");
        unsigned* cnt = CNT + 64 * u.pm;
        if ((threadIdx.x & 63) == 0) __hip_atomic_fetch_add(cnt, 1u, __ATOMIC_RELAXED, __HIP_MEMORY_SCOPE_AGENT);
        {   unsigned spins = 0;
            while ((unsigned)__builtin_amdgcn_readfirstlane(__hip_atomic_load(cnt, __ATOMIC_RELAXED, __HIP_MEMORY_SCOPE_AGENT)) < 32u) { __builtin_amdgcn_s_sleep(2); if (++spins > (1u << 22)) break; }
            __builtin_amdgcn_fence(__ATOMIC_ACQUIRE, "agent"); }
        f32x4 fg[2][2];
#pragma unroll
        for (int bj = 0; bj < 2; ++bj) { fg[bj][0] = *(const f32x4*)(FG + cb + bj * HALF); fg[bj][1] = *(const f32x4*)(FG + cb + bj * HALF + 4); }
#pragma unroll
        for (int ai = 0; ai < 2; ++ai)
#pragma unroll
            for (int m = 0; m < 4; ++m) { const unsigned long long tot = __hip_atomic_load(ROWSS2 + r0 + ai * HALF + m * 16, __ATOMIC_RELAXED, __HIP_MEMORY_SCOPE_AGENT);
                const float rs = __builtin_amdgcn_rsqf((float)tot * (1.0f / (1073741824.0f * 1024.0f)) + EPS);
#pragma unroll
                for (int bj = 0; bj < 2; ++bj) { const size_t o = o0 + (size_t)(ai * HALF + m * 16) * 1024 + bj * HALF;
                    *(f32x4*)(O + o) = acc[ai][bj][m][0] * rs * fg[bj][0]; *(f32x4*)(O + o + 4) = acc[ai][bj][m][1] * rs * fg[bj][1]; } }
    }
};
struct EpiSwi { bf16_t* HBp; static constexpr bool CHAIN = false;
    __device__ __forceinline__ void operator()(const f32x4 (&acc)[2][2][4][2], const Unit& u, int wr, int wc, int fr, int fq) const {
        const size_t o0 = (size_t)(u.pm * BM + wr * 64 + fr) * DFF + u.pn * HALF + wc * 32 + 8 * fq;
#pragma unroll
        for (int ai = 0; ai < 2; ++ai)
#pragma unroll
            for (int m = 0; m < 4; ++m) { const f32x4 a0 = acc[ai][0][m][0], a1 = acc[ai][0][m][1], g0 = acc[ai][1][m][0], g1 = acc[ai][1][m][1]; f32x4 v0, v1;
#pragma unroll
                for (int j = 0; j < 4; ++j) { v0[j] = a0[j] * g0[j] * sigm(g0[j]); v1[j] = a1[j] * g1[j] * sigm(g1[j]); }
                u32x4 w; w.x = cvt_pk_bf16(v0[0], v0[1]); w.y = cvt_pk_bf16(v0[2], v0[3]); w.z = cvt_pk_bf16(v1[0], v1[1]); w.w = cvt_pk_bf16(v1[2], v1[3]);
                *(u32x4*)(HBp + o0 + (size_t)(ai * HALF + m * 16) * DFF) = w; }
    }
};

struct EpiRes2 { static constexpr bool CHAIN = false; const float* X; const float* MOD; const float* GV2; float* X1; bf16_t* A2; unsigned long long* ROWSS;
    __device__ __forceinline__ void operator()(const f32x4 (&acc)[2][2][4][2], const Unit& u, int wr, int wc, int fr, int fq) const {
        const int cb = u.pn * BM + wc * 32 + 8 * fq, bidx = (u.pm * BM) / T; const int r0 = u.pm * BM + wr * 64 + fr; const size_t o0 = (size_t)r0 * 1024 + cb;
        const float* gp = MOD + bidx * 6144 + 2048 + cb; const float* vp = GV2 + bidx * 1024 + cb;
        f32x4 g[2][2], gv[2][2];
#pragma unroll
        for (int bj = 0; bj < 2; ++bj) { g[bj][0] = *(const f32x4*)(gp + bj * HALF); g[bj][1] = *(const f32x4*)(gp + bj * HALF + 4); gv[bj][0] = *(const f32x4*)(vp + bj * HALF); gv[bj][1] = *(const f32x4*)(vp + bj * HALF + 4); }
#pragma unroll
        for (int ai = 0; ai < 2; ++ai)
#pragma unroll
            for (int m = 0; m < 4; ++m) { float ss = 0.f;
#pragma unroll
                for (int bj = 0; bj < 2; ++bj) { const size_t o = o0 + (size_t)(ai * HALF + m * 16) * 1024 + bj * HALF;
                    const f32x4 x0 = *(const f32x4*)(X + o) + g[bj][0] * acc[ai][bj][m][0], x1 = *(const f32x4*)(X + o + 4) + g[bj][1] * acc[ai][bj][m][1];
                    *(f32x4*)(X1 + o) = x0; *(f32x4*)(X1 + o + 4) = x1;
                    ss += (x0[0] * x0[0] + x0[1] * x0[1]) + (x0[2] * x0[2] + x0[3] * x0[3]) + (x1[0] * x1[0] + x1[1] * x1[1]) + (x1[2] * x1[2] + x1[3] * x1[3]);
                    const f32x4 a0 = x0 * gv[bj][0], a1 = x1 * gv[bj][1];
                    u32x4 w; w.x = cvt_pk_bf16(a0[0], a0[1]); w.y = cvt_pk_bf16(a0[2], a0[3]); w.z = cvt_pk_bf16(a1[0], a1[1]); w.w = cvt_pk_bf16(a1[2], a1[3]);
                    *(u32x4*)(A2 + o) = w; }
                ss += __shfl_xor(ss, 16); ss += __shfl_xor(ss, 32);
                if (fq == 0) atomicAdd(ROWSS + r0 + ai * HALF + m * 16, (unsigned long long)(ss * 1073741824.0f)); }
    }
};
struct EpiSwi2 { static constexpr bool CHAIN = false; bf16_t* HBp; const unsigned long long* ROWSS; const float* CV;
    __device__ __forceinline__ void operator()(const f32x4 (&acc)[2][2][4][2], const Unit& u, int wr, int wc, int fr, int fq) const {
        const int r0 = u.pm * BM + wr * 64 + fr, cc = u.pn * HALF + wc * 32 + 8 * fq, bidx = (u.pm * BM) / T;
        const size_t o0 = (size_t)r0 * DFF + cc;
        const float* cp = CV + bidx * (2 * DFF) + cc;
        const f32x4 ca0 = *(const f32x4*)cp, ca1 = *(const f32x4*)(cp + 4), cg0 = *(const f32x4*)(cp + DFF), cg1 = *(const f32x4*)(cp + DFF + 4);
#pragma unroll
        for (int ai = 0; ai < 2; ++ai)
#pragma unroll
            for (int m = 0; m < 4; ++m) { const float rs = __builtin_amdgcn_rsqf((float)ROWSS[r0 + ai * HALF + m * 16] * (1.0f / (1073741824.0f * 1024.0f)) + EPS);
                const f32x4 a0 = acc[ai][0][m][0] * rs + ca0, a1 = acc[ai][0][m][1] * rs + ca1, g0 = acc[ai][1][m][0] * rs + cg0, g1 = acc[ai][1][m][1] * rs + cg1; f32x4 v0, v1;
#pragma unroll
                for (int j = 0; j < 4; ++j) { v0[j] = a0[j] * g0[j] * sigm(g0[j]); v1[j] = a1[j] * g1[j] * sigm(g1[j]); }
                u32x4 w; w.x = cvt_pk_bf16(v0[0], v0[1]); w.y = cvt_pk_bf16(v0[2], v0[3]); w.z = cvt_pk_bf16(v1[0], v1[1]); w.w = cvt_pk_bf16(v1[2], v1[3]);
                *(u32x4*)(HBp + o0 + (size_t)(ai * HALF + m * 16) * DFF) = w; }
    }
};
struct OrderGrid { const char* A; const char* Bt; int nM, nN, K, G, c;
    __device__ __forceinline__ bool next(int i, Unit& u) const {
        const int nwg = nM * nN; const long L = (long)i * G + c; if (L >= nwg) return false;
        const int w = xcd_remap((int)L, nwg);
        const int nig = 8 * nN, gid = w / nig, fm = gid * 8, gsz = (nM - fm) < 8 ? (nM - fm) : 8;
        u.pm = fm + ((w % nig) % gsz); u.pn = (w % nig) / gsz;
        u.pA = A + (size_t)u.pm * 256 * K * 2; u.pB = Bt + (size_t)u.pn * 256 * K * 2; u.pO = nullptr; u.ldc = 0; u.act = 0; u.aux = 0; return true;
    }
};
struct OrderMrg { const char* A0; const char* B0; const char* A1; const char* B1; int G, c;
    __device__ __forceinline__ bool next(int i, Unit& u) const {
        constexpr int nM = 128, nN = 4, nwg = nM * nN; const long L = (long)(i >> 1) * G + c; if (L >= nwg) return false;
        const int w = xcd_remap((int)L, nwg);
        const int nig = 8 * nN, gid = w / nig, fm = gid * 8;
        u.pm = fm + ((w % nig) & 7); u.pn = (w % nig) >> 3; u.aux = i & 1;
        u.pA = ((i & 1) ? A1 : A0) + (size_t)u.pm * 256 * 1024 * 2; u.pB = ((i & 1) ? B1 : B0) + (size_t)u.pn * 256 * 1024 * 2; u.pO = nullptr; u.ldc = 0; u.act = 0; return true;
    }
};
struct Order1A { const char* H; const char* WT1A; const char* WTVV; char* Q; char* Kb; char* AFp; char* VVT; int G, c;
    __device__ __forceinline__ bool next(int i, Unit& u) const {
        constexpr int NWG = 1208; const long L = (long)i * G + c; if (L >= NWG) return false;
        int w = xcd_remap((int)L, NWG);
        int tok, col; bool swapped;
        if (w < 640) { const int gid = w / 40, r = w % 40; tok = gid * 8 + (r & 7); col = r >> 3; swapped = false; }
        else if (w < 1152) { w -= 640; const int gid = w / 32, r = w & 31; tok = gid * 8 + (r & 7); col = r >> 3; swapped = true; }
        else if (w < 1176) { w -= 1152; tok = 128 + (w & 7); col = 2 + (w >> 3); swapped = false; }
        else { w -= 1176; tok = 128 + (w & 7); col = w >> 3; swapped = true; }
        u.pm = tok; u.pn = col; u.aux = 0;
        const char* hp = H + (size_t)tok * 256 * 1024 * 2;
        if (swapped) { u.pA = WTVV + (size_t)col * 256 * 1024 * 2; u.pB = hp; u.pO = VVT + ((size_t)(tok * 4) * 65536 + (size_t)(col * 256) * 64) * 2; u.ldc = 64; u.act = ACT_VT; }
        else { u.pA = hp; u.pB = WT1A + (size_t)col * 256 * 1024 * 2;
            if (col < 2) { u.pO = Q + ((size_t)(tok * 256) * QKW + col * 256) * 2; u.ldc = QKW; u.act = ACT_QSC; }
            else if (col < 4) { u.pO = Kb + ((size_t)(tok * 256) * QKW + (col - 2) * 256) * 2; u.ldc = QKW; u.act = ACT_NONE; }
            else { u.pO = AFp + (size_t)(tok * 256) * 32 * 4; u.ldc = 32; u.act = ACT_AF32; } }
        return true;
    }
};
struct Order1B { const char* H; const char* WT1B; const char* WTVA; char* U; char* R; char* GA; char* GB; char* GVT; int G, c;
    __device__ __forceinline__ bool next(int i, Unit& u) const {
        constexpr int NWG = 2560; const long L = (long)i * G + c; if (L >= NWG) return false;
        int w = xcd_remap((int)L, NWG);
        u.aux = 0;
        if (w < 2048) { const int gid = w >> 7, r = w & 127, tok = gid * 8 + (r & 7), col = r >> 3; u.pm = tok; u.pn = col;
            u.pA = H + (size_t)tok * 256 * 1024 * 2; u.pB = WT1B + (size_t)col * 256 * 1024 * 2; u.ldc = 1024;
            const int seg = col >> 2; const long long dR = R - U, dGA = GA - U, dGB = GB - U;
            const long long dsel = (seg == 1 ? dR : 0ll) + (seg == 2 ? dGA : 0ll) + (seg == 3 ? dGB : 0ll);
            u.act = seg == 0 ? ACT_GELU : seg == 1 ? ACT_SILU : ACT_SIGM;
            u.pO = U + dsel + ((size_t)(tok * 256) * 1024 + (col & 3) * 256) * 2; }
        else { w -= 2048; const int gid = w >> 5, r = w & 31, tok = gid * 8 + (r & 7), ch = r >> 3; u.pm = tok; u.pn = ch;
            u.pA = WTVA + (size_t)ch * 256 * 1024 * 2; u.pB = H + (size_t)tok * 256 * 1024 * 2; u.pO = GVT + ((size_t)(ch * 256) * ML + tok * 256) * 2; u.ldc = ML; u.act = ACT_GELU; }
        return true;
    }
};
}

#define LAS __attribute__((address_space(3)))

namespace gla {
typedef short bf16x8 __attribute__((ext_vector_type(8)));
typedef float f32x4 __attribute__((ext_vector_type(4)));
typedef unsigned u32x4 __attribute__((ext_vector_type(4)));
typedef unsigned u32x2 __attribute__((ext_vector_type(2)));
constexpr int PKG_L_BYTES = 41984, PKG_C_BYTES = 17408, OFF_EL = 0, OFF_KS = 1024, OFF_QD = 17408, OFF_AT = 33792;
constexpr int SLOT_BYTES = PKG_L_BYTES + 8192, OFF_V = PKG_L_BYTES;
constexpr size_t WS_PKGC = 487 * MiB;
static_assert(WS_PKG + (size_t)64 * 64 * PKG_L_BYTES <= WS_OF && WS_PKGC + (size_t)64 * 4 * PKG_C_BYTES <= WS_END, "package regions");
constexpr float LOG2E = 1.44269504088896f;
__device__ __forceinline__ unsigned cvt_pk(float lo, float hi) { typedef __bf16 v2bf __attribute__((ext_vector_type(2))); typedef float v2f __attribute__((ext_vector_type(2)));
    const v2f x = {lo, hi}; const v2bf y = __builtin_convertvector(x, v2bf); return __builtin_bit_cast(unsigned, y); }
__device__ __forceinline__ float bfr(float f) { return __uint_as_float((__float_as_uint(f) + 0x7fffu + ((__float_as_uint(f) >> 16) & 1u)) & 0xffff0000u); }
__device__ __forceinline__ char* pkg_ptr(unsigned char* ws, int seq, int ch) {
    return ch < 4 ? (char*)ws + WS_PKGC + (size_t)(seq * 4 + ch) * PKG_C_BYTES : (char*)ws + WS_PKG + (size_t)(seq * 64 + (ch - 4)) * PKG_L_BYTES;
}
#define GLA_BAR() do { asm volatile("s_waitcnt lgkmcnt(0)" ::: "memory"); __builtin_amdgcn_s_barrier(); asm volatile("" ::: "memory"); } while (0)

__device__ __forceinline__ void prepass_phase(LAS unsigned char* lds, unsigned char* ws, const float* w_af, const float* b_af, const float* w_ab, const float* b_ab, int G, int c) {
    const int tid = threadIdx.x, w = __builtin_amdgcn_readfirstlane(tid >> 6), lane = tid & 63, lc = lane & 15, lg = lane >> 4;
    LAS float* B2 = (LAS float*)lds;
    LAS float* BL = (LAS float*)(lds + 33792);
    LAS unsigned char* QD = lds + 34816;
    LAS unsigned char* KI = lds + 51200;
    LAS unsigned short* KST = (LAS unsigned short*)(lds + 67584);
    const bf16* Qg = (const bf16*)(ws + WS_Q); const bf16* Kg = (const bf16*)(ws + WS_K); const float* AF = (const float*)(ws + WS_AF);
    for (int item = c; item < 64 * 68; item += G) {
        const int seq = item / 68, ch = item - seq * 68, dir = seq >> 5, b = (seq >> 2) & 7, h = seq & 3;
        const bool isctx = ch < 4;
        const int row0 = isctx ? ML + b * TC + ch * 64 : b * T + (ch - 4) * 64;
        char* pk = pkg_ptr(ws, seq, ch);
        {
            const int dk = 16 * w + lc;
            const float* wsrc = (dir ? w_ab : w_af) + h * DK + dk;
            bf16x8 bh, bl;
#pragma unroll
            for (int j = 0; j < 8; ++j) { const float wv = wsrc[((8 * lg + j) & 15) * QKW]; const float hi = bfr(wv); const float lo = bfr(wv - hi);
                bh[j] = (short)(__float_as_uint(hi) >> 16); bl[j] = lg < 2 ? (short)(__float_as_uint(lo) >> 16) : (short)0; }
            const float bias = (dir ? b_ab : b_af)[h * DK + dk];
            float g2[4][4];
#pragma unroll
            for (int tt = 0; tt < 4; ++tt) {
                const float* ap = AF + (size_t)(row0 + 16 * tt + lc) * 32 + dir * 16 + 8 * (lg & 1);
                const f32x4 a0 = *(const f32x4*)ap, a1 = *(const f32x4*)(ap + 4);
                bf16x8 af;
#pragma unroll
                for (int j = 0; j < 8; ++j) { const float v = j < 4 ? a0[j] : a1[j - 4]; const float hi = bfr(v); const float lo = bfr(v - hi); af[j] = (short)(__float_as_uint(lg < 2 ? hi : lo) >> 16); }
                f32x4 z = (f32x4){0.f, 0.f, 0.f, 0.f};
                z = __builtin_amdgcn_mfma_f32_16x16x32_bf16(af, bh, z, 0, 0, 0);
                z = __builtin_amdgcn_mfma_f32_16x16x32_bf16(af, bl, z, 0, 0, 0);
#pragma unroll
                for (int r = 0; r < 4; ++r) { const float zz = z[r] + bias;
                    const float ls2 = fminf(zz, 0.f) * LOG2E - __builtin_amdgcn_logf(1.0f + __builtin_amdgcn_exp2f(-fabsf(zz) * LOG2E));
                    g2[tt][r] = ls2 * (1.0f / 16.0f); }
            }
            float pre[4][4], tot[4], all[4][4];
#pragma unroll
            for (int tt = 0; tt < 4; ++tt) { pre[tt][0] = g2[tt][0]; pre[tt][1] = pre[tt][0] + g2[tt][1]; pre[tt][2] = pre[tt][1] + g2[tt][2]; pre[tt][3] = pre[tt][2] + g2[tt][3]; tot[tt] = pre[tt][3]; }
#pragma unroll
            for (int tt = 0; tt < 4; ++tt)
#pragma unroll
                for (int q = 0; q < 4; ++q) all[tt][q] = __shfl(tot[tt], lc + 16 * q);
            float run = 0.f, total;
            float offs[4];
#pragma unroll
            for (int tt = 0; tt < 4; ++tt) { offs[tt] = run + (lg > 0 ? all[tt][0] : 0.f) + (lg > 1 ? all[tt][1] : 0.f) + (lg > 2 ? all[tt][2] : 0.f); run += (all[tt][0] + all[tt][1]) + (all[tt][2] + all[tt][3]); }
            total = run;
#pragma unroll
            for (int tt = 0; tt < 4; ++tt)
#pragma unroll
                for (int r = 0; r < 4; ++r) { const float incl = offs[tt] + pre[tt][r]; const float bb = dir ? (total - incl) + g2[tt][r] : incl; B2[(16 * tt + 4 * lg + r) * 132 + dk] = bb; }
            if (lg == 0) { BL[dk] = total; ((float*)(pk + OFF_EL))[dk] = __builtin_amdgcn_exp2f(total); }
        }
        GLA_BAR();
#pragma unroll
        for (int rep = 0; rep < 2; ++rep) {
            const int f = w + 8 * rep, it = f >> 2, s = f & 3, i = 16 * it + lc, d0 = 32 * s + 4 * lg, d1 = d0 + 16;
            const f32x4 b0 = *(const LAS f32x4*)(B2 + i * 132 + d0), b1 = *(const LAS f32x4*)(B2 + i * 132 + d1), l0 = *(const LAS f32x4*)(BL + d0), l1 = *(const LAS f32x4*)(BL + d1);
            const size_t ro = (size_t)(row0 + i) * QKW + h * DK;
            const u32x2 k0 = *(const u32x2*)(Kg + ro + d0), k1 = *(const u32x2*)(Kg + ro + d1);
            float kv[8] = {__uint_as_float(k0.x << 16), __uint_as_float(k0.x & 0xffff0000u), __uint_as_float(k0.y << 16), __uint_as_float(k0.y & 0xffff0000u),
                           __uint_as_float(k1.x << 16), __uint_as_float(k1.x & 0xffff0000u), __uint_as_float(k1.y << 16), __uint_as_float(k1.y & 0xffff0000u)};
            float bb[8] = {b0[0], b0[1], b0[2], b0[3], b1[0], b1[1], b1[2], b1[3]}, ll[8] = {l0[0], l0[1], l0[2], l0[3], l1[0], l1[1], l1[2], l1[3]};
#pragma unroll
            for (int e = 0; e < 8; ++e) { const int dk = (e < 4 ? d0 : d1) + (e & 3); KST[dk * 64 + i] = (unsigned short)(__float_as_uint(bfr(kv[e] * __builtin_amdgcn_exp2f(ll[e] - bb[e]))) >> 16); }
            if (!isctx) {
                const u32x2 q0 = *(const u32x2*)(Qg + ro + d0), q1 = *(const u32x2*)(Qg + ro + d1);
                float qv[8] = {__uint_as_float(q0.x << 16), __uint_as_float(q0.x & 0xffff0000u), __uint_as_float(q0.y << 16), __uint_as_float(q0.y & 0xffff0000u),
                               __uint_as_float(q1.x << 16), __uint_as_float(q1.x & 0xffff0000u), __uint_as_float(q1.y << 16), __uint_as_float(q1.y & 0xffff0000u)};
                float qd[8], ki[8];
#pragma unroll
                for (int e = 0; e < 8; ++e) { qd[e] = qv[e] * __builtin_amdgcn_exp2f(bb[e]); ki[e] = kv[e] * __builtin_amdgcn_exp2f(-bb[e]); }
                u32x4 qw, kw; qw.x = cvt_pk(qd[0], qd[1]); qw.y = cvt_pk(qd[2], qd[3]); qw.z = cvt_pk(qd[4], qd[5]); qw.w = cvt_pk(qd[6], qd[7]);
                kw.x = cvt_pk(ki[0], ki[1]); kw.y = cvt_pk(ki[2], ki[3]); kw.z = cvt_pk(ki[4], ki[5]); kw.w = cvt_pk(ki[6], ki[7]);
                *(LAS u32x4*)(QD + f * 1024 + lane * 16) = qw; *(LAS u32x4*)(KI + f * 1024 + lane * 16) = kw;
                *(u32x4*)(pk + OFF_QD + f * 1024 + lane * 16) = qw;
            }
        }
        GLA_BAR();
        if (!isctx) {
            const int s2 = w >> 2, it = w & 3;
            f32x4 d0v = (f32x4){0.f, 0.f, 0.f, 0.f}, d1v = (f32x4){0.f, 0.f, 0.f, 0.f};
#pragma unroll
            for (int s = 0; s < 4; ++s) { const bf16x8 qf = *(const LAS bf16x8*)(QD + (it * 4 + s) * 1024 + lane * 16);
                const bf16x8 ka = *(const LAS bf16x8*)(KI + ((2 * s2) * 4 + s) * 1024 + lane * 16), kb = *(const LAS bf16x8*)(KI + ((2 * s2 + 1) * 4 + s) * 1024 + lane * 16);
                d0v = __builtin_amdgcn_mfma_f32_16x16x32_bf16(ka, qf, d0v, 0, 0, 0); d1v = __builtin_amdgcn_mfma_f32_16x16x32_bf16(kb, qf, d1v, 0, 0, 0); }
            const int i = 16 * it + lc; float a[8];
#pragma unroll
            for (int e = 0; e < 8; ++e) { const int j = 32 * s2 + (e < 4 ? 0 : 16) + 4 * lg + (e & 3); const float v = e < 4 ? d0v[e] : d1v[e - 4]; a[e] = (dir ? (i <= j) : (i >= j)) ? v : 0.f; }
            u32x4 aw; aw.x = cvt_pk(a[0], a[1]); aw.y = cvt_pk(a[2], a[3]); aw.z = cvt_pk(a[4], a[5]); aw.w = cvt_pk(a[6], a[7]);
            *(u32x4*)(pk + OFF_AT + (it * 2 + s2) * 1024 + lane * 16) = aw;
        }
#pragma unroll
        for (int rep = 0; rep < 2; ++rep) { const int fi = 2 * w + rep, dkt = fi >> 1, sp = fi & 1, dk = 16 * dkt + lc;
            const u32x2 x0 = *(const LAS u32x2*)(KST + dk * 64 + 32 * sp + 4 * lg), x1 = *(const LAS u32x2*)(KST + dk * 64 + 32 * sp + 16 + 4 * lg);
            u32x4 o; o.x = x0.x; o.y = x0.y; o.z = x1.x; o.w = x1.y;
            *(u32x4*)(pk + OFF_KS + fi * 1024 + lane * 16) = o; }
    }
}

__device__ __forceinline__ void scan_phase(LAS unsigned char* lds, unsigned char* ws, int G, int c) {
    const int tid = threadIdx.x, w = __builtin_amdgcn_readfirstlane(tid >> 6), lane = tid & 63, lc = lane & 15, lg = lane >> 4;
    const bf16* VVT = (const bf16*)(ws + WS_VVT);
    const int vc = (G % 8 == 0) ? (c % 8) * (G / 8) + c / 8 : c;
    for (int item = vc; item < 256; item += G) {
        const int seq = item >> 2, vs = item & 3, dir = seq >> 5, b = (seq >> 2) & 7, h = seq & 3;
        bf16* O = (bf16*)(ws + (dir ? WS_OB : WS_OF));
        auto chunk_of = [&](int st) { return st < 4 ? (dir ? 3 - st : st) : 4 + (dir ? 63 - (st - 4) : st - 4); };
        if (w == 7) {
            constexpr int LOOK = 4;
            LAS unsigned char* dummy = lds + 3 * SLOT_BYTES;
            auto warm = [&](int st) { if (st >= 68) return; const int ch = chunk_of(st); const char* pk = pkg_ptr(ws, seq, ch);
                const int per = ch < 4 ? 4 : 10, last = ch < 4 ? 16 : 40;
                for (int p = 0; p < per; ++p) __builtin_amdgcn_global_load_lds((const unsigned*)(pk + (vs * per + p) * 1024 + lane * 16), (LAS unsigned*)dummy, 16, 0, 0);
                if (vs == 3) __builtin_amdgcn_global_load_lds((const unsigned*)(pk + last * 1024 + lane * 16), (LAS unsigned*)dummy, 16, 0, 0); };
            for (int st = 2; st < LOOK; ++st) warm(st);
            for (int st = 0; st < 68; ++st) { __builtin_amdgcn_s_barrier(); warm(st + LOOK); }
            asm volatile("s_waitcnt vmcnt(0)" ::: "memory");
            __builtin_amdgcn_s_barrier();
        } else if (w >= 4) {
            const int lw = w - 4;
            const int nv = lw < 2 ? 3 : 2;
            auto npieces = [&](int ch) { const int tot = ch < 4 ? 17 : 41; return (tot - lw + 2) / 3 + nv; };
            auto issue = [&](int st) { const int ch = chunk_of(st); const char* pk = pkg_ptr(ws, seq, ch); LAS unsigned char* dst = lds + (st % 3) * SLOT_BYTES;
                const int tot = ch < 4 ? 17 : 41;
                for (int piece = lw; piece < tot; piece += 3) __builtin_amdgcn_global_load_lds((const unsigned*)(pk + piece * 1024 + lane * 16), (LAS unsigned*)(dst + piece * 1024), 16, 0, 0);
                const int trow = ch < 4 ? ML + b * TC + ch * 64 : b * T + (ch - 4) * 64;
                const bf16* vsrc = VVT + ((size_t)(trow >> 6) * 1024 + h * DV + vs * 64) * 64 + lane * 8;
                for (int p = lw; p < 8; p += 3) __builtin_amdgcn_global_load_lds((const unsigned*)(vsrc + p * 512), (LAS unsigned*)(dst + OFF_V + p * 1024), 16, 0, 0); };
            issue(0); issue(1);
            for (int st = 0; st < 68; ++st) {
                const int nn = st + 1 < 68 ? npieces(chunk_of(st + 1)) : 0;
                if (nn == 17) asm volatile("s_waitcnt vmcnt(17)" ::: "memory"); else if (nn == 15) asm volatile("s_waitcnt vmcnt(15)" ::: "memory");
                else if (nn == 9) asm volatile("s_waitcnt vmcnt(9)" ::: "memory"); else if (nn == 7) asm volatile("s_waitcnt vmcnt(7)" ::: "memory"); else asm volatile("s_waitcnt vmcnt(0)" ::: "memory");
                __builtin_amdgcn_s_barrier();
                if (st + 2 < 68) issue(st + 2);
            }
            __builtin_amdgcn_s_barrier();
        } else {
            const int dvb = vs * 64 + 16 * w;
            f32x4 S[8];
#pragma unroll
            for (int t = 0; t < 8; ++t) S[t] = (f32x4){0.f, 0.f, 0.f, 0.f};
#define GLA_FRAG(off) (*(const LAS bf16x8*)(base + (off) + lane * 16))
#define GLA_PIN() __builtin_amdgcn_sched_barrier(0)
            for (int st = 0; st < 68; ++st) {
                GLA_BAR();
                const LAS unsigned char* base = lds + (st % 3) * SLOT_BYTES;
                const int ch = chunk_of(st);
                bf16x8 vf[2];
                {   const LAS unsigned char* vp = base + OFF_V + (16 * w + lc) * 128 + 8 * lg;
                    const u32x2 x0 = *(const LAS u32x2*)vp, x1 = *(const LAS u32x2*)(vp + 32), x2 = *(const LAS u32x2*)(vp + 64), x3 = *(const LAS u32x2*)(vp + 96);
                    u32x4 t0, t1; t0.x = x0.x; t0.y = x0.y; t0.z = x1.x; t0.w = x1.y; t1.x = x2.x; t1.y = x2.y; t1.z = x3.x; t1.w = x3.y; vf[0] = __builtin_bit_cast(bf16x8, t0); vf[1] = __builtin_bit_cast(bf16x8, t1); }
                f32x4 el[8]; bf16x8 ks[8][2];
                if (ch >= 4) {
                    bf16x8 qa[4][6];
#pragma unroll
                    for (int it = 0; it < 4; ++it) {
#pragma unroll
                        for (int s = 0; s < 4; ++s) qa[it][s] = GLA_FRAG(OFF_QD + (it * 4 + s) * 1024);
#pragma unroll
                        for (int s2 = 0; s2 < 2; ++s2) qa[it][4 + s2] = GLA_FRAG(OFF_AT + (it * 2 + s2) * 1024); }
                    GLA_PIN();
                    bf16x8 sa[4];
#pragma unroll
                    for (int s = 0; s < 4; ++s) { u32x4 t; t.x = cvt_pk(S[2 * s][0], S[2 * s][1]); t.y = cvt_pk(S[2 * s][2], S[2 * s][3]); t.z = cvt_pk(S[2 * s + 1][0], S[2 * s + 1][1]); t.w = cvt_pk(S[2 * s + 1][2], S[2 * s + 1][3]); sa[s] = __builtin_bit_cast(bf16x8, t); }
                    const int row0 = b * T + (ch - 4) * 64;
                    f32x4 o[4];
#pragma unroll
                    for (int it = 0; it < 2; ++it) { o[it] = (f32x4){0.f, 0.f, 0.f, 0.f};
#pragma unroll
                        for (int s = 0; s < 4; ++s) o[it] = __builtin_amdgcn_mfma_f32_16x16x32_bf16(sa[s], qa[it][s], o[it], 0, 0, 0);
#pragma unroll
                        for (int s2 = 0; s2 < 2; ++s2) o[it] = __builtin_amdgcn_mfma_f32_16x16x32_bf16(vf[s2], qa[it][4 + s2], o[it], 0, 0, 0); }
                    GLA_PIN();
#pragma unroll
                    for (int t = 0; t < 4; ++t) { el[t] = *(const LAS f32x4*)(base + OFF_EL + (16 * t + 4 * lg) * 4); ks[t][0] = GLA_FRAG(OFF_KS + (t * 2) * 1024); ks[t][1] = GLA_FRAG(OFF_KS + (t * 2 + 1) * 1024); }
                    GLA_PIN();
#pragma unroll
                    for (int it = 2; it < 4; ++it) { o[it] = (f32x4){0.f, 0.f, 0.f, 0.f};
#pragma unroll
                        for (int s = 0; s < 4; ++s) o[it] = __builtin_amdgcn_mfma_f32_16x16x32_bf16(sa[s], qa[it][s], o[it], 0, 0, 0);
#pragma unroll
                        for (int s2 = 0; s2 < 2; ++s2) o[it] = __builtin_amdgcn_mfma_f32_16x16x32_bf16(vf[s2], qa[it][4 + s2], o[it], 0, 0, 0); }
                    GLA_PIN();
#pragma unroll
                    for (int t = 4; t < 8; ++t) { el[t] = *(const LAS f32x4*)(base + OFF_EL + (16 * t + 4 * lg) * 4); ks[t][0] = GLA_FRAG(OFF_KS + (t * 2) * 1024); ks[t][1] = GLA_FRAG(OFF_KS + (t * 2 + 1) * 1024); }
#pragma unroll
                    for (int it = 0; it < 4; ++it) { u32x2 ow; ow.x = cvt_pk(o[it][0], o[it][1]); ow.y = cvt_pk(o[it][2], o[it][3]);
                        *(u32x2*)(O + (size_t)(row0 + 16 * it + lc) * VW + h * DV + dvb + 4 * lg) = ow; }
                    GLA_PIN();
                } else {
#pragma unroll
                    for (int t = 0; t < 8; ++t) { el[t] = *(const LAS f32x4*)(base + OFF_EL + (16 * t + 4 * lg) * 4); ks[t][0] = GLA_FRAG(OFF_KS + (t * 2) * 1024); ks[t][1] = GLA_FRAG(OFF_KS + (t * 2 + 1) * 1024); }
                    GLA_PIN();
                }
#pragma unroll
                for (int t = 0; t < 8; ++t) { S[t] = S[t] * el[t]; S[t] = __builtin_amdgcn_mfma_f32_16x16x32_bf16(ks[t][0], vf[0], S[t], 0, 0, 0); S[t] = __builtin_amdgcn_mfma_f32_16x16x32_bf16(ks[t][1], vf[1], S[t], 0, 0, 0); }
            }
#undef GLA_FRAG
#undef GLA_PIN
            GLA_BAR();
        }
    }
}
}


#define XB_TMO      128
#define XB_XCNT(j)  (256  + 64 * (j))
#define XB_XSUB(j)  (1280 + 64 * (j))
#define XB_XGEN(j)  (2304 + 64 * (j))
#define XB_TOP      3328
#define XB_TOPGEN   3392
#define XCD_BAR_WORDS 3456
#define XB_SPIN_CAP (1u << 18)
__device__ __forceinline__ unsigned xb_ld(unsigned* p)              { return __hip_atomic_load(p, __ATOMIC_RELAXED, __HIP_MEMORY_SCOPE_AGENT); }
__device__ __forceinline__ unsigned xb_add(unsigned* p, unsigned v) { return __hip_atomic_fetch_add(p, v, __ATOMIC_RELAXED, __HIP_MEMORY_SCOPE_AGENT); }
__device__ __forceinline__ unsigned xb_xcc_id() { return (unsigned)__builtin_amdgcn_s_getreg((3 << 11) | 20) & 0xFu; }
#define XB_SPIN(cond, bar) do { unsigned _sp = 0; while (cond) { __builtin_amdgcn_s_sleep(1); \
    if ((++_sp & 255u) == 0u) { if (xb_ld(&(bar)[XB_TMO])) break; if (_sp > XB_SPIN_CAP) { atomicAdd(&(bar)[XB_TMO], 1u); break; } } } } while (0)
struct XcdBarrier { unsigned* bar; unsigned x; volatile LAS unsigned* st; };
__device__ __forceinline__ XcdBarrier xcd_barrier_post(unsigned* bar, volatile LAS unsigned* st) {
    XcdBarrier b; b.bar = bar; b.x = xb_xcc_id(); b.st = st;
    if (threadIdx.x == 0) (void)xb_add(&bar[XB_XCNT(b.x)], 1u);
    return b;
}
__device__ __forceinline__ void xcd_barrier_complete(unsigned* bar, unsigned x, unsigned& nloc, unsigned& nx) {
    const unsigned G = gridDim.x * gridDim.y * gridDim.z;
    unsigned sum, cnt, mine, sp = 0u;
    for (;;) {
        sum = 0u; cnt = 0u; mine = 0u;
#pragma unroll
        for (unsigned j = 0; j < 16; ++j) { const unsigned c = xb_ld(&bar[XB_XCNT(j)]); sum += c; cnt += (c > 0u) ? 1u : 0u; mine = (j == x) ? c : mine; }
        if (sum == G) break;
        __builtin_amdgcn_s_sleep(1);
        if ((++sp & 255u) == 0u) { if (xb_ld(&bar[XB_TMO])) break; if (sp > XB_SPIN_CAP) { atomicAdd(&bar[XB_TMO], 1u); break; } }
    }
    nloc = mine > 0u ? mine : 1u; nx = cnt > 0u ? cnt : 1u;
}
__device__ __forceinline__ void xcd_barrier(const XcdBarrier& b) {
    asm volatile("s_waitcnt vmcnt(0)" ::: "memory");
    __syncthreads();
    if (threadIdx.x == 0) {
        unsigned* bar = b.bar;
        __builtin_amdgcn_s_waitcnt(0);
        unsigned nloc = b.st[0], nx = b.st[1];
        if (nloc == 0u) { xcd_barrier_complete(bar, b.x, nloc, nx); b.st[0] = nloc; b.st[1] = nx; }
        const unsigned old = xb_add(&bar[XB_XSUB(b.x)], 1u);
        const unsigned gen = old / nloc;
        if (old + 1u == (gen + 1u) * nloc) {
            __builtin_amdgcn_fence(__ATOMIC_RELEASE, "agent");
            asm volatile("s_waitcnt vmcnt(0)" ::: "memory");
            const unsigned og = xb_add(&bar[XB_TOP], 1u);
            const unsigned tg = og / nx;
            if (og + 1u == (tg + 1u) * nx) xb_add(&bar[XB_TOPGEN], 1u);
            else XB_SPIN(xb_ld(&bar[XB_TOPGEN]) == tg, bar);
            __builtin_amdgcn_fence(__ATOMIC_ACQUIRE, "agent");
            xb_add(&bar[XB_XGEN(b.x)], 1u);
            asm volatile("s_waitcnt vmcnt(0)" ::: "memory");
        } else {
            XB_SPIN(xb_ld(&bar[XB_XGEN(b.x)]) == gen, bar);
            __builtin_amdgcn_fence(__ATOMIC_ACQUIRE, "agent");
            asm volatile("s_waitcnt vmcnt(0)" ::: "memory");
        }
    }
    __syncthreads();
}

namespace thin {
typedef float f32x4 __attribute__((ext_vector_type(4)));
typedef unsigned u32x4 __attribute__((ext_vector_type(4)));
typedef unsigned u32x2 __attribute__((ext_vector_type(2)));
typedef short bf16x8 __attribute__((ext_vector_type(8)));
using gla::cvt_pk;
__device__ __forceinline__ float lo16(unsigned w) { return __uint_as_float(w << 16); }
__device__ __forceinline__ float hi16(unsigned w) { return __uint_as_float(w & 0xffff0000u); }
__device__ __forceinline__ void tr_item(const float* W, int K, int ldw, int col0, bf16* WT, int mode, LAS float* scr, int item, int nblk, int lane) {
    const int kb = item / nblk, nb = item % nblk, k0 = 64 * kb, n0 = 32 * nb;
#pragma unroll 8
    for (int i = 0; i < 32; ++i) { const int kk = 2 * i + (lane >> 5); scr[kk * 33 + (lane & 31)] = W[(size_t)(k0 + kk) * ldw + col0 + n0 + (lane & 31)]; }
    asm volatile("s_waitcnt lgkmcnt(0)" ::: "memory");
    int r0 = n0;
    if (mode == 1) { const int col = col0 + n0; r0 = col < DFF ? 256 * (col >> 7) + (col & 127) : 256 * ((col - DFF) >> 7) + 128 + ((col - DFF) & 127); }
    const int cch = lane & 7;
#pragma unroll
    for (int j = 0; j < 4; ++j) { const int n = (lane >> 3) + 8 * j; const LAS float* sp = scr + (8 * cch) * 33 + n;
        u32x4 o; o.x = cvt_pk(sp[0 * 33], sp[1 * 33]); o.y = cvt_pk(sp[2 * 33], sp[3 * 33]); o.z = cvt_pk(sp[4 * 33], sp[5 * 33]); o.w = cvt_pk(sp[6 * 33], sp[7 * 33]);
        *(u32x4*)(WT + (size_t)(r0 + n) * K + k0 + 8 * cch) = o; }
    asm volatile("s_waitcnt lgkmcnt(0)" ::: "memory");
}
template <int NR, int NC>
__device__ __forceinline__ void gemv_block(const LAS float* sv, LAS float* red, const float* W, int ldw, int col0, const float* bias, float* out, int ldo) {
    const int tid = threadIdx.x, w = tid >> 6, lane = tid & 63, col = lane % NC, kk = lane / NC;
    float acc[NR];
#pragma unroll
    for (int r = 0; r < NR; ++r) acc[r] = 0.f;
    if (kk < 2) {
#pragma unroll 4
        for (int j = 0; j < 64; ++j) { const int k = 128 * w + 2 * j + kk; const float wv = W[(size_t)k * ldw + col0 + col];
#pragma unroll
            for (int r = 0; r < NR; ++r) acc[r] += sv[r * 1024 + k] * wv; }
    }
#pragma unroll
    for (int r = 0; r < NR; ++r) { const float o = __shfl(acc[r], (lane + NC) & 63); if (lane < NC) red[(w * NR + r) * 32 + col] = acc[r] + o; }
    __syncthreads();
    if (tid < NR * NC) { const int r = tid / NC, cidx = tid % NC; float t = 0.f;
#pragma unroll
        for (int ww = 0; ww < 8; ++ww) t += red[(ww * NR + r) * 32 + cidx];
        out[(size_t)r * ldo + col0 + cidx] = t + (bias ? bias[col0 + cidx] : 0.f); }
    __syncthreads();
}
struct P0Args { const float *c, *cctx, *w_ada, *b_ada, *w_in, *w_ba, *w_bb, *w_out, *w_f1, *w_f2, *w_sp; };
__device__ __forceinline__ void p0_phase(LAS unsigned char* lds, unsigned char* ws, const P0Args& A, int G, int vcu) {
    const int tid = threadIdx.x, w = __builtin_amdgcn_readfirstlane(tid >> 6), lane = tid & 63;
    LAS float* scr = (LAS float*)(lds + w * 8448);
    LAS float* sv = (LAS float*)(lds + 69632);
    LAS float* red = (LAS float*)(lds + 69632 + 36864);
    for (int i = tid; i < 9 * 1024; i += 512) { const int r = i >> 10, k = i & 1023; const float v = r < 8 ? A.c[r * 1024 + k] : A.cctx[k]; sv[i] = v / (1.f + __expf(-v)); }
    __syncthreads();
    for (int cb = vcu; cb < 256; cb += G) gemv_block<9, 24>(sv, red, A.w_ada, 6144, 24 * cb, A.b_ada, (float*)(ws + WS_MOD), 6144);
    const int gw = vcu * 8 + w, NGW = G * 8; int base = 0;
#define TR_JOB(Wp, K_, ldw_, col0_, ncols_, dst_, mode_) do { const int nblk_ = (ncols_) / 32, items_ = ((K_) / 64) * nblk_; \
        for (int it_ = ((gw - base) % NGW + NGW) % NGW; it_ < items_; it_ += NGW) tr_item(Wp, K_, ldw_, col0_, dst_, mode_, scr, it_, nblk_, lane); base = (base + items_) % NGW; } while (0)
    bf16* WT1A = (bf16*)(ws + WS_WT1A); bf16* WT1B = (bf16*)(ws + WS_WT1B);
    TR_JOB(A.w_in, 1024, NIN, C_Q, 512, WT1A, 0); TR_JOB(A.w_in, 1024, NIN, C_K, 512, WT1A + 512 * 1024, 0); TR_JOB(A.w_in, 1024, NIN, C_AF, 32, WT1A + 1024 * 1024, 0);
    TR_JOB(A.w_in, 1024, NIN, C_VV, 1024, (bf16*)(ws + WS_WTVV), 0); TR_JOB(A.w_in, 1024, NIN, C_VA, 1024, (bf16*)(ws + WS_WTVA), 0);
    TR_JOB(A.w_in, 1024, NIN, C_U, 1024, WT1B, 0); TR_JOB(A.w_in, 1024, NIN, C_R, 1024, WT1B + 1024 * 1024, 0); TR_JOB(A.w_in, 1024, NIN, C_GA, 1024, WT1B + 2048 * 1024, 0); TR_JOB(A.w_in, 1024, NIN, C_GB, 1024, WT1B + 3072 * 1024, 0);
    TR_JOB(A.w_ba, 1024, 1024, 0, 1024, (bf16*)(ws + WS_WTA), 0); TR_JOB(A.w_bb, 1024, 1024, 0, 1024, (bf16*)(ws + WS_WTB), 0); TR_JOB(A.w_out, 1024, 1024, 0, 1024, (bf16*)(ws + WS_WTO), 0);
    TR_JOB(A.w_f1, 1024, 2 * DFF, 0, 2 * DFF, (bf16*)(ws + WS_WTF1), 1);
    TR_JOB(A.w_f2, DFF, 1024, 0, 1024, (bf16*)(ws + WS_WTF2), 0);
#undef TR_JOB
    { u32x4* z = (u32x4*)(WT1A + 1056 * 1024); const u32x4 zero = {0u, 0u, 0u, 0u}; for (int i = vcu * 512 + tid; i < 224 * 1024 / 8; i += G * 512) z[i] = zero; }
    for (int i = vcu * 512 + tid; i < 8 * 8 * 4 * 64; i += G * 512) { const int ln = i & 63, sidx = (i >> 6) & 3, pt = (i >> 8) & 7, g = i >> 11;
        const float* src = A.w_sp + ((size_t)g * 128 + 16 * pt + (ln & 15)) * 128 + 32 * sidx + 8 * (ln >> 4);
        const f32x4 a = *(const f32x4*)src, b = *(const f32x4*)(src + 4);
        u32x4 o; o.x = cvt_pk(a[0], a[1]); o.y = cvt_pk(a[2], a[3]); o.z = cvt_pk(b[0], b[1]); o.w = cvt_pk(b[2], b[3]);
        ((u32x4*)(ws + WS_WSPF))[i] = o; }
    __syncthreads();
}
__device__ __forceinline__ float wsum(float v) {
#pragma unroll
    for (int o = 1; o < 64; o <<= 1) v += __shfl_xor(v, o);
    return v;
}
__device__ __forceinline__ void p1_phase(LAS unsigned char* lds, unsigned char* ws, const float* x, const float* ctx, const float* n1g, const float* n2g, const float* w_f1, int G, int vcu) {
    const int tid = threadIdx.x, w = __builtin_amdgcn_readfirstlane(tid >> 6), lane = tid & 63;
    const float* MOD = (const float*)(ws + WS_MOD); bf16* H = (bf16*)(ws + WS_H);
    const int gw = vcu * 8 + w, NGW = G * 8;
    for (int row = gw; row < M; row += NGW) {
        const float* xr = row < ML ? x + (size_t)row * D : ctx + (size_t)(row - ML) * D; const int mr = row < ML ? row / T : 8;
        f32x4 v[4]; float ss = 0.f;
#pragma unroll
        for (int j = 0; j < 4; ++j) { v[j] = *(const f32x4*)(xr + 4 * lane + 256 * j); ss += (v[j][0] * v[j][0] + v[j][1] * v[j][1]) + (v[j][2] * v[j][2] + v[j][3] * v[j][3]); }
        const float rstd = rsqrtf(wsum(ss) * (1.f / D) + EPS);
#pragma unroll
        for (int j = 0; j < 4; ++j) { const int cidx = 4 * lane + 256 * j; const f32x4 g = *(const f32x4*)(n1g + cidx), sh = *(const f32x4*)(MOD + mr * 6144 + cidx), sc = *(const f32x4*)(MOD + mr * 6144 + 1024 + cidx);
            const f32x4 y = v[j] * rstd * g * (sc + 1.0f) + sh; u32x2 o; o.x = cvt_pk(y[0], y[1]); o.y = cvt_pk(y[2], y[3]); *(u32x2*)(H + (size_t)row * D + cidx) = o; }
    }
    for (int i = vcu * 512 + tid; i < 8 * 1024; i += G * 512) ((float*)(ws + WS_GV2))[i] = n2g[i & 1023] * (1.f + MOD[(i >> 10) * 6144 + 4096 + (i & 1023)]);
    LAS float* sv = (LAS float*)lds; LAS float* red = (LAS float*)(lds + 32768);
    for (int i = tid; i < 8 * 1024; i += 512) sv[i] = MOD[(i >> 10) * 6144 + 3072 + (i & 1023)];
    __syncthreads();
    for (int cb = vcu; cb < 256; cb += G) gemv_block<8, 22>(sv, red, w_f1, 2 * DFF, 22 * cb, nullptr, (float*)(ws + WS_CV), 2 * DFF);
}
__device__ __forceinline__ void mix_phase(LAS unsigned char* lds, unsigned char* ws, const float* lng, const float* lnb, const float* bsp, const float* gain, int G, int vcu) {
    const int tid = threadIdx.x, w = __builtin_amdgcn_readfirstlane(tid >> 6), lane = tid & 63, lc = lane & 15, lg = lane >> 4;
    const bf16* GVT = (const bf16*)(ws + WS_GVT); bf16* U = (bf16*)(ws + WS_U); const u32x4* WSPF = (const u32x4*)(ws + WS_WSPF);
    LAS unsigned char* WB = lds;
    LAS float* RS = (LAS float*)(lds + 32768);
    LAS float* RQ = (LAS float*)(lds + 32768 + 4096);
    LAS float* MR = (LAS float*)(lds + 32768 + 8192);
    for (int ch = vcu; ch < ML / 128; ch += G) {
        const int tok0 = ch * 128;
        {
            const int tp = tid & 63, cs = tid >> 6; float s0 = 0.f, s1 = 0.f, q0 = 0.f, q1 = 0.f;
            const bf16* gp = GVT + (size_t)(cs * 128) * ML + tok0 + 2 * tp;
#pragma unroll 8
            for (int cc = 0; cc < 128; ++cc) { const unsigned v = *(const unsigned*)(gp + (size_t)cc * ML); const float a = lo16(v), b = hi16(v); s0 += a; q0 += a * a; s1 += b; q1 += b * b; }
            RS[cs * 128 + 2 * tp] = s0; RS[cs * 128 + 2 * tp + 1] = s1; RQ[cs * 128 + 2 * tp] = q0; RQ[cs * 128 + 2 * tp + 1] = q1;
        }
        __syncthreads();
        if (tid < 128) { float sx = 0.f, qx = 0.f;
#pragma unroll
            for (int k = 0; k < 8; ++k) { sx += RS[k * 128 + tid]; qx += RQ[k * 128 + tid]; }
            const float mean = sx * (1.f / 1024.f), var = fmaxf(qx * (1.f / 1024.f) - mean * mean, 0.f); MR[2 * tid] = mean; MR[2 * tid + 1] = rsqrtf(var + EPS); }
        for (int g = 0; g < 8; ++g) {
            __syncthreads();
#pragma unroll
            for (int k = 0; k < 4; ++k) *(LAS u32x4*)(WB + (tid + 512 * k) * 16) = WSPF[g * 2048 + tid + 512 * k];
            __syncthreads();
            const int chn = g * 128 + 16 * w + lc; const float gg = lng[chn], bb = lnb[chn];
            bf16x8 af[4];
#pragma unroll
            for (int sidx = 0; sidx < 4; ++sidx) { const int q0 = 32 * sidx + 8 * lg; const u32x4 raw = *(const u32x4*)(GVT + (size_t)chn * ML + tok0 + q0);
                const unsigned rw[4] = {raw.x, raw.y, raw.z, raw.w}; float y[8];
#pragma unroll
                for (int e = 0; e < 4; ++e) { const f32x4 mr = *(const LAS f32x4*)(MR + 2 * (q0 + 2 * e));
                    y[2 * e] = (lo16(rw[e]) - mr[0]) * mr[1] * gg + bb; y[2 * e + 1] = (hi16(rw[e]) - mr[2]) * mr[3] * gg + bb; }
                u32x4 t; t.x = cvt_pk(y[0], y[1]); t.y = cvt_pk(y[2], y[3]); t.z = cvt_pk(y[4], y[5]); t.w = cvt_pk(y[6], y[7]); af[sidx] = __builtin_bit_cast(bf16x8, t); }
#pragma unroll
            for (int pt = 0; pt < 8; ++pt) { f32x4 d = (f32x4){0.f, 0.f, 0.f, 0.f};
#pragma unroll
                for (int sidx = 0; sidx < 4; ++sidx) { const bf16x8 bf = *(const LAS bf16x8*)(WB + ((pt * 4 + sidx) * 64 + lane) * 16); d = __builtin_amdgcn_mfma_f32_16x16x32_bf16(af[sidx], bf, d, 0, 0, 0); }
                const int p = 16 * pt + lc; const float bs = bsp[g * 128 + p];
                bf16* up = U + (size_t)(tok0 + p) * D + g * 128 + 16 * w + 4 * lg; const u32x2 uv = *(const u32x2*)up;
                u32x2 o; o.x = cvt_pk(lo16(uv.x) * (d[0] + bs), hi16(uv.x) * (d[1] + bs)); o.y = cvt_pk(lo16(uv.y) * (d[2] + bs), hi16(uv.y) * (d[3] + bs)); *(u32x2*)up = o; }
        }
        __syncthreads();
    }
    bf16* OF = (bf16*)(ws + WS_OF); const bf16* OB = (const bf16*)(ws + WS_OB); const bf16* R = (const bf16*)(ws + WS_R);
    const int gw = vcu * 8 + w, NGW = G * 8;
    for (int row = gw; row < ML; row += NGW) {
        const size_t o = (size_t)row * VW + 16 * lane; float v[16], r[16]; float ss = 0.f;
#pragma unroll
        for (int hv = 0; hv < 2; ++hv) { const u32x4 a = *(const u32x4*)(OF + o + 8 * hv), b = *(const u32x4*)(OB + o + 8 * hv), rr = *(const u32x4*)(R + o + 8 * hv);
            const unsigned aw[4] = {a.x, a.y, a.z, a.w}, bw[4] = {b.x, b.y, b.z, b.w}, rw[4] = {rr.x, rr.y, rr.z, rr.w};
#pragma unroll
            for (int e = 0; e < 4; ++e) { v[8 * hv + 2 * e] = lo16(aw[e]) + lo16(bw[e]); v[8 * hv + 2 * e + 1] = hi16(aw[e]) + hi16(bw[e]); r[8 * hv + 2 * e] = lo16(rw[e]); r[8 * hv + 2 * e + 1] = hi16(rw[e]); } }
#pragma unroll
        for (int e = 0; e < 16; ++e) ss += v[e] * v[e];
        ss += __shfl_xor(ss, 1); ss += __shfl_xor(ss, 2); ss += __shfl_xor(ss, 4); ss += __shfl_xor(ss, 8);
        const float rstd = rsqrtf(ss * (1.f / DV) + EPS);
#pragma unroll
        for (int hv = 0; hv < 2; ++hv) { const f32x4 g0 = *(const f32x4*)(gain + 16 * lane + 8 * hv), g1 = *(const f32x4*)(gain + 16 * lane + 8 * hv + 4); float y[8];
#pragma unroll
            for (int e = 0; e < 4; ++e) { y[e] = v[8 * hv + e] * rstd * g0[e] * r[8 * hv + e]; y[4 + e] = v[8 * hv + 4 + e] * rstd * g1[e] * r[8 * hv + 4 + e]; }
            u32x4 t; t.x = cvt_pk(y[0], y[1]); t.y = cvt_pk(y[2], y[3]); t.z = cvt_pk(y[4], y[5]); t.w = cvt_pk(y[6], y[7]); *(u32x4*)(OF + o + 8 * hv) = t; }
    }
}
__device__ __forceinline__ void fin_phase(float* X, const float* g, int G, int vcu) {
    const int w = threadIdx.x >> 6, lane = threadIdx.x & 63, gw = vcu * 8 + w, NGW = G * 8;
    for (int row = gw; row < ML; row += NGW) { float* xr = X + (size_t)row * D; f32x4 v[4]; float ss = 0.f;
#pragma unroll
        for (int j = 0; j < 4; ++j) { v[j] = *(const f32x4*)(xr + 4 * lane + 256 * j); ss += (v[j][0] * v[j][0] + v[j][1] * v[j][1]) + (v[j][2] * v[j][2] + v[j][3] * v[j][3]); }
        const float rstd = rsqrtf(wsum(ss) * (1.f / D) + EPS);
#pragma unroll
        for (int j = 0; j < 4; ++j) *(f32x4*)(xr + 4 * lane + 256 * j) = v[j] * rstd * *(const f32x4*)(g + 4 * lane + 256 * j); }
}
}

constexpr int NWAVES = 8, LDS_BYTES = 163840;
#ifndef PG8_SP2
#define PG8_SP2 true
#endif
#ifndef PG8_ALIGN
#define PG8_ALIGN true
#endif
enum Phase { PH_P0 = 0, PH_P1 = 1, PH_G1A = 2, PH_PRE = 3, PH_SCAN = 4, PH_G1B = 5, PH_MIX = 6, PH_MRG = 7, PH_WOUT = 8, PH_FF1 = 9, PH_FF2 = 10, PH_END = 11 };
constexpr int CW_FINCNT = 32768;
constexpr int CW_BAR = 4096;
constexpr int MISC_OFF = LDS_BYTES - 256;
struct Args { const float* in[24]; float* out; unsigned char* ws; int ph_lo, ph_hi; };
__global__ void __launch_bounds__(NWAVES * 64, 2) mega_fwd(Args a) {
    extern __shared__ __attribute__((aligned(16))) unsigned char lds_raw[];
    LAS unsigned char* lds = (LAS unsigned char*)lds_raw;
    unsigned char* ws = a.ws;
    const int G = gridDim.x, c = blockIdx.x;
    const int vcu = (G % 8 == 0) ? (c % 8) * (G / 8) + c / 8 : c;
    const char* Hc = (const char*)(ws + WS_H);
    volatile LAS unsigned* MISC = (volatile LAS unsigned*)(lds + MISC_OFF);
    if (threadIdx.x < 64) MISC[threadIdx.x] = 0u;
    __syncthreads();
    XcdBarrier bar; bar.bar = (unsigned*)(ws + WS_CTL) + CW_BAR; bar.x = 0; bar.st = nullptr;
    const bool multi = a.ph_hi - a.ph_lo > 1;
    if (multi) bar = xcd_barrier_post((unsigned*)(ws + WS_CTL) + CW_BAR, MISC + 8);
#define IN(k) (a.ph_lo <= (k) && (k) < a.ph_hi)
#define SEAM(k) do { if (IN(k) && IN((k) + 1)) xcd_barrier(bar); } while (0)
    if (IN(PH_P0)) { thin::P0Args pa{a.in[1], a.in[3], a.in[4], a.in[5], a.in[7], a.in[17], a.in[18], a.in[19], a.in[21], a.in[22], a.in[10]}; thin::p0_phase(lds, ws, pa, G, vcu); }
    SEAM(PH_P0);
    if (IN(PH_P1)) thin::p1_phase(lds, ws, a.in[0], a.in[2], a.in[6], a.in[20], a.in[21], G, vcu);
    SEAM(PH_P1);
    if (IN(PH_G1A)) {
        pg8::Order1A S{Hc, (const char*)(ws + WS_WT1A), (const char*)(ws + WS_WTVV), (char*)(ws + WS_Q), (char*)(ws + WS_K), (char*)(ws + WS_AF), (char*)(ws + WS_VVT), G, c};
        pg8::EpiAct E;
        pg8::gemm_phase<pg8::EpiAct, pg8::Order1A, PG8_ALIGN, PG8_SP2>(lds, 1024, S, E);
    }
    SEAM(PH_G1A);
    if (IN(PH_PRE)) { gla::prepass_phase(lds, ws, a.in[12], a.in[13], a.in[14], a.in[15], G, c); __syncthreads(); }
    SEAM(PH_PRE);
    if (IN(PH_SCAN)) { gla::scan_phase(lds, ws, G, c); __syncthreads(); }
    SEAM(PH_SCAN);
    if (IN(PH_G1B)) {
        pg8::Order1B S{Hc, (const char*)(ws + WS_WT1B), (const char*)(ws + WS_WTVA), (char*)(ws + WS_U), (char*)(ws + WS_R), (char*)a.out, (char*)a.out + (size_t)ML * D * 2, (char*)(ws + WS_GVT), G, c};
        pg8::EpiAct E;
        pg8::gemm_phase<pg8::EpiAct, pg8::Order1B, PG8_ALIGN, PG8_SP2>(lds, 1024, S, E);
    }
    SEAM(PH_G1B);
    if (IN(PH_MIX)) thin::mix_phase(lds, ws, a.in[8], a.in[9], a.in[11], a.in[16], G, vcu);
    SEAM(PH_MIX);
    if (IN(PH_MRG)) {
        pg8::OrderMrg S{(const char*)(ws + WS_U), (const char*)(ws + WS_WTA), (const char*)(ws + WS_OF), (const char*)(ws + WS_WTB), G, c};
        pg8::EpiMrg E{(const bf16*)a.out, (const bf16*)a.out + (size_t)ML * D, (bf16*)(ws + WS_Y)};
        pg8::gemm_phase<pg8::EpiMrg, pg8::OrderMrg, PG8_ALIGN, PG8_SP2>(lds, 1024, S, E);
    }
    SEAM(PH_MRG);
    if (IN(PH_WOUT)) {
        pg8::OrderGrid S{(const char*)(ws + WS_Y), (const char*)(ws + WS_WTO), 128, 4, 1024, G, c};
        pg8::EpiRes2 E{a.in[0], (const float*)(ws + WS_MOD), (const float*)(ws + WS_GV2), (float*)(ws + WS_X1), (bf16*)(ws + WS_A2), (unsigned long long*)(ws + WS_ROWSS)};
        pg8::gemm_phase<pg8::EpiRes2, pg8::OrderGrid, PG8_ALIGN, PG8_SP2>(lds, 1024, S, E);
    }
    SEAM(PH_WOUT);
    if (IN(PH_FF1)) {
        pg8::OrderGrid S{(const char*)(ws + WS_A2), (const char*)(ws + WS_WTF1), 128, 22, 1024, G, c};
        pg8::EpiSwi2 E{(bf16*)(ws + WS_HB), (const unsigned long long*)(ws + WS_ROWSS), (const float*)(ws + WS_CV)};
        pg8::gemm_phase<pg8::EpiSwi2, pg8::OrderGrid, PG8_ALIGN, PG8_SP2>(lds, 1024, S, E);
    }
    SEAM(PH_FF1);
    if (IN(PH_FF2)) {
        pg8::OrderGrid S{(const char*)(ws + WS_HB), (const char*)(ws + WS_WTF2), 128, 4, DFF, G, c};
        pg8::EpiFin E{(const float*)(ws + WS_X1), (const float*)(ws + WS_MOD), a.in[23], a.out, (unsigned long long*)(ws + WS_ROWSS2), (unsigned*)(ws + WS_CTL) + CW_FINCNT};
        pg8::gemm_phase<pg8::EpiFin, pg8::OrderGrid, PG8_ALIGN, PG8_SP2>(lds, DFF, S, E);
    }
#undef IN
#undef SEAM
}
static int g_grid = 0;
static void run_mega(hipStream_t stream, void* const* d_in, void* d_out, void* d_ws, int lo, int hi) {
    Args a{}; for (int i = 0; i < 24; ++i) a.in[i] = (const float*)d_in[i];
    a.out = (float*)d_out; a.ws = (unsigned char*)d_ws; a.ph_lo = lo; a.ph_hi = hi;
    hipLaunchKernelGGL(mega_fwd, dim3(g_grid), dim3(NWAVES * 64), LDS_BYTES, stream, a);
}

template <class Epi, bool DUAL = false>
static void run_gemm(hipStream_t s, const bf16* A, const bf16* Bt, int Mrows, int N, int K, const Epi& e) {
    hipLaunchKernelGGL((nv_gemm<Epi, DUAL>), dim3((N + 63) / 64, Mrows / 64), dim3(256), 0, s, A, Bt, Mrows, N, K, 0, e);
}
static void run_tr(hipStream_t s, const float* W, int K, int ldw, int col0, int ncols, bf16* WT) {
    hipLaunchKernelGGL(nv_transpose, dim3(ncols / 32, K / 32), dim3(256), 0, s, W, K, ldw, col0, ncols, WT);
}

extern "C" void kernel_launch(void* const* d_in, const int* in_sizes, int n_in, void* d_out, int out_size, void* d_ws, size_t ws_size, hipStream_t stream) {
    if (n_in != 24 || out_size != ML * D || ws_size < WS_END) { fprintf(stderr, "kernel_launch: unexpected sizes n_in %d out %d ws %zu\n", n_in, out_size, ws_size); return; }
    const float* x = (const float*)d_in[0]; const float* c = (const float*)d_in[1]; const float* ctx = (const float*)d_in[2]; const float* cctx = (const float*)d_in[3];
    const float* w_ada = (const float*)d_in[4]; const float* b_ada = (const float*)d_in[5]; const float* norm1_g = (const float*)d_in[6]; const float* w_in = (const float*)d_in[7];
    const float* ln_v_g = (const float*)d_in[8]; const float* ln_v_b = (const float*)d_in[9]; const float* w_sp = (const float*)d_in[10]; const float* b_sp = (const float*)d_in[11];
    const float* w_af = (const float*)d_in[12]; const float* b_af = (const float*)d_in[13]; const float* w_ab = (const float*)d_in[14]; const float* b_ab = (const float*)d_in[15];
    const float* gla_g = (const float*)d_in[16]; const float* w_ba = (const float*)d_in[17]; const float* w_bb = (const float*)d_in[18]; const float* w_out = (const float*)d_in[19];
    const float* norm2_g = (const float*)d_in[20]; const float* w_f1 = (const float*)d_in[21]; const float* w_f2 = (const float*)d_in[22]; const float* fin_g = (const float*)d_in[23];
    unsigned char* ws = (unsigned char*)d_ws; float* out = (float*)d_out;
    if (g_grid == 0) {
        int dev = 0, cus = 0, per_cu = 0;
        hipGetDevice(&dev); hipDeviceGetAttribute(&cus, hipDeviceAttributeMultiprocessorCount, dev);
        hipFuncSetAttribute((const void*)mega_fwd, hipFuncAttributeMaxDynamicSharedMemorySize, LDS_BYTES);
        hipOccupancyMaxActiveBlocksPerMultiprocessor(&per_cu, (const void*)mega_fwd, NWAVES * 64, LDS_BYTES);
        (void)hipGetLastError();
        if (per_cu < 1) fprintf(stderr, "kernel_launch: occupancy query says %d blocks/CU\n", per_cu);
        g_grid = cus;
    }
    bf16 *WT1A = (bf16*)(ws + WS_WT1A), *WTVV = (bf16*)(ws + WS_WTVV), *WT1B = (bf16*)(ws + WS_WT1B), *WTVA = (bf16*)(ws + WS_WTVA), *WTA = (bf16*)(ws + WS_WTA), *WTB = (bf16*)(ws + WS_WTB),
         *WTO = (bf16*)(ws + WS_WTO), *WTF1 = (bf16*)(ws + WS_WTF1), *WTF2 = (bf16*)(ws + WS_WTF2);
    float* MOD = (float*)(ws + WS_MOD); float* LNST = (float*)(ws + WS_LNST);
    bf16 *H = (bf16*)(ws + WS_H), *Q = (bf16*)(ws + WS_Q), *Kb = (bf16*)(ws + WS_K), *VVT = (bf16*)(ws + WS_VVT), *OF = (bf16*)(ws + WS_OF), *OB = (bf16*)(ws + WS_OB), *U = (bf16*)(ws + WS_U),
         *GVT = (bf16*)(ws + WS_GVT), *R = (bf16*)(ws + WS_R), *Y = (bf16*)(ws + WS_Y), *A2 = (bf16*)(ws + WS_A2), *HB = (bf16*)(ws + WS_HB);
    float *AF = (float*)(ws + WS_AF), *Y1 = (float*)(ws + WS_Y1), *X1 = (float*)(ws + WS_X1);
    bf16 *GA = (bf16*)d_out, *GB = (bf16*)d_out + (size_t)ML * D;
    hipMemsetAsync(ws + WS_CTL, 0, 1 * MiB, stream);
#ifndef MK_ONE_LAUNCH
#define MK_ONE_LAUNCH 1
#endif
#ifndef MK_REP
#define MK_REP 0
#endif
    if (MK_ONE_LAUNCH) run_mega(stream, d_in, d_out, d_ws, 0, PH_END);
    else for (int p = 0; p < PH_END; ++p) { run_mega(stream, d_in, d_out, d_ws, p, p + 1); if ((MK_REP >> p) & 1) run_mega(stream, d_in, d_out, d_ws, p, p + 1); }
}
```

```cpp
#include <hip/hip_runtime.h>
#include <stdint.h>
#include <cstdio>

typedef unsigned short bf16;
__device__ __forceinline__ float bf2f(bf16 v) { return __uint_as_float(((unsigned)v) << 16); }
__device__ __forceinline__ bf16 f2bf(float f) { unsigned u = __float_as_uint(f); u += 0x7fffu + ((u >> 16) & 1u); return (bf16)(u >> 16); }

constexpr int NB = 8, T = 4096, D = 1024, TC = 256;
constexpr int ML = NB * T;
constexpr int MC = NB * TC;
constexpr int M = ML + MC;
constexpr int NH = 4, DK = 128, DV = 256, QKW = 512, VW = 1024, RANK = 16;
constexpr int DFF = 2816, NIN = 7200;
constexpr float EPS = 1e-6f;
constexpr int C_U = 0, C_VA = 1024, C_Q = 2048, C_K = 2560, C_VV = 3072, C_R = 4096, C_AF = 5120, C_GA = 5152, C_GB = 6176;

constexpr size_t MiB = 1u << 20;
constexpr size_t WS_CTL = 0;
constexpr size_t WS_ROWSS = 256 * 1024, WS_ROWSS2 = 512 * 1024;
constexpr size_t WS_MOD = 1 * MiB;
constexpr size_t WS_CV = WS_MOD + 256 * 1024;
constexpr size_t WS_LNST = 2 * MiB;
constexpr size_t WS_GV2 = WS_MOD + 512 * 1024;
constexpr size_t WS_WSPF = 3 * MiB;
constexpr size_t WS_WT1A = 4 * MiB;
constexpr size_t WS_WTVV = WS_WT1A + 1280 * 1024 * 2;
constexpr size_t WS_WT1B = WS_WTVV + 2 * MiB;
constexpr size_t WS_WTVA = WS_WT1B + 8 * MiB;
constexpr size_t WS_WTA = WS_WTVA + 2 * MiB, WS_WTB = WS_WTA + 2 * MiB, WS_WTO = WS_WTB + 2 * MiB;
constexpr size_t WS_WTF1 = WS_WTO + 2 * MiB;
constexpr size_t WS_WTF2 = WS_WTF1 + 11 * MiB;
static_assert(WS_WTF2 + (size_t)1024 * 2816 * 2 <= 48 * MiB, "weights region");
constexpr size_t WS_H = 48 * MiB;
constexpr size_t WS_Q = 116 * MiB;
constexpr size_t WS_K = 148 * MiB;
constexpr size_t WS_AF = 182 * MiB;
constexpr size_t WS_VVT = 188 * MiB;
constexpr size_t WS_PKG = 256 * MiB;
constexpr size_t WS_OF = 423 * MiB;
constexpr size_t WS_OB = 116 * MiB;
constexpr size_t WS_U = 188 * MiB;
constexpr size_t WS_GVT = 256 * MiB;
constexpr size_t WS_R = 320 * MiB;
constexpr size_t WS_Y1 = 256 * MiB;
constexpr size_t WS_Y = 48 * MiB;
constexpr size_t WS_X1 = 384 * MiB;
constexpr size_t WS_A2 = 116 * MiB;
constexpr size_t WS_HB = 180 * MiB;
constexpr size_t WS_END = 512 * MiB;

__global__ void nv_transpose(const float* __restrict__ W, int K, int ldw, int col0, int ncols, bf16* __restrict__ WT) {
    __shared__ float tile[32][33];
    const int k0 = blockIdx.y * 32, n0 = blockIdx.x * 32, tx = threadIdx.x & 31, ty = threadIdx.x >> 5;
    for (int i = ty; i < 32; i += 8) tile[i][tx] = W[(size_t)(k0 + i) * ldw + col0 + n0 + tx];
    __syncthreads();
    for (int i = ty; i < 32; i += 8) WT[(size_t)(n0 + i) * K + k0 + tx] = f2bf(tile[tx][i]);
}
__global__ void nv_zero_bf16(bf16* p, size_t n) { for (size_t i = (size_t)blockIdx.x * blockDim.x + threadIdx.x; i < n; i += (size_t)gridDim.x * blockDim.x) p[i] = 0; }

__global__ void nv_ada(const float* __restrict__ c, const float* __restrict__ cctx, const float* __restrict__ w_ada, const float* __restrict__ b_ada, float* __restrict__ MOD) {
    __shared__ float s[9][1024];
    for (int i = threadIdx.x; i < 9 * 1024; i += blockDim.x) { const int r = i >> 10, k = i & 1023; const float v = r < 8 ? c[r * 1024 + k] : cctx[k]; s[r][k] = v / (1.f + expf(-v)); }
    __syncthreads();
    const int n = blockIdx.x * blockDim.x + threadIdx.x;
    float acc[9];
    for (int r = 0; r < 9; ++r) acc[r] = 0.f;
    for (int k = 0; k < 1024; ++k) { const float w = w_ada[(size_t)k * 6144 + n];
#pragma unroll
        for (int r = 0; r < 9; ++r) acc[r] += s[r][k] * w; }
    for (int r = 0; r < 9; ++r) MOD[r * 6144 + n] = acc[r] + b_ada[n];
}

__device__ __forceinline__ float wave_sum(float v) {
#pragma unroll
    for (int o = 1; o < 64; o <<= 1) v += __shfl_xor(v, o);
    return v;
}
__global__ void nv_modnorm(const float* __restrict__ xl, const float* __restrict__ xc, const float* __restrict__ g, const float* __restrict__ MOD, int shoff, int scoff, bf16* __restrict__ out, int nrows, int pad_) {
    const int row = blockIdx.x * (blockDim.x >> 6) + (threadIdx.x >> 6), lane = threadIdx.x & 63;
    if (row >= nrows) return;
    const float* xr = row < ML ? xl + (size_t)row * D : xc + (size_t)(row - ML) * D;
    const int mr = row < ML ? row / T : 8;
    float v[16]; float ss = 0.f;
#pragma unroll
    for (int j = 0; j < 16; ++j) { v[j] = xr[lane + 64 * j]; ss += v[j] * v[j]; }
    const float rstd = rsqrtf(wave_sum(ss) * (1.f / D) + EPS);
#pragma unroll
    for (int j = 0; j < 16; ++j) { const int cidx = lane + 64 * j; const float y = v[j] * rstd * g[cidx];
        out[(size_t)row * D + cidx] = f2bf(y * (1.f + MOD[mr * 6144 + scoff + cidx]) + MOD[mr * 6144 + shoff + cidx]); }
}

template <class Epi, bool DUAL>
__global__ void __launch_bounds__(256) nv_gemm(const bf16* __restrict__ A, const bf16* __restrict__ Bt, int Mrows, int N, int K, int pad_, Epi epi) {
    __shared__ float As[32][65], Bs[32][65], Bs2[DUAL ? 32 : 1][65];
    const int tid = threadIdx.x, tx = tid & 15, ty = tid >> 4;
    const int m0 = blockIdx.y * 64, n0 = blockIdx.x * 64;
    float acc[4][4], acc2[4][4];
#pragma unroll
    for (int i = 0; i < 4; ++i)
#pragma unroll
        for (int j = 0; j < 4; ++j) { acc[i][j] = 0.f; acc2[i][j] = 0.f; }
    const int lr = tid >> 2, lk = (tid & 3) * 8;
    const int am = m0 + lr, bn = n0 + lr < N ? n0 + lr : N - 1;
    const bf16* ap = A + (size_t)am * K + lk;
    const bf16* bp = Bt + (size_t)epi.brow(bn) * K + lk;
    const bf16* bp2 = DUAL ? Bt + (size_t)epi.brow2(bn) * K + lk : bp;
    for (int k0 = 0; k0 < K; k0 += 32) {
        const uint4 av = *(const uint4*)(ap + k0), bv = *(const uint4*)(bp + k0);
        const unsigned aw[4] = {av.x, av.y, av.z, av.w}, bw[4] = {bv.x, bv.y, bv.z, bv.w};
#pragma unroll
        for (int j = 0; j < 4; ++j) { As[lk + 2 * j][lr] = __uint_as_float(aw[j] << 16); As[lk + 2 * j + 1][lr] = __uint_as_float(aw[j] & 0xffff0000u);
                                      Bs[lk + 2 * j][lr] = __uint_as_float(bw[j] << 16); Bs[lk + 2 * j + 1][lr] = __uint_as_float(bw[j] & 0xffff0000u); }
        if (DUAL) { const uint4 cv = *(const uint4*)(bp2 + k0); const unsigned cw[4] = {cv.x, cv.y, cv.z, cv.w};
#pragma unroll
            for (int j = 0; j < 4; ++j) { Bs2[lk + 2 * j][lr] = __uint_as_float(cw[j] << 16); Bs2[lk + 2 * j + 1][lr] = __uint_as_float(cw[j] & 0xffff0000u); } }
        __syncthreads();
#pragma unroll 8
        for (int k = 0; k < 32; ++k) {
            float a[4], b[4], b2[4];
#pragma unroll
            for (int i = 0; i < 4; ++i) { a[i] = As[k][ty * 4 + i]; b[i] = Bs[k][tx * 4 + i]; b2[i] = DUAL ? Bs2[k][tx * 4 + i] : 0.f; }
#pragma unroll
            for (int i = 0; i < 4; ++i)
#pragma unroll
                for (int j = 0; j < 4; ++j) { acc[i][j] += a[i] * b[j]; if (DUAL) acc2[i][j] += a[i] * b2[j]; }
        }
        __syncthreads();
    }
#pragma unroll
    for (int i = 0; i < 4; ++i)
#pragma unroll
        for (int j = 0; j < 4; ++j) { const int m = m0 + ty * 4 + i, n = n0 + tx * 4 + j; if (m < Mrows && n < N) epi(m, n, acc[i][j], acc2[i][j]); }
}
__device__ __forceinline__ float gelu_erf(float v) { return 0.5f * v * (1.f + erff(v * 0.70710678118654752f)); }
__device__ __forceinline__ float sigmoidf_(float v) { return 1.f / (1.f + expf(-v)); }
struct EpBase { __device__ int brow(int n) const { return n; } __device__ int brow2(int n) const { return n; } };
struct EpQ : EpBase { bf16* O; int ld; float sc; __device__ void operator()(int m, int n, float a, float) const { O[(size_t)m * ld + n] = f2bf(a * sc); } };
struct EpF32 : EpBase { float* O; int ld; int pad; __device__ void operator()(int m, int n, float a, float) const { O[(size_t)m * ld + n] = a; } };
struct EpT : EpBase { bf16* O; int ld; int act; __device__ void operator()(int m, int n, float a, float) const { O[(size_t)n * ld + m] = f2bf(act ? gelu_erf(a) : a); } };
struct EpAct : EpBase { bf16* O; int ld; int act; __device__ void operator()(int m, int n, float a, float) const { float v = act == 1 ? gelu_erf(a) : act == 2 ? a * sigmoidf_(a) : sigmoidf_(a); O[(size_t)m * ld + n] = f2bf(v); } };
struct EpY1 : EpBase { const bf16* G; float* Y1; __device__ void operator()(int m, int n, float a, float) const { Y1[(size_t)m * D + n] = bf2f(G[(size_t)m * D + n]) * a; } };
struct EpY : EpBase { const bf16* G; const float* Y1; bf16* Y; __device__ void operator()(int m, int n, float a, float) const { Y[(size_t)m * D + n] = f2bf(Y1[(size_t)m * D + n] + bf2f(G[(size_t)m * D + n]) * a); } };
struct EpRes : EpBase { const float* X; const float* MOD; float* O; int goff; int pad; __device__ void operator()(int m, int n, float a, float) const { O[(size_t)m * D + n] = X[(size_t)m * D + n] + MOD[(m / T) * 6144 + goff + n] * a; } };
struct EpSwi { bf16* O; __device__ int brow(int n) const { return 256 * (n >> 7) + (n & 127); } __device__ int brow2(int n) const { return 256 * (n >> 7) + 128 + (n & 127); }
    __device__ void operator()(int m, int n, float a, float g) const { O[(size_t)m * DFF + n] = f2bf(a * (g * sigmoidf_(g))); } };

__global__ void __launch_bounds__(256) nv_gla(const bf16* __restrict__ Q, const bf16* __restrict__ Kb, const float* __restrict__ AF, const bf16* __restrict__ VVT,
                                              const float* __restrict__ w_af, const float* __restrict__ b_af, const float* __restrict__ w_ab, const float* __restrict__ b_ab,
                                              bf16* __restrict__ OF, bf16* __restrict__ OB) {
    const int dir = blockIdx.x & 1, h = (blockIdx.x >> 1) & 3, b = blockIdx.x >> 3, tid = threadIdx.x;
    __shared__ float sa[128], sk[128], sq[128], wl[16][128], bl[128];
    const float* wsrc = dir ? w_ab : w_af; const float* bsrc = dir ? b_ab : b_af;
    for (int i = tid; i < 16 * 128; i += 256) wl[i >> 7][i & 127] = wsrc[(i >> 7) * QKW + h * DK + (i & 127)];
    if (tid < 128) bl[tid] = bsrc[h * DK + tid];
    float S[128];
#pragma unroll
    for (int i = 0; i < 128; ++i) S[i] = 0.f;
    bf16* O = dir ? OB : OF;
    const bf16* vrow = VVT + (size_t)(h * DV + tid) * M;
    __syncthreads();
    for (int step = 0; step < TC + T; ++step) {
        const bool isctx = step < TC;
        int row;
        if (isctx) row = ML + b * TC + (dir ? TC - 1 - step : step);
        else { const int t = step - TC; row = b * T + (dir ? T - 1 - t : t); }
        if (tid < 128) {
            float z = bl[tid];
#pragma unroll
            for (int r = 0; r < 16; ++r) z += AF[(size_t)row * 32 + dir * 16 + r] * wl[r][tid];
            const float ls = fminf(z, 0.f) - log1pf(expf(-fabsf(z)));
            sa[tid] = expf(ls * (1.f / 16.f));
            sk[tid] = bf2f(Kb[(size_t)row * QKW + h * DK + tid]);
            sq[tid] = isctx ? 0.f : bf2f(Q[(size_t)row * QKW + h * DK + tid]);
        }
        const float v = bf2f(vrow[row]);
        __syncthreads();
        float o = 0.f;
#pragma unroll
        for (int i = 0; i < 128; ++i) { S[i] = sa[i] * S[i] + sk[i] * v; o += sq[i] * S[i]; }
        if (!isctx) O[(size_t)row * VW + h * DV + tid] = f2bf(o);
        __syncthreads();
    }
}

__global__ void nv_lnstat(const bf16* __restrict__ GVT, float* __restrict__ ST) {
    const int t = blockIdx.x * blockDim.x + threadIdx.x;
    float s = 0.f, s2 = 0.f;
    for (int c = 0; c < 1024; ++c) { const float v = bf2f(GVT[(size_t)c * ML + t]); s += v; }
    const float mean = s * (1.f / 1024.f);
    for (int c = 0; c < 1024; ++c) { const float d = bf2f(GVT[(size_t)c * ML + t]) - mean; s2 += d * d; }
    ST[2 * t] = mean; ST[2 * t + 1] = rsqrtf(s2 * (1.f / 1024.f) + EPS);
}
__global__ void __launch_bounds__(256) nv_chunkmlp(bf16* __restrict__ U, const bf16* __restrict__ GVT, const float* __restrict__ ST, const float* __restrict__ lng, const float* __restrict__ lnb,
                                                   const float* __restrict__ wsp, const float* __restrict__ bsp) {
    extern __shared__ float vt[];
    const int ch = blockIdx.x, g = blockIdx.y, tok0 = ch * 128, tid = threadIdx.x;
    for (int i = tid; i < 128 * 128; i += 256) { const int c = i >> 7, q = i & 127; const int cc = g * 128 + c;
        const float v = bf2f(GVT[(size_t)cc * ML + tok0 + q]);
        vt[q * 128 + c] = (v - ST[2 * (tok0 + q)]) * ST[2 * (tok0 + q) + 1] * lng[cc] + lnb[cc]; }
    __syncthreads();
    const int c = tid & 127;
    for (int p = tid >> 7; p < 128; p += 2) {
        float acc = 0.f;
        const float* wr = wsp + ((size_t)g * 128 + p) * 128;
        for (int q = 0; q < 128; ++q) acc += wr[q] * vt[q * 128 + c];
        acc += bsp[g * 128 + p];
        const size_t o = (size_t)(tok0 + p) * D + g * 128 + c;
        U[o] = f2bf(bf2f(U[o]) * acc);
    }
}
__global__ void nv_glaout(bf16* __restrict__ OF, const bf16* __restrict__ OB, const bf16* __restrict__ R, const float* __restrict__ gain) {
    const int w = blockIdx.x * (blockDim.x >> 6) + (threadIdx.x >> 6), lane = threadIdx.x & 63;
    const int row = w >> 2, h = w & 3;
    float v[4]; float ss = 0.f;
#pragma unroll
    for (int j = 0; j < 4; ++j) { const size_t o = (size_t)row * VW + h * DV + lane + 64 * j; v[j] = bf2f(OF[o]) + bf2f(OB[o]); ss += v[j] * v[j]; }
    const float rstd = rsqrtf(wave_sum(ss) * (1.f / DV) + EPS);
#pragma unroll
    for (int j = 0; j < 4; ++j) { const int cidx = h * DV + lane + 64 * j; const size_t o = (size_t)row * VW + cidx; OF[o] = f2bf(v[j] * rstd * gain[cidx] * bf2f(R[o])); }
}
__global__ void nv_finalnorm(float* __restrict__ X, const float* __restrict__ g) {
    const int row = blockIdx.x * (blockDim.x >> 6) + (threadIdx.x >> 6), lane = threadIdx.x & 63;
    float v[16]; float ss = 0.f;
#pragma unroll
    for (int j = 0; j < 16; ++j) { v[j] = X[(size_t)row * D + lane + 64 * j]; ss += v[j] * v[j]; }
    const float rstd = rsqrtf(wave_sum(ss) * (1.f / D) + EPS);
#pragma unroll
    for (int j = 0; j < 16; ++j) X[(size_t)row * D + lane + 64 * j] = v[j] * rstd * g[lane + 64 * j];
}


#ifndef MK_STAGGER
#define MK_STAGGER 0
#endif
namespace pg8 {
#define PG8_LAS __attribute__((address_space(3)))
typedef unsigned short bf16_t;
typedef short bf16x8 __attribute__((ext_vector_type(8)));
typedef float f32x4 __attribute__((ext_vector_type(4)));
typedef float f32x2 __attribute__((ext_vector_type(2)));
typedef unsigned u32x4 __attribute__((ext_vector_type(4)));
typedef unsigned u32x2 __attribute__((ext_vector_type(2)));
constexpr int BM = 256, BK = 64, HALF = 128, HTB = HALF * BK * 2, STAGE_BYTES = 8 * HTB;
__host__ __device__ __forceinline__ int lds_byte(int r, int c) { const int st = (r >> 4) * 2 + (c >> 5), rr = r & 15, cc = c & 31, ob = rr * 64 + cc * 2; return st * 1024 + (ob ^ (((ob >> 9) & 1) << 5)); }
__host__ __device__ __forceinline__ void stage_rc(int b, int& R, int& C) { const int st = b / 1024, sb = b % 1024, swz = sb ^ (((sb >> 9) & 1) << 5); R = (st >> 1) * 16 + swz / 64; C = (st & 1) * 32 + (swz % 64) / 2; }
__host__ __device__ __forceinline__ int perm32(int rho) { const int n = rho >> 4, i = rho & 15; return 8 * (i >> 2) + 4 * n + (i & 3); }
struct Unit { const char* pA; const char* pB; char* pO; int ldc, act, aux, pm, pn; };
__device__ __forceinline__ unsigned cvt_pk_bf16(float lo, float hi) { typedef __bf16 v2bf __attribute__((ext_vector_type(2))); typedef float v2f __attribute__((ext_vector_type(2)));
    const v2f x = {lo, hi}; const v2bf y = __builtin_convertvector(x, v2bf); return __builtin_bit_cast(unsigned, y); }
__device__ __forceinline__ f32x2 gelu_pk(f32x2 v) {
    const f32x2 av = __builtin_elementwise_abs(v), d = av * 0.2316418882f + 1.0f;
    f32x2 t; t.x = __builtin_amdgcn_rcpf(d.x); t.y = __builtin_amdgcn_rcpf(d.y);
    f32x2 q = t * 0.5307027145f + (-0.7265760135f); q = q * t + 0.7107068705f; q = q * t + (-0.142248368f); q = q * t + 0.127414796f; q = q * t;
    const f32x2 s = (v * v) * (-0.72134752044f);
    f32x2 e; e.x = __builtin_amdgcn_exp2f(s.x); e.y = __builtin_amdgcn_exp2f(s.y);
    const f32x2 m = v * (q * e), r = v - m;
    f32x2 o; o.x = v.x < 0.f ? m.x : r.x; o.y = v.y < 0.f ? m.y : r.y; return o;
}
__device__ __forceinline__ float ub8(unsigned w, int n) { return (float)((w >> (8 * n)) & 0xffu); }
__device__ __forceinline__ float sigm(float x) { return __builtin_amdgcn_rcpf(1.0f + __builtin_amdgcn_exp2f(x * -1.44269504089f)); }
__device__ __forceinline__ int xcd_remap(int L, int nwg) { const int q = nwg / 8, r = nwg % 8, xcd = L % 8, off = L / 8; return (xcd < r ? xcd * (q + 1) : r * (q + 1) + (xcd - r) * q) + off; }

template <class Epi, class Sched, bool ALIGN_EPI, bool SP2>
__device__ __forceinline__ void gemm_phase(PG8_LAS unsigned char* lds, const int K, const Sched& S, const Epi& E) {
    const int tid = threadIdx.x, wid = __builtin_amdgcn_readfirstlane(tid >> 6), lane = tid & 63, wr = wid >> 2, wc = wid & 3, fr = lane & 15, fq = lane >> 4;
    const int nt = K / BK;
    unsigned voffA[2], voffB[2];
#pragma unroll
    for (int i = 0; i < 2; ++i) { int R, C; stage_rc(tid * 16 + i * 8192, R, C); const int Rb = (R & ~31) + perm32(R & 31);
        voffA[i] = (unsigned)(R * K + C) * 2u; voffB[i] = (unsigned)(Rb * K + C) * 2u; }
    const size_t kstep = (size_t)(BK * 2);
    const size_t hstep = (size_t)HALF * K * 2;
    const unsigned ldsw = (unsigned)wid * 1024u;
    const int aoff = lds_byte(wr * 64 + fr, fq * 8), boff = lds_byte(wc * 32 + fr, fq * 8);
#define PG8_SA(b, h) (((b) * 2 + (h)) * HTB)
#define PG8_SB(b, h) ((4 + (b) * 2 + (h)) * HTB)
#define PG8_STAGE(bufoff, gbase, voff) do { _Pragma("unroll") for (int _i = 0; _i < 2; ++_i) \
        __builtin_amdgcn_global_load_lds((const unsigned*)((const char*)(gbase) + (voff)[_i]), (PG8_LAS unsigned*)(lds + (bufoff) + ldsw + _i * 8192), 16, 0, 0); } while (0)
#define PG8_LDA(dst, b, h) do { _Pragma("unroll") for (int m = 0; m < 4; ++m) _Pragma("unroll") for (int k = 0; k < 2; ++k) dst[m][k] = *(const PG8_LAS bf16x8*)(lds + PG8_SA(b, h) + aoff + m * 2048 + k * 1024); } while (0)
#define PG8_LDB(dst, b, h) do { _Pragma("unroll") for (int n = 0; n < 2; ++n) _Pragma("unroll") for (int k = 0; k < 2; ++k) dst[n][k] = *(const PG8_LAS bf16x8*)(lds + PG8_SB(b, h) + boff + n * 2048 + k * 1024); } while (0)
#define PG8_MMA(ai, bj, At, Bt) do { __builtin_amdgcn_s_setprio(1); _Pragma("unroll") for (int m = 0; m < 4; ++m) _Pragma("unroll") for (int n = 0; n < 2; ++n) _Pragma("unroll") for (int k = 0; k < 2; ++k) \
        acc[ai][bj][m][n] = __builtin_amdgcn_mfma_f32_16x16x32_bf16(Bt[n][k], At[m][k], acc[ai][bj][m][n], 0, 0, 0); __builtin_amdgcn_s_setprio(0); } while (0)
#define PG8_WAIT_V(n) asm volatile("s_waitcnt vmcnt(" #n ")" ::: "memory")
#define PG8_WAIT_L(n) asm volatile("s_waitcnt lgkmcnt(" #n ")" ::: "memory")
#define PG8_BAR __builtin_amdgcn_s_barrier()
#define PG8_SCHED __builtin_amdgcn_sched_barrier(0)
    Unit cur, nxt; int ui = 0;
    if (!S.next(0, cur)) return;
    if (MK_STAGGER > 0) { const unsigned long long t0_ = __builtin_amdgcn_s_memrealtime(); const unsigned long long dl_ = (unsigned long long)((blockIdx.x >> 3) & 3) * MK_STAGGER;
        while (__builtin_amdgcn_s_memrealtime() - t0_ < dl_) __builtin_amdgcn_s_sleep(8); }
    f32x4 acc[2][2][4][2];
#pragma unroll
    for (int a = 0; a < 2; ++a)
#pragma unroll
        for (int b = 0; b < 2; ++b)
#pragma unroll
            for (int m = 0; m < 4; ++m)
#pragma unroll
                for (int n = 0; n < 2; ++n) acc[a][b][m][n] = (f32x4){0.f, 0.f, 0.f, 0.f};
    bf16x8 At[4][2], B0[2][2], B1[2][2];
    const char* cA = cur.pA; const char* cB = cur.pB;
    if constexpr (SP2) {
        PG8_STAGE(PG8_SB(0, 0), cB, voffB); PG8_STAGE(PG8_SB(0, 1), cB + hstep, voffB); PG8_STAGE(PG8_SA(0, 0), cA, voffA); PG8_STAGE(PG8_SA(0, 1), cA + hstep, voffA);
        if (wr == 1) PG8_BAR;
        PG8_WAIT_V(2); PG8_BAR;
        PG8_STAGE(PG8_SB(1, 0), cB + kstep, voffB); PG8_STAGE(PG8_SA(1, 0), cA + kstep, voffA); PG8_STAGE(PG8_SB(1, 1), cB + hstep + kstep, voffB);
        PG8_WAIT_V(6); PG8_BAR;
    } else {
        PG8_STAGE(PG8_SB(0, 0), cB, voffB); PG8_STAGE(PG8_SA(0, 0), cA, voffA); PG8_STAGE(PG8_SB(0, 1), cB + hstep, voffB); PG8_STAGE(PG8_SA(0, 1), cA + hstep, voffA);
        if (wr == 1) PG8_BAR;
        PG8_WAIT_V(4); PG8_BAR;
        PG8_STAGE(PG8_SB(1, 0), cB + kstep, voffB); PG8_STAGE(PG8_SA(1, 0), cA + kstep, voffA); PG8_STAGE(PG8_SB(1, 1), cB + hstep + kstep, voffB);
        PG8_WAIT_V(6); PG8_BAR;
    }
    for (;;) {
        const bool has_next = S.next(ui + 1, nxt);
        const char* nA = has_next ? nxt.pA : cA; const char* nB = has_next ? nxt.pB : cB;
        for (int t = 0; t < nt; t += 2) {
            const bool last = (t == nt - 2);
            const char* a1 = cA + (size_t)(t + 1) * kstep;
            const char* a2 = last ? nA : cA + (size_t)(t + 2) * kstep; const char* b2 = last ? nB : cB + (size_t)(t + 2) * kstep;
            const char* a3 = a2 + kstep; const char* b3 = b2 + kstep;
            if constexpr (SP2) {
            PG8_LDB(B0, 0, 0); PG8_LDB(B1, 0, 1); PG8_SCHED; PG8_LDA(At, 0, 0); PG8_STAGE(PG8_SA(1, 1), a1 + hstep, voffA);
            PG8_WAIT_V(8); PG8_WAIT_L(0); PG8_BAR; PG8_MMA(0, 0, At, B0); PG8_MMA(0, 1, At, B1); PG8_BAR; PG8_SCHED;
            PG8_LDA(At, 0, 1); PG8_STAGE(PG8_SB(0, 0), b2, voffB); PG8_STAGE(PG8_SB(0, 1), b2 + hstep, voffB); PG8_STAGE(PG8_SA(0, 0), a2, voffA);
            PG8_WAIT_V(8); PG8_WAIT_L(0); PG8_BAR; PG8_MMA(1, 0, At, B0); PG8_MMA(1, 1, At, B1); PG8_BAR; PG8_SCHED;
            PG8_LDB(B0, 1, 0); PG8_LDB(B1, 1, 1); PG8_SCHED; PG8_LDA(At, 1, 0); PG8_STAGE(PG8_SA(0, 1), a2 + hstep, voffA);
            PG8_WAIT_V(8); PG8_WAIT_L(0); PG8_BAR; PG8_MMA(0, 0, At, B0); PG8_MMA(0, 1, At, B1); PG8_BAR; PG8_SCHED;
            PG8_LDA(At, 1, 1); PG8_STAGE(PG8_SB(1, 0), b3, voffB); PG8_STAGE(PG8_SB(1, 1), b3 + hstep, voffB); PG8_STAGE(PG8_SA(1, 0), a3, voffA);
            PG8_WAIT_V(8); PG8_WAIT_L(0); PG8_BAR; PG8_MMA(1, 0, At, B0); PG8_MMA(1, 1, At, B1); PG8_BAR; PG8_SCHED;
            } else {
            PG8_LDB(B0, 0, 0); PG8_SCHED; PG8_LDA(At, 0, 0); PG8_STAGE(PG8_SA(1, 1), a1 + hstep, voffA);
            PG8_WAIT_L(8); PG8_BAR; PG8_WAIT_L(0); PG8_MMA(0, 0, At, B0); PG8_BAR; PG8_SCHED;
            PG8_LDB(B1, 0, 1); PG8_STAGE(PG8_SB(0, 0), b2, voffB);
            PG8_BAR; PG8_WAIT_L(0); PG8_MMA(0, 1, At, B1); PG8_BAR;
            PG8_LDA(At, 0, 1); PG8_STAGE(PG8_SA(0, 0), a2, voffA);
            PG8_BAR; PG8_WAIT_L(0); PG8_MMA(1, 0, At, B0); PG8_BAR; PG8_SCHED;
            PG8_STAGE(PG8_SB(0, 1), b2 + hstep, voffB);
            PG8_WAIT_V(6); PG8_BAR; PG8_MMA(1, 1, At, B1); PG8_BAR;
            PG8_LDB(B0, 1, 0); PG8_SCHED; PG8_LDA(At, 1, 0); PG8_STAGE(PG8_SA(0, 1), a2 + hstep, voffA);
            PG8_WAIT_L(8); PG8_BAR; PG8_WAIT_L(0); PG8_MMA(0, 0, At, B0); PG8_BAR; PG8_SCHED;
            PG8_LDB(B1, 1, 1); PG8_STAGE(PG8_SB(1, 0), b3, voffB);
            PG8_BAR; PG8_WAIT_L(0); PG8_MMA(0, 1, At, B1); PG8_BAR;
            PG8_LDA(At, 1, 1); PG8_STAGE(PG8_SA(1, 0), a3, voffA);
            PG8_BAR; PG8_WAIT_L(0); PG8_MMA(1, 0, At, B0); PG8_BAR; PG8_SCHED;
            PG8_STAGE(PG8_SB(1, 1), b3 + hstep, voffB);
            PG8_WAIT_V(6); PG8_BAR; PG8_MMA(1, 1, At, B1); PG8_BAR;
            }
        }
        if constexpr (ALIGN_EPI) { if (wr == 0) PG8_BAR; }
        bool keep = false;
        if constexpr (Epi::CHAIN) { E.chain(acc, cur, wr, wc, fr, fq); keep = Epi::KEEP && (cur.aux == 0); } else E(acc, cur, wr, wc, fr, fq);
        if (!has_next) break;
        if (!keep) {
#pragma unroll
        for (int a = 0; a < 2; ++a)
#pragma unroll
            for (int b = 0; b < 2; ++b)
#pragma unroll
                for (int m = 0; m < 4; ++m)
#pragma unroll
                    for (int n = 0; n < 2; ++n) acc[a][b][m][n] = (f32x4){0.f, 0.f, 0.f, 0.f};
        }
        cur = nxt; cA = nA; cB = nB; ++ui;
        if constexpr (ALIGN_EPI) { if (wr == 1) PG8_BAR; }
    }
    PG8_WAIT_V(0);
    if constexpr (!ALIGN_EPI) { if (wr == 0) PG8_BAR; }
    PG8_BAR;
#undef PG8_SA
#undef PG8_SB
#undef PG8_STAGE
#undef PG8_LDA
#undef PG8_LDB
#undef PG8_MMA
#undef PG8_WAIT_V
#undef PG8_WAIT_L
#undef PG8_BAR
#undef PG8_SCHED
}

enum Act { ACT_NONE = 0, ACT_GELU = 1, ACT_SILU = 2, ACT_SIGM = 3, ACT_QSC = 4, ACT_AF32 = 5, ACT_VT = 6 };
struct EpiAct { static constexpr bool CHAIN = false;
    template <int ACT> __device__ __forceinline__ void run(const f32x4 (&acc)[2][2][4][2], const Unit& u, int r0, int c0) const {
        bf16_t* O = (bf16_t*)u.pO; if (ACT == ACT_VT) c0 = (c0 >> 6) * 65536 + (c0 & 63);
#pragma unroll
        for (int ai = 0; ai < 2; ++ai)
#pragma unroll
            for (int m = 0; m < 4; ++m) { bf16_t* rowp = O + (size_t)(r0 + ai * HALF + m * 16) * u.ldc + c0;
#pragma unroll
                for (int bj = 0; bj < 2; ++bj) { f32x4 v0 = acc[ai][bj][m][0], v1 = acc[ai][bj][m][1];
                    if (ACT == ACT_GELU) { f32x2 a = gelu_pk((f32x2){v0[0], v0[1]}), b = gelu_pk((f32x2){v0[2], v0[3]}), c = gelu_pk((f32x2){v1[0], v1[1]}), d = gelu_pk((f32x2){v1[2], v1[3]});
                        v0 = (f32x4){a.x, a.y, b.x, b.y}; v1 = (f32x4){c.x, c.y, d.x, d.y}; }
                    if (ACT == ACT_SILU) {
#pragma unroll
                        for (int j = 0; j < 4; ++j) { v0[j] = v0[j] * sigm(v0[j]); v1[j] = v1[j] * sigm(v1[j]); } }
                    if (ACT == ACT_SIGM) {
#pragma unroll
                        for (int j = 0; j < 4; ++j) { v0[j] = sigm(v0[j]); v1[j] = sigm(v1[j]); } }
                    if (ACT == ACT_QSC) { v0 = v0 * 0.08838834764831845f; v1 = v1 * 0.08838834764831845f; }
                    u32x4 w; w.x = cvt_pk_bf16(v0[0], v0[1]); w.y = cvt_pk_bf16(v0[2], v0[3]); w.z = cvt_pk_bf16(v1[0], v1[1]); w.w = cvt_pk_bf16(v1[2], v1[3]);
                    *(u32x4*)(rowp + (ACT == ACT_VT ? bj * 2 * 65536 : bj * HALF)) = w; } }
    }
    __device__ __forceinline__ void run_gate8(const f32x4 (&acc)[2][2][4][2], const Unit& u, int r0, int c0, float lo) const {
        unsigned char* O = (unsigned char*)u.pO;
#pragma unroll
        for (int ai = 0; ai < 2; ++ai)
#pragma unroll
            for (int m = 0; m < 4; ++m) { unsigned char* rowp = O + (size_t)(r0 + ai * HALF + m * 16) * u.ldc + c0;
#pragma unroll
                for (int bj = 0; bj < 2; ++bj) { u32x2 w = {0u, 0u};
#pragma unroll
                    for (int j = 0; j < 8; ++j) { const float x = j < 4 ? acc[ai][bj][m][0][j] : acc[ai][bj][m][1][j - 4];
                        const float q = fmaxf(__builtin_amdgcn_rcpf(__builtin_amdgcn_exp2f(x) * (1.0f / 255.0f) + (1.0f / 255.0f)), lo);
                        if (j < 4) w.x = __builtin_amdgcn_cvt_pk_u8_f32(q, j, w.x); else w.y = __builtin_amdgcn_cvt_pk_u8_f32(q, j - 4, w.y); }
                    *(u32x2*)(rowp + bj * HALF) = w; } }
    }
    __device__ __forceinline__ void operator()(const f32x4 (&acc)[2][2][4][2], const Unit& u, int wr, int wc, int fr, int fq) const {
        const int r0 = wr * 64 + fr, c0 = wc * 32 + 8 * fq;
        switch (u.act) {
        case ACT_NONE: run<ACT_NONE>(acc, u, r0, c0); break;
        case ACT_GELU: run<ACT_GELU>(acc, u, r0, c0); break;
        case ACT_SILU: run<ACT_SILU>(acc, u, r0, c0); break;
        case ACT_SIGM: run_gate8(acc, u, r0, c0, u.aux ? 1.0f : 0.0f); break;
        case ACT_QSC:  run<ACT_QSC>(acc, u, r0, c0); break;
        case ACT_VT:   run<ACT_VT>(acc, u, r0, c0); break;
        default:
            if (wc == 0) { float* O = (float*)u.pO;
#pragma unroll
                for (int ai = 0; ai < 2; ++ai)
#pragma unroll
                    for (int m = 0; m < 4; ++m) { float* rowp = O + (size_t)(r0 + ai * HALF + m * 16) * u.ldc + 8 * fq;
                        *(f32x4*)rowp = acc[ai][0][m][0]; *(f32x4*)(rowp + 4) = acc[ai][0][m][1]; } }
            break;
        }
    }
};
struct EpiMrg { static constexpr bool CHAIN = true, KEEP = true; const unsigned char* GA; const unsigned char* GB; bf16_t* Y;
    __device__ __forceinline__ void chain(f32x4 (&acc)[2][2][4][2], const Unit& u, int wr, int wc, int fr, int fq) const {
        const size_t o0 = (size_t)(u.pm * BM + wr * 64 + fr) * 1024 + u.pn * BM + wc * 32 + 8 * fq;
        if (u.aux == 0) {
#pragma unroll
            for (int ai = 0; ai < 2; ++ai)
#pragma unroll
                for (int m = 0; m < 4; ++m)
#pragma unroll
                    for (int bj = 0; bj < 2; ++bj) { const size_t o = o0 + (size_t)(ai * HALF + m * 16) * 1024 + bj * HALF;
                        const u32x2 a = *(const u32x2*)(GA + o), b = *(const u32x2*)(GB + o);
                        const float ra[8] = {ub8(a.x, 0), ub8(a.x, 1), ub8(a.x, 2), ub8(a.x, 3),
                                             ub8(a.y, 0), ub8(a.y, 1), ub8(a.y, 2), ub8(a.y, 3)};
                        const float rb[8] = {ub8(b.x, 0), ub8(b.x, 1), ub8(b.x, 2), ub8(b.x, 3),
                                             ub8(b.y, 0), ub8(b.y, 1), ub8(b.y, 2), ub8(b.y, 3)};
#pragma unroll
                        for (int e = 0; e < 8; ++e) { const float r = ra[e] * __builtin_amdgcn_rcpf(rb[e]); if (e < 4) acc[ai][bj][m][0][e] *= r; else acc[ai][bj][m][1][e - 4] *= r; } }
        } else {
#pragma unroll
            for (int ai = 0; ai < 2; ++ai)
#pragma unroll
                for (int m = 0; m < 4; ++m)
#pragma unroll
                    for (int bj = 0; bj < 2; ++bj) { const size_t o = o0 + (size_t)(ai * HALF + m * 16) * 1024 + bj * HALF;
                        const u32x2 g = *(const u32x2*)(GB + o); constexpr float s8 = 1.0f / 255.0f;
                        f32x4 v0 = acc[ai][bj][m][0], v1 = acc[ai][bj][m][1];
                        v0[0] *= ub8(g.x, 0) * s8; v0[1] *= ub8(g.x, 1) * s8; v0[2] *= ub8(g.x, 2) * s8; v0[3] *= ub8(g.x, 3) * s8;
                        v1[0] *= ub8(g.y, 0) * s8; v1[1] *= ub8(g.y, 1) * s8; v1[2] *= ub8(g.y, 2) * s8; v1[3] *= ub8(g.y, 3) * s8;
                        u32x4 w; w.x = cvt_pk_bf16(v0[0], v0[1]); w.y = cvt_pk_bf16(v0[2], v0[3]); w.z = cvt_pk_bf16(v1[0], v1[1]); w.w = cvt_pk_bf16(v1[2], v1[3]);
                        *(u32x4*)(Y + o) = w; }
        }
    }
};
struct EpiRes { const float* X; static constexpr bool CHAIN = false; const float* MOD; float* O; int goff;
    __device__ __forceinline__ void operator()(const f32x4 (&acc)[2][2][4][2], const Unit& u, int wr, int wc, int fr, int fq) const {
        const int cb = u.pn * BM + wc * 32 + 8 * fq; const size_t o0 = (size_t)(u.pm * BM + wr * 64 + fr) * 1024 + cb;
        const float* gp = MOD + ((u.pm * BM) / T) * 6144 + goff + cb;
        f32x4 g[2][2];
#pragma unroll
        for (int bj = 0; bj < 2; ++bj) { g[bj][0] = *(const f32x4*)(gp + bj * HALF); g[bj][1] = *(const f32x4*)(gp + bj * HALF + 4); }
#pragma unroll
        for (int ai = 0; ai < 2; ++ai)
#pragma unroll
            for (int m = 0; m < 4; ++m)
#pragma unroll
                for (int bj = 0; bj < 2; ++bj) { const size_t o = o0 + (size_t)(ai * HALF + m * 16) * 1024 + bj * HALF;
                    const f32x4 x0 = *(const f32x4*)(X + o), x1 = *(const f32x4*)(X + o + 4);
                    *(f32x4*)(O + o) = x0 + g[bj][0] * acc[ai][bj][m][0]; *(f32x4*)(O + o + 4) = x1 + g[bj][1] * acc[ai][bj][m][1]; }
    }
};
struct EpiFin { static constexpr bool CHAIN = true, KEEP = false; const bf16_t* X1; const float* GV2; const float* MOD; const float* FG; float* O; unsigned long long* ROWSS2; unsigned* CNT;
    __device__ __forceinline__ void chain(f32x4 (&acc)[2][2][4][2], const Unit& u, int wr, int wc, int fr, int fq) const {
        const int cb = u.pn * BM + wc * 32 + 8 * fq, r0 = u.pm * BM + wr * 64 + fr; const size_t o0 = (size_t)r0 * 1024 + cb;
        const float* gp = MOD + ((u.pm * BM) / T) * 6144 + 5120 + cb;
        {   f32x4 g[2][2], iv[2][2]; float ssv[8]; const float* vp = GV2 + ((u.pm * BM) / T) * 1024 + cb;
#pragma unroll
            for (int bj = 0; bj < 2; ++bj) { g[bj][0] = *(const f32x4*)(gp + bj * HALF); g[bj][1] = *(const f32x4*)(gp + bj * HALF + 4);
                const f32x4 v0 = *(const f32x4*)(vp + bj * HALF), v1 = *(const f32x4*)(vp + bj * HALF + 4);
#pragma unroll
                for (int e = 0; e < 4; ++e) { iv[bj][0][e] = 1.0f / v0[e]; iv[bj][1][e] = 1.0f / v1[e]; } }
#pragma unroll
            for (int ai = 0; ai < 2; ++ai)
#pragma unroll
                for (int m = 0; m < 4; ++m) { float ss = 0.f;
#pragma unroll
                    for (int bj = 0; bj < 2; ++bj) { const size_t o = o0 + (size_t)(ai * HALF + m * 16) * 1024 + bj * HALF;
                        const u32x4 xr = *(const u32x4*)(X1 + o);
                        const f32x4 xa = {__uint_as_float(xr.x << 16), __uint_as_float(xr.x & 0xffff0000u), __uint_as_float(xr.y << 16), __uint_as_float(xr.y & 0xffff0000u)}, xb = {__uint_as_float(xr.z << 16), __uint_as_float(xr.z & 0xffff0000u), __uint_as_float(xr.w << 16), __uint_as_float(xr.w & 0xffff0000u)};
                        const f32x4 x0 = xa * iv[bj][0] + g[bj][0] * acc[ai][bj][m][0], x1 = xb * iv[bj][1] + g[bj][1] * acc[ai][bj][m][1];
                        acc[ai][bj][m][0] = x0; acc[ai][bj][m][1] = x1;
                        ss += (x0[0] * x0[0] + x0[1] * x0[1]) + (x0[2] * x0[2] + x0[3] * x0[3]) + (x1[0] * x1[0] + x1[1] * x1[1]) + (x1[2] * x1[2] + x1[3] * x1[3]); }
                    ss += __shfl_xor(ss, 16); ss += __shfl_xor(ss, 32); ssv[ai * 4 + m] = ss;
                    asm volatile("" ::: "memory"); }
#pragma unroll
            for (int h = 0; h < 2; ++h) { const int gs = 2 * fq + h; float v = 0.f;
#pragma unroll
                for (int g2 = 0; g2 < 8; ++g2) v = gs == g2 ? ssv[g2] : v;
                atomicAdd(ROWSS2 + r0 + (gs >> 2) * HALF + (gs & 3) * 16, (unsigned long long)(v * 1073741824.0f) + (1ull << 58)); }
        }
        f32x4 fg[2][2];
#pragma unroll
        for (int bj = 0; bj < 2; ++bj) { fg[bj][0] = *(const f32x4*)(FG + cb + bj * HALF); fg[bj][1] = *(const f32x4*)(FG + cb + bj * HALF + 4); }
        unsigned long long tot[2][4];
        for (unsigned spins = 0;; ++spins) { bool ok = true;
#pragma unroll
            for (int ai = 0; ai < 2; ++ai)
#pragma unroll
                for (int m = 0; m < 4; ++m) tot[ai][m] = __hip_atomic_load(ROWSS2 + r0 + ai * HALF + m * 16, __ATOMIC_RELAXED, __HIP_MEMORY_SCOPE_AGENT);
#pragma unroll
            for (int ai = 0; ai < 2; ++ai)
#pragma unroll
                for (int m = 0; m < 4; ++m) ok = ok && ((tot[ai][m] >> 58) >= 16ull);
            if (__builtin_amdgcn_ballot_w64(!ok) == 0ull || spins > (1u << 20)) break;
            __builtin_amdgcn_s_sleep(1); }
#pragma unroll
        for (int ai = 0; ai < 2; ++ai)
#pragma unroll
            for (int m = 0; m < 4; ++m) tot[ai][m] &= ((1ull << 58) - 1ull);
#pragma unroll
        for (int ai = 0; ai < 2; ++ai)
#pragma unroll
            for (int m = 0; m < 4; ++m) {
                const float rs = __builtin_amdgcn_rsqf((float)tot[ai][m] * (1.0f / (1073741824.0f * 1024.0f)) + EPS);
#pragma unroll
                for (int bj = 0; bj < 2; ++bj) { const size_t o = o0 + (size_t)(ai * HALF + m * 16) * 1024 + bj * HALF;
                    *(f32x4*)(O + o) = acc[ai][bj][m][0] * rs * fg[bj][0]; *(f32x4*)(O + o + 4) = acc[ai][bj][m][1] * rs * fg[bj][1]; } }
    }
};
struct EpiSwi { bf16_t* HBp; static constexpr bool CHAIN = false;
    __device__ __forceinline__ void operator()(const f32x4 (&acc)[2][2][4][2], const Unit& u, int wr, int wc, int fr, int fq) const {
        const size_t o0 = (size_t)(u.pm * BM + wr * 64 + fr) * DFF + u.pn * HALF + wc * 32 + 8 * fq;
#pragma unroll
        for (int ai = 0; ai < 2; ++ai)
#pragma unroll
            for (int m = 0; m < 4; ++m) { const f32x4 a0 = acc[ai][0][m][0], a1 = acc[ai][0][m][1], g0 = acc[ai][1][m][0], g1 = acc[ai][1][m][1]; f32x4 v0, v1;
#pragma unroll
                for (int j = 0; j < 4; ++j) { v0[j] = a0[j] * g0[j] * sigm(g0[j]); v1[j] = a1[j] * g1[j] * sigm(g1[j]); }
                u32x4 w; w.x = cvt_pk_bf16(v0[0], v0[1]); w.y = cvt_pk_bf16(v0[2], v0[3]); w.z = cvt_pk_bf16(v1[0], v1[1]); w.w = cvt_pk_bf16(v1[2], v1[3]);
                *(u32x4*)(HBp + o0 + (size_t)(ai * HALF + m * 16) * DFF) = w; }
    }
};

struct EpiRes2 { static constexpr bool CHAIN = false; const float* X; const float* MOD; const float* GV2; bf16_t* X1; bf16_t* A2; unsigned long long* ROWSS;
    __device__ __forceinline__ void operator()(const f32x4 (&acc)[2][2][4][2], const Unit& u, int wr, int wc, int fr, int fq) const {
        const int cb = u.pn * BM + wc * 32 + 8 * fq, bidx = (u.pm * BM) / T; const int r0 = u.pm * BM + wr * 64 + fr; const size_t o0 = (size_t)r0 * 1024 + cb;
        const float* gp = MOD + bidx * 6144 + 2048 + cb; const float* vp = GV2 + bidx * 1024 + cb;
        f32x4 g[2][2], gv[2][2]; float ssv[8];
#pragma unroll
        for (int bj = 0; bj < 2; ++bj) { g[bj][0] = *(const f32x4*)(gp + bj * HALF); g[bj][1] = *(const f32x4*)(gp + bj * HALF + 4); gv[bj][0] = *(const f32x4*)(vp + bj * HALF); gv[bj][1] = *(const f32x4*)(vp + bj * HALF + 4); }
#pragma unroll
        for (int ai = 0; ai < 2; ++ai)
#pragma unroll
            for (int m = 0; m < 4; ++m) { float ss = 0.f;
#pragma unroll
                for (int bj = 0; bj < 2; ++bj) { const size_t o = o0 + (size_t)(ai * HALF + m * 16) * 1024 + bj * HALF;
                    const f32x4 x0 = *(const f32x4*)(X + o) + g[bj][0] * acc[ai][bj][m][0], x1 = *(const f32x4*)(X + o + 4) + g[bj][1] * acc[ai][bj][m][1];
                    ss += (x0[0] * x0[0] + x0[1] * x0[1]) + (x0[2] * x0[2] + x0[3] * x0[3]) + (x1[0] * x1[0] + x1[1] * x1[1]) + (x1[2] * x1[2] + x1[3] * x1[3]);
                    const f32x4 a0 = x0 * gv[bj][0], a1 = x1 * gv[bj][1];
                    u32x4 w; w.x = cvt_pk_bf16(a0[0], a0[1]); w.y = cvt_pk_bf16(a0[2], a0[3]); w.z = cvt_pk_bf16(a1[0], a1[1]); w.w = cvt_pk_bf16(a1[2], a1[3]);
                    *(u32x4*)(A2 + o) = w; }
                ss += __shfl_xor(ss, 16); ss += __shfl_xor(ss, 32); ssv[ai * 4 + m] = ss; }
#pragma unroll
        for (int h = 0; h < 2; ++h) { const int gs = 2 * fq + h; float v = 0.f;
#pragma unroll
            for (int g = 0; g < 8; ++g) v = gs == g ? ssv[g] : v;
            atomicAdd(ROWSS + r0 + (gs >> 2) * HALF + (gs & 3) * 16, (unsigned long long)(v * 1073741824.0f)); }
    }
};
struct EpiSwi2 { static constexpr bool CHAIN = false; bf16_t* HBp; const unsigned long long* ROWSS; const float* CV;
    __device__ __forceinline__ void operator()(const f32x4 (&acc)[2][2][4][2], const Unit& u, int wr, int wc, int fr, int fq) const {
        const int r0 = u.pm * BM + wr * 64 + fr, cc = u.pn * HALF + wc * 32 + 8 * fq, bidx = (u.pm * BM) / T;
        const size_t o0 = (size_t)r0 * DFF + cc;
        const float* cp = CV + bidx * (2 * DFF) + cc;
        const f32x4 ca0 = *(const f32x4*)cp, ca1 = *(const f32x4*)(cp + 4), cg0 = *(const f32x4*)(cp + DFF), cg1 = *(const f32x4*)(cp + DFF + 4);
        float rsv[2][4];
#pragma unroll
        for (int ai = 0; ai < 2; ++ai)
#pragma unroll
            for (int m = 0; m < 4; ++m) rsv[ai][m] = (float)ROWSS[r0 + ai * HALF + m * 16];
#pragma unroll
        for (int ai = 0; ai < 2; ++ai)
#pragma unroll
            for (int m = 0; m < 4; ++m) { const float rs = __builtin_amdgcn_rsqf(rsv[ai][m] * (1.0f / (1073741824.0f * 1024.0f)) + EPS);
                const f32x4 a0 = acc[ai][0][m][0] * rs + ca0, a1 = acc[ai][0][m][1] * rs + ca1, g0 = acc[ai][1][m][0] * rs + cg0, g1 = acc[ai][1][m][1] * rs + cg1; f32x4 v0, v1;
#pragma unroll
                for (int j = 0; j < 4; ++j) { v0[j] = a0[j] * g0[j] * sigm(g0[j]); v1[j] = a1[j] * g1[j] * sigm(g1[j]); }
                u32x4 w; w.x = cvt_pk_bf16(v0[0], v0[1]); w.y = cvt_pk_bf16(v0[2], v0[3]); w.z = cvt_pk_bf16(v1[0], v1[1]); w.w = cvt_pk_bf16(v1[2], v1[3]);
                *(u32x4*)(HBp + o0 + (size_t)(ai * HALF + m * 16) * DFF) = w; }
    }
};
struct OrderGrid { const char* A; const char* Bt; int nM, nN, K, G, c;
    __device__ __forceinline__ bool next(int i, Unit& u) const {
        const int nwg = nM * nN; const long L = (long)i * G + c; if (L >= nwg) return false;
        const int w = xcd_remap((int)L, nwg);
        const int nig = 8 * nN, gid = w / nig, fm = gid * 8, gsz = (nM - fm) < 8 ? (nM - fm) : 8;
        u.pm = fm + ((w % nig) % gsz); u.pn = (w % nig) / gsz;
        u.pA = A + (size_t)u.pm * 256 * K * 2; u.pB = Bt + (size_t)u.pn * 256 * K * 2; u.pO = nullptr; u.ldc = 0; u.act = 0; u.aux = 0; return true;
    }
};
struct OrderMrg { const char* A0; const char* B0; const char* A1; const char* B1; int G, c;
    __device__ __forceinline__ bool next(int i, Unit& u) const {
        constexpr int nM = 128, nN = 4, nwg = nM * nN; const long L = (long)(i >> 1) * G + c; if (L >= nwg) return false;
        const int w = xcd_remap((int)L, nwg);
        const int nig = 8 * nN, gid = w / nig, fm = gid * 8;
        u.pm = fm + ((w % nig) & 7); u.pn = (w % nig) >> 3; u.aux = i & 1;
        u.pA = ((i & 1) ? A1 : A0) + (size_t)u.pm * 256 * 1024 * 2; u.pB = ((i & 1) ? B1 : B0) + (size_t)u.pn * 256 * 1024 * 2; u.pO = nullptr; u.ldc = 0; u.act = 0; return true;
    }
};
struct Order1A { const char* H; const char* WT1A; const char* WTVV; char* Q; char* Kb; char* AFp; char* VVT; int G, c;
    __device__ __forceinline__ bool next(int i, Unit& u) const {
        constexpr int NWG = 1208; const long L = (long)i * G + c; if (L >= NWG) return false;
        int w = xcd_remap((int)L, NWG);
        int tok, col; bool swapped;
        if (w < 640) { const int gid = w / 40, r = w % 40; tok = gid * 8 + (r & 7); col = r >> 3; swapped = false; }
        else if (w < 1152) { w -= 640; const int gid = w / 32, r = w & 31; tok = gid * 8 + (r & 7); col = r >> 3; swapped = true; }
        else if (w < 1176) { w -= 1152; tok = 128 + (w & 7); col = 2 + (w >> 3); swapped = false; }
        else { w -= 1176; tok = 128 + (w & 7); col = w >> 3; swapped = true; }
        u.pm = tok; u.pn = col; u.aux = 0;
        const char* hp = H + (size_t)tok * 256 * 1024 * 2;
        if (swapped) { u.pA = WTVV + (size_t)col * 256 * 1024 * 2; u.pB = hp; u.pO = VVT + ((size_t)(tok * 4) * 65536 + (size_t)(col * 256) * 64) * 2; u.ldc = 64; u.act = ACT_VT; }
        else { u.pA = hp; u.pB = WT1A + (size_t)col * 256 * 1024 * 2;
            if (col < 2) { u.pO = Q + ((size_t)(tok * 256) * QKW + col * 256) * 2; u.ldc = QKW; u.act = ACT_NONE; }
            else if (col < 4) { u.pO = Kb + ((size_t)(tok * 256) * QKW + (col - 2) * 256) * 2; u.ldc = QKW; u.act = ACT_NONE; }
            else { u.pO = AFp + (size_t)(tok * 256) * 32 * 4; u.ldc = 32; u.act = ACT_AF32; } }
        return true;
    }
};
struct Order1B { const char* H; const char* WT1B; const char* WTVA; char* U; char* R; char* GA; char* GB; char* GVT; int G, c;
    __device__ __forceinline__ bool next(int i, Unit& u) const {
        const long L = (long)i * G + c; if (L >= 2560) return false;
        int w = L < 2048 ? xcd_remap((int)L, 2048) : 2048 + xcd_remap((int)L - 2048, 512);
        u.aux = 0;
        if (w < 2048) { const int gid = w >> 7, r = w & 127, tok = gid * 8 + (r & 7), col = r >> 3; u.pm = tok; u.pn = col;
            u.pA = H + (size_t)tok * 256 * 1024 * 2; u.pB = WT1B + (size_t)col * 256 * 1024 * 2; u.ldc = 1024;
            const int seg = col >> 2; const long long dR = R - U, dGA = GA - U, dGB = GB - U;
            const long long dsel = (seg == 1 ? dR : 0ll) + (seg == 2 ? dGA : 0ll) + (seg == 3 ? dGB : 0ll);
            u.act = seg == 0 ? ACT_GELU : seg == 1 ? ACT_NONE : ACT_SIGM;
            const size_t eo = (size_t)(tok * 256) * 1024 + (col & 3) * 256; u.pO = U + dsel + (seg >= 2 ? eo : eo * 2); u.aux = seg == 3 ? 1 : 0; }
        else { w -= 2048; const int gid = w >> 5, r = w & 31, tok = gid * 8 + (r & 7), ch = r >> 3; u.pm = tok; u.pn = ch;
            u.pA = WTVA + (size_t)ch * 256 * 1024 * 2; u.pB = H + (size_t)tok * 256 * 1024 * 2; u.pO = GVT + ((size_t)(ch * 256) * ML + tok * 256) * 2; u.ldc = ML; u.act = ACT_GELU; }
        return true;
    }
};
}

#define LAS __attribute__((address_space(3)))

namespace gla {
typedef short bf16x8 __attribute__((ext_vector_type(8)));
typedef float f32x4 __attribute__((ext_vector_type(4)));
typedef unsigned u32x4 __attribute__((ext_vector_type(4)));
typedef unsigned u32x2 __attribute__((ext_vector_type(2)));
constexpr int PKG_L_BYTES = 41984, PKG_C_BYTES = 17408, OFF_EL = 0, OFF_KS = 1024, OFF_QD = 17408, OFF_AT = 33792;
constexpr int SLOT_BYTES = PKG_L_BYTES + 8192, OFF_V = PKG_L_BYTES;
constexpr size_t WS_PKGC = 487 * MiB, WS_PKGD = 500 * MiB;
static_assert(WS_PKG + (size_t)64 * 64 * PKG_L_BYTES <= WS_OF && WS_PKGC + (size_t)64 * 4 * PKG_C_BYTES <= WS_END, "package regions");
constexpr float LOG2E = 1.44269504088896f;
__device__ __forceinline__ unsigned cvt_pk(float lo, float hi) { typedef __bf16 v2bf __attribute__((ext_vector_type(2))); typedef float v2f __attribute__((ext_vector_type(2)));
    const v2f x = {lo, hi}; const v2bf y = __builtin_convertvector(x, v2bf); return __builtin_bit_cast(unsigned, y); }
__device__ __forceinline__ float bfr(float f) { return __uint_as_float((__float_as_uint(f) + 0x7fffu + ((__float_as_uint(f) >> 16) & 1u)) & 0xffff0000u); }
__device__ __forceinline__ char* pkg_ptr(unsigned char* ws, int seq, int ch) {
    return ch < 4 ? (char*)ws + WS_PKGC + (size_t)(seq * 4 + ch) * PKG_C_BYTES : (char*)ws + WS_PKG + (size_t)(seq * 64 + (ch - 4)) * PKG_L_BYTES;
}
#define GLA_BAR() do { asm volatile("s_waitcnt lgkmcnt(0)" ::: "memory"); __builtin_amdgcn_s_barrier(); asm volatile("" ::: "memory"); } while (0)

__device__ __forceinline__ void prepass_phase(LAS unsigned char* lds, unsigned char* ws, const float* w_af, const float* b_af, const float* w_ab, const float* b_ab, int G, int c) {
    const int tid = threadIdx.x, w = __builtin_amdgcn_readfirstlane(tid >> 6), lane = tid & 63, lc = lane & 15, lg = lane >> 4;
    LAS float* B2 = (LAS float*)lds;
    LAS float* BL = (LAS float*)(lds + 33792);
    LAS unsigned char* QD = lds + 34816;
    LAS unsigned char* KI = lds + 51200;
    LAS unsigned short* KST = (LAS unsigned short*)(lds + 67584);
    LAS float* AFL = (LAS float*)(lds + 83968);
    LAS float* WL = (LAS float*)(lds + 93184);
    const bf16* Qg = (const bf16*)(ws + WS_Q); const bf16* Kg = (const bf16*)(ws + WS_K); const float* AF = (const float*)(ws + WS_AF);
    constexpr int NITEMS = 64 * 68;
    struct In1 { f32x4 araw; float bias; };
    struct In2 { u32x4 k[2]; u32x4 q[2]; };
    auto load1 = [&](int item_, In1& p) { const int item = item_ < NITEMS ? item_ : NITEMS - 1; const int seq = item / 68, ch = item - seq * 68, dir = seq >> 5, b = (seq >> 2) & 7, h = seq & 3;
        const int row0 = ch < 4 ? ML + b * TC + ch * 64 : b * T + (ch - 4) * 64, dk = 16 * w + lc;
        p.bias = (dir ? b_ab : b_af)[h * DK + dk];
        p.araw = *(const f32x4*)(AF + (size_t)row0 * 32 + tid * 4); };
    auto put_af = [&](const In1& p) { float hi[4], lo[4];
#pragma unroll
        for (int j = 0; j < 4; ++j) { hi[j] = bfr(p.araw[j]); lo[j] = bfr(p.araw[j] - hi[j]); }
        u32x2 h, l; h.x = (__float_as_uint(hi[0]) >> 16) | (__float_as_uint(hi[1]) & 0xffff0000u); h.y = (__float_as_uint(hi[2]) >> 16) | (__float_as_uint(hi[3]) & 0xffff0000u);
        l.x = (__float_as_uint(lo[0]) >> 16) | (__float_as_uint(lo[1]) & 0xffff0000u); l.y = (__float_as_uint(lo[2]) >> 16) | (__float_as_uint(lo[3]) & 0xffff0000u);
        LAS unsigned char* rp = (LAS unsigned char*)AFL + (tid >> 3) * 144 + (tid & 7) * 8; *(LAS u32x2*)rp = h; *(LAS u32x2*)(rp + 64) = l; };
    auto load2 = [&](int item_, In2& p) { const int item = item_ < NITEMS ? item_ : NITEMS - 1; const int seq = item / 68, ch = item - seq * 68, b = (seq >> 2) & 7, h = seq & 3;
        const int row0 = ch < 4 ? ML + b * TC + ch * 64 : b * T + (ch - 4) * 64;
        const bf16* qsrc = Qg + (ch < 4 ? (long long)(Kg - Qg) : 0ll);
#pragma unroll
        for (int rep = 0; rep < 2; ++rep) { const int f = w + 8 * rep, it = f >> 2, sidx = f & 3, i = 16 * it + lc;
            const size_t ro = (size_t)(row0 + i) * QKW + h * DK + 32 * sidx + 8 * lg;
            p.k[rep] = *(const u32x4*)(Kg + ro); p.q[rep] = *(const u32x4*)(qsrc + ro); } };
    struct Def { u32x4 aw, k0, k1; char* pq; char* pk; };
    auto flush = [&](const Def& d) { *(u32x4*)(d.pq + OFF_AT + ((w & 3) * 2 + (w >> 2)) * 1024 + lane * 16) = d.aw; *(u32x4*)(d.pk + OFF_KS + (2 * w) * 1024 + lane * 16) = d.k0; *(u32x4*)(d.pk + OFF_KS + (2 * w + 1) * 1024 + lane * 16) = d.k1; };
    auto body = [&](int item_, const In1& c1, const In2& c2, In1& n1, In2& n2, const Def& din, Def& dout) {
        const bool oob = item_ >= NITEMS; const int item = oob ? NITEMS - 1 : item_;
        const int seq = item / 68, ch = item - seq * 68, dir = seq >> 5, hh = seq & 3;
        const bool isctx = ch < 4;
        char* pkr = pkg_ptr(ws, seq, ch); char* dummy = (char*)ws + WS_PKGD;
        char* pk = dummy + (oob ? 0ll : (long long)(pkr - dummy));
        char* pkq = dummy + ((oob || isctx) ? 0ll : (long long)(pkr - dummy));
        {
            const int dk = 16 * w + lc;
            bf16x8 bh, bl;
#pragma unroll
            for (int j = 0; j < 8; ++j) { const float wv = WL[(dir * 16 + ((8 * lg + j) & 15)) * 512 + hh * DK + dk]; const float hi = bfr(wv); const float lo = bfr(wv - hi);
                bh[j] = (short)(__float_as_uint(hi) >> 16); bl[j] = lg < 2 ? (short)(__float_as_uint(lo) >> 16) : (short)0; }
            const float bias = c1.bias;
            float g2[4][4];
#pragma unroll
            for (int tt = 0; tt < 4; ++tt) {
                const bf16x8 af = *(const LAS bf16x8*)((const LAS unsigned char*)AFL + (16 * tt + lc) * 144 + (lg < 2 ? 0 : 64) + (dir * 16 + 8 * (lg & 1)) * 2);
                f32x4 z = (f32x4){0.f, 0.f, 0.f, 0.f};
                z = __builtin_amdgcn_mfma_f32_16x16x32_bf16(af, bh, z, 0, 0, 0);
                z = __builtin_amdgcn_mfma_f32_16x16x32_bf16(af, bl, z, 0, 0, 0);
#pragma unroll
                for (int r = 0; r < 4; ++r) { const float zz = z[r] + bias;
                    const float ls2 = fminf(zz, 0.f) * LOG2E - __builtin_amdgcn_logf(1.0f + __builtin_amdgcn_exp2f(-fabsf(zz) * LOG2E));
                    g2[tt][r] = ls2 * (1.0f / 16.0f); }
            }
            float pre[4][4], tot[4], all[4][4];
#pragma unroll
            for (int tt = 0; tt < 4; ++tt) { pre[tt][0] = g2[tt][0]; pre[tt][1] = pre[tt][0] + g2[tt][1]; pre[tt][2] = pre[tt][1] + g2[tt][2]; pre[tt][3] = pre[tt][2] + g2[tt][3]; tot[tt] = pre[tt][3]; }
#pragma unroll
            for (int tt = 0; tt < 4; ++tt)
#pragma unroll
                for (int q = 0; q < 4; ++q) all[tt][q] = __shfl(tot[tt], lc + 16 * q);
            float run = 0.f, total;
            float offs[4];
#pragma unroll
            for (int tt = 0; tt < 4; ++tt) { offs[tt] = run + (lg > 0 ? all[tt][0] : 0.f) + (lg > 1 ? all[tt][1] : 0.f) + (lg > 2 ? all[tt][2] : 0.f); run += (all[tt][0] + all[tt][1]) + (all[tt][2] + all[tt][3]); }
            total = run;
#pragma unroll
            for (int tt = 0; tt < 4; ++tt)
#pragma unroll
                for (int r = 0; r < 4; ++r) { const float incl = offs[tt] + pre[tt][r]; const float bb = dir ? (total - incl) + g2[tt][r] : incl; B2[(16 * tt + 4 * lg + r) * 132 + dk] = bb; }
            { const float et = __builtin_amdgcn_exp2f(total); BL[dk] = et; ((float*)(pk + OFF_EL))[dk] = et; }
        }
        GLA_BAR();
        load1(item_ + G, n1);
        flush(din);
#pragma unroll
        for (int rep = 0; rep < 2; ++rep) {
            const int f = w + 8 * rep, it = f >> 2, s = f & 3, i = 16 * it + lc, d0 = 32 * s + 4 * lg, d1 = d0 + 16;
            const f32x4 b0 = *(const LAS f32x4*)(B2 + i * 132 + d0), b1 = *(const LAS f32x4*)(B2 + i * 132 + d1), l0 = *(const LAS f32x4*)(BL + d0), l1 = *(const LAS f32x4*)(BL + d1);
            const u32x2 k0 = {c2.k[rep].x, c2.k[rep].y}, k1 = {c2.k[rep].z, c2.k[rep].w};
            float kv[8] = {__uint_as_float(k0.x << 16), __uint_as_float(k0.x & 0xffff0000u), __uint_as_float(k0.y << 16), __uint_as_float(k0.y & 0xffff0000u),
                           __uint_as_float(k1.x << 16), __uint_as_float(k1.x & 0xffff0000u), __uint_as_float(k1.y << 16), __uint_as_float(k1.y & 0xffff0000u)};
            float bb[8] = {b0[0], b0[1], b0[2], b0[3], b1[0], b1[1], b1[2], b1[3]}, ll[8] = {l0[0], l0[1], l0[2], l0[3], l1[0], l1[1], l1[2], l1[3]};
            float ki[8];
#pragma unroll
            for (int e = 0; e < 8; ++e) ki[e] = kv[e] * __builtin_amdgcn_exp2f(-bb[e]);
#pragma unroll
            for (int e = 0; e < 8; e += 2) { const int dk = (e < 4 ? d0 : d1) + (e & 3); const unsigned p = cvt_pk(ki[e] * ll[e], ki[e + 1] * ll[e + 1]);
                KST[dk * 64 + i] = (unsigned short)p; KST[(dk + 1) * 64 + i] = (unsigned short)(p >> 16); }
            {
                const u32x2 q0 = {c2.q[rep].x, c2.q[rep].y}, q1 = {c2.q[rep].z, c2.q[rep].w};
                float qv[8] = {__uint_as_float(q0.x << 16), __uint_as_float(q0.x & 0xffff0000u), __uint_as_float(q0.y << 16), __uint_as_float(q0.y & 0xffff0000u),
                               __uint_as_float(q1.x << 16), __uint_as_float(q1.x & 0xffff0000u), __uint_as_float(q1.y << 16), __uint_as_float(q1.y & 0xffff0000u)};
                float qd[8];
#pragma unroll
                for (int e = 0; e < 8; ++e) qd[e] = qv[e] * __builtin_amdgcn_exp2f(bb[e]);
                u32x4 qw, kw; qw.x = cvt_pk(qd[0], qd[1]); qw.y = cvt_pk(qd[2], qd[3]); qw.z = cvt_pk(qd[4], qd[5]); qw.w = cvt_pk(qd[6], qd[7]);
                kw.x = cvt_pk(ki[0], ki[1]); kw.y = cvt_pk(ki[2], ki[3]); kw.z = cvt_pk(ki[4], ki[5]); kw.w = cvt_pk(ki[6], ki[7]);
                *(LAS u32x4*)(QD + f * 1024 + lane * 16) = qw; *(LAS u32x4*)(KI + f * 1024 + lane * 16) = kw;
                *(u32x4*)(pkq + OFF_QD + f * 1024 + lane * 16) = qw;
            }
        }
        put_af(n1);
        GLA_BAR();
        load2(item_ + G, n2);
        {
            const int s2 = w >> 2, it = w & 3;
            f32x4 d0v = (f32x4){0.f, 0.f, 0.f, 0.f}, d1v = (f32x4){0.f, 0.f, 0.f, 0.f};
#pragma unroll
            for (int s = 0; s < 4; ++s) { const bf16x8 qf = *(const LAS bf16x8*)(QD + (it * 4 + s) * 1024 + lane * 16);
                const bf16x8 ka = *(const LAS bf16x8*)(KI + ((2 * s2) * 4 + s) * 1024 + lane * 16), kb = *(const LAS bf16x8*)(KI + ((2 * s2 + 1) * 4 + s) * 1024 + lane * 16);
                d0v = __builtin_amdgcn_mfma_f32_16x16x32_bf16(ka, qf, d0v, 0, 0, 0); d1v = __builtin_amdgcn_mfma_f32_16x16x32_bf16(kb, qf, d1v, 0, 0, 0); }
            const int i = 16 * it + lc; float a[8];
#pragma unroll
            for (int e = 0; e < 8; ++e) { const int j = 32 * s2 + (e < 4 ? 0 : 16) + 4 * lg + (e & 3); const float v = e < 4 ? d0v[e] : d1v[e - 4]; a[e] = (dir ? (i <= j) : (i >= j)) ? v : 0.f; }
            u32x4 aw; aw.x = cvt_pk(a[0], a[1]); aw.y = cvt_pk(a[2], a[3]); aw.z = cvt_pk(a[4], a[5]); aw.w = cvt_pk(a[6], a[7]);
            dout.aw = aw; dout.pq = pkq; dout.pk = pk;
        }
#pragma unroll
        for (int rep = 0; rep < 2; ++rep) { const int fi = 2 * w + rep, dkt = fi >> 1, sp = fi & 1, dk = 16 * dkt + lc;
            const u32x2 x0 = *(const LAS u32x2*)(KST + dk * 64 + 32 * sp + 4 * lg), x1 = *(const LAS u32x2*)(KST + dk * 64 + 32 * sp + 16 + 4 * lg);
            u32x4 o; o.x = x0.x; o.y = x0.y; o.z = x1.x; o.w = x1.y;
            if (rep == 0) dout.k0 = o; else dout.k1 = o; }
    };
    In1 a1, b1; In2 a2, b2;
    load1(c, a1); load2(c, a2);
    for (int i = tid; i < 2 * 16 * 512 / 4; i += 512) ((LAS f32x4*)WL)[i] = i < 2048 ? ((const f32x4*)w_af)[i] : ((const f32x4*)w_ab)[i - 2048];
    put_af(a1);
    GLA_BAR();
    Def da, db; { char* dummy = (char*)ws + WS_PKGD; da.pq = dummy; da.pk = dummy; da.aw = (u32x4){0u, 0u, 0u, 0u}; da.k0 = da.aw; da.k1 = da.aw; }
    int item = c;
    for (; item + G < NITEMS; item += 2 * G) {
        body(item, a1, a2, b1, b2, da, db);
        body(item + G, b1, b2, a1, a2, db, da);
    }
    if (item < NITEMS) { body(item, a1, a2, b1, b2, da, db); flush(db); }
    else flush(da);
}

__device__ __forceinline__ void scan_phase(LAS unsigned char* lds, unsigned char* ws, int G, int c) {
    const int tid = threadIdx.x, w = __builtin_amdgcn_readfirstlane(tid >> 6), lane = tid & 63, lc = lane & 15, lg = lane >> 4;
    const bf16* VVT = (const bf16*)(ws + WS_VVT);
    const int vc = (G % 8 == 0) ? (c % 8) * (G / 8) + c / 8 : c;
    for (int item = vc; item < 256; item += G) {
        const int seq = item >> 2, vs = item & 3, dir = seq >> 5, b = (seq >> 2) & 7, h = seq & 3;
        bf16* O = (bf16*)(ws + (dir ? WS_OB : WS_OF));
        auto chunk_of = [&](int st) { return st < 4 ? (dir ? 3 - st : st) : 4 + (dir ? 63 - (st - 4) : st - 4); };
        if (w >= 4) {
            const int lw = w - 4;
            auto ptr_of = [&](int st_) { const int st = st_ < 68 ? st_ : 67; return chunk_of(st); };
            auto own_src = [&](int st_, int k) -> const char* { const int ch = ptr_of(st_); const char* pk = pkg_ptr(ws, seq, ch); const int tot = ch < 4 ? 17 : 41, nown = (tot - vs + 3) >> 2;
                const int trow = ch < 4 ? ML + b * TC + ch * 64 : b * T + (ch - 4) * 64;
                const int j = lw + 4 * k;
                if (j < nown) return pk + (vs + 4 * j) * 1024 + lane * 16;
                if (j < nown + 8) return (const char*)(VVT + ((size_t)(trow >> 6) * 1024 + h * DV + vs * 64) * 64 + lane * 8) + (j - nown) * 1024;
                return pk + vs * 1024 + lane * 16; };
            auto own_dst = [&](int st, int k) -> int { const int ch = chunk_of(st); const int tot = ch < 4 ? 17 : 41, nown = (tot - vs + 3) >> 2; const int j = lw + 4 * k;
                return j < nown ? (vs + 4 * j) * 1024 : j < nown + 8 ? OFF_V + (j - nown) * 1024 : vs * 1024; };
            auto rest_piece = [&](int st_, int k) -> int { const int ch = ptr_of(st_); const int tot = ch < 4 ? 17 : 41, nown = (tot - vs + 3) >> 2, nrest = tot - nown; const int j = lw + 4 * k;
                const int jj = j < nrest ? j : 0, i3 = jj % 3; return (jj / 3) * 4 + (i3 < vs ? i3 : i3 + 1); };
            u32x4 oa[5], ob[5], rb[8];
            auto ld_own = [&](int st, u32x4 (&r)[5]) {
#pragma unroll
                for (int k = 0; k < 5; ++k) r[k] = *(const u32x4*)own_src(st, k); };
            auto st_own = [&](int st, const u32x4 (&r)[5]) { if (st >= 68) return; LAS unsigned char* dst = lds + (st % 3) * SLOT_BYTES;
#pragma unroll
                for (int k = 0; k < 5; ++k) *(LAS u32x4*)(dst + own_dst(st, k) + lane * 16) = r[k]; };
            auto ld_rest = [&](int st) { const char* pk = pkg_ptr(ws, seq, ptr_of(st));
#pragma unroll
                for (int k = 0; k < 8; ++k) rb[k] = *(const u32x4*)(pk + rest_piece(st, k) * 1024 + lane * 16); };
            auto st_rest = [&](int st) { if (st >= 68) return; LAS unsigned char* dst = lds + (st % 3) * SLOT_BYTES;
#pragma unroll
                for (int k = 0; k < 8; ++k) *(LAS u32x4*)(dst + rest_piece(st, k) * 1024 + lane * 16) = rb[k]; };
            ld_own(0, oa); ld_own(1, ob); ld_rest(0);
            st_own(0, oa); st_rest(0);
            for (int st = 0; st < 68; st += 2) {
                GLA_BAR();
                ld_rest(st + 1); ld_own(st + 2, oa);
                st_own(st + 1, ob); st_rest(st + 1);
                GLA_BAR();
                ld_rest(st + 2); ld_own(st + 3, ob);
                st_own(st + 2, oa); st_rest(st + 2);
            }
            GLA_BAR();
        } else {
            const int dvb = vs * 64 + 16 * w;
            f32x4 S[8];
#pragma unroll
            for (int t = 0; t < 8; ++t) S[t] = (f32x4){0.f, 0.f, 0.f, 0.f};
#define GLA_FRAG(off) (*(const LAS bf16x8*)(base + (off) + lane * 16))
#define GLA_PIN() __builtin_amdgcn_sched_barrier(0)
            for (int st = 0; st < 68; ++st) {
                GLA_BAR();
                const LAS unsigned char* base = lds + (st % 3) * SLOT_BYTES;
                const int ch = chunk_of(st);
                bf16x8 vf[2];
                {   const LAS unsigned char* vp = base + OFF_V + (16 * w + lc) * 128 + 8 * lg;
                    const u32x2 x0 = *(const LAS u32x2*)vp, x1 = *(const LAS u32x2*)(vp + 32), x2 = *(const LAS u32x2*)(vp + 64), x3 = *(const LAS u32x2*)(vp + 96);
                    u32x4 t0, t1; t0.x = x0.x; t0.y = x0.y; t0.z = x1.x; t0.w = x1.y; t1.x = x2.x; t1.y = x2.y; t1.z = x3.x; t1.w = x3.y; vf[0] = __builtin_bit_cast(bf16x8, t0); vf[1] = __builtin_bit_cast(bf16x8, t1); }
                f32x4 el[8]; bf16x8 ks[8][2];
                if (ch >= 4) {
                    bf16x8 qa[4][6];
#pragma unroll
                    for (int it = 0; it < 4; ++it) {
#pragma unroll
                        for (int s = 0; s < 4; ++s) qa[it][s] = GLA_FRAG(OFF_QD + (it * 4 + s) * 1024);
#pragma unroll
                        for (int s2 = 0; s2 < 2; ++s2) qa[it][4 + s2] = GLA_FRAG(OFF_AT + (it * 2 + s2) * 1024); }
                    GLA_PIN();
                    bf16x8 sa[4];
#pragma unroll
                    for (int s = 0; s < 4; ++s) { u32x4 t; t.x = cvt_pk(S[2 * s][0], S[2 * s][1]); t.y = cvt_pk(S[2 * s][2], S[2 * s][3]); t.z = cvt_pk(S[2 * s + 1][0], S[2 * s + 1][1]); t.w = cvt_pk(S[2 * s + 1][2], S[2 * s + 1][3]); sa[s] = __builtin_bit_cast(bf16x8, t); }
                    const int row0 = b * T + (ch - 4) * 64;
                    f32x4 o[4];
#pragma unroll
                    for (int it = 0; it < 2; ++it) { o[it] = (f32x4){0.f, 0.f, 0.f, 0.f};
#pragma unroll
                        for (int s = 0; s < 4; ++s) o[it] = __builtin_amdgcn_mfma_f32_16x16x32_bf16(sa[s], qa[it][s], o[it], 0, 0, 0);
#pragma unroll
                        for (int s2 = 0; s2 < 2; ++s2) o[it] = __builtin_amdgcn_mfma_f32_16x16x32_bf16(vf[s2], qa[it][4 + s2], o[it], 0, 0, 0); }
                    GLA_PIN();
#pragma unroll
                    for (int t = 0; t < 4; ++t) { el[t] = *(const LAS f32x4*)(base + OFF_EL + (16 * t + 4 * lg) * 4); ks[t][0] = GLA_FRAG(OFF_KS + (t * 2) * 1024); ks[t][1] = GLA_FRAG(OFF_KS + (t * 2 + 1) * 1024); }
                    GLA_PIN();
#pragma unroll
                    for (int it = 2; it < 4; ++it) { o[it] = (f32x4){0.f, 0.f, 0.f, 0.f};
#pragma unroll
                        for (int s = 0; s < 4; ++s) o[it] = __builtin_amdgcn_mfma_f32_16x16x32_bf16(sa[s], qa[it][s], o[it], 0, 0, 0);
#pragma unroll
                        for (int s2 = 0; s2 < 2; ++s2) o[it] = __builtin_amdgcn_mfma_f32_16x16x32_bf16(vf[s2], qa[it][4 + s2], o[it], 0, 0, 0); }
                    GLA_PIN();
#pragma unroll
                    for (int t = 4; t < 8; ++t) { el[t] = *(const LAS f32x4*)(base + OFF_EL + (16 * t + 4 * lg) * 4); ks[t][0] = GLA_FRAG(OFF_KS + (t * 2) * 1024); ks[t][1] = GLA_FRAG(OFF_KS + (t * 2 + 1) * 1024); }
#pragma unroll
                    for (int it = 0; it < 4; ++it) { u32x2 ow; ow.x = cvt_pk(o[it][0], o[it][1]); ow.y = cvt_pk(o[it][2], o[it][3]);
                        *(u32x2*)(O + (size_t)(row0 + 16 * it + lc) * VW + h * DV + dvb + 4 * lg) = ow; }
                    GLA_PIN();
                } else {
#pragma unroll
                    for (int t = 0; t < 8; ++t) { el[t] = *(const LAS f32x4*)(base + OFF_EL + (16 * t + 4 * lg) * 4); ks[t][0] = GLA_FRAG(OFF_KS + (t * 2) * 1024); ks[t][1] = GLA_FRAG(OFF_KS + (t * 2 + 1) * 1024); }
                    GLA_PIN();
                }
#pragma unroll
                for (int t = 0; t < 8; ++t) { S[t] = S[t] * el[t]; S[t] = __builtin_amdgcn_mfma_f32_16x16x32_bf16(ks[t][0], vf[0], S[t], 0, 0, 0); S[t] = __builtin_amdgcn_mfma_f32_16x16x32_bf16(ks[t][1], vf[1], S[t], 0, 0, 0); }
            }
#undef GLA_FRAG
#undef GLA_PIN
            GLA_BAR();
        }
    }
}
}


#define XB_TMO      128
#define XB_XCNT(j)  (256  + 64 * (j))
#define XB_XSUB(j)  (1280 + 64 * (j))
#define XB_XGEN(j)  (2304 + 64 * (j))
#define XB_TOP      3328
#define XB_TOPGEN   3392
#define XCD_BAR_WORDS 3456
#define XB_SPIN_CAP (1u << 18)
__device__ __forceinline__ unsigned xb_ld(unsigned* p)              { return __hip_atomic_load(p, __ATOMIC_RELAXED, __HIP_MEMORY_SCOPE_AGENT); }
__device__ __forceinline__ unsigned xb_add(unsigned* p, unsigned v) { return __hip_atomic_fetch_add(p, v, __ATOMIC_RELAXED, __HIP_MEMORY_SCOPE_AGENT); }
__device__ __forceinline__ unsigned xb_xcc_id() { return (unsigned)__builtin_amdgcn_s_getreg((3 << 11) | 20) & 0xFu; }
#define XB_SPIN(cond, bar) do { unsigned _sp = 0; while (cond) { __builtin_amdgcn_s_sleep(1); \
    if ((++_sp & 255u) == 0u) { if (xb_ld(&(bar)[XB_TMO])) break; if (_sp > XB_SPIN_CAP) { atomicAdd(&(bar)[XB_TMO], 1u); break; } } } } while (0)
struct XcdBarrier { unsigned* bar; unsigned x; volatile LAS unsigned* st; };
__device__ __forceinline__ XcdBarrier xcd_barrier_post(unsigned* bar, volatile LAS unsigned* st) {
    XcdBarrier b; b.bar = bar; b.x = xb_xcc_id(); b.st = st;
    if (threadIdx.x == 0) (void)xb_add(&bar[XB_XCNT(b.x)], 1u);
    return b;
}
__device__ __forceinline__ void xcd_barrier_complete(unsigned* bar, unsigned x, unsigned& nloc, unsigned& nx) {
    const unsigned G = gridDim.x * gridDim.y * gridDim.z;
    unsigned sum, cnt, mine, sp = 0u;
    for (;;) {
        sum = 0u; cnt = 0u; mine = 0u;
#pragma unroll
        for (unsigned j = 0; j < 16; ++j) { const unsigned c = xb_ld(&bar[XB_XCNT(j)]); sum += c; cnt += (c > 0u) ? 1u : 0u; mine = (j == x) ? c : mine; }
        if (sum == G) break;
        __builtin_amdgcn_s_sleep(1);
        if ((++sp & 255u) == 0u) { if (xb_ld(&bar[XB_TMO])) break; if (sp > XB_SPIN_CAP) { atomicAdd(&bar[XB_TMO], 1u); break; } }
    }
    nloc = mine > 0u ? mine : 1u; nx = cnt > 0u ? cnt : 1u;
}
__device__ __forceinline__ void xcd_barrier(const XcdBarrier& b) {
    asm volatile("s_waitcnt vmcnt(0)" ::: "memory");
    __syncthreads();
    if (threadIdx.x == 0) {
        unsigned* bar = b.bar;
        __builtin_amdgcn_s_waitcnt(0);
        unsigned nloc = b.st[0], nx = b.st[1];
        if (nloc == 0u) { xcd_barrier_complete(bar, b.x, nloc, nx); b.st[0] = nloc; b.st[1] = nx; }
        const unsigned old = xb_add(&bar[XB_XSUB(b.x)], 1u);
        const unsigned gen = old / nloc;
        if (old + 1u == (gen + 1u) * nloc) {
            __builtin_amdgcn_fence(__ATOMIC_RELEASE, "agent");
            asm volatile("s_waitcnt vmcnt(0)" ::: "memory");
            const unsigned og = xb_add(&bar[XB_TOP], 1u);
            const unsigned tg = og / nx;
            if (og + 1u == (tg + 1u) * nx) xb_add(&bar[XB_TOPGEN], 1u);
            else XB_SPIN(xb_ld(&bar[XB_TOPGEN]) == tg, bar);
            __builtin_amdgcn_fence(__ATOMIC_ACQUIRE, "agent");
            xb_add(&bar[XB_XGEN(b.x)], 1u);
            asm volatile("s_waitcnt vmcnt(0)" ::: "memory");
        } else {
            XB_SPIN(xb_ld(&bar[XB_XGEN(b.x)]) == gen, bar);
            __builtin_amdgcn_fence(__ATOMIC_ACQUIRE, "agent");
            asm volatile("s_waitcnt vmcnt(0)" ::: "memory");
        }
    }
    __syncthreads();
}

namespace thin {
typedef float f32x4 __attribute__((ext_vector_type(4)));
typedef unsigned u32x4 __attribute__((ext_vector_type(4)));
typedef unsigned u32x2 __attribute__((ext_vector_type(2)));
typedef short bf16x8 __attribute__((ext_vector_type(8)));
using gla::cvt_pk;
__device__ __forceinline__ float lo16(unsigned w) { return __uint_as_float(w << 16); }
__device__ __forceinline__ float hi16(unsigned w) { return __uint_as_float(w & 0xffff0000u); }
__device__ __forceinline__ void tr_item(const float* W, int K, int ldw, int col0, bf16* WT, int mode_, LAS float* scr, int item, int nblk, int lane) {
    const int mode = mode_ & 15; const float wsc = (mode_ & 16) ? -1.44269504089f : (mode_ & 32) ? 0.08838834764831845f : 1.0f;
    const int kb = item / nblk, nb = item % nblk, k0 = 64 * kb, n0 = 32 * nb;
#pragma unroll 8
    for (int i = 0; i < 32; ++i) { const int kk = 2 * i + (lane >> 5); scr[kk * 33 + (lane & 31)] = W[(size_t)(k0 + kk) * ldw + col0 + n0 + (lane & 31)]; }
    asm volatile("s_waitcnt lgkmcnt(0)" ::: "memory");
    int r0 = n0;
    if (mode == 1) { const int col = col0 + n0; r0 = col < DFF ? 256 * (col >> 7) + (col & 127) : 256 * ((col - DFF) >> 7) + 128 + ((col - DFF) & 127); }
    const int cch = lane & 7;
#pragma unroll
    for (int j = 0; j < 4; ++j) { const int n = (lane >> 3) + 8 * j; const LAS float* sp = scr + (8 * cch) * 33 + n;
        u32x4 o; o.x = cvt_pk(sp[0 * 33] * wsc, sp[1 * 33] * wsc); o.y = cvt_pk(sp[2 * 33] * wsc, sp[3 * 33] * wsc); o.z = cvt_pk(sp[4 * 33] * wsc, sp[5 * 33] * wsc); o.w = cvt_pk(sp[6 * 33] * wsc, sp[7 * 33] * wsc);
        *(u32x4*)(WT + (size_t)(r0 + (mode == 2 ? pg8::perm32(n) : n)) * K + k0 + 8 * cch) = o; }
    asm volatile("s_waitcnt lgkmcnt(0)" ::: "memory");
}
template <int NR, int NC>
__device__ __forceinline__ void gemv_block(const LAS float* sv, LAS float* red, const float* W, int ldw, int col0, const float* bias, float* out, int ldo) {
    const int tid = threadIdx.x, w = tid >> 6, lane = tid & 63, col = lane % NC, kk = lane / NC;
    float acc[NR];
#pragma unroll
    for (int r = 0; r < NR; ++r) acc[r] = 0.f;
    if (kk < 2) {
#pragma unroll 16
        for (int j = 0; j < 64; ++j) { const int k = 128 * w + 2 * j + kk; const float wv = W[(size_t)k * ldw + col0 + col];
#pragma unroll
            for (int r = 0; r < NR; ++r) acc[r] += sv[r * 1024 + k] * wv; }
    }
#pragma unroll
    for (int r = 0; r < NR; ++r) { const float o = __shfl(acc[r], (lane + NC) & 63); if (lane < NC) red[(w * NR + r) * 32 + col] = acc[r] + o; }
    __syncthreads();
    if (tid < NR * NC) { const int r = tid / NC, cidx = tid % NC; float t = 0.f;
#pragma unroll
        for (int ww = 0; ww < 8; ++ww) t += red[(ww * NR + r) * 32 + cidx];
        out[(size_t)r * ldo + col0 + cidx] = t + (bias ? bias[col0 + cidx] : 0.f); }
    __syncthreads();
}
struct P0Args { const float *c, *cctx, *w_ada, *b_ada, *w_in, *w_ba, *w_bb, *w_out, *w_f1, *w_f2, *w_sp; };
__device__ __forceinline__ void p0_phase(LAS unsigned char* lds, unsigned char* ws, const P0Args& A, int G, int vcu) {
    const int tid = threadIdx.x, w = __builtin_amdgcn_readfirstlane(tid >> 6), lane = tid & 63;
    LAS float* scr = (LAS float*)(lds + w * 8448);
    LAS float* sv = (LAS float*)(lds + 69632);
    LAS float* red = (LAS float*)(lds + 69632 + 36864);
    for (int i = tid; i < 9 * 1024; i += 512) { const int r = i >> 10, k = i & 1023; const float v = r < 8 ? A.c[r * 1024 + k] : A.cctx[k]; sv[i] = v / (1.f + __expf(-v)); }
    __syncthreads();
    for (int cb = vcu; cb < 256; cb += G) gemv_block<9, 24>(sv, red, A.w_ada, 6144, 24 * cb, A.b_ada, (float*)(ws + WS_MOD), 6144);
    const int gw = vcu * 8 + w, NGW = G * 8; int base = 0;
#define TR_JOB(Wp, K_, ldw_, col0_, ncols_, dst_, mode_) do { const int nblk_ = (ncols_) / 32, items_ = ((K_) / 64) * nblk_; \
        for (int it_ = ((gw - base) % NGW + NGW) % NGW; it_ < items_; it_ += NGW) tr_item(Wp, K_, ldw_, col0_, dst_, mode_, scr, it_, nblk_, lane); base = (base + items_) % NGW; } while (0)
    bf16* WT1A = (bf16*)(ws + WS_WT1A); bf16* WT1B = (bf16*)(ws + WS_WT1B);
    TR_JOB(A.w_in, 1024, NIN, C_Q, 512, WT1A, 2 + 32); TR_JOB(A.w_in, 1024, NIN, C_K, 512, WT1A + 512 * 1024, 2); TR_JOB(A.w_in, 1024, NIN, C_AF, 32, WT1A + 1024 * 1024, 0);
    TR_JOB(A.w_in, 1024, NIN, C_VV, 1024, (bf16*)(ws + WS_WTVV), 0); TR_JOB(A.w_in, 1024, NIN, C_VA, 1024, (bf16*)(ws + WS_WTVA), 0);
    TR_JOB(A.w_in, 1024, NIN, C_U, 1024, WT1B, 0); TR_JOB(A.w_in, 1024, NIN, C_R, 1024, WT1B + 1024 * 1024, 0); TR_JOB(A.w_in, 1024, NIN, C_GA, 1024, WT1B + 2048 * 1024, 16); TR_JOB(A.w_in, 1024, NIN, C_GB, 1024, WT1B + 3072 * 1024, 16);
    TR_JOB(A.w_ba, 1024, 1024, 0, 1024, (bf16*)(ws + WS_WTA), 0); TR_JOB(A.w_bb, 1024, 1024, 0, 1024, (bf16*)(ws + WS_WTB), 0); TR_JOB(A.w_out, 1024, 1024, 0, 1024, (bf16*)(ws + WS_WTO), 0);
    TR_JOB(A.w_f1, 1024, 2 * DFF, 0, 2 * DFF, (bf16*)(ws + WS_WTF1), 1);
    TR_JOB(A.w_f2, DFF, 1024, 0, 1024, (bf16*)(ws + WS_WTF2), 0);
#undef TR_JOB
    { u32x4* z = (u32x4*)(WT1A + 1056 * 1024); const u32x4 zero = {0u, 0u, 0u, 0u}; for (int i = vcu * 512 + tid; i < 224 * 1024 / 8; i += G * 512) z[i] = zero; }
    for (int i = vcu * 512 + tid; i < 8 * 8 * 4 * 64; i += G * 512) { const int ln = i & 63, sidx = (i >> 6) & 3, pt = (i >> 8) & 7, g = i >> 11;
        const float* src = A.w_sp + ((size_t)g * 128 + 16 * pt + (ln & 15)) * 128 + 32 * sidx + 8 * (ln >> 4);
        const f32x4 a = *(const f32x4*)src, b = *(const f32x4*)(src + 4);
        u32x4 o; o.x = cvt_pk(a[0], a[1]); o.y = cvt_pk(a[2], a[3]); o.z = cvt_pk(b[0], b[1]); o.w = cvt_pk(b[2], b[3]);
        ((u32x4*)(ws + WS_WSPF))[i] = o; }
    __syncthreads();
}
__device__ __forceinline__ float wsum(float v) {
#pragma unroll
    for (int o = 1; o < 64; o <<= 1) v += __shfl_xor(v, o);
    return v;
}
__device__ __forceinline__ void p1_phase(LAS unsigned char* lds, unsigned char* ws, const float* x, const float* ctx, const float* n1g, const float* n2g, const float* w_f1, int G, int vcu) {
    const int tid = threadIdx.x, w = __builtin_amdgcn_readfirstlane(tid >> 6), lane = tid & 63;
    const float* MOD = (const float*)(ws + WS_MOD); bf16* H = (bf16*)(ws + WS_H);
    const int gw = vcu * 8 + w, NGW = G * 8;
    LAS float* TA = (LAS float*)lds; LAS float* TB = TA + 9 * 1024;
    for (int i = tid; i < 9 * 1024; i += 512) { const int mr = i >> 10, ci = i & 1023; TA[i] = n1g[ci] * (MOD[mr * 6144 + 1024 + ci] + 1.0f); TB[i] = MOD[mr * 6144 + ci]; }
    __syncthreads();
    auto rowp = [&](int row) { return row < ML ? x + (size_t)row * D : ctx + (size_t)(row - ML) * D; };
    auto store_row = [&](const f32x4 (&v)[4], float t, int row) {
        const int mr = row < ML ? row / T : 8; const float rstd = rsqrtf(t * (1.f / D) + EPS);
#pragma unroll
        for (int j = 0; j < 4; ++j) { const int cidx = 4 * lane + 256 * j; const f32x4 ga = *(const LAS f32x4*)(TA + mr * 1024 + cidx), sh = *(const LAS f32x4*)(TB + mr * 1024 + cidx);
            const f32x4 y = v[j] * rstd * ga + sh; u32x2 o; o.x = cvt_pk(y[0], y[1]); o.y = cvt_pk(y[2], y[3]); *(u32x2*)(H + (size_t)row * D + cidx) = o; } };
    auto sumsq = [&](const f32x4 (&v)[4]) { float t = 0.f;
#pragma unroll
        for (int j = 0; j < 4; ++j) t += (v[j][0] * v[j][0] + v[j][1] * v[j][1]) + (v[j][2] * v[j][2] + v[j][3] * v[j][3]);
        return t; };
    if (G == 256) {
        constexpr int NQ = 3, NR = M / 2048, NIT = (NR + NQ - 1) / NQ; static_assert(M % 2048 == 0, "rows per wave");
        f32x4 v[2][NQ][4];
#pragma unroll
        for (int q = 0; q < NQ; ++q) { const float* xr = rowp(gw + q * 2048);
#pragma unroll
            for (int j = 0; j < 4; ++j) v[0][q][j] = *(const f32x4*)(xr + 4 * lane + 256 * j); }
#pragma unroll
        for (int it = 0; it < NIT; ++it) {
            if (it + 1 < NIT) {
#pragma unroll
                for (int q = 0; q < NQ; ++q) if ((it + 1) * NQ + q < NR) { const float* xr = rowp(gw + ((it + 1) * NQ + q) * 2048);
#pragma unroll
                    for (int j = 0; j < 4; ++j) v[(it + 1) & 1][q][j] = *(const f32x4*)(xr + 4 * lane + 256 * j); } }
            float ss[NQ];
#pragma unroll
            for (int q = 0; q < NQ; ++q) ss[q] = (it * NQ + q < NR) ? sumsq(v[it & 1][q]) : 0.f;
#pragma unroll
            for (int o = 1; o < 64; o <<= 1) {
#pragma unroll
                for (int q = 0; q < NQ; ++q) if (it * NQ + q < NR) ss[q] += __shfl_xor(ss[q], o); }
#pragma unroll
            for (int q = 0; q < NQ; ++q) if (it * NQ + q < NR) store_row(v[it & 1][q], ss[q], gw + (it * NQ + q) * 2048);
        }
    } else {
    for (int row0 = gw; row0 < M; row0 += 4 * NGW) {
        f32x4 v[4][4]; float ss[4];
#pragma unroll
        for (int q = 0; q < 4; ++q) { const int row = row0 + q * NGW < M ? row0 + q * NGW : row0; const float* xr = rowp(row);
#pragma unroll
            for (int j = 0; j < 4; ++j) v[q][j] = *(const f32x4*)(xr + 4 * lane + 256 * j); }
#pragma unroll
        for (int q = 0; q < 4; ++q) ss[q] = sumsq(v[q]);
#pragma unroll
        for (int o = 1; o < 64; o <<= 1) {
#pragma unroll
            for (int q = 0; q < 4; ++q) ss[q] += __shfl_xor(ss[q], o); }
#pragma unroll
        for (int q = 0; q < 4; ++q) { const int row = row0 + q * NGW; if (row < M) store_row(v[q], ss[q], row); }
    }
    }
    __syncthreads();
    for (int i = vcu * 512 + tid; i < 8 * 1024; i += G * 512) ((float*)(ws + WS_GV2))[i] = n2g[i & 1023] * (1.f + MOD[(i >> 10) * 6144 + 4096 + (i & 1023)]);
    LAS float* sv = (LAS float*)lds; LAS float* red = (LAS float*)(lds + 32768);
    for (int i = tid; i < 8 * 1024; i += 512) sv[i] = MOD[(i >> 10) * 6144 + 3072 + (i & 1023)];
    __syncthreads();
    for (int cb = vcu; cb < 256; cb += G) gemv_block<8, 22>(sv, red, w_f1, 2 * DFF, 22 * cb, nullptr, (float*)(ws + WS_CV), 2 * DFF);
}
__device__ __forceinline__ void mix_phase(LAS unsigned char* lds, unsigned char* ws, const float* lng, const float* lnb, const float* bsp, const float* gain, int G, int vcu) {
    const int tid = threadIdx.x, w = __builtin_amdgcn_readfirstlane(tid >> 6), lane = tid & 63, lc = lane & 15, lg = lane >> 4;
    const bf16* GVT = (const bf16*)(ws + WS_GVT); bf16* U = (bf16*)(ws + WS_U); const u32x4* WSPF = (const u32x4*)(ws + WS_WSPF);
    LAS float* RS = (LAS float*)lds;
    LAS float* RQ = (LAS float*)(lds + 16384);
    LAS float* MR = (LAS float*)(lds + 32768);
    LAS unsigned char* WB = lds + 36864;
    LAS float* LNG = (LAS float*)(lds + 135168); LAS float* LNB = LNG + 1024; LAS float* BSL = LNB + 1024;
    for (int i = tid; i < 1024; i += 512) { LNG[i] = lng[i]; LNB[i] = lnb[i]; BSL[i] = bsp[i]; }
    for (int ch = vcu; ch < ML / 128; ch += G) {
        const int tok0 = ch * 128;
        {
            const int to = tid & 15, cs = tid >> 4; float sm[8], sq[8];
#pragma unroll
            for (int e = 0; e < 8; ++e) { sm[e] = 0.f; sq[e] = 0.f; }
            const bf16* gp = GVT + (size_t)(cs * 32) * ML + tok0 + 8 * to;
            u32x4 raw[32];
#pragma unroll
            for (int cc = 0; cc < 32; ++cc) raw[cc] = *(const u32x4*)(gp + (size_t)cc * ML);
#pragma unroll
            for (int cc = 0; cc < 32; ++cc) { const unsigned rw[4] = {raw[cc].x, raw[cc].y, raw[cc].z, raw[cc].w};
#pragma unroll
                for (int e = 0; e < 4; ++e) { const float x0 = lo16(rw[e]), x1 = hi16(rw[e]); sm[2 * e] += x0; sq[2 * e] += x0 * x0; sm[2 * e + 1] += x1; sq[2 * e + 1] += x1 * x1; } }
#pragma unroll
            for (int e = 0; e < 8; ++e) { RS[cs * 128 + 8 * to + e] = sm[e]; RQ[cs * 128 + 8 * to + e] = sq[e]; }
        }
        __syncthreads();
        if (tid < 128) { float sx = 0.f, qx = 0.f;
#pragma unroll
            for (int k = 0; k < 32; ++k) { sx += RS[k * 128 + tid]; qx += RQ[k * 128 + tid]; }
            const float mean = sx * (1.f / 1024.f), var = fmaxf(qx * (1.f / 1024.f) - mean * mean, 0.f); MR[2 * tid] = mean; MR[2 * tid + 1] = rsqrtf(var + EPS); }
        __syncthreads();
        struct GIn { u32x4 wq[4]; u32x4 av[4]; u32x4 uq[4]; };
        auto gload = [&](int g_, GIn& x) { const int g = g_ < 8 ? g_ : 7;
#pragma unroll
            for (int k = 0; k < 4; ++k) x.wq[k] = WSPF[g * 2048 + tid + 512 * k];
#pragma unroll
            for (int k = 0; k < 4; ++k) { const int e = tid + 512 * k; x.av[k] = *(const u32x4*)(GVT + (size_t)(g * 128 + (e >> 4)) * ML + tok0 + (e & 15) * 8); }
#pragma unroll
            for (int k = 0; k < 4; ++k) { const int e = tid + 512 * k; x.uq[k] = *(const u32x4*)(U + (size_t)(tok0 + (e >> 4)) * D + g * 128 + (e & 15) * 8); } };
        auto gcomp = [&](int g, const GIn& x, GIn& nx) {
            LAS unsigned char* wb = WB; LAS unsigned char* gt = lds + 102400;
#pragma unroll
            for (int k = 0; k < 4; ++k) *(LAS u32x4*)(wb + (tid + 512 * k) * 16) = x.wq[k];
            LAS unsigned char* ut = lds + ((g & 1) ? 69632 : 0);
#pragma unroll
            for (int k = 0; k < 4; ++k) { const int e = tid + 512 * k, row = e >> 4, cu = e & 15, so = row * 256 + ((cu ^ (row & 15)) << 4); *(LAS u32x4*)(ut + so) = x.uq[k]; *(LAS u32x4*)(gt + so) = x.av[k]; }
            GLA_BAR();
            gload(g + 1, nx);
            const int chn = g * 128 + 16 * w + lc; const float gg = LNG[chn], bb = LNB[chn];
            bf16x8 af[4];
#pragma unroll
            for (int sidx = 0; sidx < 4; ++sidx) { const int q0 = 32 * sidx + 8 * lg; const u32x4 raw = *(const LAS u32x4*)(gt + (16 * w + lc) * 256 + (((4 * sidx + lg) ^ lc) << 4));
                const unsigned rw[4] = {raw.x, raw.y, raw.z, raw.w}; float y[8];
#pragma unroll
                for (int e = 0; e < 4; ++e) { const f32x4 mr = *(const LAS f32x4*)(MR + 2 * (q0 + 2 * e));
                    y[2 * e] = (lo16(rw[e]) - mr[0]) * mr[1] * gg + bb; y[2 * e + 1] = (hi16(rw[e]) - mr[2]) * mr[3] * gg + bb; }
                u32x4 t; t.x = cvt_pk(y[0], y[1]); t.y = cvt_pk(y[2], y[3]); t.z = cvt_pk(y[4], y[5]); t.w = cvt_pk(y[6], y[7]); af[sidx] = __builtin_bit_cast(bf16x8, t); }
#pragma unroll
            for (int pt = 0; pt < 8; ++pt) { f32x4 d = (f32x4){0.f, 0.f, 0.f, 0.f};
#pragma unroll
                for (int sidx = 0; sidx < 4; ++sidx) { const bf16x8 bf = *(const LAS bf16x8*)(wb + ((pt * 4 + sidx) * 64 + lane) * 16); d = __builtin_amdgcn_mfma_f32_16x16x32_bf16(af[sidx], bf, d, 0, 0, 0); }
                const float bs = BSL[g * 128 + 16 * pt + lc];
                LAS u32x2* up = (LAS u32x2*)(ut + (16 * pt + lc) * 256 + (((2 * w + (lg >> 1)) ^ lc) << 4) + (lg & 1) * 8); const u32x2 uv = *up;
                u32x2 o; o.x = cvt_pk(lo16(uv.x) * (d[0] + bs), hi16(uv.x) * (d[1] + bs)); o.y = cvt_pk(lo16(uv.y) * (d[2] + bs), hi16(uv.y) * (d[3] + bs)); *up = o; }
            GLA_BAR();
#pragma unroll
            for (int k = 0; k < 4; ++k) { const int e = tid + 512 * k, row = e >> 4, cu = e & 15;
                *(u32x4*)(U + (size_t)(tok0 + row) * D + g * 128 + cu * 8) = *(const LAS u32x4*)(ut + row * 256 + ((cu ^ (row & 15)) << 4)); } };
        GIn ga, gb;
        gload(0, ga);
        for (int g = 0; g < 8; g += 2) { gcomp(g, ga, gb); gcomp(g + 1, gb, ga); }
        __syncthreads();
    }
    bf16* OF = (bf16*)(ws + WS_OF); const bf16* OB = (const bf16*)(ws + WS_OB); const bf16* R = (const bf16*)(ws + WS_R);
    const int gw = vcu * 8 + w, NGW = G * 8;
    for (int row0 = gw; row0 < ML; row0 += 2 * NGW) {
        u32x4 ra[2][2], rb[2][2], rr[2][2];
#pragma unroll
        for (int q = 0; q < 2; ++q) { const int row = row0 + q * NGW < ML ? row0 + q * NGW : row0; const size_t o = (size_t)row * VW + 16 * lane;
#pragma unroll
            for (int hv = 0; hv < 2; ++hv) { ra[q][hv] = *(const u32x4*)(OF + o + 8 * hv); rb[q][hv] = *(const u32x4*)(OB + o + 8 * hv); rr[q][hv] = *(const u32x4*)(R + o + 8 * hv); } }
#pragma unroll
        for (int q = 0; q < 2; ++q) { const int row = row0 + q * NGW; if (row < ML) { const size_t o = (size_t)row * VW + 16 * lane; float v[16], r[16]; float ss = 0.f;
#pragma unroll
            for (int hv = 0; hv < 2; ++hv) { const u32x4 a = ra[q][hv], b = rb[q][hv], rq = rr[q][hv];
                const unsigned aw[4] = {a.x, a.y, a.z, a.w}, bw[4] = {b.x, b.y, b.z, b.w}, rw[4] = {rq.x, rq.y, rq.z, rq.w};
#pragma unroll
                for (int e = 0; e < 4; ++e) { v[8 * hv + 2 * e] = lo16(aw[e]) + lo16(bw[e]); v[8 * hv + 2 * e + 1] = hi16(aw[e]) + hi16(bw[e]); { const float r0_ = lo16(rw[e]), r1_ = hi16(rw[e]); r[8 * hv + 2 * e] = r0_ * pg8::sigm(r0_); r[8 * hv + 2 * e + 1] = r1_ * pg8::sigm(r1_); } } }
#pragma unroll
            for (int e = 0; e < 16; ++e) ss += v[e] * v[e];
            ss += __shfl_xor(ss, 1); ss += __shfl_xor(ss, 2); ss += __shfl_xor(ss, 4); ss += __shfl_xor(ss, 8);
            const float rstd = rsqrtf(ss * (1.f / DV) + EPS);
#pragma unroll
            for (int hv = 0; hv < 2; ++hv) { const f32x4 g0 = *(const f32x4*)(gain + 16 * lane + 8 * hv), g1 = *(const f32x4*)(gain + 16 * lane + 8 * hv + 4); float y[8];
#pragma unroll
                for (int e = 0; e < 4; ++e) { y[e] = v[8 * hv + e] * rstd * g0[e] * r[8 * hv + e]; y[4 + e] = v[8 * hv + 4 + e] * rstd * g1[e] * r[8 * hv + 4 + e]; }
                u32x4 t; t.x = cvt_pk(y[0], y[1]); t.y = cvt_pk(y[2], y[3]); t.z = cvt_pk(y[4], y[5]); t.w = cvt_pk(y[6], y[7]); *(u32x4*)(OF + o + 8 * hv) = t; } } }
    }
}
__device__ __forceinline__ void fin_phase(float* X, const float* g, int G, int vcu) {
    const int w = threadIdx.x >> 6, lane = threadIdx.x & 63, gw = vcu * 8 + w, NGW = G * 8;
    for (int row = gw; row < ML; row += NGW) { float* xr = X + (size_t)row * D; f32x4 v[4]; float ss = 0.f;
#pragma unroll
        for (int j = 0; j < 4; ++j) { v[j] = *(const f32x4*)(xr + 4 * lane + 256 * j); ss += (v[j][0] * v[j][0] + v[j][1] * v[j][1]) + (v[j][2] * v[j][2] + v[j][3] * v[j][3]); }
        const float rstd = rsqrtf(wsum(ss) * (1.f / D) + EPS);
#pragma unroll
        for (int j = 0; j < 4; ++j) *(f32x4*)(xr + 4 * lane + 256 * j) = v[j] * rstd * *(const f32x4*)(g + 4 * lane + 256 * j); }
}
}

constexpr int NWAVES = 8, LDS_BYTES = 163840;
#ifndef PG8_SP2
#define PG8_SP2 true
#endif
#ifndef PG8_ALIGN
#define PG8_ALIGN true
#endif
enum Phase { PH_P0 = 0, PH_P1 = 1, PH_G1A = 2, PH_PRE = 3, PH_SCAN = 4, PH_G1B = 5, PH_MIX = 6, PH_MRG = 7, PH_WOUT = 8, PH_FF1 = 9, PH_FF2 = 10, PH_END = 11 };
constexpr int CW_FINCNT = 32768;
constexpr int CW_BAR = 4096;
constexpr int MISC_OFF = LDS_BYTES - 256;
struct Args { const float* in[24]; float* out; unsigned char* ws; int ph_lo, ph_hi; };
__global__ void __launch_bounds__(NWAVES * 64, 2) mega_fwd(Args a) {
    extern __shared__ __attribute__((aligned(16))) unsigned char lds_raw[];
    LAS unsigned char* lds = (LAS unsigned char*)lds_raw;
    unsigned char* ws = a.ws;
    const int G = gridDim.x, c = blockIdx.x;
    const int vcu = (G % 8 == 0) ? (c % 8) * (G / 8) + c / 8 : c;
    const char* Hc = (const char*)(ws + WS_H);
    volatile LAS unsigned* MISC = (volatile LAS unsigned*)(lds + MISC_OFF);
    if (threadIdx.x < 64) MISC[threadIdx.x] = 0u;
    __syncthreads();
    XcdBarrier bar; bar.bar = (unsigned*)(ws + WS_CTL) + CW_BAR; bar.x = 0; bar.st = nullptr;
    const bool multi = a.ph_hi - a.ph_lo > 1;
    if (multi) bar = xcd_barrier_post((unsigned*)(ws + WS_CTL) + CW_BAR, MISC + 8);
#define IN(k) (a.ph_lo <= (k) && (k) < a.ph_hi)
#define SEAM(k) do { if (IN(k) && IN((k) + 1)) xcd_barrier(bar); } while (0)
    if (IN(PH_P0)) { thin::P0Args pa{a.in[1], a.in[3], a.in[4], a.in[5], a.in[7], a.in[17], a.in[18], a.in[19], a.in[21], a.in[22], a.in[10]}; thin::p0_phase(lds, ws, pa, G, vcu); }
    SEAM(PH_P0);
    if (IN(PH_P1)) thin::p1_phase(lds, ws, a.in[0], a.in[2], a.in[6], a.in[20], a.in[21], G, vcu);
    SEAM(PH_P1);
    if (IN(PH_G1A)) {
        pg8::Order1A S{Hc, (const char*)(ws + WS_WT1A), (const char*)(ws + WS_WTVV), (char*)(ws + WS_Q), (char*)(ws + WS_K), (char*)(ws + WS_AF), (char*)(ws + WS_VVT), G, c};
        pg8::EpiAct E;
        pg8::gemm_phase<pg8::EpiAct, pg8::Order1A, PG8_ALIGN, PG8_SP2>(lds, 1024, S, E);
    }
    SEAM(PH_G1A);
    if (IN(PH_PRE)) { gla::prepass_phase(lds, ws, a.in[12], a.in[13], a.in[14], a.in[15], G, c); __syncthreads(); }
    SEAM(PH_PRE);
    if (IN(PH_SCAN)) { gla::scan_phase(lds, ws, G, c); __syncthreads(); }
    SEAM(PH_SCAN);
    if (IN(PH_G1B)) {
        pg8::Order1B S{Hc, (const char*)(ws + WS_WT1B), (const char*)(ws + WS_WTVA), (char*)(ws + WS_U), (char*)(ws + WS_R), (char*)a.out, (char*)a.out + (size_t)ML * D, (char*)(ws + WS_GVT), G, c};
        pg8::EpiAct E;
        pg8::gemm_phase<pg8::EpiAct, pg8::Order1B, PG8_ALIGN, PG8_SP2>(lds, 1024, S, E);
    }
    SEAM(PH_G1B);
    if (IN(PH_MIX)) thin::mix_phase(lds, ws, a.in[8], a.in[9], a.in[11], a.in[16], G, vcu);
    SEAM(PH_MIX);
    if (IN(PH_MRG)) {
        pg8::OrderMrg S{(const char*)(ws + WS_U), (const char*)(ws + WS_WTA), (const char*)(ws + WS_OF), (const char*)(ws + WS_WTB), G, c};
        pg8::EpiMrg E{(const unsigned char*)a.out, (const unsigned char*)a.out + (size_t)ML * D, (bf16*)(ws + WS_Y)};
        pg8::gemm_phase<pg8::EpiMrg, pg8::OrderMrg, PG8_ALIGN, PG8_SP2>(lds, 1024, S, E);
    }
    SEAM(PH_MRG);
    if (IN(PH_WOUT)) {
        pg8::OrderGrid S{(const char*)(ws + WS_Y), (const char*)(ws + WS_WTO), 128, 4, 1024, G, c};
        pg8::EpiRes2 E{a.in[0], (const float*)(ws + WS_MOD), (const float*)(ws + WS_GV2), (bf16*)(ws + WS_X1), (bf16*)(ws + WS_A2), (unsigned long long*)(ws + WS_ROWSS)};
        pg8::gemm_phase<pg8::EpiRes2, pg8::OrderGrid, PG8_ALIGN, PG8_SP2>(lds, 1024, S, E);
    }
    SEAM(PH_WOUT);
    if (IN(PH_FF1)) {
        pg8::OrderGrid S{(const char*)(ws + WS_A2), (const char*)(ws + WS_WTF1), 128, 22, 1024, G, c};
        pg8::EpiSwi2 E{(bf16*)(ws + WS_HB), (const unsigned long long*)(ws + WS_ROWSS), (const float*)(ws + WS_CV)};
        pg8::gemm_phase<pg8::EpiSwi2, pg8::OrderGrid, PG8_ALIGN, PG8_SP2>(lds, 1024, S, E);
    }
    SEAM(PH_FF1);
    if (IN(PH_FF2)) {
        pg8::OrderGrid S{(const char*)(ws + WS_HB), (const char*)(ws + WS_WTF2), 128, 4, DFF, G, c};
        pg8::EpiFin E{(const bf16*)(ws + WS_A2), (const float*)(ws + WS_GV2), (const float*)(ws + WS_MOD), a.in[23], a.out, (unsigned long long*)(ws + WS_ROWSS2), (unsigned*)(ws + WS_CTL) + CW_FINCNT};
        pg8::gemm_phase<pg8::EpiFin, pg8::OrderGrid, PG8_ALIGN, PG8_SP2>(lds, DFF, S, E);
    }
#undef IN
#undef SEAM
}
static int g_grid = 0;
static void run_mega(hipStream_t stream, void* const* d_in, void* d_out, void* d_ws, int lo, int hi) {
    Args a{}; for (int i = 0; i < 24; ++i) a.in[i] = (const float*)d_in[i];
    a.out = (float*)d_out; a.ws = (unsigned char*)d_ws; a.ph_lo = lo; a.ph_hi = hi;
    hipLaunchKernelGGL(mega_fwd, dim3(g_grid), dim3(NWAVES * 64), LDS_BYTES, stream, a);
}

template <class Epi, bool DUAL = false>
static void run_gemm(hipStream_t s, const bf16* A, const bf16* Bt, int Mrows, int N, int K, const Epi& e) {
    hipLaunchKernelGGL((nv_gemm<Epi, DUAL>), dim3((N + 63) / 64, Mrows / 64), dim3(256), 0, s, A, Bt, Mrows, N, K, 0, e);
}
static void run_tr(hipStream_t s, const float* W, int K, int ldw, int col0, int ncols, bf16* WT) {
    hipLaunchKernelGGL(nv_transpose, dim3(ncols / 32, K / 32), dim3(256), 0, s, W, K, ldw, col0, ncols, WT);
}

extern "C" void kernel_launch(void* const* d_in, const int* in_sizes, int n_in, void* d_out, int out_size, void* d_ws, size_t ws_size, hipStream_t stream) {
    if (n_in != 24 || out_size != ML * D || ws_size < WS_END) { fprintf(stderr, "kernel_launch: unexpected sizes n_in %d out %d ws %zu\n", n_in, out_size, ws_size); return; }
    const float* x = (const float*)d_in[0]; const float* c = (const float*)d_in[1]; const float* ctx = (const float*)d_in[2]; const float* cctx = (const float*)d_in[3];
    const float* w_ada = (const float*)d_in[4]; const float* b_ada = (const float*)d_in[5]; const float* norm1_g = (const float*)d_in[6]; const float* w_in = (const float*)d_in[7];
    const float* ln_v_g = (const float*)d_in[8]; const float* ln_v_b = (const float*)d_in[9]; const float* w_sp = (const float*)d_in[10]; const float* b_sp = (const float*)d_in[11];
    const float* w_af = (const float*)d_in[12]; const float* b_af = (const float*)d_in[13]; const float* w_ab = (const float*)d_in[14]; const float* b_ab = (const float*)d_in[15];
    const float* gla_g = (const float*)d_in[16]; const float* w_ba = (const float*)d_in[17]; const float* w_bb = (const float*)d_in[18]; const float* w_out = (const float*)d_in[19];
    const float* norm2_g = (const float*)d_in[20]; const float* w_f1 = (const float*)d_in[21]; const float* w_f2 = (const float*)d_in[22]; const float* fin_g = (const float*)d_in[23];
    unsigned char* ws = (unsigned char*)d_ws; float* out = (float*)d_out;
    if (g_grid == 0) {
        int dev = 0, cus = 0, per_cu = 0;
        hipGetDevice(&dev); hipDeviceGetAttribute(&cus, hipDeviceAttributeMultiprocessorCount, dev);
        hipFuncSetAttribute((const void*)mega_fwd, hipFuncAttributeMaxDynamicSharedMemorySize, LDS_BYTES);
        hipOccupancyMaxActiveBlocksPerMultiprocessor(&per_cu, (const void*)mega_fwd, NWAVES * 64, LDS_BYTES);
        (void)hipGetLastError();
        if (per_cu < 1) fprintf(stderr, "kernel_launch: occupancy query says %d blocks/CU\n", per_cu);
        g_grid = cus;
    }
    bf16 *WT1A = (bf16*)(ws + WS_WT1A), *WTVV = (bf16*)(ws + WS_WTVV), *WT1B = (bf16*)(ws + WS_WT1B), *WTVA = (bf16*)(ws + WS_WTVA), *WTA = (bf16*)(ws + WS_WTA), *WTB = (bf16*)(ws + WS_WTB),
         *WTO = (bf16*)(ws + WS_WTO), *WTF1 = (bf16*)(ws + WS_WTF1), *WTF2 = (bf16*)(ws + WS_WTF2);
    float* MOD = (float*)(ws + WS_MOD); float* LNST = (float*)(ws + WS_LNST);
    bf16 *H = (bf16*)(ws + WS_H), *Q = (bf16*)(ws + WS_Q), *Kb = (bf16*)(ws + WS_K), *VVT = (bf16*)(ws + WS_VVT), *OF = (bf16*)(ws + WS_OF), *OB = (bf16*)(ws + WS_OB), *U = (bf16*)(ws + WS_U),
         *GVT = (bf16*)(ws + WS_GVT), *R = (bf16*)(ws + WS_R), *Y = (bf16*)(ws + WS_Y), *A2 = (bf16*)(ws + WS_A2), *HB = (bf16*)(ws + WS_HB);
    float *AF = (float*)(ws + WS_AF), *Y1 = (float*)(ws + WS_Y1), *X1 = (float*)(ws + WS_X1);
    bf16 *GA = (bf16*)d_out, *GB = (bf16*)d_out + (size_t)ML * D;
    hipMemsetAsync(ws + WS_CTL, 0, 1 * MiB, stream);
#ifndef MK_ONE_LAUNCH
#define MK_ONE_LAUNCH 1
#endif
#ifndef MK_REP
#define MK_REP 0
#endif
    if (MK_ONE_LAUNCH) run_mega(stream, d_in, d_out, d_ws, 0, PH_END);
    else for (int p = 0; p < PH_END; ++p) { run_mega(stream, d_in, d_out, d_ws, p, p + 1); if ((MK_REP >> p) & 1) run_mega(stream, d_in, d_out, d_ws, p, p + 1); }
}
```

```cpp
#include <hip/hip_runtime.h>
#include <stdint.h>
#include <cstdio>

typedef unsigned short bf16;
__device__ __forceinline__ float bf2f(bf16 v) { return __uint_as_float(((unsigned)v) << 16); }
__device__ __forceinline__ bf16 f2bf(float f) { unsigned u = __float_as_uint(f); u += 0x7fffu + ((u >> 16) & 1u); return (bf16)(u >> 16); }

constexpr int NB = 8, T = 4096, D = 1024, TC = 256;
constexpr int ML = NB * T;
constexpr int MC = NB * TC;
constexpr int M = ML + MC;
constexpr int NH = 4, DK = 128, DV = 256, QKW = 512, VW = 1024, RANK = 16;
constexpr int DFF = 2816, NIN = 7200;
constexpr float EPS = 1e-6f;
constexpr int C_U = 0, C_VA = 1024, C_Q = 2048, C_K = 2560, C_VV = 3072, C_R = 4096, C_AF = 5120, C_GA = 5152, C_GB = 6176;

constexpr size_t MiB = 1u << 20;
constexpr size_t WS_CTL = 0;
constexpr size_t WS_ROWSS = 256 * 1024, WS_ROWSS2 = 512 * 1024;
constexpr size_t WS_MOD = 1 * MiB;
constexpr size_t WS_CV = WS_MOD + 256 * 1024;
constexpr size_t WS_LNST = 2 * MiB;
constexpr size_t WS_GV2 = WS_MOD + 512 * 1024;
constexpr size_t WS_WSPF = 3 * MiB;
constexpr size_t WS_WT1A = 4 * MiB;
constexpr size_t WS_WTVV = WS_WT1A + 1280 * 1024 * 2;
constexpr size_t WS_WT1B = WS_WTVV + 2 * MiB;
constexpr size_t WS_WTVA = WS_WT1B + 8 * MiB;
constexpr size_t WS_WTA = WS_WTVA + 2 * MiB, WS_WTB = WS_WTA + 2 * MiB, WS_WTO = WS_WTB + 2 * MiB;
constexpr size_t WS_WTF1 = WS_WTO + 2 * MiB;
constexpr size_t WS_WTF2 = WS_WTF1 + 11 * MiB;
static_assert(WS_WTF2 + (size_t)1024 * 2816 * 2 <= 48 * MiB, "weights region");
constexpr size_t WS_H = 48 * MiB;
constexpr size_t WS_Q = 116 * MiB;
constexpr size_t WS_K = 148 * MiB;
constexpr size_t WS_AF = 182 * MiB;
constexpr size_t WS_VVT = 188 * MiB;
constexpr size_t WS_PKG = 256 * MiB;
constexpr size_t WS_OF = 423 * MiB;
constexpr size_t WS_OB = 116 * MiB;
constexpr size_t WS_U = 188 * MiB;
constexpr size_t WS_GVT = 256 * MiB;
constexpr size_t WS_R = 320 * MiB;
constexpr size_t WS_Y1 = 256 * MiB;
constexpr size_t WS_Y = 48 * MiB;
constexpr size_t WS_X1 = 384 * MiB;
constexpr size_t WS_A2 = 116 * MiB;
constexpr size_t WS_HB = 180 * MiB;
constexpr size_t WS_END = 512 * MiB;

__global__ void nv_transpose(const float* __restrict__ W, int K, int ldw, int col0, int ncols, bf16* __restrict__ WT) {
    __shared__ float tile[32][33];
    const int k0 = blockIdx.y * 32, n0 = blockIdx.x * 32, tx = threadIdx.x & 31, ty = threadIdx.x >> 5;
    for (int i = ty; i < 32; i += 8) tile[i][tx] = W[(size_t)(k0 + i) * ldw + col0 + n0 + tx];
    __syncthreads();
    for (int i = ty; i < 32; i += 8) WT[(size_t)(n0 + i) * K + k0 + tx] = f2bf(tile[tx][i]);
}
__global__ void nv_zero_bf16(bf16* p, size_t n) { for (size_t i = (size_t)blockIdx.x * blockDim.x + threadIdx.x; i < n; i += (size_t)gridDim.x * blockDim.x) p[i] = 0; }

__global__ void nv_ada(const float* __restrict__ c, const float* __restrict__ cctx, const float* __restrict__ w_ada, const float* __restrict__ b_ada, float* __restrict__ MOD) {
    __shared__ float s[9][1024];
    for (int i = threadIdx.x; i < 9 * 1024; i += blockDim.x) { const int r = i >> 10, k = i & 1023; const float v = r < 8 ? c[r * 1024 + k] : cctx[k]; s[r][k] = v / (1.f + expf(-v)); }
    __syncthreads();
    const int n = blockIdx.x * blockDim.x + threadIdx.x;
    float acc[9];
    for (int r = 0; r < 9; ++r) acc[r] = 0.f;
    for (int k = 0; k < 1024; ++k) { const float w = w_ada[(size_t)k * 6144 + n];
#pragma unroll
        for (int r = 0; r < 9; ++r) acc[r] += s[r][k] * w; }
    for (int r = 0; r < 9; ++r) MOD[r * 6144 + n] = acc[r] + b_ada[n];
}

__device__ __forceinline__ float wave_sum(float v) {
#pragma unroll
    for (int o = 1; o < 64; o <<= 1) v += __shfl_xor(v, o);
    return v;
}
__global__ void nv_modnorm(const float* __restrict__ xl, const float* __restrict__ xc, const float* __restrict__ g, const float* __restrict__ MOD, int shoff, int scoff, bf16* __restrict__ out, int nrows, int pad_) {
    const int row = blockIdx.x * (blockDim.x >> 6) + (threadIdx.x >> 6), lane = threadIdx.x & 63;
    if (row >= nrows) return;
    const float* xr = row < ML ? xl + (size_t)row * D : xc + (size_t)(row - ML) * D;
    const int mr = row < ML ? row / T : 8;
    float v[16]; float ss = 0.f;
#pragma unroll
    for (int j = 0; j < 16; ++j) { v[j] = xr[lane + 64 * j]; ss += v[j] * v[j]; }
    const float rstd = rsqrtf(wave_sum(ss) * (1.f / D) + EPS);
#pragma unroll
    for (int j = 0; j < 16; ++j) { const int cidx = lane + 64 * j; const float y = v[j] * rstd * g[cidx];
        out[(size_t)row * D + cidx] = f2bf(y * (1.f + MOD[mr * 6144 + scoff + cidx]) + MOD[mr * 6144 + shoff + cidx]); }
}

template <class Epi, bool DUAL>
__global__ void __launch_bounds__(256) nv_gemm(const bf16* __restrict__ A, const bf16* __restrict__ Bt, int Mrows, int N, int K, int pad_, Epi epi) {
    __shared__ float As[32][65], Bs[32][65], Bs2[DUAL ? 32 : 1][65];
    const int tid = threadIdx.x, tx = tid & 15, ty = tid >> 4;
    const int m0 = blockIdx.y * 64, n0 = blockIdx.x * 64;
    float acc[4][4], acc2[4][4];
#pragma unroll
    for (int i = 0; i < 4; ++i)
#pragma unroll
        for (int j = 0; j < 4; ++j) { acc[i][j] = 0.f; acc2[i][j] = 0.f; }
    const int lr = tid >> 2, lk = (tid & 3) * 8;
    const int am = m0 + lr, bn = n0 + lr < N ? n0 + lr : N - 1;
    const bf16* ap = A + (size_t)am * K + lk;
    const bf16* bp = Bt + (size_t)epi.brow(bn) * K + lk;
    const bf16* bp2 = DUAL ? Bt + (size_t)epi.brow2(bn) * K + lk : bp;
    for (int k0 = 0; k0 < K; k0 += 32) {
        const uint4 av = *(const uint4*)(ap + k0), bv = *(const uint4*)(bp + k0);
        const unsigned aw[4] = {av.x, av.y, av.z, av.w}, bw[4] = {bv.x, bv.y, bv.z, bv.w};
#pragma unroll
        for (int j = 0; j < 4; ++j) { As[lk + 2 * j][lr] = __uint_as_float(aw[j] << 16); As[lk + 2 * j + 1][lr] = __uint_as_float(aw[j] & 0xffff0000u);
                                      Bs[lk + 2 * j][lr] = __uint_as_float(bw[j] << 16); Bs[lk + 2 * j + 1][lr] = __uint_as_float(bw[j] & 0xffff0000u); }
        if (DUAL) { const uint4 cv = *(const uint4*)(bp2 + k0); const unsigned cw[4] = {cv.x, cv.y, cv.z, cv.w};
#pragma unroll
            for (int j = 0; j < 4; ++j) { Bs2[lk + 2 * j][lr] = __uint_as_float(cw[j] << 16); Bs2[lk + 2 * j + 1][lr] = __uint_as_float(cw[j] & 0xffff0000u); } }
        __syncthreads();
#pragma unroll 8
        for (int k = 0; k < 32; ++k) {
            float a[4], b[4], b2[4];
#pragma unroll
            for (int i = 0; i < 4; ++i) { a[i] = As[k][ty * 4 + i]; b[i] = Bs[k][tx * 4 + i]; b2[i] = DUAL ? Bs2[k][tx * 4 + i] : 0.f; }
#pragma unroll
            for (int i = 0; i < 4; ++i)
#pragma unroll
                for (int j = 0; j < 4; ++j) { acc[i][j] += a[i] * b[j]; if (DUAL) acc2[i][j] += a[i] * b2[j]; }
        }
        __syncthreads();
    }
#pragma unroll
    for (int i = 0; i < 4; ++i)
#pragma unroll
        for (int j = 0; j < 4; ++j) { const int m = m0 + ty * 4 + i, n = n0 + tx * 4 + j; if (m < Mrows && n < N) epi(m, n, acc[i][j], acc2[i][j]); }
}
__device__ __forceinline__ float gelu_erf(float v) { return 0.5f * v * (1.f + erff(v * 0.70710678118654752f)); }
__device__ __forceinline__ float sigmoidf_(float v) { return 1.f / (1.f + expf(-v)); }
struct EpBase { __device__ int brow(int n) const { return n; } __device__ int brow2(int n) const { return n; } };
struct EpQ : EpBase { bf16* O; int ld; float sc; __device__ void operator()(int m, int n, float a, float) const { O[(size_t)m * ld + n] = f2bf(a * sc); } };
struct EpF32 : EpBase { float* O; int ld; int pad; __device__ void operator()(int m, int n, float a, float) const { O[(size_t)m * ld + n] = a; } };
struct EpT : EpBase { bf16* O; int ld; int act; __device__ void operator()(int m, int n, float a, float) const { O[(size_t)n * ld + m] = f2bf(act ? gelu_erf(a) : a); } };
struct EpAct : EpBase { bf16* O; int ld; int act; __device__ void operator()(int m, int n, float a, float) const { float v = act == 1 ? gelu_erf(a) : act == 2 ? a * sigmoidf_(a) : sigmoidf_(a); O[(size_t)m * ld + n] = f2bf(v); } };
struct EpY1 : EpBase { const bf16* G; float* Y1; __device__ void operator()(int m, int n, float a, float) const { Y1[(size_t)m * D + n] = bf2f(G[(size_t)m * D + n]) * a; } };
struct EpY : EpBase { const bf16* G; const float* Y1; bf16* Y; __device__ void operator()(int m, int n, float a, float) const { Y[(size_t)m * D + n] = f2bf(Y1[(size_t)m * D + n] + bf2f(G[(size_t)m * D + n]) * a); } };
struct EpRes : EpBase { const float* X; const float* MOD; float* O; int goff; int pad; __device__ void operator()(int m, int n, float a, float) const { O[(size_t)m * D + n] = X[(size_t)m * D + n] + MOD[(m / T) * 6144 + goff + n] * a; } };
struct EpSwi { bf16* O; __device__ int brow(int n) const { return 256 * (n >> 7) + (n & 127); } __device__ int brow2(int n) const { return 256 * (n >> 7) + 128 + (n & 127); }
    __device__ void operator()(int m, int n, float a, float g) const { O[(size_t)m * DFF + n] = f2bf(a * (g * sigmoidf_(g))); } };

__global__ void __launch_bounds__(256) nv_gla(const bf16* __restrict__ Q, const bf16* __restrict__ Kb, const float* __restrict__ AF, const bf16* __restrict__ VVT,
                                              const float* __restrict__ w_af, const float* __restrict__ b_af, const float* __restrict__ w_ab, const float* __restrict__ b_ab,
                                              bf16* __restrict__ OF, bf16* __restrict__ OB) {
    const int dir = blockIdx.x & 1, h = (blockIdx.x >> 1) & 3, b = blockIdx.x >> 3, tid = threadIdx.x;
    __shared__ float sa[128], sk[128], sq[128], wl[16][128], bl[128];
    const float* wsrc = dir ? w_ab : w_af; const float* bsrc = dir ? b_ab : b_af;
    for (int i = tid; i < 16 * 128; i += 256) wl[i >> 7][i & 127] = wsrc[(i >> 7) * QKW + h * DK + (i & 127)];
    if (tid < 128) bl[tid] = bsrc[h * DK + tid];
    float S[128];
#pragma unroll
    for (int i = 0; i < 128; ++i) S[i] = 0.f;
    bf16* O = dir ? OB : OF;
    const bf16* vrow = VVT + (size_t)(h * DV + tid) * M;
    __syncthreads();
    for (int step = 0; step < TC + T; ++step) {
        const bool isctx = step < TC;
        int row;
        if (isctx) row = ML + b * TC + (dir ? TC - 1 - step : step);
        else { const int t = step - TC; row = b * T + (dir ? T - 1 - t : t); }
        if (tid < 128) {
            float z = bl[tid];
#pragma unroll
            for (int r = 0; r < 16; ++r) z += AF[(size_t)row * 32 + dir * 16 + r] * wl[r][tid];
            const float ls = fminf(z, 0.f) - log1pf(expf(-fabsf(z)));
            sa[tid] = expf(ls * (1.f / 16.f));
            sk[tid] = bf2f(Kb[(size_t)row * QKW + h * DK + tid]);
            sq[tid] = isctx ? 0.f : bf2f(Q[(size_t)row * QKW + h * DK + tid]);
        }
        const float v = bf2f(vrow[row]);
        __syncthreads();
        float o = 0.f;
#pragma unroll
        for (int i = 0; i < 128; ++i) { S[i] = sa[i] * S[i] + sk[i] * v; o += sq[i] * S[i]; }
        if (!isctx) O[(size_t)row * VW + h * DV + tid] = f2bf(o);
        __syncthreads();
    }
}

__global__ void nv_lnstat(const bf16* __restrict__ GVT, float* __restrict__ ST) {
    const int t = blockIdx.x * blockDim.x + threadIdx.x;
    float s = 0.f, s2 = 0.f;
    for (int c = 0; c < 1024; ++c) { const float v = bf2f(GVT[(size_t)c * ML + t]); s += v; }
    const float mean = s * (1.f / 1024.f);
    for (int c = 0; c < 1024; ++c) { const float d = bf2f(GVT[(size_t)c * ML + t]) - mean; s2 += d * d; }
    ST[2 * t] = mean; ST[2 * t + 1] = rsqrtf(s2 * (1.f / 1024.f) + EPS);
}
__global__ void __launch_bounds__(256) nv_chunkmlp(bf16* __restrict__ U, const bf16* __restrict__ GVT, const float* __restrict__ ST, const float* __restrict__ lng, const float* __restrict__ lnb,
                                                   const float* __restrict__ wsp, const float* __restrict__ bsp) {
    extern __shared__ float vt[];
    const int ch = blockIdx.x, g = blockIdx.y, tok0 = ch * 128, tid = threadIdx.x;
    for (int i = tid; i < 128 * 128; i += 256) { const int c = i >> 7, q = i & 127; const int cc = g * 128 + c;
        const float v = bf2f(GVT[(size_t)cc * ML + tok0 + q]);
        vt[q * 128 + c] = (v - ST[2 * (tok0 + q)]) * ST[2 * (tok0 + q) + 1] * lng[cc] + lnb[cc]; }
    __syncthreads();
    const int c = tid & 127;
    for (int p = tid >> 7; p < 128; p += 2) {
        float acc = 0.f;
        const float* wr = wsp + ((size_t)g * 128 + p) * 128;
        for (int q = 0; q < 128; ++q) acc += wr[q] * vt[q * 128 + c];
        acc += bsp[g * 128 + p];
        const size_t o = (size_t)(tok0 + p) * D + g * 128 + c;
        U[o] = f2bf(bf2f(U[o]) * acc);
    }
}
__global__ void nv_glaout(bf16* __restrict__ OF, const bf16* __restrict__ OB, const bf16* __restrict__ R, const float* __restrict__ gain) {
    const int w = blockIdx.x * (blockDim.x >> 6) + (threadIdx.x >> 6), lane = threadIdx.x & 63;
    const int row = w >> 2, h = w & 3;
    float v[4]; float ss = 0.f;
#pragma unroll
    for (int j = 0; j < 4; ++j) { const size_t o = (size_t)row * VW + h * DV + lane + 64 * j; v[j] = bf2f(OF[o]) + bf2f(OB[o]); ss += v[j] * v[j]; }
    const float rstd = rsqrtf(wave_sum(ss) * (1.f / DV) + EPS);
#pragma unroll
    for (int j = 0; j < 4; ++j) { const int cidx = h * DV + lane + 64 * j; const size_t o = (size_t)row * VW + cidx; OF[o] = f2bf(v[j] * rstd * gain[cidx] * bf2f(R[o])); }
}
__global__ void nv_finalnorm(float* __restrict__ X, const float* __restrict__ g) {
    const int row = blockIdx.x * (blockDim.x >> 6) + (threadIdx.x >> 6), lane = threadIdx.x & 63;
    float v[16]; float ss = 0.f;
#pragma unroll
    for (int j = 0; j < 16; ++j) { v[j] = X[(size_t)row * D + lane + 64 * j]; ss += v[j] * v[j]; }
    const float rstd = rsqrtf(wave_sum(ss) * (1.f / D) + EPS);
#pragma unroll
    for (int j = 0; j < 16; ++j) X[(size_t)row * D + lane + 64 * j] = v[j] * rstd * g[lane + 64 * j];
}


#ifndef MK_STAGGER
#define MK_STAGGER 0
#endif
namespace pg8 {
#define PG8_LAS __attribute__((address_space(3)))
typedef unsigned short bf16_t;
typedef short bf16x8 __attribute__((ext_vector_type(8)));
typedef float f32x4 __attribute__((ext_vector_type(4)));
typedef float f32x2 __attribute__((ext_vector_type(2)));
typedef unsigned u32x4 __attribute__((ext_vector_type(4)));
typedef unsigned u32x2 __attribute__((ext_vector_type(2)));
constexpr int BM = 256, BK = 64, HALF = 128, HTB = HALF * BK * 2, STAGE_BYTES = 8 * HTB;
__host__ __device__ __forceinline__ int lds_byte(int r, int c) { const int st = (r >> 4) * 2 + (c >> 5), rr = r & 15, cc = c & 31, ob = rr * 64 + cc * 2; return st * 1024 + (ob ^ (((ob >> 9) & 1) << 5)); }
__host__ __device__ __forceinline__ void stage_rc(int b, int& R, int& C) { const int st = b / 1024, sb = b % 1024, swz = sb ^ (((sb >> 9) & 1) << 5); R = (st >> 1) * 16 + swz / 64; C = (st & 1) * 32 + (swz % 64) / 2; }
__host__ __device__ __forceinline__ int perm32(int rho) { const int n = rho >> 4, i = rho & 15; return 8 * (i >> 2) + 4 * n + (i & 3); }
struct Unit { const char* pA; const char* pB; char* pO; int ldc, act, aux, pm, pn; };
__device__ __forceinline__ unsigned cvt_pk_bf16(float lo, float hi) { typedef __bf16 v2bf __attribute__((ext_vector_type(2))); typedef float v2f __attribute__((ext_vector_type(2)));
    const v2f x = {lo, hi}; const v2bf y = __builtin_convertvector(x, v2bf); return __builtin_bit_cast(unsigned, y); }
__device__ __forceinline__ f32x2 gelu_pk(f32x2 v) {
    const f32x2 av = __builtin_elementwise_abs(v), d = av * 0.2316418882f + 1.0f;
    f32x2 t; t.x = __builtin_amdgcn_rcpf(d.x); t.y = __builtin_amdgcn_rcpf(d.y);
    f32x2 q = t * 0.5307027145f + (-0.7265760135f); q = q * t + 0.7107068705f; q = q * t + (-0.142248368f); q = q * t + 0.127414796f; q = q * t;
    const f32x2 s = (v * v) * (-0.72134752044f);
    f32x2 e; e.x = __builtin_amdgcn_exp2f(s.x); e.y = __builtin_amdgcn_exp2f(s.y);
    const f32x2 m = v * (q * e), r = v - m;
    f32x2 o; o.x = v.x < 0.f ? m.x : r.x; o.y = v.y < 0.f ? m.y : r.y; return o;
}
__device__ __forceinline__ float ub8(unsigned w, int n) { return (float)((w >> (8 * n)) & 0xffu); }
__device__ __forceinline__ float sigm(float x) { return __builtin_amdgcn_rcpf(1.0f + __builtin_amdgcn_exp2f(x * -1.44269504089f)); }
__device__ __forceinline__ int xcd_remap(int L, int nwg) { const int q = nwg / 8, r = nwg % 8, xcd = L % 8, off = L / 8; return (xcd < r ? xcd * (q + 1) : r * (q + 1) + (xcd - r) * q) + off; }

template <class Epi, class Sched, bool ALIGN_EPI, bool SP2>
__device__ __forceinline__ void gemm_phase(PG8_LAS unsigned char* lds, const int K, const Sched& S, const Epi& E) {
    const int tid = threadIdx.x, wid = __builtin_amdgcn_readfirstlane(tid >> 6), lane = tid & 63, wr = wid >> 2, wc = wid & 3, fr = lane & 15, fq = lane >> 4;
    const int nt = K / BK;
    unsigned voffA[2], voffB[2];
#pragma unroll
    for (int i = 0; i < 2; ++i) { int R, C; stage_rc(tid * 16 + i * 8192, R, C); const int Rb = (R & ~31) + perm32(R & 31);
        voffA[i] = (unsigned)(R * K + C) * 2u; voffB[i] = (unsigned)(Rb * K + C) * 2u; }
    const size_t kstep = (size_t)(BK * 2);
    const size_t hstep = (size_t)HALF * K * 2;
    const unsigned ldsw = (unsigned)wid * 1024u;
    const int aoff = lds_byte(wr * 64 + fr, fq * 8), boff = lds_byte(wc * 32 + fr, fq * 8);
#define PG8_SA(b, h) (((b) * 2 + (h)) * HTB)
#define PG8_SB(b, h) ((4 + (b) * 2 + (h)) * HTB)
#define PG8_STAGE(bufoff, gbase, voff) do { _Pragma("unroll") for (int _i = 0; _i < 2; ++_i) \
        __builtin_amdgcn_global_load_lds((const unsigned*)((const char*)(gbase) + (voff)[_i]), (PG8_LAS unsigned*)(lds + (bufoff) + ldsw + _i * 8192), 16, 0, 0); } while (0)
#define PG8_LDA(dst, b, h) do { _Pragma("unroll") for (int m = 0; m < 4; ++m) _Pragma("unroll") for (int k = 0; k < 2; ++k) dst[m][k] = *(const PG8_LAS bf16x8*)(lds + PG8_SA(b, h) + aoff + m * 2048 + k * 1024); } while (0)
#define PG8_LDB(dst, b, h) do { _Pragma("unroll") for (int n = 0; n < 2; ++n) _Pragma("unroll") for (int k = 0; k < 2; ++k) dst[n][k] = *(const PG8_LAS bf16x8*)(lds + PG8_SB(b, h) + boff + n * 2048 + k * 1024); } while (0)
#define PG8_MMA(ai, bj, At, Bt) do { __builtin_amdgcn_s_setprio(1); _Pragma("unroll") for (int m = 0; m < 4; ++m) _Pragma("unroll") for (int n = 0; n < 2; ++n) _Pragma("unroll") for (int k = 0; k < 2; ++k) \
        acc[ai][bj][m][n] = __builtin_amdgcn_mfma_f32_16x16x32_bf16(Bt[n][k], At[m][k], acc[ai][bj][m][n], 0, 0, 0); __builtin_amdgcn_s_setprio(0); } while (0)
#define PG8_WAIT_V(n) asm volatile("s_waitcnt vmcnt(" #n ")" ::: "memory")
#define PG8_WAIT_L(n) asm volatile("s_waitcnt lgkmcnt(" #n ")" ::: "memory")
#define PG8_BAR __builtin_amdgcn_s_barrier()
#define PG8_SCHED __builtin_amdgcn_sched_barrier(0)
    Unit cur, nxt; int ui = 0;
    if (!S.next(0, cur)) return;
    if (MK_STAGGER > 0) { const unsigned long long t0_ = __builtin_amdgcn_s_memrealtime(); const unsigned long long dl_ = (unsigned long long)((blockIdx.x >> 3) & 3) * MK_STAGGER;
        while (__builtin_amdgcn_s_memrealtime() - t0_ < dl_) __builtin_amdgcn_s_sleep(8); }
    f32x4 acc[2][2][4][2];
#pragma unroll
    for (int a = 0; a < 2; ++a)
#pragma unroll
        for (int b = 0; b < 2; ++b)
#pragma unroll
            for (int m = 0; m < 4; ++m)
#pragma unroll
                for (int n = 0; n < 2; ++n) acc[a][b][m][n] = (f32x4){0.f, 0.f, 0.f, 0.f};
    bf16x8 At[4][2], B0[2][2], B1[2][2];
    const char* cA = cur.pA; const char* cB = cur.pB;
    if constexpr (SP2) {
        PG8_STAGE(PG8_SB(0, 0), cB, voffB); PG8_STAGE(PG8_SB(0, 1), cB + hstep, voffB); PG8_STAGE(PG8_SA(0, 0), cA, voffA); PG8_STAGE(PG8_SA(0, 1), cA + hstep, voffA);
        if (wr == 1) PG8_BAR;
        PG8_WAIT_V(2); PG8_BAR;
        PG8_STAGE(PG8_SB(1, 0), cB + kstep, voffB); PG8_STAGE(PG8_SA(1, 0), cA + kstep, voffA); PG8_STAGE(PG8_SB(1, 1), cB + hstep + kstep, voffB);
        PG8_WAIT_V(6); PG8_BAR;
    } else {
        PG8_STAGE(PG8_SB(0, 0), cB, voffB); PG8_STAGE(PG8_SA(0, 0), cA, voffA); PG8_STAGE(PG8_SB(0, 1), cB + hstep, voffB); PG8_STAGE(PG8_SA(0, 1), cA + hstep, voffA);
        if (wr == 1) PG8_BAR;
        PG8_WAIT_V(4); PG8_BAR;
        PG8_STAGE(PG8_SB(1, 0), cB + kstep, voffB); PG8_STAGE(PG8_SA(1, 0), cA + kstep, voffA); PG8_STAGE(PG8_SB(1, 1), cB + hstep + kstep, voffB);
        PG8_WAIT_V(6); PG8_BAR;
    }
    for (;;) {
        const bool has_next = S.next(ui + 1, nxt);
        const char* nA = has_next ? nxt.pA : cA; const char* nB = has_next ? nxt.pB : cB;
        for (int t = 0; t < nt; t += 2) {
            const bool last = (t == nt - 2);
            const char* a1 = cA + (size_t)(t + 1) * kstep;
            const char* a2 = last ? nA : cA + (size_t)(t + 2) * kstep; const char* b2 = last ? nB : cB + (size_t)(t + 2) * kstep;
            const char* a3 = a2 + kstep; const char* b3 = b2 + kstep;
            if constexpr (SP2) {
            PG8_LDB(B0, 0, 0); PG8_LDB(B1, 0, 1); PG8_SCHED; PG8_LDA(At, 0, 0); PG8_STAGE(PG8_SA(1, 1), a1 + hstep, voffA);
            PG8_WAIT_V(8); PG8_WAIT_L(0); PG8_BAR; PG8_MMA(0, 0, At, B0); PG8_MMA(0, 1, At, B1); PG8_BAR; PG8_SCHED;
            PG8_LDA(At, 0, 1); PG8_STAGE(PG8_SB(0, 0), b2, voffB); PG8_STAGE(PG8_SB(0, 1), b2 + hstep, voffB); PG8_STAGE(PG8_SA(0, 0), a2, voffA);
            PG8_WAIT_V(8); PG8_WAIT_L(0); PG8_BAR; PG8_MMA(1, 0, At, B0); PG8_MMA(1, 1, At, B1); PG8_BAR; PG8_SCHED;
            PG8_LDB(B0, 1, 0); PG8_LDB(B1, 1, 1); PG8_SCHED; PG8_LDA(At, 1, 0); PG8_STAGE(PG8_SA(0, 1), a2 + hstep, voffA);
            PG8_WAIT_V(8); PG8_WAIT_L(0); PG8_BAR; PG8_MMA(0, 0, At, B0); PG8_MMA(0, 1, At, B1); PG8_BAR; PG8_SCHED;
            PG8_LDA(At, 1, 1); PG8_STAGE(PG8_SB(1, 0), b3, voffB); PG8_STAGE(PG8_SB(1, 1), b3 + hstep, voffB); PG8_STAGE(PG8_SA(1, 0), a3, voffA);
            PG8_WAIT_V(8); PG8_WAIT_L(0); PG8_BAR; PG8_MMA(1, 0, At, B0); PG8_MMA(1, 1, At, B1); PG8_BAR; PG8_SCHED;
            } else {
            PG8_LDB(B0, 0, 0); PG8_SCHED; PG8_LDA(At, 0, 0); PG8_STAGE(PG8_SA(1, 1), a1 + hstep, voffA);
            PG8_WAIT_L(8); PG8_BAR; PG8_WAIT_L(0); PG8_MMA(0, 0, At, B0); PG8_BAR; PG8_SCHED;
            PG8_LDB(B1, 0, 1); PG8_STAGE(PG8_SB(0, 0), b2, voffB);
            PG8_BAR; PG8_WAIT_L(0); PG8_MMA(0, 1, At, B1); PG8_BAR;
            PG8_LDA(At, 0, 1); PG8_STAGE(PG8_SA(0, 0), a2, voffA);
            PG8_BAR; PG8_WAIT_L(0); PG8_MMA(1, 0, At, B0); PG8_BAR; PG8_SCHED;
            PG8_STAGE(PG8_SB(0, 1), b2 + hstep, voffB);
            PG8_WAIT_V(6); PG8_BAR; PG8_MMA(1, 1, At, B1); PG8_BAR;
            PG8_LDB(B0, 1, 0); PG8_SCHED; PG8_LDA(At, 1, 0); PG8_STAGE(PG8_SA(0, 1), a2 + hstep, voffA);
            PG8_WAIT_L(8); PG8_BAR; PG8_WAIT_L(0); PG8_MMA(0, 0, At, B0); PG8_BAR; PG8_SCHED;
            PG8_LDB(B1, 1, 1); PG8_STAGE(PG8_SB(1, 0), b3, voffB);
            PG8_BAR; PG8_WAIT_L(0); PG8_MMA(0, 1, At, B1); PG8_BAR;
            PG8_LDA(At, 1, 1); PG8_STAGE(PG8_SA(1, 0), a3, voffA);
            PG8_BAR; PG8_WAIT_L(0); PG8_MMA(1, 0, At, B0); PG8_BAR; PG8_SCHED;
            PG8_STAGE(PG8_SB(1, 1), b3 + hstep, voffB);
            PG8_WAIT_V(6); PG8_BAR; PG8_MMA(1, 1, At, B1); PG8_BAR;
            }
        }
        if constexpr (ALIGN_EPI) { if (wr == 0) PG8_BAR; }
        bool keep = false;
        if constexpr (Epi::CHAIN) { E.chain(acc, cur, wr, wc, fr, fq); keep = Epi::KEEP && (cur.aux == 0); } else E(acc, cur, wr, wc, fr, fq);
        if (!has_next) break;
        if (!keep) {
#pragma unroll
        for (int a = 0; a < 2; ++a)
#pragma unroll
            for (int b = 0; b < 2; ++b)
#pragma unroll
                for (int m = 0; m < 4; ++m)
#pragma unroll
                    for (int n = 0; n < 2; ++n) acc[a][b][m][n] = (f32x4){0.f, 0.f, 0.f, 0.f};
        }
        cur = nxt; cA = nA; cB = nB; ++ui;
        if constexpr (ALIGN_EPI) { if (wr == 1) PG8_BAR; }
    }
    PG8_WAIT_V(0);
    if constexpr (!ALIGN_EPI) { if (wr == 0) PG8_BAR; }
    PG8_BAR;
#undef PG8_SA
#undef PG8_SB
#undef PG8_STAGE
#undef PG8_LDA
#undef PG8_LDB
#undef PG8_MMA
#undef PG8_WAIT_V
#undef PG8_WAIT_L
#undef PG8_BAR
#undef PG8_SCHED
}

enum Act { ACT_NONE = 0, ACT_GELU = 1, ACT_SILU = 2, ACT_SIGM = 3, ACT_QSC = 4, ACT_AF32 = 5, ACT_VT = 6 };
struct EpiAct { static constexpr bool CHAIN = false;
    template <int ACT> __device__ __forceinline__ void run(const f32x4 (&acc)[2][2][4][2], const Unit& u, int r0, int c0) const {
        bf16_t* O = (bf16_t*)u.pO; if (ACT == ACT_VT) c0 = (c0 >> 6) * 65536 + (c0 & 63);
#pragma unroll
        for (int ai = 0; ai < 2; ++ai)
#pragma unroll
            for (int m = 0; m < 4; ++m) { bf16_t* rowp = O + (size_t)(r0 + ai * HALF + m * 16) * u.ldc + c0;
#pragma unroll
                for (int bj = 0; bj < 2; ++bj) { f32x4 v0 = acc[ai][bj][m][0], v1 = acc[ai][bj][m][1];
                    if (ACT == ACT_GELU) { f32x2 a = gelu_pk((f32x2){v0[0], v0[1]}), b = gelu_pk((f32x2){v0[2], v0[3]}), c = gelu_pk((f32x2){v1[0], v1[1]}), d = gelu_pk((f32x2){v1[2], v1[3]});
                        v0 = (f32x4){a.x, a.y, b.x, b.y}; v1 = (f32x4){c.x, c.y, d.x, d.y}; }
                    if (ACT == ACT_SILU) {
#pragma unroll
                        for (int j = 0; j < 4; ++j) { v0[j] = v0[j] * sigm(v0[j]); v1[j] = v1[j] * sigm(v1[j]); } }
                    if (ACT == ACT_SIGM) {
#pragma unroll
                        for (int j = 0; j < 4; ++j) { v0[j] = sigm(v0[j]); v1[j] = sigm(v1[j]); } }
                    if (ACT == ACT_QSC) { v0 = v0 * 0.08838834764831845f; v1 = v1 * 0.08838834764831845f; }
                    u32x4 w; w.x = cvt_pk_bf16(v0[0], v0[1]); w.y = cvt_pk_bf16(v0[2], v0[3]); w.z = cvt_pk_bf16(v1[0], v1[1]); w.w = cvt_pk_bf16(v1[2], v1[3]);
                    *(u32x4*)(rowp + (ACT == ACT_VT ? bj * 2 * 65536 : bj * HALF)) = w; } }
    }
    __device__ __forceinline__ void run_gate8(const f32x4 (&acc)[2][2][4][2], const Unit& u, int r0, int c0, float lo) const {
        unsigned char* O = (unsigned char*)u.pO;
#pragma unroll
        for (int ai = 0; ai < 2; ++ai)
#pragma unroll
            for (int m = 0; m < 4; ++m) { unsigned char* rowp = O + (size_t)(r0 + ai * HALF + m * 16) * u.ldc + c0;
#pragma unroll
                for (int bj = 0; bj < 2; ++bj) { u32x2 w = {0u, 0u};
#pragma unroll
                    for (int j = 0; j < 8; ++j) { const float x = j < 4 ? acc[ai][bj][m][0][j] : acc[ai][bj][m][1][j - 4];
                        const float q = fmaxf(__builtin_amdgcn_rcpf(__builtin_amdgcn_exp2f(x) * (1.0f / 255.0f) + (1.0f / 255.0f)), lo);
                        if (j < 4) w.x = __builtin_amdgcn_cvt_pk_u8_f32(q, j, w.x); else w.y = __builtin_amdgcn_cvt_pk_u8_f32(q, j - 4, w.y); }
                    *(u32x2*)(rowp + bj * HALF) = w; } }
    }
    __device__ __forceinline__ void operator()(const f32x4 (&acc)[2][2][4][2], const Unit& u, int wr, int wc, int fr, int fq) const {
        const int r0 = wr * 64 + fr, c0 = wc * 32 + 8 * fq;
        switch (u.act) {
        case ACT_NONE: run<ACT_NONE>(acc, u, r0, c0); break;
        case ACT_GELU: run<ACT_GELU>(acc, u, r0, c0); break;
        case ACT_SILU: run<ACT_SILU>(acc, u, r0, c0); break;
        case ACT_SIGM: run_gate8(acc, u, r0, c0, u.aux ? 1.0f : 0.0f); break;
        case ACT_QSC:  run<ACT_QSC>(acc, u, r0, c0); break;
        case ACT_VT:   run<ACT_VT>(acc, u, r0, c0); break;
        default:
            if (wc == 0) { float* O = (float*)u.pO;
#pragma unroll
                for (int ai = 0; ai < 2; ++ai)
#pragma unroll
                    for (int m = 0; m < 4; ++m) { float* rowp = O + (size_t)(r0 + ai * HALF + m * 16) * u.ldc + 8 * fq;
                        *(f32x4*)rowp = acc[ai][0][m][0]; *(f32x4*)(rowp + 4) = acc[ai][0][m][1]; } }
            break;
        }
    }
};
struct EpiMrg { static constexpr bool CHAIN = true, KEEP = true; const unsigned char* GA; const unsigned char* GB; bf16_t* Y;
    __device__ __forceinline__ void chain(f32x4 (&acc)[2][2][4][2], const Unit& u, int wr, int wc, int fr, int fq) const {
        const size_t o0 = (size_t)(u.pm * BM + wr * 64 + fr) * 1024 + u.pn * BM + wc * 32 + 8 * fq;
        if (u.aux == 0) {
#pragma unroll
            for (int ai = 0; ai < 2; ++ai)
#pragma unroll
                for (int m = 0; m < 4; ++m)
#pragma unroll
                    for (int bj = 0; bj < 2; ++bj) { const size_t o = o0 + (size_t)(ai * HALF + m * 16) * 1024 + bj * HALF;
                        const u32x2 a = *(const u32x2*)(GA + o), b = *(const u32x2*)(GB + o);
                        const float ra[8] = {ub8(a.x, 0), ub8(a.x, 1), ub8(a.x, 2), ub8(a.x, 3),
                                             ub8(a.y, 0), ub8(a.y, 1), ub8(a.y, 2), ub8(a.y, 3)};
                        const float rb[8] = {ub8(b.x, 0), ub8(b.x, 1), ub8(b.x, 2), ub8(b.x, 3),
                                             ub8(b.y, 0), ub8(b.y, 1), ub8(b.y, 2), ub8(b.y, 3)};
#pragma unroll
                        for (int e = 0; e < 8; ++e) { const float r = ra[e] * __builtin_amdgcn_rcpf(rb[e]); if (e < 4) acc[ai][bj][m][0][e] *= r; else acc[ai][bj][m][1][e - 4] *= r; }
                        if (bj == 1) asm volatile("" ::: "memory"); }
        } else {
#pragma unroll
            for (int ai = 0; ai < 2; ++ai)
#pragma unroll
                for (int m = 0; m < 4; ++m)
#pragma unroll
                    for (int bj = 0; bj < 2; ++bj) { const size_t o = o0 + (size_t)(ai * HALF + m * 16) * 1024 + bj * HALF;
                        const u32x2 g = *(const u32x2*)(GB + o); constexpr float s8 = 1.0f / 255.0f;
                        f32x4 v0 = acc[ai][bj][m][0], v1 = acc[ai][bj][m][1];
                        v0[0] *= ub8(g.x, 0) * s8; v0[1] *= ub8(g.x, 1) * s8; v0[2] *= ub8(g.x, 2) * s8; v0[3] *= ub8(g.x, 3) * s8;
                        v1[0] *= ub8(g.y, 0) * s8; v1[1] *= ub8(g.y, 1) * s8; v1[2] *= ub8(g.y, 2) * s8; v1[3] *= ub8(g.y, 3) * s8;
                        u32x4 w; w.x = cvt_pk_bf16(v0[0], v0[1]); w.y = cvt_pk_bf16(v0[2], v0[3]); w.z = cvt_pk_bf16(v1[0], v1[1]); w.w = cvt_pk_bf16(v1[2], v1[3]);
                        *(u32x4*)(Y + o) = w; }
        }
    }
};
struct EpiRes { const float* X; static constexpr bool CHAIN = false; const float* MOD; float* O; int goff;
    __device__ __forceinline__ void operator()(const f32x4 (&acc)[2][2][4][2], const Unit& u, int wr, int wc, int fr, int fq) const {
        const int cb = u.pn * BM + wc * 32 + 8 * fq; const size_t o0 = (size_t)(u.pm * BM + wr * 64 + fr) * 1024 + cb;
        const float* gp = MOD + ((u.pm * BM) / T) * 6144 + goff + cb;
        f32x4 g[2][2];
#pragma unroll
        for (int bj = 0; bj < 2; ++bj) { g[bj][0] = *(const f32x4*)(gp + bj * HALF); g[bj][1] = *(const f32x4*)(gp + bj * HALF + 4); }
#pragma unroll
        for (int ai = 0; ai < 2; ++ai)
#pragma unroll
            for (int m = 0; m < 4; ++m)
#pragma unroll
                for (int bj = 0; bj < 2; ++bj) { const size_t o = o0 + (size_t)(ai * HALF + m * 16) * 1024 + bj * HALF;
                    const f32x4 x0 = *(const f32x4*)(X + o), x1 = *(const f32x4*)(X + o + 4);
                    *(f32x4*)(O + o) = x0 + g[bj][0] * acc[ai][bj][m][0]; *(f32x4*)(O + o + 4) = x1 + g[bj][1] * acc[ai][bj][m][1]; }
    }
};
struct EpiFin { static constexpr bool CHAIN = true, KEEP = false; const bf16_t* X1; const float* GV2; const float* MOD; const float* FG; float* O; unsigned long long* ROWSS2; unsigned* CNT;
    __device__ __forceinline__ void chain(f32x4 (&acc)[2][2][4][2], const Unit& u, int wr, int wc, int fr, int fq) const {
        const int cb = u.pn * BM + wc * 32 + 8 * fq, r0 = u.pm * BM + wr * 64 + fr; const size_t o0 = (size_t)r0 * 1024 + cb;
        const float* gp = MOD + ((u.pm * BM) / T) * 6144 + 5120 + cb;
        {   f32x4 g[2][2], iv[2][2]; float ssv[8]; const float* vp = GV2 + ((u.pm * BM) / T) * 1024 + cb;
#pragma unroll
            for (int bj = 0; bj < 2; ++bj) { g[bj][0] = *(const f32x4*)(gp + bj * HALF); g[bj][1] = *(const f32x4*)(gp + bj * HALF + 4);
                const f32x4 v0 = *(const f32x4*)(vp + bj * HALF), v1 = *(const f32x4*)(vp + bj * HALF + 4);
#pragma unroll
                for (int e = 0; e < 4; ++e) { iv[bj][0][e] = 1.0f / v0[e]; iv[bj][1][e] = 1.0f / v1[e]; } }
#pragma unroll
            for (int ai = 0; ai < 2; ++ai)
#pragma unroll
                for (int m = 0; m < 4; ++m) { float ss = 0.f;
#pragma unroll
                    for (int bj = 0; bj < 2; ++bj) { const size_t o = o0 + (size_t)(ai * HALF + m * 16) * 1024 + bj * HALF;
                        const u32x4 xr = *(const u32x4*)(X1 + o);
                        const f32x4 xa = {__uint_as_float(xr.x << 16), __uint_as_float(xr.x & 0xffff0000u), __uint_as_float(xr.y << 16), __uint_as_float(xr.y & 0xffff0000u)}, xb = {__uint_as_float(xr.z << 16), __uint_as_float(xr.z & 0xffff0000u), __uint_as_float(xr.w << 16), __uint_as_float(xr.w & 0xffff0000u)};
                        const f32x4 x0 = xa * iv[bj][0] + g[bj][0] * acc[ai][bj][m][0], x1 = xb * iv[bj][1] + g[bj][1] * acc[ai][bj][m][1];
                        acc[ai][bj][m][0] = x0; acc[ai][bj][m][1] = x1;
                        ss += (x0[0] * x0[0] + x0[1] * x0[1]) + (x0[2] * x0[2] + x0[3] * x0[3]) + (x1[0] * x1[0] + x1[1] * x1[1]) + (x1[2] * x1[2] + x1[3] * x1[3]); }
                    ss += __shfl_xor(ss, 16); ss += __shfl_xor(ss, 32); ssv[ai * 4 + m] = ss;
                    asm volatile("" ::: "memory"); }
#pragma unroll
            for (int h = 0; h < 2; ++h) { const int gs = 2 * fq + h; float v = 0.f;
#pragma unroll
                for (int g2 = 0; g2 < 8; ++g2) v = gs == g2 ? ssv[g2] : v;
                atomicAdd(ROWSS2 + r0 + (gs >> 2) * HALF + (gs & 3) * 16, (unsigned long long)(v * 1073741824.0f) + (1ull << 58)); }
        }
        f32x4 fg[2][2];
#pragma unroll
        for (int bj = 0; bj < 2; ++bj) { fg[bj][0] = *(const f32x4*)(FG + cb + bj * HALF); fg[bj][1] = *(const f32x4*)(FG + cb + bj * HALF + 4); }
        unsigned long long tot[2][4];
        for (unsigned spins = 0;; ++spins) { bool ok = true;
#pragma unroll
            for (int ai = 0; ai < 2; ++ai)
#pragma unroll
                for (int m = 0; m < 4; ++m) tot[ai][m] = __hip_atomic_load(ROWSS2 + r0 + ai * HALF + m * 16, __ATOMIC_RELAXED, __HIP_MEMORY_SCOPE_AGENT);
#pragma unroll
            for (int ai = 0; ai < 2; ++ai)
#pragma unroll
                for (int m = 0; m < 4; ++m) ok = ok && ((tot[ai][m] >> 58) >= 16ull);
            if (__builtin_amdgcn_ballot_w64(!ok) == 0ull || spins > (1u << 20)) break;
            __builtin_amdgcn_s_sleep(1); }
#pragma unroll
        for (int ai = 0; ai < 2; ++ai)
#pragma unroll
            for (int m = 0; m < 4; ++m) tot[ai][m] &= ((1ull << 58) - 1ull);
#pragma unroll
        for (int ai = 0; ai < 2; ++ai)
#pragma unroll
            for (int m = 0; m < 4; ++m) {
                const float rs = __builtin_amdgcn_rsqf((float)tot[ai][m] * (1.0f / (1073741824.0f * 1024.0f)) + EPS);
#pragma unroll
                for (int bj = 0; bj < 2; ++bj) { const size_t o = o0 + (size_t)(ai * HALF + m * 16) * 1024 + bj * HALF;
                    *(f32x4*)(O + o) = acc[ai][bj][m][0] * rs * fg[bj][0]; *(f32x4*)(O + o + 4) = acc[ai][bj][m][1] * rs * fg[bj][1]; } }
    }
};
struct EpiSwi { bf16_t* HBp; static constexpr bool CHAIN = false;
    __device__ __forceinline__ void operator()(const f32x4 (&acc)[2][2][4][2], const Unit& u, int wr, int wc, int fr, int fq) const {
        const size_t o0 = (size_t)(u.pm * BM + wr * 64 + fr) * DFF + u.pn * HALF + wc * 32 + 8 * fq;
#pragma unroll
        for (int ai = 0; ai < 2; ++ai)
#pragma unroll
            for (int m = 0; m < 4; ++m) { const f32x4 a0 = acc[ai][0][m][0], a1 = acc[ai][0][m][1], g0 = acc[ai][1][m][0], g1 = acc[ai][1][m][1]; f32x4 v0, v1;
#pragma unroll
                for (int j = 0; j < 4; ++j) { v0[j] = a0[j] * g0[j] * sigm(g0[j]); v1[j] = a1[j] * g1[j] * sigm(g1[j]); }
                u32x4 w; w.x = cvt_pk_bf16(v0[0], v0[1]); w.y = cvt_pk_bf16(v0[2], v0[3]); w.z = cvt_pk_bf16(v1[0], v1[1]); w.w = cvt_pk_bf16(v1[2], v1[3]);
                *(u32x4*)(HBp + o0 + (size_t)(ai * HALF + m * 16) * DFF) = w; }
    }
};

struct EpiRes2 { static constexpr bool CHAIN = false; const float* X; const float* MOD; const float* GV2; bf16_t* X1; bf16_t* A2; unsigned long long* ROWSS;
    __device__ __forceinline__ void operator()(const f32x4 (&acc)[2][2][4][2], const Unit& u, int wr, int wc, int fr, int fq) const {
        const int cb = u.pn * BM + wc * 32 + 8 * fq, bidx = (u.pm * BM) / T; const int r0 = u.pm * BM + wr * 64 + fr; const size_t o0 = (size_t)r0 * 1024 + cb;
        const float* gp = MOD + bidx * 6144 + 2048 + cb; const float* vp = GV2 + bidx * 1024 + cb;
        f32x4 g[2][2], gv[2][2]; float ssv[8];
#pragma unroll
        for (int bj = 0; bj < 2; ++bj) { g[bj][0] = *(const f32x4*)(gp + bj * HALF); g[bj][1] = *(const f32x4*)(gp + bj * HALF + 4); gv[bj][0] = *(const f32x4*)(vp + bj * HALF); gv[bj][1] = *(const f32x4*)(vp + bj * HALF + 4); }
#pragma unroll
        for (int ai = 0; ai < 2; ++ai)
#pragma unroll
            for (int m = 0; m < 4; ++m) { float ss = 0.f;
#pragma unroll
                for (int bj = 0; bj < 2; ++bj) { const size_t o = o0 + (size_t)(ai * HALF + m * 16) * 1024 + bj * HALF;
                    const f32x4 x0 = *(const f32x4*)(X + o) + g[bj][0] * acc[ai][bj][m][0], x1 = *(const f32x4*)(X + o + 4) + g[bj][1] * acc[ai][bj][m][1];
                    ss += (x0[0] * x0[0] + x0[1] * x0[1]) + (x0[2] * x0[2] + x0[3] * x0[3]) + (x1[0] * x1[0] + x1[1] * x1[1]) + (x1[2] * x1[2] + x1[3] * x1[3]);
                    const f32x4 a0 = x0 * gv[bj][0], a1 = x1 * gv[bj][1];
                    u32x4 w; w.x = cvt_pk_bf16(a0[0], a0[1]); w.y = cvt_pk_bf16(a0[2], a0[3]); w.z = cvt_pk_bf16(a1[0], a1[1]); w.w = cvt_pk_bf16(a1[2], a1[3]);
                    *(u32x4*)(A2 + o) = w; }
                ss += __shfl_xor(ss, 16); ss += __shfl_xor(ss, 32); ssv[ai * 4 + m] = ss; }
#pragma unroll
        for (int h = 0; h < 2; ++h) { const int gs = 2 * fq + h; float v = 0.f;
#pragma unroll
            for (int g = 0; g < 8; ++g) v = gs == g ? ssv[g] : v;
            atomicAdd(ROWSS + r0 + (gs >> 2) * HALF + (gs & 3) * 16, (unsigned long long)(v * 1073741824.0f)); }
    }
};
struct EpiSwi2 { static constexpr bool CHAIN = false; bf16_t* HBp; const unsigned long long* ROWSS; const float* CV;
    __device__ __forceinline__ void operator()(const f32x4 (&acc)[2][2][4][2], const Unit& u, int wr, int wc, int fr, int fq) const {
        const int r0 = u.pm * BM + wr * 64 + fr, cc = u.pn * HALF + wc * 32 + 8 * fq, bidx = (u.pm * BM) / T;
        const size_t o0 = (size_t)r0 * DFF + cc;
        const float* cp = CV + bidx * (2 * DFF) + cc;
        const f32x4 ca0 = *(const f32x4*)cp, ca1 = *(const f32x4*)(cp + 4), cg0 = *(const f32x4*)(cp + DFF), cg1 = *(const f32x4*)(cp + DFF + 4);
        float rsv[2][4];
#pragma unroll
        for (int ai = 0; ai < 2; ++ai)
#pragma unroll
            for (int m = 0; m < 4; ++m) rsv[ai][m] = (float)ROWSS[r0 + ai * HALF + m * 16];
#pragma unroll
        for (int ai = 0; ai < 2; ++ai)
#pragma unroll
            for (int m = 0; m < 4; ++m) { const float rs = __builtin_amdgcn_rsqf(rsv[ai][m] * (1.0f / (1073741824.0f * 1024.0f)) + EPS);
                const f32x4 a0 = acc[ai][0][m][0] * rs + ca0, a1 = acc[ai][0][m][1] * rs + ca1, g0 = acc[ai][1][m][0] * rs + cg0, g1 = acc[ai][1][m][1] * rs + cg1; f32x4 v0, v1;
#pragma unroll
                for (int j = 0; j < 4; ++j) { v0[j] = a0[j] * g0[j] * sigm(g0[j]); v1[j] = a1[j] * g1[j] * sigm(g1[j]); }
                u32x4 w; w.x = cvt_pk_bf16(v0[0], v0[1]); w.y = cvt_pk_bf16(v0[2], v0[3]); w.z = cvt_pk_bf16(v1[0], v1[1]); w.w = cvt_pk_bf16(v1[2], v1[3]);
                *(u32x4*)(HBp + o0 + (size_t)(ai * HALF + m * 16) * DFF) = w; }
    }
};
struct OrderGrid { const char* A; const char* Bt; int nM, nN, K, G, c;
    __device__ __forceinline__ bool next(int i, Unit& u) const {
        const int nwg = nM * nN; const long L = (long)i * G + c; if (L >= nwg) return false;
        const int w = xcd_remap((int)L, nwg);
        const int nig = 8 * nN, gid = w / nig, fm = gid * 8, gsz = (nM - fm) < 8 ? (nM - fm) : 8;
        u.pm = fm + ((w % nig) % gsz); u.pn = (w % nig) / gsz;
        u.pA = A + (size_t)u.pm * 256 * K * 2; u.pB = Bt + (size_t)u.pn * 256 * K * 2; u.pO = nullptr; u.ldc = 0; u.act = 0; u.aux = 0; return true;
    }
};
struct OrderMrg { const char* A0; const char* B0; const char* A1; const char* B1; int G, c;
    __device__ __forceinline__ bool next(int i, Unit& u) const {
        constexpr int nM = 128, nN = 4, nwg = nM * nN; const long L = (long)(i >> 1) * G + c; if (L >= nwg) return false;
        const int w = xcd_remap((int)L, nwg);
        const int nig = 8 * nN, gid = w / nig, fm = gid * 8;
        u.pm = fm + ((w % nig) & 7); u.pn = (w % nig) >> 3; u.aux = i & 1;
        u.pA = ((i & 1) ? A1 : A0) + (size_t)u.pm * 256 * 1024 * 2; u.pB = ((i & 1) ? B1 : B0) + (size_t)u.pn * 256 * 1024 * 2; u.pO = nullptr; u.ldc = 0; u.act = 0; return true;
    }
};
struct Order1A { const char* H; const char* WT1A; const char* WTVV; char* Q; char* Kb; char* AFp; char* VVT; int G, c;
    __device__ __forceinline__ bool next(int i, Unit& u) const {
        constexpr int NWG = 1208; const long L = (long)i * G + c; if (L >= NWG) return false;
        int w = xcd_remap((int)L, NWG);
        int tok, col; bool swapped;
        if (w < 640) { const int gid = w / 40, r = w % 40; tok = gid * 8 + (r & 7); col = r >> 3; swapped = false; }
        else if (w < 1152) { w -= 640; const int gid = w / 32, r = w & 31; tok = gid * 8 + (r & 7); col = r >> 3; swapped = true; }
        else if (w < 1176) { w -= 1152; tok = 128 + (w & 7); col = 2 + (w >> 3); swapped = false; }
        else { w -= 1176; tok = 128 + (w & 7); col = w >> 3; swapped = true; }
        u.pm = tok; u.pn = col; u.aux = 0;
        const char* hp = H + (size_t)tok * 256 * 1024 * 2;
        if (swapped) { u.pA = WTVV + (size_t)col * 256 * 1024 * 2; u.pB = hp; u.pO = VVT + ((size_t)(tok * 4) * 65536 + (size_t)(col * 256) * 64) * 2; u.ldc = 64; u.act = ACT_VT; }
        else { u.pA = hp; u.pB = WT1A + (size_t)col * 256 * 1024 * 2;
            if (col < 2) { u.pO = Q + ((size_t)(tok * 256) * QKW + col * 256) * 2; u.ldc = QKW; u.act = ACT_NONE; }
            else if (col < 4) { u.pO = Kb + ((size_t)(tok * 256) * QKW + (col - 2) * 256) * 2; u.ldc = QKW; u.act = ACT_NONE; }
            else { u.pO = AFp + (size_t)(tok * 256) * 32 * 4; u.ldc = 32; u.act = ACT_AF32; } }
        return true;
    }
};
struct Order1B { const char* H; const char* WT1B; const char* WTVA; char* U; char* R; char* GA; char* GB; char* GVT; int G, c;
    __device__ __forceinline__ bool next(int i, Unit& u) const {
        const long L = (long)i * G + c; if (L >= 2560) return false;
        int w = L < 2048 ? xcd_remap((int)L, 2048) : 2048 + xcd_remap((int)L - 2048, 512);
        u.aux = 0;
        if (w < 2048) { const int gid = w >> 7, r = w & 127, tok = gid * 8 + (r & 7), col = r >> 3; u.pm = tok; u.pn = col;
            u.pA = H + (size_t)tok * 256 * 1024 * 2; u.pB = WT1B + (size_t)col * 256 * 1024 * 2; u.ldc = 1024;
            const int seg = col >> 2; const long long dR = R - U, dGA = GA - U, dGB = GB - U;
            const long long dsel = (seg == 1 ? dR : 0ll) + (seg == 2 ? dGA : 0ll) + (seg == 3 ? dGB : 0ll);
            u.act = seg == 0 ? ACT_GELU : seg == 1 ? ACT_SILU : ACT_SIGM;
            const size_t eo = (size_t)(tok * 256) * 1024 + (col & 3) * 256; u.pO = U + dsel + (seg >= 2 ? eo : eo * 2); u.aux = seg == 3 ? 1 : 0; }
        else { w -= 2048; const int gid = w >> 5, r = w & 31, tok = gid * 8 + (r & 7), ch = r >> 3; u.pm = tok; u.pn = ch;
            u.pA = WTVA + (size_t)ch * 256 * 1024 * 2; u.pB = H + (size_t)tok * 256 * 1024 * 2; u.pO = GVT + ((size_t)(ch * 256) * ML + tok * 256) * 2; u.ldc = ML; u.act = ACT_GELU; }
        return true;
    }
};
}

#define LAS __attribute__((address_space(3)))

namespace gla {
typedef short bf16x8 __attribute__((ext_vector_type(8)));
typedef float f32x4 __attribute__((ext_vector_type(4)));
typedef unsigned u32x4 __attribute__((ext_vector_type(4)));
typedef unsigned u32x2 __attribute__((ext_vector_type(2)));
constexpr int PKG_L_BYTES = 41984, PKG_C_BYTES = 17408, OFF_EL = 0, OFF_KS = 1024, OFF_QD = 17408, OFF_AT = 33792;
constexpr int SLOT_BYTES = PKG_L_BYTES + 8192, OFF_V = PKG_L_BYTES;
constexpr size_t WS_PKGC = 487 * MiB, WS_PKGD = 500 * MiB;
static_assert(WS_PKG + (size_t)64 * 64 * PKG_L_BYTES <= WS_OF && WS_PKGC + (size_t)64 * 4 * PKG_C_BYTES <= WS_END, "package regions");
constexpr float LOG2E = 1.44269504088896f;
__device__ __forceinline__ unsigned cvt_pk(float lo, float hi) { typedef __bf16 v2bf __attribute__((ext_vector_type(2))); typedef float v2f __attribute__((ext_vector_type(2)));
    const v2f x = {lo, hi}; const v2bf y = __builtin_convertvector(x, v2bf); return __builtin_bit_cast(unsigned, y); }
__device__ __forceinline__ float bfr(float f) { return __uint_as_float((__float_as_uint(f) + 0x7fffu + ((__float_as_uint(f) >> 16) & 1u)) & 0xffff0000u); }
__device__ __forceinline__ char* pkg_ptr(unsigned char* ws, int seq, int ch) {
    return ch < 4 ? (char*)ws + WS_PKGC + (size_t)(seq * 4 + ch) * PKG_C_BYTES : (char*)ws + WS_PKG + (size_t)(seq * 64 + (ch - 4)) * PKG_L_BYTES;
}
#define GLA_BAR() do { asm volatile("s_waitcnt lgkmcnt(0)" ::: "memory"); __builtin_amdgcn_s_barrier(); asm volatile("" ::: "memory"); } while (0)

__device__ __forceinline__ void prepass_phase(LAS unsigned char* lds, unsigned char* ws, const float* w_af, const float* b_af, const float* w_ab, const float* b_ab, int G, int c) {
    const int tid = threadIdx.x, w = __builtin_amdgcn_readfirstlane(tid >> 6), lane = tid & 63, lc = lane & 15, lg = lane >> 4;
    LAS float* B2 = (LAS float*)lds;
    LAS float* BL = (LAS float*)(lds + 33792);
    LAS unsigned char* QD = lds + 34816;
    LAS unsigned char* KI = lds + 51200;
    LAS unsigned short* KST = (LAS unsigned short*)(lds + 67584);
    LAS float* AFL = (LAS float*)(lds + 83968);
    LAS float* WL = (LAS float*)(lds + 93184);
    const bf16* Qg = (const bf16*)(ws + WS_Q); const bf16* Kg = (const bf16*)(ws + WS_K); const float* AF = (const float*)(ws + WS_AF);
    constexpr int NITEMS = 64 * 68;
    struct In1 { f32x4 araw; float bias; };
    struct In2 { u32x4 k[2]; u32x4 q[2]; };
    auto load1 = [&](int item_, In1& p) { const int item = item_ < NITEMS ? item_ : NITEMS - 1; const int seq = item / 68, ch = item - seq * 68, dir = seq >> 5, b = (seq >> 2) & 7, h = seq & 3;
        const int row0 = ch < 4 ? ML + b * TC + ch * 64 : b * T + (ch - 4) * 64, dk = 16 * w + lc;
        p.bias = (dir ? b_ab : b_af)[h * DK + dk];
        p.araw = *(const f32x4*)(AF + (size_t)row0 * 32 + tid * 4); };
    auto put_af = [&](const In1& p) { float hi[4], lo[4];
#pragma unroll
        for (int j = 0; j < 4; ++j) { hi[j] = bfr(p.araw[j]); lo[j] = bfr(p.araw[j] - hi[j]); }
        u32x2 h, l; h.x = (__float_as_uint(hi[0]) >> 16) | (__float_as_uint(hi[1]) & 0xffff0000u); h.y = (__float_as_uint(hi[2]) >> 16) | (__float_as_uint(hi[3]) & 0xffff0000u);
        l.x = (__float_as_uint(lo[0]) >> 16) | (__float_as_uint(lo[1]) & 0xffff0000u); l.y = (__float_as_uint(lo[2]) >> 16) | (__float_as_uint(lo[3]) & 0xffff0000u);
        LAS unsigned char* rp = (LAS unsigned char*)AFL + (tid >> 3) * 144 + (tid & 7) * 8; *(LAS u32x2*)rp = h; *(LAS u32x2*)(rp + 64) = l; };
    auto load2 = [&](int item_, In2& p) { const int item = item_ < NITEMS ? item_ : NITEMS - 1; const int seq = item / 68, ch = item - seq * 68, b = (seq >> 2) & 7, h = seq & 3;
        const int row0 = ch < 4 ? ML + b * TC + ch * 64 : b * T + (ch - 4) * 64;
        const bf16* qsrc = Qg + (ch < 4 ? (long long)(Kg - Qg) : 0ll);
#pragma unroll
        for (int rep = 0; rep < 2; ++rep) { const int f = w + 8 * rep, it = f >> 2, sidx = f & 3, i = 16 * it + lc;
            const size_t ro = (size_t)(row0 + i) * QKW + h * DK + 32 * sidx + 8 * lg;
            p.k[rep] = *(const u32x4*)(Kg + ro); p.q[rep] = *(const u32x4*)(qsrc + ro); } };
    struct Def { u32x4 aw, k0, k1; char* pq; char* pk; };
    auto flush = [&](const Def& d) { *(u32x4*)(d.pq + OFF_AT + ((w & 3) * 2 + (w >> 2)) * 1024 + lane * 16) = d.aw; *(u32x4*)(d.pk + OFF_KS + (2 * w) * 1024 + lane * 16) = d.k0; *(u32x4*)(d.pk + OFF_KS + (2 * w + 1) * 1024 + lane * 16) = d.k1; };
    auto body = [&](int item_, const In1& c1, const In2& c2, In1& n1, In2& n2, const Def& din, Def& dout) {
        const bool oob = item_ >= NITEMS; const int item = oob ? NITEMS - 1 : item_;
        const int seq = item / 68, ch = item - seq * 68, dir = seq >> 5, hh = seq & 3;
        const bool isctx = ch < 4;
        char* pkr = pkg_ptr(ws, seq, ch); char* dummy = (char*)ws + WS_PKGD;
        char* pk = dummy + (oob ? 0ll : (long long)(pkr - dummy));
        char* pkq = dummy + ((oob || isctx) ? 0ll : (long long)(pkr - dummy));
        {
            const int dk = 16 * w + lc;
            bf16x8 bh, bl;
#pragma unroll
            for (int j = 0; j < 8; ++j) { const float wv = WL[(dir * 16 + ((8 * lg + j) & 15)) * 512 + hh * DK + dk]; const float hi = bfr(wv); const float lo = bfr(wv - hi);
                bh[j] = (short)(__float_as_uint(hi) >> 16); bl[j] = lg < 2 ? (short)(__float_as_uint(lo) >> 16) : (short)0; }
            const float bias = c1.bias;
            float g2[4][4];
#pragma unroll
            for (int tt = 0; tt < 4; ++tt) {
                const bf16x8 af = *(const LAS bf16x8*)((const LAS unsigned char*)AFL + (16 * tt + lc) * 144 + (lg < 2 ? 0 : 64) + (dir * 16 + 8 * (lg & 1)) * 2);
                f32x4 z = (f32x4){0.f, 0.f, 0.f, 0.f};
                z = __builtin_amdgcn_mfma_f32_16x16x32_bf16(af, bh, z, 0, 0, 0);
                z = __builtin_amdgcn_mfma_f32_16x16x32_bf16(af, bl, z, 0, 0, 0);
#pragma unroll
                for (int r = 0; r < 4; ++r) { const float zz = z[r] + bias;
                    const float ls2 = fminf(zz, 0.f) * LOG2E - __builtin_amdgcn_logf(1.0f + __builtin_amdgcn_exp2f(-fabsf(zz) * LOG2E));
                    g2[tt][r] = ls2 * (1.0f / 16.0f); }
            }
            float pre[4][4], tot[4], all[4][4];
#pragma unroll
            for (int tt = 0; tt < 4; ++tt) { pre[tt][0] = g2[tt][0]; pre[tt][1] = pre[tt][0] + g2[tt][1]; pre[tt][2] = pre[tt][1] + g2[tt][2]; pre[tt][3] = pre[tt][2] + g2[tt][3]; tot[tt] = pre[tt][3]; }
#pragma unroll
            for (int tt = 0; tt < 4; ++tt)
#pragma unroll
                for (int q = 0; q < 4; ++q) all[tt][q] = __shfl(tot[tt], lc + 16 * q);
            float run = 0.f, total;
            float offs[4];
#pragma unroll
            for (int tt = 0; tt < 4; ++tt) { offs[tt] = run + (lg > 0 ? all[tt][0] : 0.f) + (lg > 1 ? all[tt][1] : 0.f) + (lg > 2 ? all[tt][2] : 0.f); run += (all[tt][0] + all[tt][1]) + (all[tt][2] + all[tt][3]); }
            total = run;
#pragma unroll
            for (int tt = 0; tt < 4; ++tt)
#pragma unroll
                for (int r = 0; r < 4; ++r) { const float incl = offs[tt] + pre[tt][r]; const float bb = dir ? (total - incl) + g2[tt][r] : incl; B2[(16 * tt + 4 * lg + r) * 132 + dk] = bb; }
            { const float et = __builtin_amdgcn_exp2f(total); BL[dk] = et; ((float*)(pk + OFF_EL))[dk] = et; }
        }
        GLA_BAR();
        load1(item_ + G, n1);
        flush(din);
#pragma unroll
        for (int rep = 0; rep < 2; ++rep) {
            const int f = w + 8 * rep, it = f >> 2, s = f & 3, i = 16 * it + lc, d0 = 32 * s + 4 * lg, d1 = d0 + 16;
            const f32x4 b0 = *(const LAS f32x4*)(B2 + i * 132 + d0), b1 = *(const LAS f32x4*)(B2 + i * 132 + d1), l0 = *(const LAS f32x4*)(BL + d0), l1 = *(const LAS f32x4*)(BL + d1);
            const u32x2 k0 = {c2.k[rep].x, c2.k[rep].y}, k1 = {c2.k[rep].z, c2.k[rep].w};
            float kv[8] = {__uint_as_float(k0.x << 16), __uint_as_float(k0.x & 0xffff0000u), __uint_as_float(k0.y << 16), __uint_as_float(k0.y & 0xffff0000u),
                           __uint_as_float(k1.x << 16), __uint_as_float(k1.x & 0xffff0000u), __uint_as_float(k1.y << 16), __uint_as_float(k1.y & 0xffff0000u)};
            float bb[8] = {b0[0], b0[1], b0[2], b0[3], b1[0], b1[1], b1[2], b1[3]}, ll[8] = {l0[0], l0[1], l0[2], l0[3], l1[0], l1[1], l1[2], l1[3]};
            float ki[8];
#pragma unroll
            for (int e = 0; e < 8; ++e) ki[e] = kv[e] * __builtin_amdgcn_exp2f(-bb[e]);
#pragma unroll
            for (int e = 0; e < 8; e += 2) { const int dk = (e < 4 ? d0 : d1) + (e & 3); const unsigned p = cvt_pk(ki[e] * ll[e], ki[e + 1] * ll[e + 1]);
                KST[dk * 64 + i] = (unsigned short)p; KST[(dk + 1) * 64 + i] = (unsigned short)(p >> 16); }
            {
                const u32x2 q0 = {c2.q[rep].x, c2.q[rep].y}, q1 = {c2.q[rep].z, c2.q[rep].w};
                float qv[8] = {__uint_as_float(q0.x << 16), __uint_as_float(q0.x & 0xffff0000u), __uint_as_float(q0.y << 16), __uint_as_float(q0.y & 0xffff0000u),
                               __uint_as_float(q1.x << 16), __uint_as_float(q1.x & 0xffff0000u), __uint_as_float(q1.y << 16), __uint_as_float(q1.y & 0xffff0000u)};
                float qd[8];
#pragma unroll
                for (int e = 0; e < 8; ++e) qd[e] = qv[e] * __builtin_amdgcn_exp2f(bb[e]);
                u32x4 qw, kw; qw.x = cvt_pk(qd[0], qd[1]); qw.y = cvt_pk(qd[2], qd[3]); qw.z = cvt_pk(qd[4], qd[5]); qw.w = cvt_pk(qd[6], qd[7]);
                kw.x = cvt_pk(ki[0], ki[1]); kw.y = cvt_pk(ki[2], ki[3]); kw.z = cvt_pk(ki[4], ki[5]); kw.w = cvt_pk(ki[6], ki[7]);
                *(LAS u32x4*)(QD + f * 1024 + lane * 16) = qw; *(LAS u32x4*)(KI + f * 1024 + lane * 16) = kw;
                *(u32x4*)(pkq + OFF_QD + f * 1024 + lane * 16) = qw;
            }
        }
        put_af(n1);
        GLA_BAR();
        load2(item_ + G, n2);
        {
            const int s2 = w >> 2, it = w & 3;
            f32x4 d0v = (f32x4){0.f, 0.f, 0.f, 0.f}, d1v = (f32x4){0.f, 0.f, 0.f, 0.f};
#pragma unroll
            for (int s = 0; s < 4; ++s) { const bf16x8 qf = *(const LAS bf16x8*)(QD + (it * 4 + s) * 1024 + lane * 16);
                const bf16x8 ka = *(const LAS bf16x8*)(KI + ((2 * s2) * 4 + s) * 1024 + lane * 16), kb = *(const LAS bf16x8*)(KI + ((2 * s2 + 1) * 4 + s) * 1024 + lane * 16);
                d0v = __builtin_amdgcn_mfma_f32_16x16x32_bf16(ka, qf, d0v, 0, 0, 0); d1v = __builtin_amdgcn_mfma_f32_16x16x32_bf16(kb, qf, d1v, 0, 0, 0); }
            const int i = 16 * it + lc; float a[8];
#pragma unroll
            for (int e = 0; e < 8; ++e) { const int j = 32 * s2 + (e < 4 ? 0 : 16) + 4 * lg + (e & 3); const float v = e < 4 ? d0v[e] : d1v[e - 4]; a[e] = (dir ? (i <= j) : (i >= j)) ? v : 0.f; }
            u32x4 aw; aw.x = cvt_pk(a[0], a[1]); aw.y = cvt_pk(a[2], a[3]); aw.z = cvt_pk(a[4], a[5]); aw.w = cvt_pk(a[6], a[7]);
            dout.aw = aw; dout.pq = pkq; dout.pk = pk;
        }
#pragma unroll
        for (int rep = 0; rep < 2; ++rep) { const int fi = 2 * w + rep, dkt = fi >> 1, sp = fi & 1, dk = 16 * dkt + lc;
            const u32x2 x0 = *(const LAS u32x2*)(KST + dk * 64 + 32 * sp + 4 * lg), x1 = *(const LAS u32x2*)(KST + dk * 64 + 32 * sp + 16 + 4 * lg);
            u32x4 o; o.x = x0.x; o.y = x0.y; o.z = x1.x; o.w = x1.y;
            if (rep == 0) dout.k0 = o; else dout.k1 = o; }
    };
    In1 a1, b1; In2 a2, b2;
    load1(c, a1); load2(c, a2);
    for (int i = tid; i < 2 * 16 * 512 / 4; i += 512) ((LAS f32x4*)WL)[i] = i < 2048 ? ((const f32x4*)w_af)[i] : ((const f32x4*)w_ab)[i - 2048];
    put_af(a1);
    GLA_BAR();
    Def da, db; { char* dummy = (char*)ws + WS_PKGD; da.pq = dummy; da.pk = dummy; da.aw = (u32x4){0u, 0u, 0u, 0u}; da.k0 = da.aw; da.k1 = da.aw; }
    int item = c;
    for (; item + G < NITEMS; item += 2 * G) {
        body(item, a1, a2, b1, b2, da, db);
        body(item + G, b1, b2, a1, a2, db, da);
    }
    if (item < NITEMS) { body(item, a1, a2, b1, b2, da, db); flush(db); }
    else flush(da);
}

__device__ __forceinline__ void scan_phase(LAS unsigned char* lds, unsigned char* ws, int G, int c) {
    const int tid = threadIdx.x, w = __builtin_amdgcn_readfirstlane(tid >> 6), lane = tid & 63, lc = lane & 15, lg = lane >> 4;
    const bf16* VVT = (const bf16*)(ws + WS_VVT);
    const int vc = (G % 8 == 0) ? (c % 8) * (G / 8) + c / 8 : c;
    for (int item = vc; item < 256; item += G) {
        const int seq = item >> 2, vs = item & 3, dir = seq >> 5, b = (seq >> 2) & 7, h = seq & 3;
        bf16* O = (bf16*)(ws + (dir ? WS_OB : WS_OF));
        auto chunk_of = [&](int st) { return st < 4 ? (dir ? 3 - st : st) : 4 + (dir ? 63 - (st - 4) : st - 4); };
        if (w >= 4) {
            const int lw = w - 4;
            auto ptr_of = [&](int st_) { const int st = st_ < 68 ? st_ : 67; return chunk_of(st); };
            auto own_src = [&](int st_, int k) -> const char* { const int ch = ptr_of(st_); const char* pk = pkg_ptr(ws, seq, ch); const int tot = ch < 4 ? 17 : 41, nown = (tot - vs + 3) >> 2;
                const int trow = ch < 4 ? ML + b * TC + ch * 64 : b * T + (ch - 4) * 64;
                const int j = lw + 4 * k;
                if (j < nown) return pk + (vs + 4 * j) * 1024 + lane * 16;
                if (j < nown + 8) return (const char*)(VVT + ((size_t)(trow >> 6) * 1024 + h * DV + vs * 64) * 64 + lane * 8) + (j - nown) * 1024;
                return pk + vs * 1024 + lane * 16; };
            auto own_dst = [&](int st, int k) -> int { const int ch = chunk_of(st); const int tot = ch < 4 ? 17 : 41, nown = (tot - vs + 3) >> 2; const int j = lw + 4 * k;
                return j < nown ? (vs + 4 * j) * 1024 : j < nown + 8 ? OFF_V + (j - nown) * 1024 : vs * 1024; };
            auto rest_piece = [&](int st_, int k) -> int { const int ch = ptr_of(st_); const int tot = ch < 4 ? 17 : 41, nown = (tot - vs + 3) >> 2, nrest = tot - nown; const int j = lw + 4 * k;
                const int jj = j < nrest ? j : 0, i3 = jj % 3; return (jj / 3) * 4 + (i3 < vs ? i3 : i3 + 1); };
            u32x4 oa[5], ob[5], rb[8];
            auto ld_own = [&](int st, u32x4 (&r)[5]) {
#pragma unroll
                for (int k = 0; k < 5; ++k) r[k] = *(const u32x4*)own_src(st, k); };
            auto st_own = [&](int st, const u32x4 (&r)[5]) { if (st >= 68) return; LAS unsigned char* dst = lds + (st % 3) * SLOT_BYTES;
#pragma unroll
                for (int k = 0; k < 5; ++k) *(LAS u32x4*)(dst + own_dst(st, k) + lane * 16) = r[k]; };
            auto ld_rest = [&](int st) { const char* pk = pkg_ptr(ws, seq, ptr_of(st));
#pragma unroll
                for (int k = 0; k < 8; ++k) rb[k] = *(const u32x4*)(pk + rest_piece(st, k) * 1024 + lane * 16); };
            auto st_rest = [&](int st) { if (st >= 68) return; LAS unsigned char* dst = lds + (st % 3) * SLOT_BYTES;
#pragma unroll
                for (int k = 0; k < 8; ++k) *(LAS u32x4*)(dst + rest_piece(st, k) * 1024 + lane * 16) = rb[k]; };
            ld_own(0, oa); ld_own(1, ob); ld_rest(0);
            st_own(0, oa); st_rest(0);
            for (int st = 0; st < 68; st += 2) {
                GLA_BAR();
                ld_rest(st + 1); ld_own(st + 2, oa);
                st_own(st + 1, ob); st_rest(st + 1);
                GLA_BAR();
                ld_rest(st + 2); ld_own(st + 3, ob);
                st_own(st + 2, oa); st_rest(st + 2);
            }
            GLA_BAR();
        } else {
            const int dvb = vs * 64 + 16 * w;
            f32x4 S[8];
#pragma unroll
            for (int t = 0; t < 8; ++t) S[t] = (f32x4){0.f, 0.f, 0.f, 0.f};
#define GLA_FRAG(off) (*(const LAS bf16x8*)(base + (off) + lane * 16))
#define GLA_PIN() __builtin_amdgcn_sched_barrier(0)
            for (int st = 0; st < 68; ++st) {
                GLA_BAR();
                const LAS unsigned char* base = lds + (st % 3) * SLOT_BYTES;
                const int ch = chunk_of(st);
                bf16x8 vf[2];
                {   const LAS unsigned char* vp = base + OFF_V + (16 * w + lc) * 128 + 8 * lg;
                    const u32x2 x0 = *(const LAS u32x2*)vp, x1 = *(const LAS u32x2*)(vp + 32), x2 = *(const LAS u32x2*)(vp + 64), x3 = *(const LAS u32x2*)(vp + 96);
                    u32x4 t0, t1; t0.x = x0.x; t0.y = x0.y; t0.z = x1.x; t0.w = x1.y; t1.x = x2.x; t1.y = x2.y; t1.z = x3.x; t1.w = x3.y; vf[0] = __builtin_bit_cast(bf16x8, t0); vf[1] = __builtin_bit_cast(bf16x8, t1); }
                f32x4 el[8]; bf16x8 ks[8][2];
                if (ch >= 4) {
                    bf16x8 qa[4][6];
#pragma unroll
                    for (int it = 0; it < 4; ++it) {
#pragma unroll
                        for (int s = 0; s < 4; ++s) qa[it][s] = GLA_FRAG(OFF_QD + (it * 4 + s) * 1024);
#pragma unroll
                        for (int s2 = 0; s2 < 2; ++s2) qa[it][4 + s2] = GLA_FRAG(OFF_AT + (it * 2 + s2) * 1024); }
                    GLA_PIN();
                    bf16x8 sa[4];
#pragma unroll
                    for (int s = 0; s < 4; ++s) { u32x4 t; t.x = cvt_pk(S[2 * s][0], S[2 * s][1]); t.y = cvt_pk(S[2 * s][2], S[2 * s][3]); t.z = cvt_pk(S[2 * s + 1][0], S[2 * s + 1][1]); t.w = cvt_pk(S[2 * s + 1][2], S[2 * s + 1][3]); sa[s] = __builtin_bit_cast(bf16x8, t); }
                    const int row0 = b * T + (ch - 4) * 64;
                    f32x4 o[4];
#pragma unroll
                    for (int it = 0; it < 2; ++it) { o[it] = (f32x4){0.f, 0.f, 0.f, 0.f};
#pragma unroll
                        for (int s = 0; s < 4; ++s) o[it] = __builtin_amdgcn_mfma_f32_16x16x32_bf16(sa[s], qa[it][s], o[it], 0, 0, 0);
#pragma unroll
                        for (int s2 = 0; s2 < 2; ++s2) o[it] = __builtin_amdgcn_mfma_f32_16x16x32_bf16(vf[s2], qa[it][4 + s2], o[it], 0, 0, 0); }
                    GLA_PIN();
#pragma unroll
                    for (int t = 0; t < 4; ++t) { el[t] = *(const LAS f32x4*)(base + OFF_EL + (16 * t + 4 * lg) * 4); ks[t][0] = GLA_FRAG(OFF_KS + (t * 2) * 1024); ks[t][1] = GLA_FRAG(OFF_KS + (t * 2 + 1) * 1024); }
                    GLA_PIN();
#pragma unroll
                    for (int it = 2; it < 4; ++it) { o[it] = (f32x4){0.f, 0.f, 0.f, 0.f};
#pragma unroll
                        for (int s = 0; s < 4; ++s) o[it] = __builtin_amdgcn_mfma_f32_16x16x32_bf16(sa[s], qa[it][s], o[it], 0, 0, 0);
#pragma unroll
                        for (int s2 = 0; s2 < 2; ++s2) o[it] = __builtin_amdgcn_mfma_f32_16x16x32_bf16(vf[s2], qa[it][4 + s2], o[it], 0, 0, 0); }
                    GLA_PIN();
#pragma unroll
                    for (int t = 4; t < 8; ++t) { el[t] = *(const LAS f32x4*)(base + OFF_EL + (16 * t + 4 * lg) * 4); ks[t][0] = GLA_FRAG(OFF_KS + (t * 2) * 1024); ks[t][1] = GLA_FRAG(OFF_KS + (t * 2 + 1) * 1024); }
#pragma unroll
                    for (int it = 0; it < 4; ++it) { u32x2 ow; ow.x = cvt_pk(o[it][0], o[it][1]); ow.y = cvt_pk(o[it][2], o[it][3]);
                        *(u32x2*)(O + (size_t)(row0 + 16 * it + lc) * VW + h * DV + dvb + 4 * lg) = ow; }
                    GLA_PIN();
                } else {
#pragma unroll
                    for (int t = 0; t < 8; ++t) { el[t] = *(const LAS f32x4*)(base + OFF_EL + (16 * t + 4 * lg) * 4); ks[t][0] = GLA_FRAG(OFF_KS + (t * 2) * 1024); ks[t][1] = GLA_FRAG(OFF_KS + (t * 2 + 1) * 1024); }
                    GLA_PIN();
                }
#pragma unroll
                for (int t = 0; t < 8; ++t) { S[t] = S[t] * el[t]; S[t] = __builtin_amdgcn_mfma_f32_16x16x32_bf16(ks[t][0], vf[0], S[t], 0, 0, 0); S[t] = __builtin_amdgcn_mfma_f32_16x16x32_bf16(ks[t][1], vf[1], S[t], 0, 0, 0); }
            }
#undef GLA_FRAG
#undef GLA_PIN
            GLA_BAR();
        }
    }
}
}


#define XB_TMO      128
#define XB_XCNT(j)  (256  + 64 * (j))
#define XB_XSUB(j)  (1280 + 64 * (j))
#define XB_XGEN(j)  (2304 + 64 * (j))
#define XB_TOP      3328
#define XB_TOPGEN   3392
#define XCD_BAR_WORDS 3456
#define XB_SPIN_CAP (1u << 18)
__device__ __forceinline__ unsigned xb_ld(unsigned* p)              { return __hip_atomic_load(p, __ATOMIC_RELAXED, __HIP_MEMORY_SCOPE_AGENT); }
__device__ __forceinline__ unsigned xb_add(unsigned* p, unsigned v) { return __hip_atomic_fetch_add(p, v, __ATOMIC_RELAXED, __HIP_MEMORY_SCOPE_AGENT); }
__device__ __forceinline__ unsigned xb_xcc_id() { return (unsigned)__builtin_amdgcn_s_getreg((3 << 11) | 20) & 0xFu; }
#define XB_SPIN(cond, bar) do { unsigned _sp = 0; while (cond) { __builtin_amdgcn_s_sleep(1); \
    if ((++_sp & 255u) == 0u) { if (xb_ld(&(bar)[XB_TMO])) break; if (_sp > XB_SPIN_CAP) { atomicAdd(&(bar)[XB_TMO], 1u); break; } } } } while (0)
struct XcdBarrier { unsigned* bar; unsigned x; volatile LAS unsigned* st; };
__device__ __forceinline__ XcdBarrier xcd_barrier_post(unsigned* bar, volatile LAS unsigned* st) {
    XcdBarrier b; b.bar = bar; b.x = xb_xcc_id(); b.st = st;
    if (threadIdx.x == 0) (void)xb_add(&bar[XB_XCNT(b.x)], 1u);
    return b;
}
__device__ __forceinline__ void xcd_barrier_complete(unsigned* bar, unsigned x, unsigned& nloc, unsigned& nx) {
    const unsigned G = gridDim.x * gridDim.y * gridDim.z;
    unsigned sum, cnt, mine, sp = 0u;
    for (;;) {
        sum = 0u; cnt = 0u; mine = 0u;
#pragma unroll
        for (unsigned j = 0; j < 16; ++j) { const unsigned c = xb_ld(&bar[XB_XCNT(j)]); sum += c; cnt += (c > 0u) ? 1u : 0u; mine = (j == x) ? c : mine; }
        if (sum == G) break;
        __builtin_amdgcn_s_sleep(1);
        if ((++sp & 255u) == 0u) { if (xb_ld(&bar[XB_TMO])) break; if (sp > XB_SPIN_CAP) { atomicAdd(&bar[XB_TMO], 1u); break; } }
    }
    nloc = mine > 0u ? mine : 1u; nx = cnt > 0u ? cnt : 1u;
}
__device__ __forceinline__ void xcd_barrier(const XcdBarrier& b) {
    asm volatile("s_waitcnt vmcnt(0)" ::: "memory");
    __syncthreads();
    if (threadIdx.x == 0) {
        unsigned* bar = b.bar;
        __builtin_amdgcn_s_waitcnt(0);
        unsigned nloc = b.st[0], nx = b.st[1];
        if (nloc == 0u) { xcd_barrier_complete(bar, b.x, nloc, nx); b.st[0] = nloc; b.st[1] = nx; }
        const unsigned old = xb_add(&bar[XB_XSUB(b.x)], 1u);
        const unsigned gen = old / nloc;
        if (old + 1u == (gen + 1u) * nloc) {
            __builtin_amdgcn_fence(__ATOMIC_RELEASE, "agent");
            asm volatile("s_waitcnt vmcnt(0)" ::: "memory");
            const unsigned og = xb_add(&bar[XB_TOP], 1u);
            const unsigned tg = og / nx;
            if (og + 1u == (tg + 1u) * nx) xb_add(&bar[XB_TOPGEN], 1u);
            else XB_SPIN(xb_ld(&bar[XB_TOPGEN]) == tg, bar);
            __builtin_amdgcn_fence(__ATOMIC_ACQUIRE, "agent");
            xb_add(&bar[XB_XGEN(b.x)], 1u);
            asm volatile("s_waitcnt vmcnt(0)" ::: "memory");
        } else {
            XB_SPIN(xb_ld(&bar[XB_XGEN(b.x)]) == gen, bar);
            __builtin_amdgcn_fence(__ATOMIC_ACQUIRE, "agent");
            asm volatile("s_waitcnt vmcnt(0)" ::: "memory");
        }
    }
    __syncthreads();
}

namespace thin {
typedef float f32x4 __attribute__((ext_vector_type(4)));
typedef unsigned u32x4 __attribute__((ext_vector_type(4)));
typedef unsigned u32x2 __attribute__((ext_vector_type(2)));
typedef short bf16x8 __attribute__((ext_vector_type(8)));
using gla::cvt_pk;
__device__ __forceinline__ float lo16(unsigned w) { return __uint_as_float(w << 16); }
__device__ __forceinline__ float hi16(unsigned w) { return __uint_as_float(w & 0xffff0000u); }
__device__ __forceinline__ void tr_item(const float* W, int K, int ldw, int col0, bf16* WT, int mode_, LAS float* scr, int item, int nblk, int lane) {
    const int mode = mode_ & 15; const float wsc = (mode_ & 16) ? -1.44269504089f : (mode_ & 32) ? 0.08838834764831845f : 1.0f;
    const int kb = item / nblk, nb = item % nblk, k0 = 64 * kb, n0 = 32 * nb;
#pragma unroll 8
    for (int i = 0; i < 32; ++i) { const int kk = 2 * i + (lane >> 5); scr[kk * 33 + (lane & 31)] = W[(size_t)(k0 + kk) * ldw + col0 + n0 + (lane & 31)]; }
    asm volatile("s_waitcnt lgkmcnt(0)" ::: "memory");
    int r0 = n0;
    if (mode == 1) { const int col = col0 + n0; r0 = col < DFF ? 256 * (col >> 7) + (col & 127) : 256 * ((col - DFF) >> 7) + 128 + ((col - DFF) & 127); }
    const int cch = lane & 7;
#pragma unroll
    for (int j = 0; j < 4; ++j) { const int n = (lane >> 3) + 8 * j; const LAS float* sp = scr + (8 * cch) * 33 + n;
        u32x4 o; o.x = cvt_pk(sp[0 * 33] * wsc, sp[1 * 33] * wsc); o.y = cvt_pk(sp[2 * 33] * wsc, sp[3 * 33] * wsc); o.z = cvt_pk(sp[4 * 33] * wsc, sp[5 * 33] * wsc); o.w = cvt_pk(sp[6 * 33] * wsc, sp[7 * 33] * wsc);
        *(u32x4*)(WT + (size_t)(r0 + (mode == 2 ? pg8::perm32(n) : n)) * K + k0 + 8 * cch) = o; }
    asm volatile("s_waitcnt lgkmcnt(0)" ::: "memory");
}
template <int NR, int NC>
__device__ __forceinline__ void gemv_block(const LAS float* sv, LAS float* red, const float* W, int ldw, int col0, const float* bias, float* out, int ldo) {
    const int tid = threadIdx.x, w = tid >> 6, lane = tid & 63, col = lane % NC, kk = lane / NC;
    float acc[NR];
#pragma unroll
    for (int r = 0; r < NR; ++r) acc[r] = 0.f;
    if (kk < 2) {
#pragma unroll 16
        for (int j = 0; j < 64; ++j) { const int k = 128 * w + 2 * j + kk; const float wv = W[(size_t)k * ldw + col0 + col];
#pragma unroll
            for (int r = 0; r < NR; ++r) acc[r] += sv[r * 1024 + k] * wv; }
    }
#pragma unroll
    for (int r = 0; r < NR; ++r) { const float o = __shfl(acc[r], (lane + NC) & 63); if (lane < NC) red[(w * NR + r) * 32 + col] = acc[r] + o; }
    __syncthreads();
    if (tid < NR * NC) { const int r = tid / NC, cidx = tid % NC; float t = 0.f;
#pragma unroll
        for (int ww = 0; ww < 8; ++ww) t += red[(ww * NR + r) * 32 + cidx];
        out[(size_t)r * ldo + col0 + cidx] = t + (bias ? bias[col0 + cidx] : 0.f); }
    __syncthreads();
}
struct P0Args { const float *c, *cctx, *w_ada, *b_ada, *w_in, *w_ba, *w_bb, *w_out, *w_f1, *w_f2, *w_sp; };
__device__ __forceinline__ void p0_phase(LAS unsigned char* lds, unsigned char* ws, const P0Args& A, int G, int vcu) {
    const int tid = threadIdx.x, w = __builtin_amdgcn_readfirstlane(tid >> 6), lane = tid & 63;
    LAS float* scr = (LAS float*)(lds + w * 8448);
    LAS float* sv = (LAS float*)(lds + 69632);
    LAS float* red = (LAS float*)(lds + 69632 + 36864);
    for (int i = tid; i < 9 * 1024; i += 512) { const int r = i >> 10, k = i & 1023; const float v = r < 8 ? A.c[r * 1024 + k] : A.cctx[k]; sv[i] = v / (1.f + __expf(-v)); }
    __syncthreads();
    for (int cb = vcu; cb < 256; cb += G) gemv_block<9, 24>(sv, red, A.w_ada, 6144, 24 * cb, A.b_ada, (float*)(ws + WS_MOD), 6144);
    const int gw = vcu * 8 + w, NGW = G * 8; int base = 0;
#define TR_JOB(Wp, K_, ldw_, col0_, ncols_, dst_, mode_) do { const int nblk_ = (ncols_) / 32, items_ = ((K_) / 64) * nblk_; \
        for (int it_ = ((gw - base) % NGW + NGW) % NGW; it_ < items_; it_ += NGW) tr_item(Wp, K_, ldw_, col0_, dst_, mode_, scr, it_, nblk_, lane); base = (base + items_) % NGW; } while (0)
    bf16* WT1A = (bf16*)(ws + WS_WT1A); bf16* WT1B = (bf16*)(ws + WS_WT1B);
    TR_JOB(A.w_in, 1024, NIN, C_Q, 512, WT1A, 2 + 32); TR_JOB(A.w_in, 1024, NIN, C_K, 512, WT1A + 512 * 1024, 2); TR_JOB(A.w_in, 1024, NIN, C_AF, 32, WT1A + 1024 * 1024, 0);
    TR_JOB(A.w_in, 1024, NIN, C_VV, 1024, (bf16*)(ws + WS_WTVV), 0); TR_JOB(A.w_in, 1024, NIN, C_VA, 1024, (bf16*)(ws + WS_WTVA), 0);
    TR_JOB(A.w_in, 1024, NIN, C_U, 1024, WT1B, 0); TR_JOB(A.w_in, 1024, NIN, C_R, 1024, WT1B + 1024 * 1024, 0); TR_JOB(A.w_in, 1024, NIN, C_GA, 1024, WT1B + 2048 * 1024, 16); TR_JOB(A.w_in, 1024, NIN, C_GB, 1024, WT1B + 3072 * 1024, 16);
    TR_JOB(A.w_ba, 1024, 1024, 0, 1024, (bf16*)(ws + WS_WTA), 0); TR_JOB(A.w_bb, 1024, 1024, 0, 1024, (bf16*)(ws + WS_WTB), 0); TR_JOB(A.w_out, 1024, 1024, 0, 1024, (bf16*)(ws + WS_WTO), 0);
    TR_JOB(A.w_f1, 1024, 2 * DFF, 0, 2 * DFF, (bf16*)(ws + WS_WTF1), 1);
    TR_JOB(A.w_f2, DFF, 1024, 0, 1024, (bf16*)(ws + WS_WTF2), 0);
#undef TR_JOB
    { u32x4* z = (u32x4*)(WT1A + 1056 * 1024); const u32x4 zero = {0u, 0u, 0u, 0u}; for (int i = vcu * 512 + tid; i < 224 * 1024 / 8; i += G * 512) z[i] = zero; }
    for (int i = vcu * 512 + tid; i < 8 * 8 * 4 * 64; i += G * 512) { const int ln = i & 63, sidx = (i >> 6) & 3, pt = (i >> 8) & 7, g = i >> 11;
        const float* src = A.w_sp + ((size_t)g * 128 + 16 * pt + (ln & 15)) * 128 + 32 * sidx + 8 * (ln >> 4);
        const f32x4 a = *(const f32x4*)src, b = *(const f32x4*)(src + 4);
        u32x4 o; o.x = cvt_pk(a[0], a[1]); o.y = cvt_pk(a[2], a[3]); o.z = cvt_pk(b[0], b[1]); o.w = cvt_pk(b[2], b[3]);
        ((u32x4*)(ws + WS_WSPF))[i] = o; }
    __syncthreads();
}
__device__ __forceinline__ float wsum(float v) {
#pragma unroll
    for (int o = 1; o < 64; o <<= 1) v += __shfl_xor(v, o);
    return v;
}
__device__ __forceinline__ void p1_phase(LAS unsigned char* lds, unsigned char* ws, const float* x, const float* ctx, const float* n1g, const float* n2g, const float* w_f1, int G, int vcu) {
    const int tid = threadIdx.x, w = __builtin_amdgcn_readfirstlane(tid >> 6), lane = tid & 63;
    const float* MOD = (const float*)(ws + WS_MOD); bf16* H = (bf16*)(ws + WS_H);
    const int gw = vcu * 8 + w, NGW = G * 8;
    LAS float* TA = (LAS float*)lds; LAS float* TB = TA + 9 * 1024;
    for (int i = tid; i < 9 * 1024; i += 512) { const int mr = i >> 10, ci = i & 1023; TA[i] = n1g[ci] * (MOD[mr * 6144 + 1024 + ci] + 1.0f); TB[i] = MOD[mr * 6144 + ci]; }
    __syncthreads();
    auto rowp = [&](int row) { return row < ML ? x + (size_t)row * D : ctx + (size_t)(row - ML) * D; };
    auto store_row = [&](const f32x4 (&v)[4], float t, int row) {
        const int mr = row < ML ? row / T : 8; const float rstd = rsqrtf(t * (1.f / D) + EPS);
#pragma unroll
        for (int j = 0; j < 4; ++j) { const int cidx = 4 * lane + 256 * j; const f32x4 ga = *(const LAS f32x4*)(TA + mr * 1024 + cidx), sh = *(const LAS f32x4*)(TB + mr * 1024 + cidx);
            const f32x4 y = v[j] * rstd * ga + sh; u32x2 o; o.x = cvt_pk(y[0], y[1]); o.y = cvt_pk(y[2], y[3]); *(u32x2*)(H + (size_t)row * D + cidx) = o; } };
    auto sumsq = [&](const f32x4 (&v)[4]) { float t = 0.f;
#pragma unroll
        for (int j = 0; j < 4; ++j) t += (v[j][0] * v[j][0] + v[j][1] * v[j][1]) + (v[j][2] * v[j][2] + v[j][3] * v[j][3]);
        return t; };
    if (G == 256) {
        constexpr int NQ = 3, NR = M / 2048, NIT = (NR + NQ - 1) / NQ; static_assert(M % 2048 == 0, "rows per wave");
        f32x4 v[2][NQ][4];
#pragma unroll
        for (int q = 0; q < NQ; ++q) { const float* xr = rowp(gw + q * 2048);
#pragma unroll
            for (int j = 0; j < 4; ++j) v[0][q][j] = *(const f32x4*)(xr + 4 * lane + 256 * j); }
#pragma unroll
        for (int it = 0; it < NIT; ++it) {
            if (it + 1 < NIT) {
#pragma unroll
                for (int q = 0; q < NQ; ++q) if ((it + 1) * NQ + q < NR) { const float* xr = rowp(gw + ((it + 1) * NQ + q) * 2048);
#pragma unroll
                    for (int j = 0; j < 4; ++j) v[(it + 1) & 1][q][j] = *(const f32x4*)(xr + 4 * lane + 256 * j); } }
            float ss[NQ];
#pragma unroll
            for (int q = 0; q < NQ; ++q) ss[q] = (it * NQ + q < NR) ? sumsq(v[it & 1][q]) : 0.f;
#pragma unroll
            for (int o = 1; o < 64; o <<= 1) {
#pragma unroll
                for (int q = 0; q < NQ; ++q) if (it * NQ + q < NR) ss[q] += __shfl_xor(ss[q], o); }
#pragma unroll
            for (int q = 0; q < NQ; ++q) if (it * NQ + q < NR) store_row(v[it & 1][q], ss[q], gw + (it * NQ + q) * 2048);
        }
    } else {
    for (int row0 = gw; row0 < M; row0 += 4 * NGW) {
        f32x4 v[4][4]; float ss[4];
#pragma unroll
        for (int q = 0; q < 4; ++q) { const int row = row0 + q * NGW < M ? row0 + q * NGW : row0; const float* xr = rowp(row);
#pragma unroll
            for (int j = 0; j < 4; ++j) v[q][j] = *(const f32x4*)(xr + 4 * lane + 256 * j); }
#pragma unroll
        for (int q = 0; q < 4; ++q) ss[q] = sumsq(v[q]);
#pragma unroll
        for (int o = 1; o < 64; o <<= 1) {
#pragma unroll
            for (int q = 0; q < 4; ++q) ss[q] += __shfl_xor(ss[q], o); }
#pragma unroll
        for (int q = 0; q < 4; ++q) { const int row = row0 + q * NGW; if (row < M) store_row(v[q], ss[q], row); }
    }
    }
    __syncthreads();
    for (int i = vcu * 512 + tid; i < 8 * 1024; i += G * 512) ((float*)(ws + WS_GV2))[i] = n2g[i & 1023] * (1.f + MOD[(i >> 10) * 6144 + 4096 + (i & 1023)]);
    LAS float* sv = (LAS float*)lds; LAS float* red = (LAS float*)(lds + 32768);
    for (int i = tid; i < 8 * 1024; i += 512) sv[i] = MOD[(i >> 10) * 6144 + 3072 + (i & 1023)];
    __syncthreads();
    for (int cb = vcu; cb < 256; cb += G) gemv_block<8, 22>(sv, red, w_f1, 2 * DFF, 22 * cb, nullptr, (float*)(ws + WS_CV), 2 * DFF);
}
__device__ __forceinline__ void mix_phase(LAS unsigned char* lds, unsigned char* ws, const float* lng, const float* lnb, const float* bsp, const float* gain, int G, int vcu) {
    const int tid = threadIdx.x, w = __builtin_amdgcn_readfirstlane(tid >> 6), lane = tid & 63, lc = lane & 15, lg = lane >> 4;
    const bf16* GVT = (const bf16*)(ws + WS_GVT); bf16* U = (bf16*)(ws + WS_U); const u32x4* WSPF = (const u32x4*)(ws + WS_WSPF);
    LAS float* RS = (LAS float*)lds;
    LAS float* RQ = (LAS float*)(lds + 16384);
    LAS float* MR = (LAS float*)(lds + 32768);
    LAS unsigned char* WB = lds + 36864;
    LAS float* LNG = (LAS float*)(lds + 135168); LAS float* LNB = LNG + 1024; LAS float* BSL = LNB + 1024;
    for (int i = tid; i < 1024; i += 512) { LNG[i] = lng[i]; LNB[i] = lnb[i]; BSL[i] = bsp[i]; }
    for (int ch = vcu; ch < ML / 128; ch += G) {
        const int tok0 = ch * 128;
        {
            const int to = tid & 15, cs = tid >> 4; float sm[8], sq[8];
#pragma unroll
            for (int e = 0; e < 8; ++e) { sm[e] = 0.f; sq[e] = 0.f; }
            const bf16* gp = GVT + (size_t)(cs * 32) * ML + tok0 + 8 * to;
            u32x4 raw[32];
#pragma unroll
            for (int cc = 0; cc < 32; ++cc) raw[cc] = *(const u32x4*)(gp + (size_t)cc * ML);
#pragma unroll
            for (int cc = 0; cc < 32; ++cc) { const unsigned rw[4] = {raw[cc].x, raw[cc].y, raw[cc].z, raw[cc].w};
#pragma unroll
                for (int e = 0; e < 4; ++e) { const float x0 = lo16(rw[e]), x1 = hi16(rw[e]); sm[2 * e] += x0; sq[2 * e] += x0 * x0; sm[2 * e + 1] += x1; sq[2 * e + 1] += x1 * x1; } }
#pragma unroll
            for (int e = 0; e < 8; ++e) { RS[cs * 128 + 8 * to + e] = sm[e]; RQ[cs * 128 + 8 * to + e] = sq[e]; }
        }
        __syncthreads();
        if (tid < 128) { float sx = 0.f, qx = 0.f;
#pragma unroll
            for (int k = 0; k < 32; ++k) { sx += RS[k * 128 + tid]; qx += RQ[k * 128 + tid]; }
            const float mean = sx * (1.f / 1024.f), var = fmaxf(qx * (1.f / 1024.f) - mean * mean, 0.f); MR[2 * tid] = mean; MR[2 * tid + 1] = rsqrtf(var + EPS); }
        __syncthreads();
        struct GIn { u32x4 wq[4]; u32x4 av[4]; u32x4 uq[4]; };
        auto gload = [&](int g_, GIn& x) { const int g = g_ < 8 ? g_ : 7;
#pragma unroll
            for (int k = 0; k < 4; ++k) x.wq[k] = WSPF[g * 2048 + tid + 512 * k];
#pragma unroll
            for (int k = 0; k < 4; ++k) { const int e = tid + 512 * k; x.av[k] = *(const u32x4*)(GVT + (size_t)(g * 128 + (e >> 4)) * ML + tok0 + (e & 15) * 8); }
#pragma unroll
            for (int k = 0; k < 4; ++k) { const int e = tid + 512 * k; x.uq[k] = *(const u32x4*)(U + (size_t)(tok0 + (e >> 4)) * D + g * 128 + (e & 15) * 8); } };
        auto gcomp = [&](int g, const GIn& x, GIn& nx) {
            LAS unsigned char* wb = WB; LAS unsigned char* gt = lds + 102400;
#pragma unroll
            for (int k = 0; k < 4; ++k) *(LAS u32x4*)(wb + (tid + 512 * k) * 16) = x.wq[k];
            LAS unsigned char* ut = lds + ((g & 1) ? 69632 : 0);
#pragma unroll
            for (int k = 0; k < 4; ++k) { const int e = tid + 512 * k, row = e >> 4, cu = e & 15, so = row * 256 + ((cu ^ (row & 15)) << 4); *(LAS u32x4*)(ut + so) = x.uq[k]; *(LAS u32x4*)(gt + so) = x.av[k]; }
            GLA_BAR();
            gload(g + 1, nx);
            const int chn = g * 128 + 16 * w + lc; const float gg = LNG[chn], bb = LNB[chn];
            bf16x8 af[4];
#pragma unroll
            for (int sidx = 0; sidx < 4; ++sidx) { const int q0 = 32 * sidx + 8 * lg; const u32x4 raw = *(const LAS u32x4*)(gt + (16 * w + lc) * 256 + (((4 * sidx + lg) ^ lc) << 4));
                const unsigned rw[4] = {raw.x, raw.y, raw.z, raw.w}; float y[8];
#pragma unroll
                for (int e = 0; e < 4; ++e) { const f32x4 mr = *(const LAS f32x4*)(MR + 2 * (q0 + 2 * e));
                    y[2 * e] = (lo16(rw[e]) - mr[0]) * mr[1] * gg + bb; y[2 * e + 1] = (hi16(rw[e]) - mr[2]) * mr[3] * gg + bb; }
                u32x4 t; t.x = cvt_pk(y[0], y[1]); t.y = cvt_pk(y[2], y[3]); t.z = cvt_pk(y[4], y[5]); t.w = cvt_pk(y[6], y[7]); af[sidx] = __builtin_bit_cast(bf16x8, t); }
#pragma unroll
            for (int pt = 0; pt < 8; ++pt) { f32x4 d = (f32x4){0.f, 0.f, 0.f, 0.f};
#pragma unroll
                for (int sidx = 0; sidx < 4; ++sidx) { const bf16x8 bf = *(const LAS bf16x8*)(wb + ((pt * 4 + sidx) * 64 + lane) * 16); d = __builtin_amdgcn_mfma_f32_16x16x32_bf16(af[sidx], bf, d, 0, 0, 0); }
                const float bs = BSL[g * 128 + 16 * pt + lc];
                LAS u32x2* up = (LAS u32x2*)(ut + (16 * pt + lc) * 256 + (((2 * w + (lg >> 1)) ^ lc) << 4) + (lg & 1) * 8); const u32x2 uv = *up;
                u32x2 o; o.x = cvt_pk(lo16(uv.x) * (d[0] + bs), hi16(uv.x) * (d[1] + bs)); o.y = cvt_pk(lo16(uv.y) * (d[2] + bs), hi16(uv.y) * (d[3] + bs)); *up = o; }
            GLA_BAR();
#pragma unroll
            for (int k = 0; k < 4; ++k) { const int e = tid + 512 * k, row = e >> 4, cu = e & 15;
                *(u32x4*)(U + (size_t)(tok0 + row) * D + g * 128 + cu * 8) = *(const LAS u32x4*)(ut + row * 256 + ((cu ^ (row & 15)) << 4)); } };
        GIn ga, gb;
        gload(0, ga);
        for (int g = 0; g < 8; g += 2) { gcomp(g, ga, gb); gcomp(g + 1, gb, ga); }
        __syncthreads();
    }
    bf16* OF = (bf16*)(ws + WS_OF); const bf16* OB = (const bf16*)(ws + WS_OB); const bf16* R = (const bf16*)(ws + WS_R);
    const int gw = vcu * 8 + w, NGW = G * 8;
    for (int row0 = gw; row0 < ML; row0 += 2 * NGW) {
        u32x4 ra[2][2], rb[2][2], rr[2][2];
#pragma unroll
        for (int q = 0; q < 2; ++q) { const int row = row0 + q * NGW < ML ? row0 + q * NGW : row0; const size_t o = (size_t)row * VW + 16 * lane;
#pragma unroll
            for (int hv = 0; hv < 2; ++hv) { ra[q][hv] = *(const u32x4*)(OF + o + 8 * hv); rb[q][hv] = *(const u32x4*)(OB + o + 8 * hv); rr[q][hv] = *(const u32x4*)(R + o + 8 * hv); } }
#pragma unroll
        for (int q = 0; q < 2; ++q) { const int row = row0 + q * NGW; if (row < ML) { const size_t o = (size_t)row * VW + 16 * lane; float v[16], r[16]; float ss = 0.f;
#pragma unroll
            for (int hv = 0; hv < 2; ++hv) { const u32x4 a = ra[q][hv], b = rb[q][hv], rq = rr[q][hv];
                const unsigned aw[4] = {a.x, a.y, a.z, a.w}, bw[4] = {b.x, b.y, b.z, b.w}, rw[4] = {rq.x, rq.y, rq.z, rq.w};
#pragma unroll
                for (int e = 0; e < 4; ++e) { v[8 * hv + 2 * e] = lo16(aw[e]) + lo16(bw[e]); v[8 * hv + 2 * e + 1] = hi16(aw[e]) + hi16(bw[e]); r[8 * hv + 2 * e] = lo16(rw[e]); r[8 * hv + 2 * e + 1] = hi16(rw[e]); } }
#pragma unroll
            for (int e = 0; e < 16; ++e) ss += v[e] * v[e];
            ss += __shfl_xor(ss, 1); ss += __shfl_xor(ss, 2); ss += __shfl_xor(ss, 4); ss += __shfl_xor(ss, 8);
            const float rstd = rsqrtf(ss * (1.f / DV) + EPS);
#pragma unroll
            for (int hv = 0; hv < 2; ++hv) { const f32x4 g0 = *(const f32x4*)(gain + 16 * lane + 8 * hv), g1 = *(const f32x4*)(gain + 16 * lane + 8 * hv + 4); float y[8];
#pragma unroll
                for (int e = 0; e < 4; ++e) { y[e] = v[8 * hv + e] * rstd * g0[e] * r[8 * hv + e]; y[4 + e] = v[8 * hv + 4 + e] * rstd * g1[e] * r[8 * hv + 4 + e]; }
                u32x4 t; t.x = cvt_pk(y[0], y[1]); t.y = cvt_pk(y[2], y[3]); t.z = cvt_pk(y[4], y[5]); t.w = cvt_pk(y[6], y[7]); *(u32x4*)(OF + o + 8 * hv) = t; } } }
    }
}
__device__ __forceinline__ void fin_phase(float* X, const float* g, int G, int vcu) {
    const int w = threadIdx.x >> 6, lane = threadIdx.x & 63, gw = vcu * 8 + w, NGW = G * 8;
    for (int row = gw; row < ML; row += NGW) { float* xr = X + (size_t)row * D; f32x4 v[4]; float ss = 0.f;
#pragma unroll
        for (int j = 0; j < 4; ++j) { v[j] = *(const f32x4*)(xr + 4 * lane + 256 * j); ss += (v[j][0] * v[j][0] + v[j][1] * v[j][1]) + (v[j][2] * v[j][2] + v[j][3] * v[j][3]); }
        const float rstd = rsqrtf(wsum(ss) * (1.f / D) + EPS);
#pragma unroll
        for (int j = 0; j < 4; ++j) *(f32x4*)(xr + 4 * lane + 256 * j) = v[j] * rstd * *(const f32x4*)(g + 4 * lane + 256 * j); }
}
}

constexpr int NWAVES = 8, LDS_BYTES = 163840;
#ifndef PG8_SP2
#define PG8_SP2 true
#endif
#ifndef PG8_ALIGN
#define PG8_ALIGN true
#endif
enum Phase { PH_P0 = 0, PH_P1 = 1, PH_G1A = 2, PH_PRE = 3, PH_SCAN = 4, PH_G1B = 5, PH_MIX = 6, PH_MRG = 7, PH_WOUT = 8, PH_FF1 = 9, PH_FF2 = 10, PH_END = 11 };
constexpr int CW_FINCNT = 32768;
constexpr int CW_BAR = 4096;
constexpr int MISC_OFF = LDS_BYTES - 256;
struct Args { const float* in[24]; float* out; unsigned char* ws; int ph_lo, ph_hi; };
__global__ void __launch_bounds__(NWAVES * 64, 2) mega_fwd(Args a) {
    extern __shared__ __attribute__((aligned(16))) unsigned char lds_raw[];
    LAS unsigned char* lds = (LAS unsigned char*)lds_raw;
    unsigned char* ws = a.ws;
    const int G = gridDim.x, c = blockIdx.x;
    const int vcu = (G % 8 == 0) ? (c % 8) * (G / 8) + c / 8 : c;
    const char* Hc = (const char*)(ws + WS_H);
    volatile LAS unsigned* MISC = (volatile LAS unsigned*)(lds + MISC_OFF);
    if (threadIdx.x < 64) MISC[threadIdx.x] = 0u;
    __syncthreads();
    XcdBarrier bar; bar.bar = (unsigned*)(ws + WS_CTL) + CW_BAR; bar.x = 0; bar.st = nullptr;
    const bool multi = a.ph_hi - a.ph_lo > 1;
    if (multi) bar = xcd_barrier_post((unsigned*)(ws + WS_CTL) + CW_BAR, MISC + 8);
#define IN(k) (a.ph_lo <= (k) && (k) < a.ph_hi)
#define SEAM(k) do { if (IN(k) && IN((k) + 1)) xcd_barrier(bar); } while (0)
    if (IN(PH_P0)) { thin::P0Args pa{a.in[1], a.in[3], a.in[4], a.in[5], a.in[7], a.in[17], a.in[18], a.in[19], a.in[21], a.in[22], a.in[10]}; thin::p0_phase(lds, ws, pa, G, vcu); }
    SEAM(PH_P0);
    if (IN(PH_P1)) thin::p1_phase(lds, ws, a.in[0], a.in[2], a.in[6], a.in[20], a.in[21], G, vcu);
    SEAM(PH_P1);
    if (IN(PH_G1A)) {
        pg8::Order1A S{Hc, (const char*)(ws + WS_WT1A), (const char*)(ws + WS_WTVV), (char*)(ws + WS_Q), (char*)(ws + WS_K), (char*)(ws + WS_AF), (char*)(ws + WS_VVT), G, c};
        pg8::EpiAct E;
        pg8::gemm_phase<pg8::EpiAct, pg8::Order1A, PG8_ALIGN, PG8_SP2>(lds, 1024, S, E);
    }
    SEAM(PH_G1A);
    if (IN(PH_PRE)) { gla::prepass_phase(lds, ws, a.in[12], a.in[13], a.in[14], a.in[15], G, c); __syncthreads(); }
    SEAM(PH_PRE);
    if (IN(PH_SCAN)) { gla::scan_phase(lds, ws, G, c); __syncthreads(); }
    SEAM(PH_SCAN);
    if (IN(PH_G1B)) {
        pg8::Order1B S{Hc, (const char*)(ws + WS_WT1B), (const char*)(ws + WS_WTVA), (char*)(ws + WS_U), (char*)(ws + WS_R), (char*)a.out, (char*)a.out + (size_t)ML * D, (char*)(ws + WS_GVT), G, c};
        pg8::EpiAct E;
        pg8::gemm_phase<pg8::EpiAct, pg8::Order1B, PG8_ALIGN, PG8_SP2>(lds, 1024, S, E);
    }
    SEAM(PH_G1B);
    if (IN(PH_MIX)) thin::mix_phase(lds, ws, a.in[8], a.in[9], a.in[11], a.in[16], G, vcu);
    SEAM(PH_MIX);
    if (IN(PH_MRG)) {
        pg8::OrderMrg S{(const char*)(ws + WS_U), (const char*)(ws + WS_WTA), (const char*)(ws + WS_OF), (const char*)(ws + WS_WTB), G, c};
        pg8::EpiMrg E{(const unsigned char*)a.out, (const unsigned char*)a.out + (size_t)ML * D, (bf16*)(ws + WS_Y)};
        pg8::gemm_phase<pg8::EpiMrg, pg8::OrderMrg, PG8_ALIGN, PG8_SP2>(lds, 1024, S, E);
    }
    SEAM(PH_MRG);
    if (IN(PH_WOUT)) {
        pg8::OrderGrid S{(const char*)(ws + WS_Y), (const char*)(ws + WS_WTO), 128, 4, 1024, G, c};
        pg8::EpiRes2 E{a.in[0], (const float*)(ws + WS_MOD), (const float*)(ws + WS_GV2), (bf16*)(ws + WS_X1), (bf16*)(ws + WS_A2), (unsigned long long*)(ws + WS_ROWSS)};
        pg8::gemm_phase<pg8::EpiRes2, pg8::OrderGrid, PG8_ALIGN, PG8_SP2>(lds, 1024, S, E);
    }
    SEAM(PH_WOUT);
    if (IN(PH_FF1)) {
        pg8::OrderGrid S{(const char*)(ws + WS_A2), (const char*)(ws + WS_WTF1), 128, 22, 1024, G, c};
        pg8::EpiSwi2 E{(bf16*)(ws + WS_HB), (const unsigned long long*)(ws + WS_ROWSS), (const float*)(ws + WS_CV)};
        pg8::gemm_phase<pg8::EpiSwi2, pg8::OrderGrid, PG8_ALIGN, PG8_SP2>(lds, 1024, S, E);
    }
    SEAM(PH_FF1);
    if (IN(PH_FF2)) {
        pg8::OrderGrid S{(const char*)(ws + WS_HB), (const char*)(ws + WS_WTF2), 128, 4, DFF, G, c};
        pg8::EpiFin E{(const bf16*)(ws + WS_A2), (const float*)(ws + WS_GV2), (const float*)(ws + WS_MOD), a.in[23], a.out, (unsigned long long*)(ws + WS_ROWSS2), (unsigned*)(ws + WS_CTL) + CW_FINCNT};
        pg8::gemm_phase<pg8::EpiFin, pg8::OrderGrid, PG8_ALIGN, PG8_SP2>(lds, DFF, S, E);
    }
#undef IN
#undef SEAM
}
static int g_grid = 0;
static void run_mega(hipStream_t stream, void* const* d_in, void* d_out, void* d_ws, int lo, int hi) {
    Args a{}; for (int i = 0; i < 24; ++i) a.in[i] = (const float*)d_in[i];
    a.out = (float*)d_out; a.ws = (unsigned char*)d_ws; a.ph_lo = lo; a.ph_hi = hi;
    hipLaunchKernelGGL(mega_fwd, dim3(g_grid), dim3(NWAVES * 64), LDS_BYTES, stream, a);
}

template <class Epi, bool DUAL = false>
static void run_gemm(hipStream_t s, const bf16* A, const bf16* Bt, int Mrows, int N, int K, const Epi& e) {
    hipLaunchKernelGGL((nv_gemm<Epi, DUAL>), dim3((N + 63) / 64, Mrows / 64), dim3(256), 0, s, A, Bt, Mrows, N, K, 0, e);
}
static void run_tr(hipStream_t s, const float* W, int K, int ldw, int col0, int ncols, bf16* WT) {
    hipLaunchKernelGGL(nv_transpose, dim3(ncols / 32, K / 32), dim3(256), 0, s, W, K, ldw, col0, ncols, WT);
}

extern "C" void kernel_launch(void* const* d_in, const int* in_sizes, int n_in, void* d_out, int out_size, void* d_ws, size_t ws_size, hipStream_t stream) {
    if (n_in != 24 || out_size != ML * D || ws_size < WS_END) { fprintf(stderr, "kernel_launch: unexpected sizes n_in %d out %d ws %zu\n", n_in, out_size, ws_size); return; }
    const float* x = (const float*)d_in[0]; const float* c = (const float*)d_in[1]; const float* ctx = (const float*)d_in[2]; const float* cctx = (const float*)d_in[3];
    const float* w_ada = (const float*)d_in[4]; const float* b_ada = (const float*)d_in[5]; const float* norm1_g = (const float*)d_in[6]; const float* w_in = (const float*)d_in[7];
    const float* ln_v_g = (const float*)d_in[8]; const float* ln_v_b = (const float*)d_in[9]; const float* w_sp = (const float*)d_in[10]; const float* b_sp = (const float*)d_in[11];
    const float* w_af = (const float*)d_in[12]; const float* b_af = (const float*)d_in[13]; const float* w_ab = (const float*)d_in[14]; const float* b_ab = (const float*)d_in[15];
    const float* gla_g = (const float*)d_in[16]; const float* w_ba = (const float*)d_in[17]; const float* w_bb = (const float*)d_in[18]; const float* w_out = (const float*)d_in[19];
    const float* norm2_g = (const float*)d_in[20]; const float* w_f1 = (const float*)d_in[21]; const float* w_f2 = (const float*)d_in[22]; const float* fin_g = (const float*)d_in[23];
    unsigned char* ws = (unsigned char*)d_ws; float* out = (float*)d_out;
    if (g_grid == 0) {
        int dev = 0, cus = 0, per_cu = 0;
        hipGetDevice(&dev); hipDeviceGetAttribute(&cus, hipDeviceAttributeMultiprocessorCount, dev);
        hipFuncSetAttribute((const void*)mega_fwd, hipFuncAttributeMaxDynamicSharedMemorySize, LDS_BYTES);
        hipOccupancyMaxActiveBlocksPerMultiprocessor(&per_cu, (const void*)mega_fwd, NWAVES * 64, LDS_BYTES);
        (void)hipGetLastError();
        if (per_cu < 1) fprintf(stderr, "kernel_launch: occupancy query says %d blocks/CU\n", per_cu);
        g_grid = cus;
    }
    bf16 *WT1A = (bf16*)(ws + WS_WT1A), *WTVV = (bf16*)(ws + WS_WTVV), *WT1B = (bf16*)(ws + WS_WT1B), *WTVA = (bf16*)(ws + WS_WTVA), *WTA = (bf16*)(ws + WS_WTA), *WTB = (bf16*)(ws + WS_WTB),
         *WTO = (bf16*)(ws + WS_WTO), *WTF1 = (bf16*)(ws + WS_WTF1), *WTF2 = (bf16*)(ws + WS_WTF2);
    float* MOD = (float*)(ws + WS_MOD); float* LNST = (float*)(ws + WS_LNST);
    bf16 *H = (bf16*)(ws + WS_H), *Q = (bf16*)(ws + WS_Q), *Kb = (bf16*)(ws + WS_K), *VVT = (bf16*)(ws + WS_VVT), *OF = (bf16*)(ws + WS_OF), *OB = (bf16*)(ws + WS_OB), *U = (bf16*)(ws + WS_U),
         *GVT = (bf16*)(ws + WS_GVT), *R = (bf16*)(ws + WS_R), *Y = (bf16*)(ws + WS_Y), *A2 = (bf16*)(ws + WS_A2), *HB = (bf16*)(ws + WS_HB);
    float *AF = (float*)(ws + WS_AF), *Y1 = (float*)(ws + WS_Y1), *X1 = (float*)(ws + WS_X1);
    bf16 *GA = (bf16*)d_out, *GB = (bf16*)d_out + (size_t)ML * D;
    hipMemsetAsync(ws + WS_CTL, 0, 1 * MiB, stream);
#ifndef MK_ONE_LAUNCH
#define MK_ONE_LAUNCH 1
#endif
#ifndef MK_REP
#define MK_REP 0
#endif
    if (MK_ONE_LAUNCH) run_mega(stream, d_in, d_out, d_ws, 0, PH_END);
    else for (int p = 0; p < PH_END; ++p) { run_mega(stream, d_in, d_out, d_ws, p, p + 1); if ((MK_REP >> p) & 1) run_mega(stream, d_in, d_out, d_ws, p, p + 1); }
}
```

```cpp
#include <hip/hip_runtime.h>
#include <stdint.h>
#include <cstdio>

typedef unsigned short bf16;
__device__ __forceinline__ float bf2f(bf16 v) { return __uint_as_float(((unsigned)v) << 16); }
__device__ __forceinline__ bf16 f2bf(float f) { unsigned u = __float_as_uint(f); u += 0x7fffu + ((u >> 16) & 1u); return (bf16)(u >> 16); }

constexpr int NB = 8, T = 4096, D = 1024, TC = 256;
constexpr int ML = NB * T;
constexpr int MC = NB * TC;
constexpr int M = ML + MC;
constexpr int NH = 4, DK = 128, DV = 256, QKW = 512, VW = 1024, RANK = 16;
constexpr int DFF = 2816, NIN = 7200;
constexpr float EPS = 1e-6f;
constexpr int C_U = 0, C_VA = 1024, C_Q = 2048, C_K = 2560, C_VV = 3072, C_R = 4096, C_AF = 5120, C_GA = 5152, C_GB = 6176;

constexpr size_t MiB = 1u << 20;
constexpr size_t WS_CTL = 0;
constexpr size_t WS_ROWSS = 256 * 1024, WS_ROWSS2 = 512 * 1024;
constexpr size_t WS_MOD = 1 * MiB;
constexpr size_t WS_CV = WS_MOD + 256 * 1024;
constexpr size_t WS_LNST = 2 * MiB;
constexpr size_t WS_GV2 = WS_MOD + 512 * 1024;
constexpr size_t WS_WSPF = 3 * MiB;
constexpr size_t WS_WT1A = 4 * MiB;
constexpr size_t WS_WTVV = WS_WT1A + 1280 * 1024 * 2;
constexpr size_t WS_WT1B = WS_WTVV + 2 * MiB;
constexpr size_t WS_WTVA = WS_WT1B + 8 * MiB;
constexpr size_t WS_WTA = WS_WTVA + 2 * MiB, WS_WTB = WS_WTA + 2 * MiB, WS_WTO = WS_WTB + 2 * MiB;
constexpr size_t WS_WTF1 = WS_WTO + 2 * MiB;
constexpr size_t WS_WTF2 = WS_WTF1 + 11 * MiB;
static_assert(WS_WTF2 + (size_t)1024 * 2816 * 2 <= 48 * MiB, "weights region");
constexpr size_t WS_H = 48 * MiB;
constexpr size_t WS_Q = 116 * MiB;
constexpr size_t WS_K = 148 * MiB;
constexpr size_t WS_AF = 182 * MiB;
constexpr size_t WS_VVT = 188 * MiB;
constexpr size_t WS_PKG = 256 * MiB;
constexpr size_t WS_OF = 423 * MiB;
constexpr size_t WS_OB = 116 * MiB;
constexpr size_t WS_U = 188 * MiB;
constexpr size_t WS_GVT = 256 * MiB;
constexpr size_t WS_R = 320 * MiB;
constexpr size_t WS_Y1 = 256 * MiB;
constexpr size_t WS_Y = 48 * MiB;
constexpr size_t WS_X1 = 384 * MiB;
constexpr size_t WS_A2 = 116 * MiB;
constexpr size_t WS_HB = 180 * MiB;
constexpr size_t WS_END = 512 * MiB;

__global__ void nv_transpose(const float* __restrict__ W, int K, int ldw, int col0, int ncols, bf16* __restrict__ WT) {
    __shared__ float tile[32][33];
    const int k0 = blockIdx.y * 32, n0 = blockIdx.x * 32, tx = threadIdx.x & 31, ty = threadIdx.x >> 5;
    for (int i = ty; i < 32; i += 8) tile[i][tx] = W[(size_t)(k0 + i) * ldw + col0 + n0 + tx];
    __syncthreads();
    for (int i = ty; i < 32; i += 8) WT[(size_t)(n0 + i) * K + k0 + tx] = f2bf(tile[tx][i]);
}
__global__ void nv_zero_bf16(bf16* p, size_t n) { for (size_t i = (size_t)blockIdx.x * blockDim.x + threadIdx.x; i < n; i += (size_t)gridDim.x * blockDim.x) p[i] = 0; }

__global__ void nv_ada(const float* __restrict__ c, const float* __restrict__ cctx, const float* __restrict__ w_ada, const float* __restrict__ b_ada, float* __restrict__ MOD) {
    __shared__ float s[9][1024];
    for (int i = threadIdx.x; i < 9 * 1024; i += blockDim.x) { const int r = i >> 10, k = i & 1023; const float v = r < 8 ? c[r * 1024 + k] : cctx[k]; s[r][k] = v / (1.f + expf(-v)); }
    __syncthreads();
    const int n = blockIdx.x * blockDim.x + threadIdx.x;
    float acc[9];
    for (int r = 0; r < 9; ++r) acc[r] = 0.f;
    for (int k = 0; k < 1024; ++k) { const float w = w_ada[(size_t)k * 6144 + n];
#pragma unroll
        for (int r = 0; r < 9; ++r) acc[r] += s[r][k] * w; }
    for (int r = 0; r < 9; ++r) MOD[r * 6144 + n] = acc[r] + b_ada[n];
}

__device__ __forceinline__ float wave_sum(float v) {
#pragma unroll
    for (int o = 1; o < 64; o <<= 1) v += __shfl_xor(v, o);
    return v;
}
__global__ void nv_modnorm(const float* __restrict__ xl, const float* __restrict__ xc, const float* __restrict__ g, const float* __restrict__ MOD, int shoff, int scoff, bf16* __restrict__ out, int nrows, int pad_) {
    const int row = blockIdx.x * (blockDim.x >> 6) + (threadIdx.x >> 6), lane = threadIdx.x & 63;
    if (row >= nrows) return;
    const float* xr = row < ML ? xl + (size_t)row * D : xc + (size_t)(row - ML) * D;
    const int mr = row < ML ? row / T : 8;
    float v[16]; float ss = 0.f;
#pragma unroll
    for (int j = 0; j < 16; ++j) { v[j] = xr[lane + 64 * j]; ss += v[j] * v[j]; }
    const float rstd = rsqrtf(wave_sum(ss) * (1.f / D) + EPS);
#pragma unroll
    for (int j = 0; j < 16; ++j) { const int cidx = lane + 64 * j; const float y = v[j] * rstd * g[cidx];
        out[(size_t)row * D + cidx] = f2bf(y * (1.f + MOD[mr * 6144 + scoff + cidx]) + MOD[mr * 6144 + shoff + cidx]); }
}

template <class Epi, bool DUAL>
__global__ void __launch_bounds__(256) nv_gemm(const bf16* __restrict__ A, const bf16* __restrict__ Bt, int Mrows, int N, int K, int pad_, Epi epi) {
    __shared__ float As[32][65], Bs[32][65], Bs2[DUAL ? 32 : 1][65];
    const int tid = threadIdx.x, tx = tid & 15, ty = tid >> 4;
    const int m0 = blockIdx.y * 64, n0 = blockIdx.x * 64;
    float acc[4][4], acc2[4][4];
#pragma unroll
    for (int i = 0; i < 4; ++i)
#pragma unroll
        for (int j = 0; j < 4; ++j) { acc[i][j] = 0.f; acc2[i][j] = 0.f; }
    const int lr = tid >> 2, lk = (tid & 3) * 8;
    const int am = m0 + lr, bn = n0 + lr < N ? n0 + lr : N - 1;
    const bf16* ap = A + (size_t)am * K + lk;
    const bf16* bp = Bt + (size_t)epi.brow(bn) * K + lk;
    const bf16* bp2 = DUAL ? Bt + (size_t)epi.brow2(bn) * K + lk : bp;
    for (int k0 = 0; k0 < K; k0 += 32) {
        const uint4 av = *(const uint4*)(ap + k0), bv = *(const uint4*)(bp + k0);
        const unsigned aw[4] = {av.x, av.y, av.z, av.w}, bw[4] = {bv.x, bv.y, bv.z, bv.w};
#pragma unroll
        for (int j = 0; j < 4; ++j) { As[lk + 2 * j][lr] = __uint_as_float(aw[j] << 16); As[lk + 2 * j + 1][lr] = __uint_as_float(aw[j] & 0xffff0000u);
                                      Bs[lk + 2 * j][lr] = __uint_as_float(bw[j] << 16); Bs[lk + 2 * j + 1][lr] = __uint_as_float(bw[j] & 0xffff0000u); }
        if (DUAL) { const uint4 cv = *(const uint4*)(bp2 + k0); const unsigned cw[4] = {cv.x, cv.y, cv.z, cv.w};
#pragma unroll
            for (int j = 0; j < 4; ++j) { Bs2[lk + 2 * j][lr] = __uint_as_float(cw[j] << 16); Bs2[lk + 2 * j + 1][lr] = __uint_as_float(cw[j] & 0xffff0000u); } }
        __syncthreads();
#pragma unroll 8
        for (int k = 0; k < 32; ++k) {
            float a[4], b[4], b2[4];
#pragma unroll
            for (int i = 0; i < 4; ++i) { a[i] = As[k][ty * 4 + i]; b[i] = Bs[k][tx * 4 + i]; b2[i] = DUAL ? Bs2[k][tx * 4 + i] : 0.f; }
#pragma unroll
            for (int i = 0; i < 4; ++i)
#pragma unroll
                for (int j = 0; j < 4; ++j) { acc[i][j] += a[i] * b[j]; if (DUAL) acc2[i][j] += a[i] * b2[j]; }
        }
        __syncthreads();
    }
#pragma unroll
    for (int i = 0; i < 4; ++i)
#pragma unroll
        for (int j = 0; j < 4; ++j) { const int m = m0 + ty * 4 + i, n = n0 + tx * 4 + j; if (m < Mrows && n < N) epi(m, n, acc[i][j], acc2[i][j]); }
}
__device__ __forceinline__ float gelu_erf(float v) { return 0.5f * v * (1.f + erff(v * 0.70710678118654752f)); }
__device__ __forceinline__ float sigmoidf_(float v) { return 1.f / (1.f + expf(-v)); }
struct EpBase { __device__ int brow(int n) const { return n; } __device__ int brow2(int n) const { return n; } };
struct EpQ : EpBase { bf16* O; int ld; float sc; __device__ void operator()(int m, int n, float a, float) const { O[(size_t)m * ld + n] = f2bf(a * sc); } };
struct EpF32 : EpBase { float* O; int ld; int pad; __device__ void operator()(int m, int n, float a, float) const { O[(size_t)m * ld + n] = a; } };
struct EpT : EpBase { bf16* O; int ld; int act; __device__ void operator()(int m, int n, float a, float) const { O[(size_t)n * ld + m] = f2bf(act ? gelu_erf(a) : a); } };
struct EpAct : EpBase { bf16* O; int ld; int act; __device__ void operator()(int m, int n, float a, float) const { float v = act == 1 ? gelu_erf(a) : act == 2 ? a * sigmoidf_(a) : sigmoidf_(a); O[(size_t)m * ld + n] = f2bf(v); } };
struct EpY1 : EpBase { const bf16* G; float* Y1; __device__ void operator()(int m, int n, float a, float) const { Y1[(size_t)m * D + n] = bf2f(G[(size_t)m * D + n]) * a; } };
struct EpY : EpBase { const bf16* G; const float* Y1; bf16* Y; __device__ void operator()(int m, int n, float a, float) const { Y[(size_t)m * D + n] = f2bf(Y1[(size_t)m * D + n] + bf2f(G[(size_t)m * D + n]) * a); } };
struct EpRes : EpBase { const float* X; const float* MOD; float* O; int goff; int pad; __device__ void operator()(int m, int n, float a, float) const { O[(size_t)m * D + n] = X[(size_t)m * D + n] + MOD[(m / T) * 6144 + goff + n] * a; } };
struct EpSwi { bf16* O; __device__ int brow(int n) const { return 256 * (n >> 7) + (n & 127); } __device__ int brow2(int n) const { return 256 * (n >> 7) + 128 + (n & 127); }
    __device__ void operator()(int m, int n, float a, float g) const { O[(size_t)m * DFF + n] = f2bf(a * (g * sigmoidf_(g))); } };

__global__ void __launch_bounds__(256) nv_gla(const bf16* __restrict__ Q, const bf16* __restrict__ Kb, const float* __restrict__ AF, const bf16* __restrict__ VVT,
                                              const float* __restrict__ w_af, const float* __restrict__ b_af, const float* __restrict__ w_ab, const float* __restrict__ b_ab,
                                              bf16* __restrict__ OF, bf16* __restrict__ OB) {
    const int dir = blockIdx.x & 1, h = (blockIdx.x >> 1) & 3, b = blockIdx.x >> 3, tid = threadIdx.x;
    __shared__ float sa[128], sk[128], sq[128], wl[16][128], bl[128];
    const float* wsrc = dir ? w_ab : w_af; const float* bsrc = dir ? b_ab : b_af;
    for (int i = tid; i < 16 * 128; i += 256) wl[i >> 7][i & 127] = wsrc[(i >> 7) * QKW + h * DK + (i & 127)];
    if (tid < 128) bl[tid] = bsrc[h * DK + tid];
    float S[128];
#pragma unroll
    for (int i = 0; i < 128; ++i) S[i] = 0.f;
    bf16* O = dir ? OB : OF;
    const bf16* vrow = VVT + (size_t)(h * DV + tid) * M;
    __syncthreads();
    for (int step = 0; step < TC + T; ++step) {
        const bool isctx = step < TC;
        int row;
        if (isctx) row = ML + b * TC + (dir ? TC - 1 - step : step);
        else { const int t = step - TC; row = b * T + (dir ? T - 1 - t : t); }
        if (tid < 128) {
            float z = bl[tid];
#pragma unroll
            for (int r = 0; r < 16; ++r) z += AF[(size_t)row * 32 + dir * 16 + r] * wl[r][tid];
            const float ls = fminf(z, 0.f) - log1pf(expf(-fabsf(z)));
            sa[tid] = expf(ls * (1.f / 16.f));
            sk[tid] = bf2f(Kb[(size_t)row * QKW + h * DK + tid]);
            sq[tid] = isctx ? 0.f : bf2f(Q[(size_t)row * QKW + h * DK + tid]);
        }
        const float v = bf2f(vrow[row]);
        __syncthreads();
        float o = 0.f;
#pragma unroll
        for (int i = 0; i < 128; ++i) { S[i] = sa[i] * S[i] + sk[i] * v; o += sq[i] * S[i]; }
        if (!isctx) O[(size_t)row * VW + h * DV + tid] = f2bf(o);
        __syncthreads();
    }
}

__global__ void nv_lnstat(const bf16* __restrict__ GVT, float* __restrict__ ST) {
    const int t = blockIdx.x * blockDim.x + threadIdx.x;
    float s = 0.f, s2 = 0.f;
    for (int c = 0; c < 1024; ++c) { const float v = bf2f(GVT[(size_t)c * ML + t]); s += v; }
    const float mean = s * (1.f / 1024.f);
    for (int c = 0; c < 1024; ++c) { const float d = bf2f(GVT[(size_t)c * ML + t]) - mean; s2 += d * d; }
    ST[2 * t] = mean; ST[2 * t + 1] = rsqrtf(s2 * (1.f / 1024.f) + EPS);
}
__global__ void __launch_bounds__(256) nv_chunkmlp(bf16* __restrict__ U, const bf16* __restrict__ GVT, const float* __restrict__ ST, const float* __restrict__ lng, const float* __restrict__ lnb,
                                                   const float* __restrict__ wsp, const float* __restrict__ bsp) {
    extern __shared__ float vt[];
    const int ch = blockIdx.x, g = blockIdx.y, tok0 = ch * 128, tid = threadIdx.x;
    for (int i = tid; i < 128 * 128; i += 256) { const int c = i >> 7, q = i & 127; const int cc = g * 128 + c;
        const float v = bf2f(GVT[(size_t)cc * ML + tok0 + q]);
        vt[q * 128 + c] = (v - ST[2 * (tok0 + q)]) * ST[2 * (tok0 + q) + 1] * lng[cc] + lnb[cc]; }
    __syncthreads();
    const int c = tid & 127;
    for (int p = tid >> 7; p < 128; p += 2) {
        float acc = 0.f;
        const float* wr = wsp + ((size_t)g * 128 + p) * 128;
        for (int q = 0; q < 128; ++q) acc += wr[q] * vt[q * 128 + c];
        acc += bsp[g * 128 + p];
        const size_t o = (size_t)(tok0 + p) * D + g * 128 + c;
        U[o] = f2bf(bf2f(U[o]) * acc);
    }
}
__global__ void nv_glaout(bf16* __restrict__ OF, const bf16* __restrict__ OB, const bf16* __restrict__ R, const float* __restrict__ gain) {
    const int w = blockIdx.x * (blockDim.x >> 6) + (threadIdx.x >> 6), lane = threadIdx.x & 63;
    const int row = w >> 2, h = w & 3;
    float v[4]; float ss = 0.f;
#pragma unroll
    for (int j = 0; j < 4; ++j) { const size_t o = (size_t)row * VW + h * DV + lane + 64 * j; v[j] = bf2f(OF[o]) + bf2f(OB[o]); ss += v[j] * v[j]; }
    const float rstd = rsqrtf(wave_sum(ss) * (1.f / DV) + EPS);
#pragma unroll
    for (int j = 0; j < 4; ++j) { const int cidx = h * DV + lane + 64 * j; const size_t o = (size_t)row * VW + cidx; OF[o] = f2bf(v[j] * rstd * gain[cidx] * bf2f(R[o])); }
}
__global__ void nv_finalnorm(float* __restrict__ X, const float* __restrict__ g) {
    const int row = blockIdx.x * (blockDim.x >> 6) + (threadIdx.x >> 6), lane = threadIdx.x & 63;
    float v[16]; float ss = 0.f;
#pragma unroll
    for (int j = 0; j < 16; ++j) { v[j] = X[(size_t)row * D + lane + 64 * j]; ss += v[j] * v[j]; }
    const float rstd = rsqrtf(wave_sum(ss) * (1.f / D) + EPS);
#pragma unroll
    for (int j = 0; j < 16; ++j) X[(size_t)row * D + lane + 64 * j] = v[j] * rstd * g[lane + 64 * j];
}


#ifndef MK_STAGGER
#define MK_STAGGER 0
#endif
namespace pg8 {
#define PG8_LAS __attribute__((address_space(3)))
typedef unsigned short bf16_t;
typedef short bf16x8 __attribute__((ext_vector_type(8)));
typedef float f32x4 __attribute__((ext_vector_type(4)));
typedef float f32x2 __attribute__((ext_vector_type(2)));
typedef unsigned u32x4 __attribute__((ext_vector_type(4)));
typedef unsigned u32x2 __attribute__((ext_vector_type(2)));
constexpr int BM = 256, BK = 64, HALF = 128, HTB = HALF * BK * 2, STAGE_BYTES = 8 * HTB;
__host__ __device__ __forceinline__ int lds_byte(int r, int c) { const int st = (r >> 4) * 2 + (c >> 5), rr = r & 15, cc = c & 31, ob = rr * 64 + cc * 2; return st * 1024 + (ob ^ (((ob >> 9) & 1) << 5)); }
__host__ __device__ __forceinline__ void stage_rc(int b, int& R, int& C) { const int st = b / 1024, sb = b % 1024, swz = sb ^ (((sb >> 9) & 1) << 5); R = (st >> 1) * 16 + swz / 64; C = (st & 1) * 32 + (swz % 64) / 2; }
__host__ __device__ __forceinline__ int perm32(int rho) { const int n = rho >> 4, i = rho & 15; return 8 * (i >> 2) + 4 * n + (i & 3); }
struct Unit { const char* pA; const char* pB; char* pO; int ldc, act, aux, pm, pn; };
__device__ __forceinline__ unsigned cvt_pk_bf16(float lo, float hi) { typedef __bf16 v2bf __attribute__((ext_vector_type(2))); typedef float v2f __attribute__((ext_vector_type(2)));
    const v2f x = {lo, hi}; const v2bf y = __builtin_convertvector(x, v2bf); return __builtin_bit_cast(unsigned, y); }
__device__ __forceinline__ f32x2 gelu_pk(f32x2 v) {
    const f32x2 av = __builtin_elementwise_abs(v), d = av * 0.2316418882f + 1.0f;
    f32x2 t; t.x = __builtin_amdgcn_rcpf(d.x); t.y = __builtin_amdgcn_rcpf(d.y);
    f32x2 q = t * 0.5307027145f + (-0.7265760135f); q = q * t + 0.7107068705f; q = q * t + (-0.142248368f); q = q * t + 0.127414796f; q = q * t;
    const f32x2 s = (v * v) * (-0.72134752044f);
    f32x2 e; e.x = __builtin_amdgcn_exp2f(s.x); e.y = __builtin_amdgcn_exp2f(s.y);
    const f32x2 m = v * (q * e), r = v - m;
    f32x2 o; o.x = v.x < 0.f ? m.x : r.x; o.y = v.y < 0.f ? m.y : r.y; return o;
}
__device__ __forceinline__ float ub8(unsigned w, int n) { return (float)((w >> (8 * n)) & 0xffu); }
__device__ __forceinline__ float sigm(float x) { return __builtin_amdgcn_rcpf(1.0f + __builtin_amdgcn_exp2f(x * -1.44269504089f)); }
__device__ __forceinline__ int xcd_remap(int L, int nwg) { const int q = nwg / 8, r = nwg % 8, xcd = L % 8, off = L / 8; return (xcd < r ? xcd * (q + 1) : r * (q + 1) + (xcd - r) * q) + off; }

template <class Epi, class Sched, bool ALIGN_EPI, bool SP2>
__device__ __forceinline__ void gemm_phase(PG8_LAS unsigned char* lds, const int K, const Sched& S, const Epi& E) {
    const int tid = threadIdx.x, wid = __builtin_amdgcn_readfirstlane(tid >> 6), lane = tid & 63, wr = wid >> 2, wc = wid & 3, fr = lane & 15, fq = lane >> 4;
    const int nt = K / BK;
    unsigned voffA[2], voffB[2];
#pragma unroll
    for (int i = 0; i < 2; ++i) { int R, C; stage_rc(tid * 16 + i * 8192, R, C); const int Rb = (R & ~31) + perm32(R & 31);
        voffA[i] = (unsigned)(R * K + C) * 2u; voffB[i] = (unsigned)(Rb * K + C) * 2u; }
    const size_t kstep = (size_t)(BK * 2);
    const size_t hstep = (size_t)HALF * K * 2;
    const unsigned ldsw = (unsigned)wid * 1024u;
    const int aoff = lds_byte(wr * 64 + fr, fq * 8), boff = lds_byte(wc * 32 + fr, fq * 8);
#define PG8_SA(b, h) (((b) * 2 + (h)) * HTB)
#define PG8_SB(b, h) ((4 + (b) * 2 + (h)) * HTB)
#define PG8_STAGE(bufoff, gbase, voff) do { _Pragma("unroll") for (int _i = 0; _i < 2; ++_i) \
        __builtin_amdgcn_global_load_lds((const unsigned*)((const char*)(gbase) + (voff)[_i]), (PG8_LAS unsigned*)(lds + (bufoff) + ldsw + _i * 8192), 16, 0, 0); } while (0)
#define PG8_LDA(dst, b, h) do { _Pragma("unroll") for (int m = 0; m < 4; ++m) _Pragma("unroll") for (int k = 0; k < 2; ++k) dst[m][k] = *(const PG8_LAS bf16x8*)(lds + PG8_SA(b, h) + aoff + m * 2048 + k * 1024); } while (0)
#define PG8_LDB(dst, b, h) do { _Pragma("unroll") for (int n = 0; n < 2; ++n) _Pragma("unroll") for (int k = 0; k < 2; ++k) dst[n][k] = *(const PG8_LAS bf16x8*)(lds + PG8_SB(b, h) + boff + n * 2048 + k * 1024); } while (0)
#define PG8_MMA(ai, bj, At, Bt) do { __builtin_amdgcn_s_setprio(1); _Pragma("unroll") for (int m = 0; m < 4; ++m) _Pragma("unroll") for (int n = 0; n < 2; ++n) _Pragma("unroll") for (int k = 0; k < 2; ++k) \
        acc[ai][bj][m][n] = __builtin_amdgcn_mfma_f32_16x16x32_bf16(Bt[n][k], At[m][k], acc[ai][bj][m][n], 0, 0, 0); __builtin_amdgcn_s_setprio(0); } while (0)
#define PG8_WAIT_V(n) asm volatile("s_waitcnt vmcnt(" #n ")" ::: "memory")
#define PG8_WAIT_L(n) asm volatile("s_waitcnt lgkmcnt(" #n ")" ::: "memory")
#define PG8_BAR __builtin_amdgcn_s_barrier()
#define PG8_SCHED __builtin_amdgcn_sched_barrier(0)
    Unit cur, nxt; int ui = 0;
    if (!S.next(0, cur)) return;
    if (MK_STAGGER > 0) { const unsigned long long t0_ = __builtin_amdgcn_s_memrealtime(); const unsigned long long dl_ = (unsigned long long)((blockIdx.x >> 3) & 3) * MK_STAGGER;
        while (__builtin_amdgcn_s_memrealtime() - t0_ < dl_) __builtin_amdgcn_s_sleep(8); }
    f32x4 acc[2][2][4][2];
#pragma unroll
    for (int a = 0; a < 2; ++a)
#pragma unroll
        for (int b = 0; b < 2; ++b)
#pragma unroll
            for (int m = 0; m < 4; ++m)
#pragma unroll
                for (int n = 0; n < 2; ++n) acc[a][b][m][n] = (f32x4){0.f, 0.f, 0.f, 0.f};
    bf16x8 At[4][2], B0[2][2], B1[2][2];
    const char* cA = cur.pA; const char* cB = cur.pB;
    if constexpr (SP2) {
        PG8_STAGE(PG8_SB(0, 0), cB, voffB); PG8_STAGE(PG8_SB(0, 1), cB + hstep, voffB); PG8_STAGE(PG8_SA(0, 0), cA, voffA); PG8_STAGE(PG8_SA(0, 1), cA + hstep, voffA);
        if (wr == 1) PG8_BAR;
        PG8_WAIT_V(2); PG8_BAR;
        PG8_STAGE(PG8_SB(1, 0), cB + kstep, voffB); PG8_STAGE(PG8_SA(1, 0), cA + kstep, voffA); PG8_STAGE(PG8_SB(1, 1), cB + hstep + kstep, voffB);
        PG8_WAIT_V(6); PG8_BAR;
    } else {
        PG8_STAGE(PG8_SB(0, 0), cB, voffB); PG8_STAGE(PG8_SA(0, 0), cA, voffA); PG8_STAGE(PG8_SB(0, 1), cB + hstep, voffB); PG8_STAGE(PG8_SA(0, 1), cA + hstep, voffA);
        if (wr == 1) PG8_BAR;
        PG8_WAIT_V(4); PG8_BAR;
        PG8_STAGE(PG8_SB(1, 0), cB + kstep, voffB); PG8_STAGE(PG8_SA(1, 0), cA + kstep, voffA); PG8_STAGE(PG8_SB(1, 1), cB + hstep + kstep, voffB);
        PG8_WAIT_V(6); PG8_BAR;
    }
    for (;;) {
        const bool has_next = S.next(ui + 1, nxt);
        const char* nA = has_next ? nxt.pA : cA; const char* nB = has_next ? nxt.pB : cB;
        for (int t = 0; t < nt; t += 2) {
            const bool last = (t == nt - 2);
            const char* a1 = cA + (size_t)(t + 1) * kstep;
            const char* a2 = last ? nA : cA + (size_t)(t + 2) * kstep; const char* b2 = last ? nB : cB + (size_t)(t + 2) * kstep;
            const char* a3 = a2 + kstep; const char* b3 = b2 + kstep;
            if constexpr (SP2) {
            PG8_LDB(B0, 0, 0); PG8_LDB(B1, 0, 1); PG8_SCHED; PG8_LDA(At, 0, 0); PG8_STAGE(PG8_SA(1, 1), a1 + hstep, voffA);
            PG8_WAIT_V(8); PG8_WAIT_L(0); PG8_BAR; PG8_MMA(0, 0, At, B0); PG8_MMA(0, 1, At, B1); PG8_BAR; PG8_SCHED;
            PG8_LDA(At, 0, 1); PG8_STAGE(PG8_SB(0, 0), b2, voffB); PG8_STAGE(PG8_SB(0, 1), b2 + hstep, voffB); PG8_STAGE(PG8_SA(0, 0), a2, voffA);
            PG8_WAIT_V(8); PG8_WAIT_L(0); PG8_BAR; PG8_MMA(1, 0, At, B0); PG8_MMA(1, 1, At, B1); PG8_BAR; PG8_SCHED;
            PG8_LDB(B0, 1, 0); PG8_LDB(B1, 1, 1); PG8_SCHED; PG8_LDA(At, 1, 0); PG8_STAGE(PG8_SA(0, 1), a2 + hstep, voffA);
            PG8_WAIT_V(8); PG8_WAIT_L(0); PG8_BAR; PG8_MMA(0, 0, At, B0); PG8_MMA(0, 1, At, B1); PG8_BAR; PG8_SCHED;
            PG8_LDA(At, 1, 1); PG8_STAGE(PG8_SB(1, 0), b3, voffB); PG8_STAGE(PG8_SB(1, 1), b3 + hstep, voffB); PG8_STAGE(PG8_SA(1, 0), a3, voffA);
            PG8_WAIT_V(8); PG8_WAIT_L(0); PG8_BAR; PG8_MMA(1, 0, At, B0); PG8_MMA(1, 1, At, B1); PG8_BAR; PG8_SCHED;
            } else {
            PG8_LDB(B0, 0, 0); PG8_SCHED; PG8_LDA(At, 0, 0); PG8_STAGE(PG8_SA(1, 1), a1 + hstep, voffA);
            PG8_WAIT_L(8); PG8_BAR; PG8_WAIT_L(0); PG8_MMA(0, 0, At, B0); PG8_BAR; PG8_SCHED;
            PG8_LDB(B1, 0, 1); PG8_STAGE(PG8_SB(0, 0), b2, voffB);
            PG8_BAR; PG8_WAIT_L(0); PG8_MMA(0, 1, At, B1); PG8_BAR;
            PG8_LDA(At, 0, 1); PG8_STAGE(PG8_SA(0, 0), a2, voffA);
            PG8_BAR; PG8_WAIT_L(0); PG8_MMA(1, 0, At, B0); PG8_BAR; PG8_SCHED;
            PG8_STAGE(PG8_SB(0, 1), b2 + hstep, voffB);
            PG8_WAIT_V(6); PG8_BAR; PG8_MMA(1, 1, At, B1); PG8_BAR;
            PG8_LDB(B0, 1, 0); PG8_SCHED; PG8_LDA(At, 1, 0); PG8_STAGE(PG8_SA(0, 1), a2 + hstep, voffA);
            PG8_WAIT_L(8); PG8_BAR; PG8_WAIT_L(0); PG8_MMA(0, 0, At, B0); PG8_BAR; PG8_SCHED;
            PG8_LDB(B1, 1, 1); PG8_STAGE(PG8_SB(1, 0), b3, voffB);
            PG8_BAR; PG8_WAIT_L(0); PG8_MMA(0, 1, At, B1); PG8_BAR;
            PG8_LDA(At, 1, 1); PG8_STAGE(PG8_SA(1, 0), a3, voffA);
            PG8_BAR; PG8_WAIT_L(0); PG8_MMA(1, 0, At, B0); PG8_BAR; PG8_SCHED;
            PG8_STAGE(PG8_SB(1, 1), b3 + hstep, voffB);
            PG8_WAIT_V(6); PG8_BAR; PG8_MMA(1, 1, At, B1); PG8_BAR;
            }
        }
        if constexpr (ALIGN_EPI) { if (wr == 0) PG8_BAR; }
        bool keep = false;
        if constexpr (Epi::CHAIN) { E.chain(acc, cur, wr, wc, fr, fq); keep = Epi::KEEP && (cur.aux == 0); } else E(acc, cur, wr, wc, fr, fq);
        if (!has_next) break;
        if (!keep) {
#pragma unroll
        for (int a = 0; a < 2; ++a)
#pragma unroll
            for (int b = 0; b < 2; ++b)
#pragma unroll
                for (int m = 0; m < 4; ++m)
#pragma unroll
                    for (int n = 0; n < 2; ++n) acc[a][b][m][n] = (f32x4){0.f, 0.f, 0.f, 0.f};
        }
        cur = nxt; cA = nA; cB = nB; ++ui;
        if constexpr (ALIGN_EPI) { if (wr == 1) PG8_BAR; }
    }
    PG8_WAIT_V(0);
    if constexpr (!ALIGN_EPI) { if (wr == 0) PG8_BAR; }
    PG8_BAR;
#undef PG8_SA
#undef PG8_SB
#undef PG8_STAGE
#undef PG8_LDA
#undef PG8_LDB
#undef PG8_MMA
#undef PG8_WAIT_V
#undef PG8_WAIT_L
#undef PG8_BAR
#undef PG8_SCHED
}

enum Act { ACT_NONE = 0, ACT_GELU = 1, ACT_SILU = 2, ACT_SIGM = 3, ACT_QSC = 4, ACT_AF32 = 5, ACT_VT = 6 };
struct EpiAct { static constexpr bool CHAIN = false;
    template <int ACT> __device__ __forceinline__ void run(const f32x4 (&acc)[2][2][4][2], const Unit& u, int r0, int c0) const {
        bf16_t* O = (bf16_t*)u.pO; if (ACT == ACT_VT) c0 = (c0 >> 6) * 65536 + (c0 & 63);
#pragma unroll
        for (int ai = 0; ai < 2; ++ai)
#pragma unroll
            for (int m = 0; m < 4; ++m) { bf16_t* rowp = O + (size_t)(r0 + ai * HALF + m * 16) * u.ldc + c0;
#pragma unroll
                for (int bj = 0; bj < 2; ++bj) { f32x4 v0 = acc[ai][bj][m][0], v1 = acc[ai][bj][m][1];
                    if (ACT == ACT_GELU) { f32x2 a = gelu_pk((f32x2){v0[0], v0[1]}), b = gelu_pk((f32x2){v0[2], v0[3]}), c = gelu_pk((f32x2){v1[0], v1[1]}), d = gelu_pk((f32x2){v1[2], v1[3]});
                        v0 = (f32x4){a.x, a.y, b.x, b.y}; v1 = (f32x4){c.x, c.y, d.x, d.y}; }
                    if (ACT == ACT_SILU) {
#pragma unroll
                        for (int j = 0; j < 4; ++j) { v0[j] = v0[j] * sigm(v0[j]); v1[j] = v1[j] * sigm(v1[j]); } }
                    if (ACT == ACT_SIGM) {
#pragma unroll
                        for (int j = 0; j < 4; ++j) { v0[j] = sigm(v0[j]); v1[j] = sigm(v1[j]); } }
                    if (ACT == ACT_QSC) { v0 = v0 * 0.08838834764831845f; v1 = v1 * 0.08838834764831845f; }
                    u32x4 w; w.x = cvt_pk_bf16(v0[0], v0[1]); w.y = cvt_pk_bf16(v0[2], v0[3]); w.z = cvt_pk_bf16(v1[0], v1[1]); w.w = cvt_pk_bf16(v1[2], v1[3]);
                    *(u32x4*)(rowp + (ACT == ACT_VT ? bj * 2 * 65536 : bj * HALF)) = w; } }
    }
    __device__ __forceinline__ void run_gate8(const f32x4 (&acc)[2][2][4][2], const Unit& u, int r0, int c0, float lo) const {
        unsigned char* O = (unsigned char*)u.pO;
#pragma unroll
        for (int ai = 0; ai < 2; ++ai)
#pragma unroll
            for (int m = 0; m < 4; ++m) { unsigned char* rowp = O + (size_t)(r0 + ai * HALF + m * 16) * u.ldc + c0;
#pragma unroll
                for (int bj = 0; bj < 2; ++bj) { u32x2 w = {0u, 0u};
#pragma unroll
                    for (int j = 0; j < 8; ++j) { const float x = j < 4 ? acc[ai][bj][m][0][j] : acc[ai][bj][m][1][j - 4];
                        const float q = fmaxf(__builtin_amdgcn_rcpf(__builtin_amdgcn_exp2f(x) * (1.0f / 255.0f) + (1.0f / 255.0f)), lo);
                        if (j < 4) w.x = __builtin_amdgcn_cvt_pk_u8_f32(q, j, w.x); else w.y = __builtin_amdgcn_cvt_pk_u8_f32(q, j - 4, w.y); }
                    *(u32x2*)(rowp + bj * HALF) = w; } }
    }
    __device__ __forceinline__ void operator()(const f32x4 (&acc)[2][2][4][2], const Unit& u, int wr, int wc, int fr, int fq) const {
        const int r0 = wr * 64 + fr, c0 = wc * 32 + 8 * fq;
        switch (u.act) {
        case ACT_NONE: run<ACT_NONE>(acc, u, r0, c0); break;
        case ACT_GELU: run<ACT_GELU>(acc, u, r0, c0); break;
        case ACT_SILU: run<ACT_SILU>(acc, u, r0, c0); break;
        case ACT_SIGM: run_gate8(acc, u, r0, c0, u.aux ? 1.0f : 0.0f); break;
        case ACT_QSC:  run<ACT_QSC>(acc, u, r0, c0); break;
        case ACT_VT:   run<ACT_VT>(acc, u, r0, c0); break;
        default:
            if (wc == 0) { float* O = (float*)u.pO;
#pragma unroll
                for (int ai = 0; ai < 2; ++ai)
#pragma unroll
                    for (int m = 0; m < 4; ++m) { float* rowp = O + (size_t)(r0 + ai * HALF + m * 16) * u.ldc + 8 * fq;
                        *(f32x4*)rowp = acc[ai][0][m][0]; *(f32x4*)(rowp + 4) = acc[ai][0][m][1]; } }
            break;
        }
    }
};
struct EpiMrg { static constexpr bool CHAIN = true, KEEP = true; const unsigned char* GA; const unsigned char* GB; bf16_t* Y;
    __device__ __forceinline__ void chain(f32x4 (&acc)[2][2][4][2], const Unit& u, int wr, int wc, int fr, int fq) const {
        const size_t o0 = (size_t)(u.pm * BM + wr * 64 + fr) * 1024 + u.pn * BM + wc * 32 + 8 * fq;
        if (u.aux == 0) {
#pragma unroll
            for (int ai = 0; ai < 2; ++ai)
#pragma unroll
                for (int m = 0; m < 4; ++m)
#pragma unroll
                    for (int bj = 0; bj < 2; ++bj) { const size_t o = o0 + (size_t)(ai * HALF + m * 16) * 1024 + bj * HALF;
                        const u32x2 a = *(const u32x2*)(GA + o), b = *(const u32x2*)(GB + o);
                        const float ra[8] = {ub8(a.x, 0), ub8(a.x, 1), ub8(a.x, 2), ub8(a.x, 3),
                                             ub8(a.y, 0), ub8(a.y, 1), ub8(a.y, 2), ub8(a.y, 3)};
                        const float rb[8] = {ub8(b.x, 0), ub8(b.x, 1), ub8(b.x, 2), ub8(b.x, 3),
                                             ub8(b.y, 0), ub8(b.y, 1), ub8(b.y, 2), ub8(b.y, 3)};
#pragma unroll
                        for (int e = 0; e < 8; ++e) { const float r = ra[e] * __builtin_amdgcn_rcpf(rb[e]); if (e < 4) acc[ai][bj][m][0][e] *= r; else acc[ai][bj][m][1][e - 4] *= r; } }
        } else {
#pragma unroll
            for (int ai = 0; ai < 2; ++ai)
#pragma unroll
                for (int m = 0; m < 4; ++m)
#pragma unroll
                    for (int bj = 0; bj < 2; ++bj) { const size_t o = o0 + (size_t)(ai * HALF + m * 16) * 1024 + bj * HALF;
                        const u32x2 g = *(const u32x2*)(GB + o); constexpr float s8 = 1.0f / 255.0f;
                        f32x4 v0 = acc[ai][bj][m][0], v1 = acc[ai][bj][m][1];
                        v0[0] *= ub8(g.x, 0) * s8; v0[1] *= ub8(g.x, 1) * s8; v0[2] *= ub8(g.x, 2) * s8; v0[3] *= ub8(g.x, 3) * s8;
                        v1[0] *= ub8(g.y, 0) * s8; v1[1] *= ub8(g.y, 1) * s8; v1[2] *= ub8(g.y, 2) * s8; v1[3] *= ub8(g.y, 3) * s8;
                        u32x4 w; w.x = cvt_pk_bf16(v0[0], v0[1]); w.y = cvt_pk_bf16(v0[2], v0[3]); w.z = cvt_pk_bf16(v1[0], v1[1]); w.w = cvt_pk_bf16(v1[2], v1[3]);
                        *(u32x4*)(Y + o) = w; }
        }
    }
};
struct EpiRes { const float* X; static constexpr bool CHAIN = false; const float* MOD; float* O; int goff;
    __device__ __forceinline__ void operator()(const f32x4 (&acc)[2][2][4][2], const Unit& u, int wr, int wc, int fr, int fq) const {
        const int cb = u.pn * BM + wc * 32 + 8 * fq; const size_t o0 = (size_t)(u.pm * BM + wr * 64 + fr) * 1024 + cb;
        const float* gp = MOD + ((u.pm * BM) / T) * 6144 + goff + cb;
        f32x4 g[2][2];
#pragma unroll
        for (int bj = 0; bj < 2; ++bj) { g[bj][0] = *(const f32x4*)(gp + bj * HALF); g[bj][1] = *(const f32x4*)(gp + bj * HALF + 4); }
#pragma unroll
        for (int ai = 0; ai < 2; ++ai)
#pragma unroll
            for (int m = 0; m < 4; ++m)
#pragma unroll
                for (int bj = 0; bj < 2; ++bj) { const size_t o = o0 + (size_t)(ai * HALF + m * 16) * 1024 + bj * HALF;
                    const f32x4 x0 = *(const f32x4*)(X + o), x1 = *(const f32x4*)(X + o + 4);
                    *(f32x4*)(O + o) = x0 + g[bj][0] * acc[ai][bj][m][0]; *(f32x4*)(O + o + 4) = x1 + g[bj][1] * acc[ai][bj][m][1]; }
    }
};
struct EpiFin { static constexpr bool CHAIN = true, KEEP = false; const bf16_t* X1; const float* GV2; const float* MOD; const float* FG; float* O; unsigned long long* ROWSS2; unsigned* CNT;
    __device__ __forceinline__ void chain(f32x4 (&acc)[2][2][4][2], const Unit& u, int wr, int wc, int fr, int fq) const {
        const int cb = u.pn * BM + wc * 32 + 8 * fq, r0 = u.pm * BM + wr * 64 + fr; const size_t o0 = (size_t)r0 * 1024 + cb;
        const float* gp = MOD + ((u.pm * BM) / T) * 6144 + 5120 + cb;
        {   f32x4 g[2][2], iv[2][2]; float ssv[8]; const float* vp = GV2 + ((u.pm * BM) / T) * 1024 + cb;
#pragma unroll
            for (int bj = 0; bj < 2; ++bj) { g[bj][0] = *(const f32x4*)(gp + bj * HALF); g[bj][1] = *(const f32x4*)(gp + bj * HALF + 4);
                const f32x4 v0 = *(const f32x4*)(vp + bj * HALF), v1 = *(const f32x4*)(vp + bj * HALF + 4);
#pragma unroll
                for (int e = 0; e < 4; ++e) { iv[bj][0][e] = 1.0f / v0[e]; iv[bj][1][e] = 1.0f / v1[e]; } }
#pragma unroll
            for (int ai = 0; ai < 2; ++ai)
#pragma unroll
                for (int m = 0; m < 4; ++m) { float ss = 0.f;
#pragma unroll
                    for (int bj = 0; bj < 2; ++bj) { const size_t o = o0 + (size_t)(ai * HALF + m * 16) * 1024 + bj * HALF;
                        const u32x4 xr = *(const u32x4*)(X1 + o);
                        const f32x4 xa = {__uint_as_float(xr.x << 16), __uint_as_float(xr.x & 0xffff0000u), __uint_as_float(xr.y << 16), __uint_as_float(xr.y & 0xffff0000u)}, xb = {__uint_as_float(xr.z << 16), __uint_as_float(xr.z & 0xffff0000u), __uint_as_float(xr.w << 16), __uint_as_float(xr.w & 0xffff0000u)};
                        const f32x4 x0 = xa * iv[bj][0] + g[bj][0] * acc[ai][bj][m][0], x1 = xb * iv[bj][1] + g[bj][1] * acc[ai][bj][m][1];
                        acc[ai][bj][m][0] = x0; acc[ai][bj][m][1] = x1;
                        ss += (x0[0] * x0[0] + x0[1] * x0[1]) + (x0[2] * x0[2] + x0[3] * x0[3]) + (x1[0] * x1[0] + x1[1] * x1[1]) + (x1[2] * x1[2] + x1[3] * x1[3]); }
                    ss += __shfl_xor(ss, 16); ss += __shfl_xor(ss, 32); ssv[ai * 4 + m] = ss;
                    asm volatile("" ::: "memory"); }
#pragma unroll
            for (int h = 0; h < 2; ++h) { const int gs = 2 * fq + h; float v = 0.f;
#pragma unroll
                for (int g2 = 0; g2 < 8; ++g2) v = gs == g2 ? ssv[g2] : v;
                atomicAdd(ROWSS2 + r0 + (gs >> 2) * HALF + (gs & 3) * 16, (unsigned long long)(v * 1073741824.0f) + (1ull << 58)); }
        }
        f32x4 fg[2][2];
#pragma unroll
        for (int bj = 0; bj < 2; ++bj) { fg[bj][0] = *(const f32x4*)(FG + cb + bj * HALF); fg[bj][1] = *(const f32x4*)(FG + cb + bj * HALF + 4); }
        unsigned long long tot[2][4];
        for (unsigned spins = 0;; ++spins) { bool ok = true;
#pragma unroll
            for (int ai = 0; ai < 2; ++ai)
#pragma unroll
                for (int m = 0; m < 4; ++m) tot[ai][m] = __hip_atomic_load(ROWSS2 + r0 + ai * HALF + m * 16, __ATOMIC_RELAXED, __HIP_MEMORY_SCOPE_AGENT);
#pragma unroll
            for (int ai = 0; ai < 2; ++ai)
#pragma unroll
                for (int m = 0; m < 4; ++m) ok = ok && ((tot[ai][m] >> 58) >= 16ull);
            if (__builtin_amdgcn_ballot_w64(!ok) == 0ull || spins > (1u << 20)) break;
            __builtin_amdgcn_s_sleep(1); }
#pragma unroll
        for (int ai = 0; ai < 2; ++ai)
#pragma unroll
            for (int m = 0; m < 4; ++m) tot[ai][m] &= ((1ull << 58) - 1ull);
#pragma unroll
        for (int ai = 0; ai < 2; ++ai)
#pragma unroll
            for (int m = 0; m < 4; ++m) {
                const float rs = __builtin_amdgcn_rsqf((float)tot[ai][m] * (1.0f / (1073741824.0f * 1024.0f)) + EPS);
#pragma unroll
                for (int bj = 0; bj < 2; ++bj) { const size_t o = o0 + (size_t)(ai * HALF + m * 16) * 1024 + bj * HALF;
                    *(f32x4*)(O + o) = acc[ai][bj][m][0] * rs * fg[bj][0]; *(f32x4*)(O + o + 4) = acc[ai][bj][m][1] * rs * fg[bj][1]; } }
    }
};
struct EpiSwi { bf16_t* HBp; static constexpr bool CHAIN = false;
    __device__ __forceinline__ void operator()(const f32x4 (&acc)[2][2][4][2], const Unit& u, int wr, int wc, int fr, int fq) const {
        const size_t o0 = (size_t)(u.pm * BM + wr * 64 + fr) * DFF + u.pn * HALF + wc * 32 + 8 * fq;
#pragma unroll
        for (int ai = 0; ai < 2; ++ai)
#pragma unroll
            for (int m = 0; m < 4; ++m) { const f32x4 a0 = acc[ai][0][m][0], a1 = acc[ai][0][m][1], g0 = acc[ai][1][m][0], g1 = acc[ai][1][m][1]; f32x4 v0, v1;
#pragma unroll
                for (int j = 0; j < 4; ++j) { v0[j] = a0[j] * g0[j] * sigm(g0[j]); v1[j] = a1[j] * g1[j] * sigm(g1[j]); }
                u32x4 w; w.x = cvt_pk_bf16(v0[0], v0[1]); w.y = cvt_pk_bf16(v0[2], v0[3]); w.z = cvt_pk_bf16(v1[0], v1[1]); w.w = cvt_pk_bf16(v1[2], v1[3]);
                *(u32x4*)(HBp + o0 + (size_t)(ai * HALF + m * 16) * DFF) = w; }
    }
};

struct EpiRes2 { static constexpr bool CHAIN = false; const float* X; const float* MOD; const float* GV2; bf16_t* X1; bf16_t* A2; unsigned long long* ROWSS;
    __device__ __forceinline__ void operator()(const f32x4 (&acc)[2][2][4][2], const Unit& u, int wr, int wc, int fr, int fq) const {
        const int cb = u.pn * BM + wc * 32 + 8 * fq, bidx = (u.pm * BM) / T; const int r0 = u.pm * BM + wr * 64 + fr; const size_t o0 = (size_t)r0 * 1024 + cb;
        const float* gp = MOD + bidx * 6144 + 2048 + cb; const float* vp = GV2 + bidx * 1024 + cb;
        f32x4 g[2][2], gv[2][2]; float ssv[8];
#pragma unroll
        for (int bj = 0; bj < 2; ++bj) { g[bj][0] = *(const f32x4*)(gp + bj * HALF); g[bj][1] = *(const f32x4*)(gp + bj * HALF + 4); gv[bj][0] = *(const f32x4*)(vp + bj * HALF); gv[bj][1] = *(const f32x4*)(vp + bj * HALF + 4); }
#pragma unroll
        for (int ai = 0; ai < 2; ++ai)
#pragma unroll
            for (int m = 0; m < 4; ++m) { float ss = 0.f;
#pragma unroll
                for (int bj = 0; bj < 2; ++bj) { const size_t o = o0 + (size_t)(ai * HALF + m * 16) * 1024 + bj * HALF;
                    const f32x4 x0 = *(const f32x4*)(X + o) + g[bj][0] * acc[ai][bj][m][0], x1 = *(const f32x4*)(X + o + 4) + g[bj][1] * acc[ai][bj][m][1];
                    ss += (x0[0] * x0[0] + x0[1] * x0[1]) + (x0[2] * x0[2] + x0[3] * x0[3]) + (x1[0] * x1[0] + x1[1] * x1[1]) + (x1[2] * x1[2] + x1[3] * x1[3]);
                    const f32x4 a0 = x0 * gv[bj][0], a1 = x1 * gv[bj][1];
                    u32x4 w; w.x = cvt_pk_bf16(a0[0], a0[1]); w.y = cvt_pk_bf16(a0[2], a0[3]); w.z = cvt_pk_bf16(a1[0], a1[1]); w.w = cvt_pk_bf16(a1[2], a1[3]);
                    *(u32x4*)(A2 + o) = w; }
                ss += __shfl_xor(ss, 16); ss += __shfl_xor(ss, 32); ssv[ai * 4 + m] = ss; }
#pragma unroll
        for (int h = 0; h < 2; ++h) { const int gs = 2 * fq + h; float v = 0.f;
#pragma unroll
            for (int g = 0; g < 8; ++g) v = gs == g ? ssv[g] : v;
            atomicAdd(ROWSS + r0 + (gs >> 2) * HALF + (gs & 3) * 16, (unsigned long long)(v * 1073741824.0f)); }
    }
};
struct EpiSwi2 { static constexpr bool CHAIN = false; bf16_t* HBp; const unsigned long long* ROWSS; const float* CV;
    __device__ __forceinline__ void operator()(const f32x4 (&acc)[2][2][4][2], const Unit& u, int wr, int wc, int fr, int fq) const {
        const int r0 = u.pm * BM + wr * 64 + fr, cc = u.pn * HALF + wc * 32 + 8 * fq, bidx = (u.pm * BM) / T;
        const size_t o0 = (size_t)r0 * DFF + cc;
        const float* cp = CV + bidx * (2 * DFF) + cc;
        const f32x4 ca0 = *(const f32x4*)cp, ca1 = *(const f32x4*)(cp + 4), cg0 = *(const f32x4*)(cp + DFF), cg1 = *(const f32x4*)(cp + DFF + 4);
        float rsv[2][4];
#pragma unroll
        for (int ai = 0; ai < 2; ++ai)
#pragma unroll
            for (int m = 0; m < 4; ++m) rsv[ai][m] = (float)ROWSS[r0 + ai * HALF + m * 16];
#pragma unroll
        for (int ai = 0; ai < 2; ++ai)
#pragma unroll
            for (int m = 0; m < 4; ++m) { const float rs = __builtin_amdgcn_rsqf(rsv[ai][m] * (1.0f / (1073741824.0f * 1024.0f)) + EPS);
                const f32x4 a0 = acc[ai][0][m][0] * rs + ca0, a1 = acc[ai][0][m][1] * rs + ca1, g0 = acc[ai][1][m][0] * rs + cg0, g1 = acc[ai][1][m][1] * rs + cg1; f32x4 v0, v1;
#pragma unroll
                for (int j = 0; j < 4; ++j) { v0[j] = a0[j] * g0[j] * sigm(g0[j]); v1[j] = a1[j] * g1[j] * sigm(g1[j]); }
                u32x4 w; w.x = cvt_pk_bf16(v0[0], v0[1]); w.y = cvt_pk_bf16(v0[2], v0[3]); w.z = cvt_pk_bf16(v1[0], v1[1]); w.w = cvt_pk_bf16(v1[2], v1[3]);
                *(u32x4*)(HBp + o0 + (size_t)(ai * HALF + m * 16) * DFF) = w; }
    }
};
struct OrderGrid { const char* A; const char* Bt; int nM, nN, K, G, c;
    __device__ __forceinline__ bool next(int i, Unit& u) const {
        const int nwg = nM * nN; const long L = (long)i * G + c; if (L >= nwg) return false;
        const int w = xcd_remap((int)L, nwg);
        const int nig = 8 * nN, gid = w / nig, fm = gid * 8, gsz = (nM - fm) < 8 ? (nM - fm) : 8;
        u.pm = fm + ((w % nig) % gsz); u.pn = (w % nig) / gsz;
        u.pA = A + (size_t)u.pm * 256 * K * 2; u.pB = Bt + (size_t)u.pn * 256 * K * 2; u.pO = nullptr; u.ldc = 0; u.act = 0; u.aux = 0; return true;
    }
};
struct OrderMrg { const char* A0; const char* B0; const char* A1; const char* B1; int G, c;
    __device__ __forceinline__ bool next(int i, Unit& u) const {
        constexpr int nM = 128, nN = 4, nwg = nM * nN; const long L = (long)(i >> 1) * G + c; if (L >= nwg) return false;
        const int w = xcd_remap((int)L, nwg);
        const int nig = 8 * nN, gid = w / nig, fm = gid * 8;
        u.pm = fm + ((w % nig) & 7); u.pn = (w % nig) >> 3; u.aux = i & 1;
        u.pA = ((i & 1) ? A1 : A0) + (size_t)u.pm * 256 * 1024 * 2; u.pB = ((i & 1) ? B1 : B0) + (size_t)u.pn * 256 * 1024 * 2; u.pO = nullptr; u.ldc = 0; u.act = 0; return true;
    }
};
struct Order1A { const char* H; const char* WT1A; const char* WTVV; char* Q; char* Kb; char* AFp; char* VVT; int G, c;
    __device__ __forceinline__ bool next(int i, Unit& u) const {
        constexpr int NWG = 1208; const long L = (long)i * G + c; if (L >= NWG) return false;
        int w = xcd_remap((int)L, NWG);
        int tok, col; bool swapped;
        if (w < 640) { const int gid = w / 40, r = w % 40; tok = gid * 8 + (r & 7); col = r >> 3; swapped = false; }
        else if (w < 1152) { w -= 640; const int gid = w / 32, r = w & 31; tok = gid * 8 + (r & 7); col = r >> 3; swapped = true; }
        else if (w < 1176) { w -= 1152; tok = 128 + (w & 7); col = 2 + (w >> 3); swapped = false; }
        else { w -= 1176; tok = 128 + (w & 7); col = w >> 3; swapped = true; }
        u.pm = tok; u.pn = col; u.aux = 0;
        const char* hp = H + (size_t)tok * 256 * 1024 * 2;
        if (swapped) { u.pA = WTVV + (size_t)col * 256 * 1024 * 2; u.pB = hp; u.pO = VVT + ((size_t)(tok * 4) * 65536 + (size_t)(col * 256) * 64) * 2; u.ldc = 64; u.act = ACT_VT; }
        else { u.pA = hp; u.pB = WT1A + (size_t)col * 256 * 1024 * 2;
            if (col < 2) { u.pO = Q + ((size_t)(tok * 256) * QKW + col * 256) * 2; u.ldc = QKW; u.act = ACT_NONE; }
            else if (col < 4) { u.pO = Kb + ((size_t)(tok * 256) * QKW + (col - 2) * 256) * 2; u.ldc = QKW; u.act = ACT_NONE; }
            else { u.pO = AFp + (size_t)(tok * 256) * 32 * 4; u.ldc = 32; u.act = ACT_AF32; } }
        return true;
    }
};
struct Order1B { const char* H; const char* WT1B; const char* WTVA; char* U; char* R; char* GA; char* GB; char* GVT; int G, c;
    __device__ __forceinline__ bool next(int i, Unit& u) const {
        const long L = (long)i * G + c; if (L >= 2560) return false;
        int w = L < 2048 ? xcd_remap((int)L, 2048) : 2048 + xcd_remap((int)L - 2048, 512);
        u.aux = 0;
        if (w < 2048) { const int gid = w >> 7, r = w & 127, tok = gid * 8 + (r & 7), col = r >> 3; u.pm = tok; u.pn = col;
            u.pA = H + (size_t)tok * 256 * 1024 * 2; u.pB = WT1B + (size_t)col * 256 * 1024 * 2; u.ldc = 1024;
            const int seg = col >> 2; const long long dR = R - U, dGA = GA - U, dGB = GB - U;
            const long long dsel = (seg == 1 ? dR : 0ll) + (seg == 2 ? dGA : 0ll) + (seg == 3 ? dGB : 0ll);
            u.act = seg == 0 ? ACT_GELU : seg == 1 ? ACT_SILU : ACT_SIGM;
            const size_t eo = (size_t)(tok * 256) * 1024 + (col & 3) * 256; u.pO = U + dsel + (seg >= 2 ? eo : eo * 2); u.aux = seg == 3 ? 1 : 0; }
        else { w -= 2048; const int gid = w >> 5, r = w & 31, tok = gid * 8 + (r & 7), ch = r >> 3; u.pm = tok; u.pn = ch;
            u.pA = WTVA + (size_t)ch * 256 * 1024 * 2; u.pB = H + (size_t)tok * 256 * 1024 * 2; u.pO = GVT + ((size_t)(ch * 256) * ML + tok * 256) * 2; u.ldc = ML; u.act = ACT_GELU; }
        return true;
    }
};
}

#define LAS __attribute__((address_space(3)))

namespace gla {
typedef short bf16x8 __attribute__((ext_vector_type(8)));
typedef float f32x4 __attribute__((ext_vector_type(4)));
typedef unsigned u32x4 __attribute__((ext_vector_type(4)));
typedef unsigned u32x2 __attribute__((ext_vector_type(2)));
constexpr int PKG_L_BYTES = 41984, PKG_C_BYTES = 17408, OFF_EL = 0, OFF_KS = 1024, OFF_QD = 17408, OFF_AT = 33792;
constexpr int SLOT_BYTES = PKG_L_BYTES + 8192, OFF_V = PKG_L_BYTES;
constexpr size_t WS_PKGC = 487 * MiB, WS_PKGD = 500 * MiB;
static_assert(WS_PKG + (size_t)64 * 64 * PKG_L_BYTES <= WS_OF && WS_PKGC + (size_t)64 * 4 * PKG_C_BYTES <= WS_END, "package regions");
constexpr float LOG2E = 1.44269504088896f;
__device__ __forceinline__ unsigned cvt_pk(float lo, float hi) { typedef __bf16 v2bf __attribute__((ext_vector_type(2))); typedef float v2f __attribute__((ext_vector_type(2)));
    const v2f x = {lo, hi}; const v2bf y = __builtin_convertvector(x, v2bf); return __builtin_bit_cast(unsigned, y); }
__device__ __forceinline__ float bfr(float f) { return __uint_as_float((__float_as_uint(f) + 0x7fffu + ((__float_as_uint(f) >> 16) & 1u)) & 0xffff0000u); }
__device__ __forceinline__ char* pkg_ptr(unsigned char* ws, int seq, int ch) {
    return ch < 4 ? (char*)ws + WS_PKGC + (size_t)(seq * 4 + ch) * PKG_C_BYTES : (char*)ws + WS_PKG + (size_t)(seq * 64 + (ch - 4)) * PKG_L_BYTES;
}
#define GLA_BAR() do { asm volatile("s_waitcnt lgkmcnt(0)" ::: "memory"); __builtin_amdgcn_s_barrier(); asm volatile("" ::: "memory"); } while (0)

__device__ __forceinline__ void prepass_phase(LAS unsigned char* lds, unsigned char* ws, const float* w_af, const float* b_af, const float* w_ab, const float* b_ab, int G, int c) {
    const int tid = threadIdx.x, w = __builtin_amdgcn_readfirstlane(tid >> 6), lane = tid & 63, lc = lane & 15, lg = lane >> 4;
    LAS float* B2 = (LAS float*)lds;
    LAS float* BL = (LAS float*)(lds + 33792);
    LAS unsigned char* QD = lds + 34816;
    LAS unsigned char* KI = lds + 51200;
    LAS unsigned short* KST = (LAS unsigned short*)(lds + 67584);
    LAS float* AFL = (LAS float*)(lds + 83968);
    LAS float* WL = (LAS float*)(lds + 93184);
    const bf16* Qg = (const bf16*)(ws + WS_Q); const bf16* Kg = (const bf16*)(ws + WS_K); const float* AF = (const float*)(ws + WS_AF);
    constexpr int NITEMS = 64 * 68;
    struct In1 { f32x4 araw; float bias; };
    struct In2 { u32x4 k[2]; u32x4 q[2]; };
    auto load1 = [&](int item_, In1& p) { const int item = item_ < NITEMS ? item_ : NITEMS - 1; const int seq = item / 68, ch = item - seq * 68, dir = seq >> 5, b = (seq >> 2) & 7, h = seq & 3;
        const int row0 = ch < 4 ? ML + b * TC + ch * 64 : b * T + (ch - 4) * 64, dk = 16 * w + lc;
        p.bias = (dir ? b_ab : b_af)[h * DK + dk];
        p.araw = *(const f32x4*)(AF + (size_t)row0 * 32 + tid * 4); };
    auto put_af = [&](const In1& p) { float hi[4], lo[4];
#pragma unroll
        for (int j = 0; j < 4; ++j) { hi[j] = bfr(p.araw[j]); lo[j] = bfr(p.araw[j] - hi[j]); }
        u32x2 h, l; h.x = (__float_as_uint(hi[0]) >> 16) | (__float_as_uint(hi[1]) & 0xffff0000u); h.y = (__float_as_uint(hi[2]) >> 16) | (__float_as_uint(hi[3]) & 0xffff0000u);
        l.x = (__float_as_uint(lo[0]) >> 16) | (__float_as_uint(lo[1]) & 0xffff0000u); l.y = (__float_as_uint(lo[2]) >> 16) | (__float_as_uint(lo[3]) & 0xffff0000u);
        LAS unsigned char* rp = (LAS unsigned char*)AFL + (tid >> 3) * 144 + (tid & 7) * 8; *(LAS u32x2*)rp = h; *(LAS u32x2*)(rp + 64) = l; };
    auto load2 = [&](int item_, In2& p) { const int item = item_ < NITEMS ? item_ : NITEMS - 1; const int seq = item / 68, ch = item - seq * 68, b = (seq >> 2) & 7, h = seq & 3;
        const int row0 = ch < 4 ? ML + b * TC + ch * 64 : b * T + (ch - 4) * 64;
        const bf16* qsrc = Qg + (ch < 4 ? (long long)(Kg - Qg) : 0ll);
#pragma unroll
        for (int rep = 0; rep < 2; ++rep) { const int f = w + 8 * rep, it = f >> 2, sidx = f & 3, i = 16 * it + lc;
            const size_t ro = (size_t)(row0 + i) * QKW + h * DK + 32 * sidx + 8 * lg;
            p.k[rep] = *(const u32x4*)(Kg + ro); p.q[rep] = *(const u32x4*)(qsrc + ro); } };
    struct Def { u32x4 aw, k0, k1; char* pq; char* pk; };
    auto flush = [&](const Def& d) { *(u32x4*)(d.pq + OFF_AT + ((w & 3) * 2 + (w >> 2)) * 1024 + lane * 16) = d.aw; *(u32x4*)(d.pk + OFF_KS + (2 * w) * 1024 + lane * 16) = d.k0; *(u32x4*)(d.pk + OFF_KS + (2 * w + 1) * 1024 + lane * 16) = d.k1; };
    auto body = [&](int item_, const In1& c1, const In2& c2, In1& n1, In2& n2, const Def& din, Def& dout) {
        const bool oob = item_ >= NITEMS; const int item = oob ? NITEMS - 1 : item_;
        const int seq = item / 68, ch = item - seq * 68, dir = seq >> 5, hh = seq & 3;
        const bool isctx = ch < 4;
        char* pkr = pkg_ptr(ws, seq, ch); char* dummy = (char*)ws + WS_PKGD;
        char* pk = dummy + (oob ? 0ll : (long long)(pkr - dummy));
        char* pkq = dummy + ((oob || isctx) ? 0ll : (long long)(pkr - dummy));
        {
            const int dk = 16 * w + lc;
            bf16x8 bh, bl;
#pragma unroll
            for (int j = 0; j < 8; ++j) { const float wv = WL[(dir * 16 + ((8 * lg + j) & 15)) * 512 + hh * DK + dk]; const float hi = bfr(wv); const float lo = bfr(wv - hi);
                bh[j] = (short)(__float_as_uint(hi) >> 16); bl[j] = lg < 2 ? (short)(__float_as_uint(lo) >> 16) : (short)0; }
            const float bias = c1.bias;
            float g2[4][4];
#pragma unroll
            for (int tt = 0; tt < 4; ++tt) {
                const bf16x8 af = *(const LAS bf16x8*)((const LAS unsigned char*)AFL + (16 * tt + lc) * 144 + (lg < 2 ? 0 : 64) + (dir * 16 + 8 * (lg & 1)) * 2);
                f32x4 z = (f32x4){0.f, 0.f, 0.f, 0.f};
                z = __builtin_amdgcn_mfma_f32_16x16x32_bf16(af, bh, z, 0, 0, 0);
                z = __builtin_amdgcn_mfma_f32_16x16x32_bf16(af, bl, z, 0, 0, 0);
#pragma unroll
                for (int r = 0; r < 4; ++r) { const float zz = z[r] + bias;
                    const float ls2 = fminf(zz, 0.f) * LOG2E - __builtin_amdgcn_logf(1.0f + __builtin_amdgcn_exp2f(-fabsf(zz) * LOG2E));
                    g2[tt][r] = ls2 * (1.0f / 16.0f); }
            }
            float pre[4][4], tot[4], all[4][4];
#pragma unroll
            for (int tt = 0; tt < 4; ++tt) { pre[tt][0] = g2[tt][0]; pre[tt][1] = pre[tt][0] + g2[tt][1]; pre[tt][2] = pre[tt][1] + g2[tt][2]; pre[tt][3] = pre[tt][2] + g2[tt][3]; tot[tt] = pre[tt][3]; }
#pragma unroll
            for (int tt = 0; tt < 4; ++tt)
#pragma unroll
                for (int q = 0; q < 4; ++q) all[tt][q] = __shfl(tot[tt], lc + 16 * q);
            float run = 0.f, total;
            float offs[4];
#pragma unroll
            for (int tt = 0; tt < 4; ++tt) { offs[tt] = run + (lg > 0 ? all[tt][0] : 0.f) + (lg > 1 ? all[tt][1] : 0.f) + (lg > 2 ? all[tt][2] : 0.f); run += (all[tt][0] + all[tt][1]) + (all[tt][2] + all[tt][3]); }
            total = run;
#pragma unroll
            for (int tt = 0; tt < 4; ++tt)
#pragma unroll
                for (int r = 0; r < 4; ++r) { const float incl = offs[tt] + pre[tt][r]; const float bb = dir ? (total - incl) + g2[tt][r] : incl; B2[(16 * tt + 4 * lg + r) * 132 + dk] = bb; }
            { const float et = __builtin_amdgcn_exp2f(total); BL[dk] = et; ((float*)(pk + OFF_EL))[dk] = et; }
        }
        GLA_BAR();
        load1(item_ + G, n1);
        flush(din);
#pragma unroll
        for (int rep = 0; rep < 2; ++rep) {
            const int f = w + 8 * rep, it = f >> 2, s = f & 3, i = 16 * it + lc, d0 = 32 * s + 4 * lg, d1 = d0 + 16;
            const f32x4 b0 = *(const LAS f32x4*)(B2 + i * 132 + d0), b1 = *(const LAS f32x4*)(B2 + i * 132 + d1), l0 = *(const LAS f32x4*)(BL + d0), l1 = *(const LAS f32x4*)(BL + d1);
            const u32x2 k0 = {c2.k[rep].x, c2.k[rep].y}, k1 = {c2.k[rep].z, c2.k[rep].w};
            float kv[8] = {__uint_as_float(k0.x << 16), __uint_as_float(k0.x & 0xffff0000u), __uint_as_float(k0.y << 16), __uint_as_float(k0.y & 0xffff0000u),
                           __uint_as_float(k1.x << 16), __uint_as_float(k1.x & 0xffff0000u), __uint_as_float(k1.y << 16), __uint_as_float(k1.y & 0xffff0000u)};
            float bb[8] = {b0[0], b0[1], b0[2], b0[3], b1[0], b1[1], b1[2], b1[3]}, ll[8] = {l0[0], l0[1], l0[2], l0[3], l1[0], l1[1], l1[2], l1[3]};
            float ki[8];
#pragma unroll
            for (int e = 0; e < 8; ++e) ki[e] = kv[e] * __builtin_amdgcn_exp2f(-bb[e]);
#pragma unroll
            for (int e = 0; e < 8; e += 2) { const int dk = (e < 4 ? d0 : d1) + (e & 3); const unsigned p = cvt_pk(ki[e] * ll[e], ki[e + 1] * ll[e + 1]);
                KST[dk * 64 + i] = (unsigned short)p; KST[(dk + 1) * 64 + i] = (unsigned short)(p >> 16); }
            {
                const u32x2 q0 = {c2.q[rep].x, c2.q[rep].y}, q1 = {c2.q[rep].z, c2.q[rep].w};
                float qv[8] = {__uint_as_float(q0.x << 16), __uint_as_float(q0.x & 0xffff0000u), __uint_as_float(q0.y << 16), __uint_as_float(q0.y & 0xffff0000u),
                               __uint_as_float(q1.x << 16), __uint_as_float(q1.x & 0xffff0000u), __uint_as_float(q1.y << 16), __uint_as_float(q1.y & 0xffff0000u)};
                float qd[8];
#pragma unroll
                for (int e = 0; e < 8; ++e) qd[e] = qv[e] * __builtin_amdgcn_exp2f(bb[e]);
                u32x4 qw, kw; qw.x = cvt_pk(qd[0], qd[1]); qw.y = cvt_pk(qd[2], qd[3]); qw.z = cvt_pk(qd[4], qd[5]); qw.w = cvt_pk(qd[6], qd[7]);
                kw.x = cvt_pk(ki[0], ki[1]); kw.y = cvt_pk(ki[2], ki[3]); kw.z = cvt_pk(ki[4], ki[5]); kw.w = cvt_pk(ki[6], ki[7]);
                *(LAS u32x4*)(QD + f * 1024 + lane * 16) = qw; *(LAS u32x4*)(KI + f * 1024 + lane * 16) = kw;
                *(u32x4*)(pkq + OFF_QD + f * 1024 + lane * 16) = qw;
            }
        }
        put_af(n1);
        GLA_BAR();
        load2(item_ + G, n2);
        {
            const int s2 = w >> 2, it = w & 3;
            f32x4 d0v = (f32x4){0.f, 0.f, 0.f, 0.f}, d1v = (f32x4){0.f, 0.f, 0.f, 0.f};
#pragma unroll
            for (int s = 0; s < 4; ++s) { const bf16x8 qf = *(const LAS bf16x8*)(QD + (it * 4 + s) * 1024 + lane * 16);
                const bf16x8 ka = *(const LAS bf16x8*)(KI + ((2 * s2) * 4 + s) * 1024 + lane * 16), kb = *(const LAS bf16x8*)(KI + ((2 * s2 + 1) * 4 + s) * 1024 + lane * 16);
                d0v = __builtin_amdgcn_mfma_f32_16x16x32_bf16(ka, qf, d0v, 0, 0, 0); d1v = __builtin_amdgcn_mfma_f32_16x16x32_bf16(kb, qf, d1v, 0, 0, 0); }
            const int i = 16 * it + lc; float a[8];
#pragma unroll
            for (int e = 0; e < 8; ++e) { const int j = 32 * s2 + (e < 4 ? 0 : 16) + 4 * lg + (e & 3); const float v = e < 4 ? d0v[e] : d1v[e - 4]; a[e] = (dir ? (i <= j) : (i >= j)) ? v : 0.f; }
            u32x4 aw; aw.x = cvt_pk(a[0], a[1]); aw.y = cvt_pk(a[2], a[3]); aw.z = cvt_pk(a[4], a[5]); aw.w = cvt_pk(a[6], a[7]);
            dout.aw = aw; dout.pq = pkq; dout.pk = pk;
        }
#pragma unroll
        for (int rep = 0; rep < 2; ++rep) { const int fi = 2 * w + rep, dkt = fi >> 1, sp = fi & 1, dk = 16 * dkt + lc;
            const u32x2 x0 = *(const LAS u32x2*)(KST + dk * 64 + 32 * sp + 4 * lg), x1 = *(const LAS u32x2*)(KST + dk * 64 + 32 * sp + 16 + 4 * lg);
            u32x4 o; o.x = x0.x; o.y = x0.y; o.z = x1.x; o.w = x1.y;
            if (rep == 0) dout.k0 = o; else dout.k1 = o; }
    };
    In1 a1, b1; In2 a2, b2;
    load1(c, a1); load2(c, a2);
    for (int i = tid; i < 2 * 16 * 512 / 4; i += 512) ((LAS f32x4*)WL)[i] = i < 2048 ? ((const f32x4*)w_af)[i] : ((const f32x4*)w_ab)[i - 2048];
    put_af(a1);
    GLA_BAR();
    Def da, db; { char* dummy = (char*)ws + WS_PKGD; da.pq = dummy; da.pk = dummy; da.aw = (u32x4){0u, 0u, 0u, 0u}; da.k0 = da.aw; da.k1 = da.aw; }
    int item = c;
    for (; item + G < NITEMS; item += 2 * G) {
        body(item, a1, a2, b1, b2, da, db);
        body(item + G, b1, b2, a1, a2, db, da);
    }
    if (item < NITEMS) { body(item, a1, a2, b1, b2, da, db); flush(db); }
    else flush(da);
}

__device__ __forceinline__ void scan_phase(LAS unsigned char* lds, unsigned char* ws, int G, int c) {
    const int tid = threadIdx.x, w = __builtin_amdgcn_readfirstlane(tid >> 6), lane = tid & 63, lc = lane & 15, lg = lane >> 4;
    const bf16* VVT = (const bf16*)(ws + WS_VVT);
    const int vc = (G % 8 == 0) ? (c % 8) * (G / 8) + c / 8 : c;
    for (int item = vc; item < 256; item += G) {
        const int seq = item >> 2, vs = item & 3, dir = seq >> 5, b = (seq >> 2) & 7, h = seq & 3;
        bf16* O = (bf16*)(ws + (dir ? WS_OB : WS_OF));
        auto chunk_of = [&](int st) { return st < 4 ? (dir ? 3 - st : st) : 4 + (dir ? 63 - (st - 4) : st - 4); };
        if (w >= 4) {
            const int lw = w - 4;
            auto ptr_of = [&](int st_) { const int st = st_ < 68 ? st_ : 67; return chunk_of(st); };
            auto own_src = [&](int st_, int k) -> const char* { const int ch = ptr_of(st_); const char* pk = pkg_ptr(ws, seq, ch); const int tot = ch < 4 ? 17 : 41, nown = (tot - vs + 3) >> 2;
                const int trow = ch < 4 ? ML + b * TC + ch * 64 : b * T + (ch - 4) * 64;
                const int j = lw + 4 * k;
                if (j < nown) return pk + (vs + 4 * j) * 1024 + lane * 16;
                if (j < nown + 8) return (const char*)(VVT + ((size_t)(trow >> 6) * 1024 + h * DV + vs * 64) * 64 + lane * 8) + (j - nown) * 1024;
                return pk + vs * 1024 + lane * 16; };
            auto own_dst = [&](int st, int k) -> int { const int ch = chunk_of(st); const int tot = ch < 4 ? 17 : 41, nown = (tot - vs + 3) >> 2; const int j = lw + 4 * k;
                return j < nown ? (vs + 4 * j) * 1024 : j < nown + 8 ? OFF_V + (j - nown) * 1024 : vs * 1024; };
            auto rest_piece = [&](int st_, int k) -> int { const int ch = ptr_of(st_); const int tot = ch < 4 ? 17 : 41, nown = (tot - vs + 3) >> 2, nrest = tot - nown; const int j = lw + 4 * k;
                const int jj = j < nrest ? j : 0, i3 = jj % 3; return (jj / 3) * 4 + (i3 < vs ? i3 : i3 + 1); };
            u32x4 oa[5], ob[5], rb[8];
            auto ld_own = [&](int st, u32x4 (&r)[5]) {
#pragma unroll
                for (int k = 0; k < 5; ++k) r[k] = *(const u32x4*)own_src(st, k); };
            auto st_own = [&](int st, const u32x4 (&r)[5]) { if (st >= 68) return; LAS unsigned char* dst = lds + (st % 3) * SLOT_BYTES;
#pragma unroll
                for (int k = 0; k < 5; ++k) *(LAS u32x4*)(dst + own_dst(st, k) + lane * 16) = r[k]; };
            auto ld_rest = [&](int st) { const char* pk = pkg_ptr(ws, seq, ptr_of(st));
#pragma unroll
                for (int k = 0; k < 8; ++k) rb[k] = *(const u32x4*)(pk + rest_piece(st, k) * 1024 + lane * 16); };
            auto st_rest = [&](int st) { if (st >= 68) return; LAS unsigned char* dst = lds + (st % 3) * SLOT_BYTES;
#pragma unroll
                for (int k = 0; k < 8; ++k) *(LAS u32x4*)(dst + rest_piece(st, k) * 1024 + lane * 16) = rb[k]; };
            ld_own(0, oa); ld_own(1, ob); ld_rest(0);
            st_own(0, oa); st_rest(0);
            for (int st = 0; st < 68; st += 2) {
                GLA_BAR();
                ld_rest(st + 1); ld_own(st + 2, oa);
                st_own(st + 1, ob); st_rest(st + 1);
                GLA_BAR();
                ld_rest(st + 2); ld_own(st + 3, ob);
                st_own(st + 2, oa); st_rest(st + 2);
            }
            GLA_BAR();
        } else {
            const int dvb = vs * 64 + 16 * w;
            f32x4 S[8];
#pragma unroll
            for (int t = 0; t < 8; ++t) S[t] = (f32x4){0.f, 0.f, 0.f, 0.f};
#define GLA_FRAG(off) (*(const LAS bf16x8*)(base + (off) + lane * 16))
#define GLA_PIN() __builtin_amdgcn_sched_barrier(0)
            for (int st = 0; st < 68; ++st) {
                GLA_BAR();
                const LAS unsigned char* base = lds + (st % 3) * SLOT_BYTES;
                const int ch = chunk_of(st);
                bf16x8 vf[2];
                {   const LAS unsigned char* vp = base + OFF_V + (16 * w + lc) * 128 + 8 * lg;
                    const u32x2 x0 = *(const LAS u32x2*)vp, x1 = *(const LAS u32x2*)(vp + 32), x2 = *(const LAS u32x2*)(vp + 64), x3 = *(const LAS u32x2*)(vp + 96);
                    u32x4 t0, t1; t0.x = x0.x; t0.y = x0.y; t0.z = x1.x; t0.w = x1.y; t1.x = x2.x; t1.y = x2.y; t1.z = x3.x; t1.w = x3.y; vf[0] = __builtin_bit_cast(bf16x8, t0); vf[1] = __builtin_bit_cast(bf16x8, t1); }
                f32x4 el[8]; bf16x8 ks[8][2];
                if (ch >= 4) {
                    bf16x8 qa[4][6];
#pragma unroll
                    for (int it = 0; it < 4; ++it) {
#pragma unroll
                        for (int s = 0; s < 4; ++s) qa[it][s] = GLA_FRAG(OFF_QD + (it * 4 + s) * 1024);
#pragma unroll
                        for (int s2 = 0; s2 < 2; ++s2) qa[it][4 + s2] = GLA_FRAG(OFF_AT + (it * 2 + s2) * 1024); }
                    GLA_PIN();
                    bf16x8 sa[4];
#pragma unroll
                    for (int s = 0; s < 4; ++s) { u32x4 t; t.x = cvt_pk(S[2 * s][0], S[2 * s][1]); t.y = cvt_pk(S[2 * s][2], S[2 * s][3]); t.z = cvt_pk(S[2 * s + 1][0], S[2 * s + 1][1]); t.w = cvt_pk(S[2 * s + 1][2], S[2 * s + 1][3]); sa[s] = __builtin_bit_cast(bf16x8, t); }
                    const int row0 = b * T + (ch - 4) * 64;
                    f32x4 o[4];
#pragma unroll
                    for (int it = 0; it < 2; ++it) { o[it] = (f32x4){0.f, 0.f, 0.f, 0.f};
#pragma unroll
                        for (int s = 0; s < 4; ++s) o[it] = __builtin_amdgcn_mfma_f32_16x16x32_bf16(sa[s], qa[it][s], o[it], 0, 0, 0);
#pragma unroll
                        for (int s2 = 0; s2 < 2; ++s2) o[it] = __builtin_amdgcn_mfma_f32_16x16x32_bf16(vf[s2], qa[it][4 + s2], o[it], 0, 0, 0); }
                    GLA_PIN();
#pragma unroll
                    for (int t = 0; t < 4; ++t) { el[t] = *(const LAS f32x4*)(base + OFF_EL + (16 * t + 4 * lg) * 4); ks[t][0] = GLA_FRAG(OFF_KS + (t * 2) * 1024); ks[t][1] = GLA_FRAG(OFF_KS + (t * 2 + 1) * 1024); }
                    GLA_PIN();
#pragma unroll
                    for (int it = 2; it < 4; ++it) { o[it] = (f32x4){0.f, 0.f, 0.f, 0.f};
#pragma unroll
                        for (int s = 0; s < 4; ++s) o[it] = __builtin_amdgcn_mfma_f32_16x16x32_bf16(sa[s], qa[it][s], o[it], 0, 0, 0);
#pragma unroll
                        for (int s2 = 0; s2 < 2; ++s2) o[it] = __builtin_amdgcn_mfma_f32_16x16x32_bf16(vf[s2], qa[it][4 + s2], o[it], 0, 0, 0); }
                    GLA_PIN();
#pragma unroll
                    for (int t = 4; t < 8; ++t) { el[t] = *(const LAS f32x4*)(base + OFF_EL + (16 * t + 4 * lg) * 4); ks[t][0] = GLA_FRAG(OFF_KS + (t * 2) * 1024); ks[t][1] = GLA_FRAG(OFF_KS + (t * 2 + 1) * 1024); }
#pragma unroll
                    for (int it = 0; it < 4; ++it) { u32x2 ow; ow.x = cvt_pk(o[it][0], o[it][1]); ow.y = cvt_pk(o[it][2], o[it][3]);
                        *(u32x2*)(O + (size_t)(row0 + 16 * it + lc) * VW + h * DV + dvb + 4 * lg) = ow; }
                    GLA_PIN();
                } else {
#pragma unroll
                    for (int t = 0; t < 8; ++t) { el[t] = *(const LAS f32x4*)(base + OFF_EL + (16 * t + 4 * lg) * 4); ks[t][0] = GLA_FRAG(OFF_KS + (t * 2) * 1024); ks[t][1] = GLA_FRAG(OFF_KS + (t * 2 + 1) * 1024); }
                    GLA_PIN();
                }
#pragma unroll
                for (int t = 0; t < 8; ++t) { S[t] = S[t] * el[t]; S[t] = __builtin_amdgcn_mfma_f32_16x16x32_bf16(ks[t][0], vf[0], S[t], 0, 0, 0); S[t] = __builtin_amdgcn_mfma_f32_16x16x32_bf16(ks[t][1], vf[1], S[t], 0, 0, 0); }
            }
#undef GLA_FRAG
#undef GLA_PIN
            GLA_BAR();
        }
    }
}
}


#define XB_TMO      128
#define XB_XCNT(j)  (256  + 64 * (j))
#define XB_XSUB(j)  (1280 + 64 * (j))
#define XB_XGEN(j)  (2304 + 64 * (j))
#define XB_TOP      3328
#define XB_TOPGEN   3392
#define XCD_BAR_WORDS 3456
#define XB_SPIN_CAP (1u << 18)
__device__ __forceinline__ unsigned xb_ld(unsigned* p)              { return __hip_atomic_load(p, __ATOMIC_RELAXED, __HIP_MEMORY_SCOPE_AGENT); }
__device__ __forceinline__ unsigned xb_add(unsigned* p, unsigned v) { return __hip_atomic_fetch_add(p, v, __ATOMIC_RELAXED, __HIP_MEMORY_SCOPE_AGENT); }
__device__ __forceinline__ unsigned xb_xcc_id() { return (unsigned)__builtin_amdgcn_s_getreg((3 << 11) | 20) & 0xFu; }
#define XB_SPIN(cond, bar) do { unsigned _sp = 0; while (cond) { __builtin_amdgcn_s_sleep(1); \
    if ((++_sp & 255u) == 0u) { if (xb_ld(&(bar)[XB_TMO])) break; if (_sp > XB_SPIN_CAP) { atomicAdd(&(bar)[XB_TMO], 1u); break; } } } } while (0)
struct XcdBarrier { unsigned* bar; unsigned x; volatile LAS unsigned* st; };
__device__ __forceinline__ XcdBarrier xcd_barrier_post(unsigned* bar, volatile LAS unsigned* st) {
    XcdBarrier b; b.bar = bar; b.x = xb_xcc_id(); b.st = st;
    if (threadIdx.x == 0) (void)xb_add(&bar[XB_XCNT(b.x)], 1u);
    return b;
}
__device__ __forceinline__ void xcd_barrier_complete(unsigned* bar, unsigned x, unsigned& nloc, unsigned& nx) {
    const unsigned G = gridDim.x * gridDim.y * gridDim.z;
    unsigned sum, cnt, mine, sp = 0u;
    for (;;) {
        sum = 0u; cnt = 0u; mine = 0u;
#pragma unroll
        for (unsigned j = 0; j < 16; ++j) { const unsigned c = xb_ld(&bar[XB_XCNT(j)]); sum += c; cnt += (c > 0u) ? 1u : 0u; mine = (j == x) ? c : mine; }
        if (sum == G) break;
        __builtin_amdgcn_s_sleep(1);
        if ((++sp & 255u) == 0u) { if (xb_ld(&bar[XB_TMO])) break; if (sp > XB_SPIN_CAP) { atomicAdd(&bar[XB_TMO], 1u); break; } }
    }
    nloc = mine > 0u ? mine : 1u; nx = cnt > 0u ? cnt : 1u;
}
__device__ __forceinline__ void xcd_barrier(const XcdBarrier& b) {
    asm volatile("s_waitcnt vmcnt(0)" ::: "memory");
    __syncthreads();
    if (threadIdx.x == 0) {
        unsigned* bar = b.bar;
        __builtin_amdgcn_s_waitcnt(0);
        unsigned nloc = b.st[0], nx = b.st[1];
        if (nloc == 0u) { xcd_barrier_complete(bar, b.x, nloc, nx); b.st[0] = nloc; b.st[1] = nx; }
        const unsigned old = xb_add(&bar[XB_XSUB(b.x)], 1u);
        const unsigned gen = old / nloc;
        if (old + 1u == (gen + 1u) * nloc) {
            __builtin_amdgcn_fence(__ATOMIC_RELEASE, "agent");
            asm volatile("s_waitcnt vmcnt(0)" ::: "memory");
            const unsigned og = xb_add(&bar[XB_TOP], 1u);
            const unsigned tg = og / nx;
            if (og + 1u == (tg + 1u) * nx) xb_add(&bar[XB_TOPGEN], 1u);
            else XB_SPIN(xb_ld(&bar[XB_TOPGEN]) == tg, bar);
            __builtin_amdgcn_fence(__ATOMIC_ACQUIRE, "agent");
            xb_add(&bar[XB_XGEN(b.x)], 1u);
            asm volatile("s_waitcnt vmcnt(0)" ::: "memory");
        } else {
            XB_SPIN(xb_ld(&bar[XB_XGEN(b.x)]) == gen, bar);
            __builtin_amdgcn_fence(__ATOMIC_ACQUIRE, "agent");
            asm volatile("s_waitcnt vmcnt(0)" ::: "memory");
        }
    }
    __syncthreads();
}

namespace thin {
typedef float f32x4 __attribute__((ext_vector_type(4)));
typedef unsigned u32x4 __attribute__((ext_vector_type(4)));
typedef unsigned u32x2 __attribute__((ext_vector_type(2)));
typedef short bf16x8 __attribute__((ext_vector_type(8)));
using gla::cvt_pk;
__device__ __forceinline__ float lo16(unsigned w) { return __uint_as_float(w << 16); }
__device__ __forceinline__ float hi16(unsigned w) { return __uint_as_float(w & 0xffff0000u); }
__device__ __forceinline__ void tr_item(const float* W, int K, int ldw, int col0, bf16* WT, int mode_, LAS float* scr, int item, int nblk, int lane) {
    const int mode = mode_ & 15; const float wsc = (mode_ & 16) ? -1.44269504089f : (mode_ & 32) ? 0.08838834764831845f : 1.0f;
    const int kb = item / nblk, nb = item % nblk, k0 = 64 * kb, n0 = 32 * nb;
#pragma unroll 8
    for (int i = 0; i < 32; ++i) { const int kk = 2 * i + (lane >> 5); scr[kk * 33 + (lane & 31)] = __builtin_nontemporal_load(&W[(size_t)(k0 + kk) * ldw + col0 + n0 + (lane & 31)]); }
    asm volatile("s_waitcnt lgkmcnt(0)" ::: "memory");
    int r0 = n0;
    if (mode == 1) { const int col = col0 + n0; r0 = col < DFF ? 256 * (col >> 7) + (col & 127) : 256 * ((col - DFF) >> 7) + 128 + ((col - DFF) & 127); }
    const int cch = lane & 7;
#pragma unroll
    for (int j = 0; j < 4; ++j) { const int n = (lane >> 3) + 8 * j; const LAS float* sp = scr + (8 * cch) * 33 + n;
        u32x4 o; o.x = cvt_pk(sp[0 * 33] * wsc, sp[1 * 33] * wsc); o.y = cvt_pk(sp[2 * 33] * wsc, sp[3 * 33] * wsc); o.z = cvt_pk(sp[4 * 33] * wsc, sp[5 * 33] * wsc); o.w = cvt_pk(sp[6 * 33] * wsc, sp[7 * 33] * wsc);
        *(u32x4*)(WT + (size_t)(r0 + (mode == 2 ? pg8::perm32(n) : n)) * K + k0 + 8 * cch) = o; }
    asm volatile("s_waitcnt lgkmcnt(0)" ::: "memory");
}
template <int NR, int NC>
__device__ __forceinline__ void gemv_block(const LAS float* sv, LAS float* red, const float* W, int ldw, int col0, const float* bias, float* out, int ldo) {
    const int tid = threadIdx.x, w = tid >> 6, lane = tid & 63, col = lane % NC, kk = lane / NC;
    float acc[NR];
#pragma unroll
    for (int r = 0; r < NR; ++r) acc[r] = 0.f;
    if (kk < 2) {
#pragma unroll 16
        for (int j = 0; j < 64; ++j) { const int k = 128 * w + 2 * j + kk; const float wv = W[(size_t)k * ldw + col0 + col];
#pragma unroll
            for (int r = 0; r < NR; ++r) acc[r] += sv[r * 1024 + k] * wv; }
    }
#pragma unroll
    for (int r = 0; r < NR; ++r) { const float o = __shfl(acc[r], (lane + NC) & 63); if (lane < NC) red[(w * NR + r) * 32 + col] = acc[r] + o; }
    __syncthreads();
    if (tid < NR * NC) { const int r = tid / NC, cidx = tid % NC; float t = 0.f;
#pragma unroll
        for (int ww = 0; ww < 8; ++ww) t += red[(ww * NR + r) * 32 + cidx];
        out[(size_t)r * ldo + col0 + cidx] = t + (bias ? bias[col0 + cidx] : 0.f); }
    __syncthreads();
}
struct P0Args { const float *c, *cctx, *w_ada, *b_ada, *w_in, *w_ba, *w_bb, *w_out, *w_f1, *w_f2, *w_sp; };
__device__ __forceinline__ void p0_phase(LAS unsigned char* lds, unsigned char* ws, const P0Args& A, int G, int vcu) {
    const int tid = threadIdx.x, w = __builtin_amdgcn_readfirstlane(tid >> 6), lane = tid & 63;
    LAS float* scr = (LAS float*)(lds + w * 8448);
    LAS float* sv = (LAS float*)(lds + 69632);
    LAS float* red = (LAS float*)(lds + 69632 + 36864);
    for (int i = tid; i < 9 * 1024; i += 512) { const int r = i >> 10, k = i & 1023; const float v = r < 8 ? A.c[r * 1024 + k] : A.cctx[k]; sv[i] = v / (1.f + __expf(-v)); }
    __syncthreads();
    for (int cb = vcu; cb < 256; cb += G) gemv_block<9, 24>(sv, red, A.w_ada, 6144, 24 * cb, A.b_ada, (float*)(ws + WS_MOD), 6144);
    const int gw = vcu * 8 + w, NGW = G * 8; int base = 0;
#define TR_JOB(Wp, K_, ldw_, col0_, ncols_, dst_, mode_) do { const int nblk_ = (ncols_) / 32, items_ = ((K_) / 64) * nblk_; \
        for (int it_ = ((gw - base) % NGW + NGW) % NGW; it_ < items_; it_ += NGW) tr_item(Wp, K_, ldw_, col0_, dst_, mode_, scr, it_, nblk_, lane); base = (base + items_) % NGW; } while (0)
    bf16* WT1A = (bf16*)(ws + WS_WT1A); bf16* WT1B = (bf16*)(ws + WS_WT1B);
    TR_JOB(A.w_in, 1024, NIN, C_Q, 512, WT1A, 2 + 32); TR_JOB(A.w_in, 1024, NIN, C_K, 512, WT1A + 512 * 1024, 2); TR_JOB(A.w_in, 1024, NIN, C_AF, 32, WT1A + 1024 * 1024, 0);
    TR_JOB(A.w_in, 1024, NIN, C_VV, 1024, (bf16*)(ws + WS_WTVV), 0); TR_JOB(A.w_in, 1024, NIN, C_VA, 1024, (bf16*)(ws + WS_WTVA), 0);
    TR_JOB(A.w_in, 1024, NIN, C_U, 1024, WT1B, 0); TR_JOB(A.w_in, 1024, NIN, C_R, 1024, WT1B + 1024 * 1024, 0); TR_JOB(A.w_in, 1024, NIN, C_GA, 1024, WT1B + 2048 * 1024, 16); TR_JOB(A.w_in, 1024, NIN, C_GB, 1024, WT1B + 3072 * 1024, 16);
    TR_JOB(A.w_ba, 1024, 1024, 0, 1024, (bf16*)(ws + WS_WTA), 0); TR_JOB(A.w_bb, 1024, 1024, 0, 1024, (bf16*)(ws + WS_WTB), 0); TR_JOB(A.w_out, 1024, 1024, 0, 1024, (bf16*)(ws + WS_WTO), 0);
    TR_JOB(A.w_f1, 1024, 2 * DFF, 0, 2 * DFF, (bf16*)(ws + WS_WTF1), 1);
    TR_JOB(A.w_f2, DFF, 1024, 0, 1024, (bf16*)(ws + WS_WTF2), 0);
#undef TR_JOB
    { u32x4* z = (u32x4*)(WT1A + 1056 * 1024); const u32x4 zero = {0u, 0u, 0u, 0u}; for (int i = vcu * 512 + tid; i < 224 * 1024 / 8; i += G * 512) z[i] = zero; }
    for (int i = vcu * 512 + tid; i < 8 * 8 * 4 * 64; i += G * 512) { const int ln = i & 63, sidx = (i >> 6) & 3, pt = (i >> 8) & 7, g = i >> 11;
        const float* src = A.w_sp + ((size_t)g * 128 + 16 * pt + (ln & 15)) * 128 + 32 * sidx + 8 * (ln >> 4);
        const f32x4 a = *(const f32x4*)src, b = *(const f32x4*)(src + 4);
        u32x4 o; o.x = cvt_pk(a[0], a[1]); o.y = cvt_pk(a[2], a[3]); o.z = cvt_pk(b[0], b[1]); o.w = cvt_pk(b[2], b[3]);
        ((u32x4*)(ws + WS_WSPF))[i] = o; }
    __syncthreads();
}
__device__ __forceinline__ float wsum(float v) {
#pragma unroll
    for (int o = 1; o < 64; o <<= 1) v += __shfl_xor(v, o);
    return v;
}
__device__ __forceinline__ void p1_phase(LAS unsigned char* lds, unsigned char* ws, const float* x, const float* ctx, const float* n1g, const float* n2g, const float* w_f1, int G, int vcu) {
    const int tid = threadIdx.x, w = __builtin_amdgcn_readfirstlane(tid >> 6), lane = tid & 63;
    const float* MOD = (const float*)(ws + WS_MOD); bf16* H = (bf16*)(ws + WS_H);
    const int gw = vcu * 8 + w, NGW = G * 8;
    LAS float* TA = (LAS float*)lds; LAS float* TB = TA + 9 * 1024;
    for (int i = tid; i < 9 * 1024; i += 512) { const int mr = i >> 10, ci = i & 1023; TA[i] = n1g[ci] * (MOD[mr * 6144 + 1024 + ci] + 1.0f); TB[i] = MOD[mr * 6144 + ci]; }
    __syncthreads();
    auto rowp = [&](int row) { return row < ML ? x + (size_t)row * D : ctx + (size_t)(row - ML) * D; };
    auto store_row = [&](const f32x4 (&v)[4], float t, int row) {
        const int mr = row < ML ? row / T : 8; const float rstd = rsqrtf(t * (1.f / D) + EPS);
#pragma unroll
        for (int j = 0; j < 4; ++j) { const int cidx = 4 * lane + 256 * j; const f32x4 ga = *(const LAS f32x4*)(TA + mr * 1024 + cidx), sh = *(const LAS f32x4*)(TB + mr * 1024 + cidx);
            const f32x4 y = v[j] * rstd * ga + sh; u32x2 o; o.x = cvt_pk(y[0], y[1]); o.y = cvt_pk(y[2], y[3]); *(u32x2*)(H + (size_t)row * D + cidx) = o; } };
    auto sumsq = [&](const f32x4 (&v)[4]) { float t = 0.f;
#pragma unroll
        for (int j = 0; j < 4; ++j) t += (v[j][0] * v[j][0] + v[j][1] * v[j][1]) + (v[j][2] * v[j][2] + v[j][3] * v[j][3]);
        return t; };
    if (G == 256) {
        constexpr int NQ = 3, NR = M / 2048, NIT = (NR + NQ - 1) / NQ; static_assert(M % 2048 == 0, "rows per wave");
        f32x4 v[2][NQ][4];
#pragma unroll
        for (int q = 0; q < NQ; ++q) { const float* xr = rowp(gw + q * 2048);
#pragma unroll
            for (int j = 0; j < 4; ++j) v[0][q][j] = __builtin_nontemporal_load((const f32x4*)(xr + 4 * lane + 256 * j)); }
#pragma unroll
        for (int it = 0; it < NIT; ++it) {
            if (it + 1 < NIT) {
#pragma unroll
                for (int q = 0; q < NQ; ++q) if ((it + 1) * NQ + q < NR) { const float* xr = rowp(gw + ((it + 1) * NQ + q) * 2048);
#pragma unroll
                    for (int j = 0; j < 4; ++j) v[(it + 1) & 1][q][j] = __builtin_nontemporal_load((const f32x4*)(xr + 4 * lane + 256 * j)); } }
            float ss[NQ];
#pragma unroll
            for (int q = 0; q < NQ; ++q) ss[q] = (it * NQ + q < NR) ? sumsq(v[it & 1][q]) : 0.f;
#pragma unroll
            for (int o = 1; o < 64; o <<= 1) {
#pragma unroll
                for (int q = 0; q < NQ; ++q) if (it * NQ + q < NR) ss[q] += __shfl_xor(ss[q], o); }
#pragma unroll
            for (int q = 0; q < NQ; ++q) if (it * NQ + q < NR) store_row(v[it & 1][q], ss[q], gw + (it * NQ + q) * 2048);
        }
    } else {
    for (int row0 = gw; row0 < M; row0 += 4 * NGW) {
        f32x4 v[4][4]; float ss[4];
#pragma unroll
        for (int q = 0; q < 4; ++q) { const int row = row0 + q * NGW < M ? row0 + q * NGW : row0; const float* xr = rowp(row);
#pragma unroll
            for (int j = 0; j < 4; ++j) v[q][j] = __builtin_nontemporal_load((const f32x4*)(xr + 4 * lane + 256 * j)); }
#pragma unroll
        for (int q = 0; q < 4; ++q) ss[q] = sumsq(v[q]);
#pragma unroll
        for (int o = 1; o < 64; o <<= 1) {
#pragma unroll
            for (int q = 0; q < 4; ++q) ss[q] += __shfl_xor(ss[q], o); }
#pragma unroll
        for (int q = 0; q < 4; ++q) { const int row = row0 + q * NGW; if (row < M) store_row(v[q], ss[q], row); }
    }
    }
    __syncthreads();
    for (int i = vcu * 512 + tid; i < 8 * 1024; i += G * 512) ((float*)(ws + WS_GV2))[i] = n2g[i & 1023] * (1.f + MOD[(i >> 10) * 6144 + 4096 + (i & 1023)]);
    LAS float* sv = (LAS float*)lds; LAS float* red = (LAS float*)(lds + 32768);
    for (int i = tid; i < 8 * 1024; i += 512) sv[i] = MOD[(i >> 10) * 6144 + 3072 + (i & 1023)];
    __syncthreads();
    for (int cb = vcu; cb < 256; cb += G) gemv_block<8, 22>(sv, red, w_f1, 2 * DFF, 22 * cb, nullptr, (float*)(ws + WS_CV), 2 * DFF);
}
__device__ __forceinline__ void mix_phase(LAS unsigned char* lds, unsigned char* ws, const float* lng, const float* lnb, const float* bsp, const float* gain, int G, int vcu) {
    const int tid = threadIdx.x, w = __builtin_amdgcn_readfirstlane(tid >> 6), lane = tid & 63, lc = lane & 15, lg = lane >> 4;
    const bf16* GVT = (const bf16*)(ws + WS_GVT); bf16* U = (bf16*)(ws + WS_U); const u32x4* WSPF = (const u32x4*)(ws + WS_WSPF);
    LAS float* RS = (LAS float*)lds;
    LAS float* RQ = (LAS float*)(lds + 16384);
    LAS float* MR = (LAS float*)(lds + 32768);
    LAS unsigned char* WB = lds + 36864;
    LAS float* LNG = (LAS float*)(lds + 135168); LAS float* LNB = LNG + 1024; LAS float* BSL = LNB + 1024;
    for (int i = tid; i < 1024; i += 512) { LNG[i] = lng[i]; LNB[i] = lnb[i]; BSL[i] = bsp[i]; }
    for (int ch = vcu; ch < ML / 128; ch += G) {
        const int tok0 = ch * 128;
        {
            const int to = tid & 15, cs = tid >> 4; float sm[8], sq[8];
#pragma unroll
            for (int e = 0; e < 8; ++e) { sm[e] = 0.f; sq[e] = 0.f; }
            const bf16* gp = GVT + (size_t)(cs * 32) * ML + tok0 + 8 * to;
            u32x4 raw[32];
#pragma unroll
            for (int cc = 0; cc < 32; ++cc) raw[cc] = *(const u32x4*)(gp + (size_t)cc * ML);
#pragma unroll
            for (int cc = 0; cc < 32; ++cc) { const unsigned rw[4] = {raw[cc].x, raw[cc].y, raw[cc].z, raw[cc].w};
#pragma unroll
                for (int e = 0; e < 4; ++e) { const float x0 = lo16(rw[e]), x1 = hi16(rw[e]); sm[2 * e] += x0; sq[2 * e] += x0 * x0; sm[2 * e + 1] += x1; sq[2 * e + 1] += x1 * x1; } }
#pragma unroll
            for (int e = 0; e < 8; ++e) { RS[cs * 128 + 8 * to + e] = sm[e]; RQ[cs * 128 + 8 * to + e] = sq[e]; }
        }
        __syncthreads();
        if (tid < 128) { float sx = 0.f, qx = 0.f;
#pragma unroll
            for (int k = 0; k < 32; ++k) { sx += RS[k * 128 + tid]; qx += RQ[k * 128 + tid]; }
            const float mean = sx * (1.f / 1024.f), var = fmaxf(qx * (1.f / 1024.f) - mean * mean, 0.f); MR[2 * tid] = mean; MR[2 * tid + 1] = rsqrtf(var + EPS); }
        __syncthreads();
        struct GIn { u32x4 wq[4]; u32x4 av[4]; u32x4 uq[4]; };
        auto gload = [&](int g_, GIn& x) { const int g = g_ < 8 ? g_ : 7;
#pragma unroll
            for (int k = 0; k < 4; ++k) x.wq[k] = WSPF[g * 2048 + tid + 512 * k];
#pragma unroll
            for (int k = 0; k < 4; ++k) { const int e = tid + 512 * k; x.av[k] = *(const u32x4*)(GVT + (size_t)(g * 128 + (e >> 4)) * ML + tok0 + (e & 15) * 8); }
#pragma unroll
            for (int k = 0; k < 4; ++k) { const int e = tid + 512 * k; x.uq[k] = *(const u32x4*)(U + (size_t)(tok0 + (e >> 4)) * D + g * 128 + (e & 15) * 8); } };
        auto gcomp = [&](int g, const GIn& x, GIn& nx) {
            LAS unsigned char* wb = WB; LAS unsigned char* gt = lds + 102400;
#pragma unroll
            for (int k = 0; k < 4; ++k) *(LAS u32x4*)(wb + (tid + 512 * k) * 16) = x.wq[k];
            LAS unsigned char* ut = lds + ((g & 1) ? 69632 : 0);
#pragma unroll
            for (int k = 0; k < 4; ++k) { const int e = tid + 512 * k, row = e >> 4, cu = e & 15, so = row * 256 + ((cu ^ (row & 15)) << 4); *(LAS u32x4*)(ut + so) = x.uq[k]; *(LAS u32x4*)(gt + so) = x.av[k]; }
            GLA_BAR();
            gload(g + 1, nx);
            const int chn = g * 128 + 16 * w + lc; const float gg = LNG[chn], bb = LNB[chn];
            bf16x8 af[4];
#pragma unroll
            for (int sidx = 0; sidx < 4; ++sidx) { const int q0 = 32 * sidx + 8 * lg; const u32x4 raw = *(const LAS u32x4*)(gt + (16 * w + lc) * 256 + (((4 * sidx + lg) ^ lc) << 4));
                const unsigned rw[4] = {raw.x, raw.y, raw.z, raw.w}; float y[8];
#pragma unroll
                for (int e = 0; e < 4; ++e) { const f32x4 mr = *(const LAS f32x4*)(MR + 2 * (q0 + 2 * e));
                    y[2 * e] = (lo16(rw[e]) - mr[0]) * mr[1] * gg + bb; y[2 * e + 1] = (hi16(rw[e]) - mr[2]) * mr[3] * gg + bb; }
                u32x4 t; t.x = cvt_pk(y[0], y[1]); t.y = cvt_pk(y[2], y[3]); t.z = cvt_pk(y[4], y[5]); t.w = cvt_pk(y[6], y[7]); af[sidx] = __builtin_bit_cast(bf16x8, t); }
#pragma unroll
            for (int pt = 0; pt < 8; ++pt) { f32x4 d = (f32x4){0.f, 0.f, 0.f, 0.f};
#pragma unroll
                for (int sidx = 0; sidx < 4; ++sidx) { const bf16x8 bf = *(const LAS bf16x8*)(wb + ((pt * 4 + sidx) * 64 + lane) * 16); d = __builtin_amdgcn_mfma_f32_16x16x32_bf16(af[sidx], bf, d, 0, 0, 0); }
                const float bs = BSL[g * 128 + 16 * pt + lc];
                LAS u32x2* up = (LAS u32x2*)(ut + (16 * pt + lc) * 256 + (((2 * w + (lg >> 1)) ^ lc) << 4) + (lg & 1) * 8); const u32x2 uv = *up;
                u32x2 o; o.x = cvt_pk(lo16(uv.x) * (d[0] + bs), hi16(uv.x) * (d[1] + bs)); o.y = cvt_pk(lo16(uv.y) * (d[2] + bs), hi16(uv.y) * (d[3] + bs)); *up = o; }
            GLA_BAR();
#pragma unroll
            for (int k = 0; k < 4; ++k) { const int e = tid + 512 * k, row = e >> 4, cu = e & 15;
                *(u32x4*)(U + (size_t)(tok0 + row) * D + g * 128 + cu * 8) = *(const LAS u32x4*)(ut + row * 256 + ((cu ^ (row & 15)) << 4)); } };
        GIn ga, gb;
        gload(0, ga);
        for (int g = 0; g < 8; g += 2) { gcomp(g, ga, gb); gcomp(g + 1, gb, ga); }
        __syncthreads();
    }
    bf16* OF = (bf16*)(ws + WS_OF); const bf16* OB = (const bf16*)(ws + WS_OB); const bf16* R = (const bf16*)(ws + WS_R);
    const int gw = vcu * 8 + w, NGW = G * 8;
    for (int row0 = gw; row0 < ML; row0 += 2 * NGW) {
        u32x4 ra[2][2], rb[2][2], rr[2][2];
#pragma unroll
        for (int q = 0; q < 2; ++q) { const int row = row0 + q * NGW < ML ? row0 + q * NGW : row0; const size_t o = (size_t)row * VW + 16 * lane;
#pragma unroll
            for (int hv = 0; hv < 2; ++hv) { ra[q][hv] = *(const u32x4*)(OF + o + 8 * hv); rb[q][hv] = *(const u32x4*)(OB + o + 8 * hv); rr[q][hv] = *(const u32x4*)(R + o + 8 * hv); } }
#pragma unroll
        for (int q = 0; q < 2; ++q) { const int row = row0 + q * NGW; if (row < ML) { const size_t o = (size_t)row * VW + 16 * lane; float v[16], r[16]; float ss = 0.f;
#pragma unroll
            for (int hv = 0; hv < 2; ++hv) { const u32x4 a = ra[q][hv], b = rb[q][hv], rq = rr[q][hv];
                const unsigned aw[4] = {a.x, a.y, a.z, a.w}, bw[4] = {b.x, b.y, b.z, b.w}, rw[4] = {rq.x, rq.y, rq.z, rq.w};
#pragma unroll
                for (int e = 0; e < 4; ++e) { v[8 * hv + 2 * e] = lo16(aw[e]) + lo16(bw[e]); v[8 * hv + 2 * e + 1] = hi16(aw[e]) + hi16(bw[e]); r[8 * hv + 2 * e] = lo16(rw[e]); r[8 * hv + 2 * e + 1] = hi16(rw[e]); } }
#pragma unroll
            for (int e = 0; e < 16; ++e) ss += v[e] * v[e];
            ss += __shfl_xor(ss, 1); ss += __shfl_xor(ss, 2); ss += __shfl_xor(ss, 4); ss += __shfl_xor(ss, 8);
            const float rstd = rsqrtf(ss * (1.f / DV) + EPS);
#pragma unroll
            for (int hv = 0; hv < 2; ++hv) { const f32x4 g0 = *(const f32x4*)(gain + 16 * lane + 8 * hv), g1 = *(const f32x4*)(gain + 16 * lane + 8 * hv + 4); float y[8];
#pragma unroll
                for (int e = 0; e < 4; ++e) { y[e] = v[8 * hv + e] * rstd * g0[e] * r[8 * hv + e]; y[4 + e] = v[8 * hv + 4 + e] * rstd * g1[e] * r[8 * hv + 4 + e]; }
                u32x4 t; t.x = cvt_pk(y[0], y[1]); t.y = cvt_pk(y[2], y[3]); t.z = cvt_pk(y[4], y[5]); t.w = cvt_pk(y[6], y[7]); *(u32x4*)(OF + o + 8 * hv) = t; } } }
    }
}
__device__ __forceinline__ void fin_phase(float* X, const float* g, int G, int vcu) {
    const int w = threadIdx.x >> 6, lane = threadIdx.x & 63, gw = vcu * 8 + w, NGW = G * 8;
    for (int row = gw; row < ML; row += NGW) { float* xr = X + (size_t)row * D; f32x4 v[4]; float ss = 0.f;
#pragma unroll
        for (int j = 0; j < 4; ++j) { v[j] = *(const f32x4*)(xr + 4 * lane + 256 * j); ss += (v[j][0] * v[j][0] + v[j][1] * v[j][1]) + (v[j][2] * v[j][2] + v[j][3] * v[j][3]); }
        const float rstd = rsqrtf(wsum(ss) * (1.f / D) + EPS);
#pragma unroll
        for (int j = 0; j < 4; ++j) *(f32x4*)(xr + 4 * lane + 256 * j) = v[j] * rstd * *(const f32x4*)(g + 4 * lane + 256 * j); }
}
}

constexpr int NWAVES = 8, LDS_BYTES = 163840;
#ifndef PG8_SP2
#define PG8_SP2 true
#endif
#ifndef PG8_ALIGN
#define PG8_ALIGN true
#endif
enum Phase { PH_P0 = 0, PH_P1 = 1, PH_G1A = 2, PH_PRE = 3, PH_SCAN = 4, PH_G1B = 5, PH_MIX = 6, PH_MRG = 7, PH_WOUT = 8, PH_FF1 = 9, PH_FF2 = 10, PH_END = 11 };
constexpr int CW_FINCNT = 32768;
constexpr int CW_BAR = 4096;
constexpr int MISC_OFF = LDS_BYTES - 256;
struct Args { const float* in[24]; float* out; unsigned char* ws; int ph_lo, ph_hi; };
__global__ void __launch_bounds__(NWAVES * 64, 2) mega_fwd(Args a) {
    extern __shared__ __attribute__((aligned(16))) unsigned char lds_raw[];
    LAS unsigned char* lds = (LAS unsigned char*)lds_raw;
    unsigned char* ws = a.ws;
    const int G = gridDim.x, c = blockIdx.x;
    const int vcu = (G % 8 == 0) ? (c % 8) * (G / 8) + c / 8 : c;
    const char* Hc = (const char*)(ws + WS_H);
    volatile LAS unsigned* MISC = (volatile LAS unsigned*)(lds + MISC_OFF);
    if (threadIdx.x < 64) MISC[threadIdx.x] = 0u;
    __syncthreads();
    XcdBarrier bar; bar.bar = (unsigned*)(ws + WS_CTL) + CW_BAR; bar.x = 0; bar.st = nullptr;
    const bool multi = a.ph_hi - a.ph_lo > 1;
    if (multi) bar = xcd_barrier_post((unsigned*)(ws + WS_CTL) + CW_BAR, MISC + 8);
#define IN(k) (a.ph_lo <= (k) && (k) < a.ph_hi)
#define SEAM(k) do { if (IN(k) && IN((k) + 1)) xcd_barrier(bar); } while (0)
    if (IN(PH_P0)) { thin::P0Args pa{a.in[1], a.in[3], a.in[4], a.in[5], a.in[7], a.in[17], a.in[18], a.in[19], a.in[21], a.in[22], a.in[10]}; thin::p0_phase(lds, ws, pa, G, vcu); }
    SEAM(PH_P0);
    if (IN(PH_P1)) thin::p1_phase(lds, ws, a.in[0], a.in[2], a.in[6], a.in[20], a.in[21], G, vcu);
    SEAM(PH_P1);
    if (IN(PH_G1A)) {
        pg8::Order1A S{Hc, (const char*)(ws + WS_WT1A), (const char*)(ws + WS_WTVV), (char*)(ws + WS_Q), (char*)(ws + WS_K), (char*)(ws + WS_AF), (char*)(ws + WS_VVT), G, c};
        pg8::EpiAct E;
        pg8::gemm_phase<pg8::EpiAct, pg8::Order1A, PG8_ALIGN, PG8_SP2>(lds, 1024, S, E);
    }
    SEAM(PH_G1A);
    if (IN(PH_PRE)) { gla::prepass_phase(lds, ws, a.in[12], a.in[13], a.in[14], a.in[15], G, c); __syncthreads(); }
    SEAM(PH_PRE);
    if (IN(PH_SCAN)) { gla::scan_phase(lds, ws, G, c); __syncthreads(); }
    SEAM(PH_SCAN);
    if (IN(PH_G1B)) {
        pg8::Order1B S{Hc, (const char*)(ws + WS_WT1B), (const char*)(ws + WS_WTVA), (char*)(ws + WS_U), (char*)(ws + WS_R), (char*)a.out, (char*)a.out + (size_t)ML * D, (char*)(ws + WS_GVT), G, c};
        pg8::EpiAct E;
        pg8::gemm_phase<pg8::EpiAct, pg8::Order1B, PG8_ALIGN, PG8_SP2>(lds, 1024, S, E);
    }
    SEAM(PH_G1B);
    if (IN(PH_MIX)) thin::mix_phase(lds, ws, a.in[8], a.in[9], a.in[11], a.in[16], G, vcu);
    SEAM(PH_MIX);
    if (IN(PH_MRG)) {
        pg8::OrderMrg S{(const char*)(ws + WS_U), (const char*)(ws + WS_WTA), (const char*)(ws + WS_OF), (const char*)(ws + WS_WTB), G, c};
        pg8::EpiMrg E{(const unsigned char*)a.out, (const unsigned char*)a.out + (size_t)ML * D, (bf16*)(ws + WS_Y)};
        pg8::gemm_phase<pg8::EpiMrg, pg8::OrderMrg, PG8_ALIGN, PG8_SP2>(lds, 1024, S, E);
    }
    SEAM(PH_MRG);
    if (IN(PH_WOUT)) {
        pg8::OrderGrid S{(const char*)(ws + WS_Y), (const char*)(ws + WS_WTO), 128, 4, 1024, G, c};
        pg8::EpiRes2 E{a.in[0], (const float*)(ws + WS_MOD), (const float*)(ws + WS_GV2), (bf16*)(ws + WS_X1), (bf16*)(ws + WS_A2), (unsigned long long*)(ws + WS_ROWSS)};
        pg8::gemm_phase<pg8::EpiRes2, pg8::OrderGrid, PG8_ALIGN, PG8_SP2>(lds, 1024, S, E);
    }
    SEAM(PH_WOUT);
    if (IN(PH_FF1)) {
        pg8::OrderGrid S{(const char*)(ws + WS_A2), (const char*)(ws + WS_WTF1), 128, 22, 1024, G, c};
        pg8::EpiSwi2 E{(bf16*)(ws + WS_HB), (const unsigned long long*)(ws + WS_ROWSS), (const float*)(ws + WS_CV)};
        pg8::gemm_phase<pg8::EpiSwi2, pg8::OrderGrid, PG8_ALIGN, PG8_SP2>(lds, 1024, S, E);
    }
    SEAM(PH_FF1);
    if (IN(PH_FF2)) {
        pg8::OrderGrid S{(const char*)(ws + WS_HB), (const char*)(ws + WS_WTF2), 128, 4, DFF, G, c};
        pg8::EpiFin E{(const bf16*)(ws + WS_A2), (const float*)(ws + WS_GV2), (const float*)(ws + WS_MOD), a.in[23], a.out, (unsigned long long*)(ws + WS_ROWSS2), (unsigned*)(ws + WS_CTL) + CW_FINCNT};
        pg8::gemm_phase<pg8::EpiFin, pg8::OrderGrid, PG8_ALIGN, PG8_SP2>(lds, DFF, S, E);
    }
#undef IN
#undef SEAM
}
static int g_grid = 0;
static void run_mega(hipStream_t stream, void* const* d_in, void* d_out, void* d_ws, int lo, int hi) {
    Args a{}; for (int i = 0; i < 24; ++i) a.in[i] = (const float*)d_in[i];
    a.out = (float*)d_out; a.ws = (unsigned char*)d_ws; a.ph_lo = lo; a.ph_hi = hi;
    hipLaunchKernelGGL(mega_fwd, dim3(g_grid), dim3(NWAVES * 64), LDS_BYTES, stream, a);
}

template <class Epi, bool DUAL = false>
static void run_gemm(hipStream_t s, const bf16* A, const bf16* Bt, int Mrows, int N, int K, const Epi& e) {
    hipLaunchKernelGGL((nv_gemm<Epi, DUAL>), dim3((N + 63) / 64, Mrows / 64), dim3(256), 0, s, A, Bt, Mrows, N, K, 0, e);
}
static void run_tr(hipStream_t s, const float* W, int K, int ldw, int col0, int ncols, bf16* WT) {
    hipLaunchKernelGGL(nv_transpose, dim3(ncols / 32, K / 32), dim3(256), 0, s, W, K, ldw, col0, ncols, WT);
}

extern "C" void kernel_launch(void* const* d_in, const int* in_sizes, int n_in, void* d_out, int out_size, void* d_ws, size_t ws_size, hipStream_t stream) {
    if (n_in != 24 || out_size != ML * D || ws_size < WS_END) { fprintf(stderr, "kernel_launch: unexpected sizes n_in %d out %d ws %zu\n", n_in, out_size, ws_size); return; }
    const float* x = (const float*)d_in[0]; const float* c = (const float*)d_in[1]; const float* ctx = (const float*)d_in[2]; const float* cctx = (const float*)d_in[3];
    const float* w_ada = (const float*)d_in[4]; const float* b_ada = (const float*)d_in[5]; const float* norm1_g = (const float*)d_in[6]; const float* w_in = (const float*)d_in[7];
    const float* ln_v_g = (const float*)d_in[8]; const float* ln_v_b = (const float*)d_in[9]; const float* w_sp = (const float*)d_in[10]; const float* b_sp = (const float*)d_in[11];
    const float* w_af = (const float*)d_in[12]; const float* b_af = (const float*)d_in[13]; const float* w_ab = (const float*)d_in[14]; const float* b_ab = (const float*)d_in[15];
    const float* gla_g = (const float*)d_in[16]; const float* w_ba = (const float*)d_in[17]; const float* w_bb = (const float*)d_in[18]; const float* w_out = (const float*)d_in[19];
    const float* norm2_g = (const float*)d_in[20]; const float* w_f1 = (const float*)d_in[21]; const float* w_f2 = (const float*)d_in[22]; const float* fin_g = (const float*)d_in[23];
    unsigned char* ws = (unsigned char*)d_ws; float* out = (float*)d_out;
    if (g_grid == 0) {
        int dev = 0, cus = 0, per_cu = 0;
        hipGetDevice(&dev); hipDeviceGetAttribute(&cus, hipDeviceAttributeMultiprocessorCount, dev);
        hipFuncSetAttribute((const void*)mega_fwd, hipFuncAttributeMaxDynamicSharedMemorySize, LDS_BYTES);
        hipOccupancyMaxActiveBlocksPerMultiprocessor(&per_cu, (const void*)mega_fwd, NWAVES * 64, LDS_BYTES);
        (void)hipGetLastError();
        if (per_cu < 1) fprintf(stderr, "kernel_launch: occupancy query says %d blocks/CU\n", per_cu);
        g_grid = cus;
    }
    bf16 *WT1A = (bf16*)(ws + WS_WT1A), *WTVV = (bf16*)(ws + WS_WTVV), *WT1B = (bf16*)(ws + WS_WT1B), *WTVA = (bf16*)(ws + WS_WTVA), *WTA = (bf16*)(ws + WS_WTA), *WTB = (bf16*)(ws + WS_WTB),
         *WTO = (bf16*)(ws + WS_WTO), *WTF1 = (bf16*)(ws + WS_WTF1), *WTF2 = (bf16*)(ws + WS_WTF2);
    float* MOD = (float*)(ws + WS_MOD); float* LNST = (float*)(ws + WS_LNST);
    bf16 *H = (bf16*)(ws + WS_H), *Q = (bf16*)(ws + WS_Q), *Kb = (bf16*)(ws + WS_K), *VVT = (bf16*)(ws + WS_VVT), *OF = (bf16*)(ws + WS_OF), *OB = (bf16*)(ws + WS_OB), *U = (bf16*)(ws + WS_U),
         *GVT = (bf16*)(ws + WS_GVT), *R = (bf16*)(ws + WS_R), *Y = (bf16*)(ws + WS_Y), *A2 = (bf16*)(ws + WS_A2), *HB = (bf16*)(ws + WS_HB);
    float *AF = (float*)(ws + WS_AF), *Y1 = (float*)(ws + WS_Y1), *X1 = (float*)(ws + WS_X1);
    bf16 *GA = (bf16*)d_out, *GB = (bf16*)d_out + (size_t)ML * D;
    hipMemsetAsync(ws + WS_CTL, 0, 1 * MiB, stream);
#ifndef MK_ONE_LAUNCH
#define MK_ONE_LAUNCH 1
#endif
#ifndef MK_REP
#define MK_REP 0
#endif
    if (MK_ONE_LAUNCH) run_mega(stream, d_in, d_out, d_ws, 0, PH_END);
    else for (int p = 0; p < PH_END; ++p) { run_mega(stream, d_in, d_out, d_ws, p, p + 1); if ((MK_REP >> p) & 1) run_mega(stream, d_in, d_out, d_ws, p, p + 1); }
}
```

```cpp
#include <hip/hip_runtime.h>
#include <stdint.h>
#include <cstdio>

typedef unsigned short bf16;
__device__ __forceinline__ float bf2f(bf16 v) { return __uint_as_float(((unsigned)v) << 16); }
__device__ __forceinline__ bf16 f2bf(float f) { unsigned u = __float_as_uint(f); u += 0x7fffu + ((u >> 16) & 1u); return (bf16)(u >> 16); }

constexpr int NB = 8, T = 4096, D = 1024, TC = 256;
constexpr int ML = NB * T;
constexpr int MC = NB * TC;
constexpr int M = ML + MC;
constexpr int NH = 4, DK = 128, DV = 256, QKW = 512, VW = 1024, RANK = 16;
constexpr int DFF = 2816, NIN = 7200;
constexpr float EPS = 1e-6f;
constexpr int C_U = 0, C_VA = 1024, C_Q = 2048, C_K = 2560, C_VV = 3072, C_R = 4096, C_AF = 5120, C_GA = 5152, C_GB = 6176;

constexpr size_t MiB = 1u << 20;
constexpr size_t WS_CTL = 0;
constexpr size_t WS_ROWSS = 256 * 1024, WS_ROWSS2 = 512 * 1024;
constexpr size_t WS_MOD = 1 * MiB;
constexpr size_t WS_CV = WS_MOD + 256 * 1024;
constexpr size_t WS_LNST = 2 * MiB;
constexpr size_t WS_GV2 = WS_MOD + 512 * 1024;
constexpr size_t WS_WSPF = 3 * MiB;
constexpr size_t WS_WT1A = 4 * MiB;
constexpr size_t WS_WTVV = WS_WT1A + 1280 * 1024 * 2;
constexpr size_t WS_WT1B = WS_WTVV + 2 * MiB;
constexpr size_t WS_WTVA = WS_WT1B + 8 * MiB;
constexpr size_t WS_WTA = WS_WTVA + 2 * MiB, WS_WTB = WS_WTA + 2 * MiB, WS_WTO = WS_WTB + 2 * MiB;
constexpr size_t WS_WTF1 = WS_WTO + 2 * MiB;
constexpr size_t WS_WTF2 = WS_WTF1 + 11 * MiB;
static_assert(WS_WTF2 + (size_t)1024 * 2816 * 2 <= 48 * MiB, "weights region");
constexpr size_t WS_H = 48 * MiB;
constexpr size_t WS_Q = 116 * MiB;
constexpr size_t WS_K = 148 * MiB;
constexpr size_t WS_AF = 182 * MiB;
constexpr size_t WS_VVT = 188 * MiB;
constexpr size_t WS_PKG = 256 * MiB;
constexpr size_t WS_OF = 423 * MiB;
constexpr size_t WS_OB = 116 * MiB;
constexpr size_t WS_U = 188 * MiB;
constexpr size_t WS_GVT = 256 * MiB;
constexpr size_t WS_R = 320 * MiB;
constexpr size_t WS_Y1 = 256 * MiB;
constexpr size_t WS_Y = 48 * MiB;
constexpr size_t WS_X1 = 384 * MiB;
constexpr size_t WS_A2 = 116 * MiB;
constexpr size_t WS_HB = 180 * MiB;
constexpr size_t WS_END = 512 * MiB;

__global__ void nv_transpose(const float* __restrict__ W, int K, int ldw, int col0, int ncols, bf16* __restrict__ WT) {
    __shared__ float tile[32][33];
    const int k0 = blockIdx.y * 32, n0 = blockIdx.x * 32, tx = threadIdx.x & 31, ty = threadIdx.x >> 5;
    for (int i = ty; i < 32; i += 8) tile[i][tx] = W[(size_t)(k0 + i) * ldw + col0 + n0 + tx];
    __syncthreads();
    for (int i = ty; i < 32; i += 8) WT[(size_t)(n0 + i) * K + k0 + tx] = f2bf(tile[tx][i]);
}
__global__ void nv_zero_bf16(bf16* p, size_t n) { for (size_t i = (size_t)blockIdx.x * blockDim.x + threadIdx.x; i < n; i += (size_t)gridDim.x * blockDim.x) p[i] = 0; }

__global__ void nv_ada(const float* __restrict__ c, const float* __restrict__ cctx, const float* __restrict__ w_ada, const float* __restrict__ b_ada, float* __restrict__ MOD) {
    __shared__ float s[9][1024];
    for (int i = threadIdx.x; i < 9 * 1024; i += blockDim.x) { const int r = i >> 10, k = i & 1023; const float v = r < 8 ? c[r * 1024 + k] : cctx[k]; s[r][k] = v / (1.f + expf(-v)); }
    __syncthreads();
    const int n = blockIdx.x * blockDim.x + threadIdx.x;
    float acc[9];
    for (int r = 0; r < 9; ++r) acc[r] = 0.f;
    for (int k = 0; k < 1024; ++k) { const float w = w_ada[(size_t)k * 6144 + n];
#pragma unroll
        for (int r = 0; r < 9; ++r) acc[r] += s[r][k] * w; }
    for (int r = 0; r < 9; ++r) MOD[r * 6144 + n] = acc[r] + b_ada[n];
}

__device__ __forceinline__ float wave_sum(float v) {
#pragma unroll
    for (int o = 1; o < 64; o <<= 1) v += __shfl_xor(v, o);
    return v;
}
__global__ void nv_modnorm(const float* __restrict__ xl, const float* __restrict__ xc, const float* __restrict__ g, const float* __restrict__ MOD, int shoff, int scoff, bf16* __restrict__ out, int nrows, int pad_) {
    const int row = blockIdx.x * (blockDim.x >> 6) + (threadIdx.x >> 6), lane = threadIdx.x & 63;
    if (row >= nrows) return;
    const float* xr = row < ML ? xl + (size_t)row * D : xc + (size_t)(row - ML) * D;
    const int mr = row < ML ? row / T : 8;
    float v[16]; float ss = 0.f;
#pragma unroll
    for (int j = 0; j < 16; ++j) { v[j] = xr[lane + 64 * j]; ss += v[j] * v[j]; }
    const float rstd = rsqrtf(wave_sum(ss) * (1.f / D) + EPS);
#pragma unroll
    for (int j = 0; j < 16; ++j) { const int cidx = lane + 64 * j; const float y = v[j] * rstd * g[cidx];
        out[(size_t)row * D + cidx] = f2bf(y * (1.f + MOD[mr * 6144 + scoff + cidx]) + MOD[mr * 6144 + shoff + cidx]); }
}

template <class Epi, bool DUAL>
__global__ void __launch_bounds__(256) nv_gemm(const bf16* __restrict__ A, const bf16* __restrict__ Bt, int Mrows, int N, int K, int pad_, Epi epi) {
    __shared__ float As[32][65], Bs[32][65], Bs2[DUAL ? 32 : 1][65];
    const int tid = threadIdx.x, tx = tid & 15, ty = tid >> 4;
    const int m0 = blockIdx.y * 64, n0 = blockIdx.x * 64;
    float acc[4][4], acc2[4][4];
#pragma unroll
    for (int i = 0; i < 4; ++i)
#pragma unroll
        for (int j = 0; j < 4; ++j) { acc[i][j] = 0.f; acc2[i][j] = 0.f; }
    const int lr = tid >> 2, lk = (tid & 3) * 8;
    const int am = m0 + lr, bn = n0 + lr < N ? n0 + lr : N - 1;
    const bf16* ap = A + (size_t)am * K + lk;
    const bf16* bp = Bt + (size_t)epi.brow(bn) * K + lk;
    const bf16* bp2 = DUAL ? Bt + (size_t)epi.brow2(bn) * K + lk : bp;
    for (int k0 = 0; k0 < K; k0 += 32) {
        const uint4 av = *(const uint4*)(ap + k0), bv = *(const uint4*)(bp + k0);
        const unsigned aw[4] = {av.x, av.y, av.z, av.w}, bw[4] = {bv.x, bv.y, bv.z, bv.w};
#pragma unroll
        for (int j = 0; j < 4; ++j) { As[lk + 2 * j][lr] = __uint_as_float(aw[j] << 16); As[lk + 2 * j + 1][lr] = __uint_as_float(aw[j] & 0xffff0000u);
                                      Bs[lk + 2 * j][lr] = __uint_as_float(bw[j] << 16); Bs[lk + 2 * j + 1][lr] = __uint_as_float(bw[j] & 0xffff0000u); }
        if (DUAL) { const uint4 cv = *(const uint4*)(bp2 + k0); const unsigned cw[4] = {cv.x, cv.y, cv.z, cv.w};
#pragma unroll
            for (int j = 0; j < 4; ++j) { Bs2[lk + 2 * j][lr] = __uint_as_float(cw[j] << 16); Bs2[lk + 2 * j + 1][lr] = __uint_as_float(cw[j] & 0xffff0000u); } }
        __syncthreads();
#pragma unroll 8
        for (int k = 0; k < 32; ++k) {
            float a[4], b[4], b2[4];
#pragma unroll
            for (int i = 0; i < 4; ++i) { a[i] = As[k][ty * 4 + i]; b[i] = Bs[k][tx * 4 + i]; b2[i] = DUAL ? Bs2[k][tx * 4 + i] : 0.f; }
#pragma unroll
            for (int i = 0; i < 4; ++i)
#pragma unroll
                for (int j = 0; j < 4; ++j) { acc[i][j] += a[i] * b[j]; if (DUAL) acc2[i][j] += a[i] * b2[j]; }
        }
        __syncthreads();
    }
#pragma unroll
    for (int i = 0; i < 4; ++i)
#pragma unroll
        for (int j = 0; j < 4; ++j) { const int m = m0 + ty * 4 + i, n = n0 + tx * 4 + j; if (m < Mrows && n < N) epi(m, n, acc[i][j], acc2[i][j]); }
}
__device__ __forceinline__ float gelu_erf(float v) { return 0.5f * v * (1.f + erff(v * 0.70710678118654752f)); }
__device__ __forceinline__ float sigmoidf_(float v) { return 1.f / (1.f + expf(-v)); }
struct EpBase { __device__ int brow(int n) const { return n; } __device__ int brow2(int n) const { return n; } };
struct EpQ : EpBase { bf16* O; int ld; float sc; __device__ void operator()(int m, int n, float a, float) const { O[(size_t)m * ld + n] = f2bf(a * sc); } };
struct EpF32 : EpBase { float* O; int ld; int pad; __device__ void operator()(int m, int n, float a, float) const { O[(size_t)m * ld + n] = a; } };
struct EpT : EpBase { bf16* O; int ld; int act; __device__ void operator()(int m, int n, float a, float) const { O[(size_t)n * ld + m] = f2bf(act ? gelu_erf(a) : a); } };
struct EpAct : EpBase { bf16* O; int ld; int act; __device__ void operator()(int m, int n, float a, float) const { float v = act == 1 ? gelu_erf(a) : act == 2 ? a * sigmoidf_(a) : sigmoidf_(a); O[(size_t)m * ld + n] = f2bf(v); } };
struct EpY1 : EpBase { const bf16* G; float* Y1; __device__ void operator()(int m, int n, float a, float) const { Y1[(size_t)m * D + n] = bf2f(G[(size_t)m * D + n]) * a; } };
struct EpY : EpBase { const bf16* G; const float* Y1; bf16* Y; __device__ void operator()(int m, int n, float a, float) const { Y[(size_t)m * D + n] = f2bf(Y1[(size_t)m * D + n] + bf2f(G[(size_t)m * D + n]) * a); } };
struct EpRes : EpBase { const float* X; const float* MOD; float* O; int goff; int pad; __device__ void operator()(int m, int n, float a, float) const { O[(size_t)m * D + n] = X[(size_t)m * D + n] + MOD[(m / T) * 6144 + goff + n] * a; } };
struct EpSwi { bf16* O; __device__ int brow(int n) const { return 256 * (n >> 7) + (n & 127); } __device__ int brow2(int n) const { return 256 * (n >> 7) + 128 + (n & 127); }
    __device__ void operator()(int m, int n, float a, float g) const { O[(size_t)m * DFF + n] = f2bf(a * (g * sigmoidf_(g))); } };

__global__ void __launch_bounds__(256) nv_gla(const bf16* __restrict__ Q, const bf16* __restrict__ Kb, const float* __restrict__ AF, const bf16* __restrict__ VVT,
                                              const float* __restrict__ w_af, const float* __restrict__ b_af, const float* __restrict__ w_ab, const float* __restrict__ b_ab,
                                              bf16* __restrict__ OF, bf16* __restrict__ OB) {
    const int dir = blockIdx.x & 1, h = (blockIdx.x >> 1) & 3, b = blockIdx.x >> 3, tid = threadIdx.x;
    __shared__ float sa[128], sk[128], sq[128], wl[16][128], bl[128];
    const float* wsrc = dir ? w_ab : w_af; const float* bsrc = dir ? b_ab : b_af;
    for (int i = tid; i < 16 * 128; i += 256) wl[i >> 7][i & 127] = wsrc[(i >> 7) * QKW + h * DK + (i & 127)];
    if (tid < 128) bl[tid] = bsrc[h * DK + tid];
    float S[128];
#pragma unroll
    for (int i = 0; i < 128; ++i) S[i] = 0.f;
    bf16* O = dir ? OB : OF;
    const bf16* vrow = VVT + (size_t)(h * DV + tid) * M;
    __syncthreads();
    for (int step = 0; step < TC + T; ++step) {
        const bool isctx = step < TC;
        int row;
        if (isctx) row = ML + b * TC + (dir ? TC - 1 - step : step);
        else { const int t = step - TC; row = b * T + (dir ? T - 1 - t : t); }
        if (tid < 128) {
            float z = bl[tid];
#pragma unroll
            for (int r = 0; r < 16; ++r) z += AF[(size_t)row * 32 + dir * 16 + r] * wl[r][tid];
            const float ls = fminf(z, 0.f) - log1pf(expf(-fabsf(z)));
            sa[tid] = expf(ls * (1.f / 16.f));
            sk[tid] = bf2f(Kb[(size_t)row * QKW + h * DK + tid]);
            sq[tid] = isctx ? 0.f : bf2f(Q[(size_t)row * QKW + h * DK + tid]);
        }
        const float v = bf2f(vrow[row]);
        __syncthreads();
        float o = 0.f;
#pragma unroll
        for (int i = 0; i < 128; ++i) { S[i] = sa[i] * S[i] + sk[i] * v; o += sq[i] * S[i]; }
        if (!isctx) O[(size_t)row * VW + h * DV + tid] = f2bf(o);
        __syncthreads();
    }
}

__global__ void nv_lnstat(const bf16* __restrict__ GVT, float* __restrict__ ST) {
    const int t = blockIdx.x * blockDim.x + threadIdx.x;
    float s = 0.f, s2 = 0.f;
    for (int c = 0; c < 1024; ++c) { const float v = bf2f(GVT[(size_t)c * ML + t]); s += v; }
    const float mean = s * (1.f / 1024.f);
    for (int c = 0; c < 1024; ++c) { const float d = bf2f(GVT[(size_t)c * ML + t]) - mean; s2 += d * d; }
    ST[2 * t] = mean; ST[2 * t + 1] = rsqrtf(s2 * (1.f / 1024.f) + EPS);
}
__global__ void __launch_bounds__(256) nv_chunkmlp(bf16* __restrict__ U, const bf16* __restrict__ GVT, const float* __restrict__ ST, const float* __restrict__ lng, const float* __restrict__ lnb,
                                                   const float* __restrict__ wsp, const float* __restrict__ bsp) {
    extern __shared__ float vt[];
    const int ch = blockIdx.x, g = blockIdx.y, tok0 = ch * 128, tid = threadIdx.x;
    for (int i = tid; i < 128 * 128; i += 256) { const int c = i >> 7, q = i & 127; const int cc = g * 128 + c;
        const float v = bf2f(GVT[(size_t)cc * ML + tok0 + q]);
        vt[q * 128 + c] = (v - ST[2 * (tok0 + q)]) * ST[2 * (tok0 + q) + 1] * lng[cc] + lnb[cc]; }
    __syncthreads();
    const int c = tid & 127;
    for (int p = tid >> 7; p < 128; p += 2) {
        float acc = 0.f;
        const float* wr = wsp + ((size_t)g * 128 + p) * 128;
        for (int q = 0; q < 128; ++q) acc += wr[q] * vt[q * 128 + c];
        acc += bsp[g * 128 + p];
        const size_t o = (size_t)(tok0 + p) * D + g * 128 + c;
        U[o] = f2bf(bf2f(U[o]) * acc);
    }
}
__global__ void nv_glaout(bf16* __restrict__ OF, const bf16* __restrict__ OB, const bf16* __restrict__ R, const float* __restrict__ gain) {
    const int w = blockIdx.x * (blockDim.x >> 6) + (threadIdx.x >> 6), lane = threadIdx.x & 63;
    const int row = w >> 2, h = w & 3;
    float v[4]; float ss = 0.f;
#pragma unroll
    for (int j = 0; j < 4; ++j) { const size_t o = (size_t)row * VW + h * DV + lane + 64 * j; v[j] = bf2f(OF[o]) + bf2f(OB[o]); ss += v[j] * v[j]; }
    const float rstd = rsqrtf(wave_sum(ss) * (1.f / DV) + EPS);
#pragma unroll
    for (int j = 0; j < 4; ++j) { const int cidx = h * DV + lane + 64 * j; const size_t o = (size_t)row * VW + cidx; OF[o] = f2bf(v[j] * rstd * gain[cidx] * bf2f(R[o])); }
}
__global__ void nv_finalnorm(float* __restrict__ X, const float* __restrict__ g) {
    const int row = blockIdx.x * (blockDim.x >> 6) + (threadIdx.x >> 6), lane = threadIdx.x & 63;
    float v[16]; float ss = 0.f;
#pragma unroll
    for (int j = 0; j < 16; ++j) { v[j] = X[(size_t)row * D + lane + 64 * j]; ss += v[j] * v[j]; }
    const float rstd = rsqrtf(wave_sum(ss) * (1.f / D) + EPS);
#pragma unroll
    for (int j = 0; j < 16; ++j) X[(size_t)row * D + lane + 64 * j] = v[j] * rstd * g[lane + 64 * j];
}


#ifndef MK_STAGGER
#define MK_STAGGER 0
#endif
namespace pg8 {
#define PG8_LAS __attribute__((address_space(3)))
typedef unsigned short bf16_t;
typedef short bf16x8 __attribute__((ext_vector_type(8)));
typedef float f32x4 __attribute__((ext_vector_type(4)));
typedef float f32x2 __attribute__((ext_vector_type(2)));
typedef unsigned u32x4 __attribute__((ext_vector_type(4)));
typedef unsigned u32x2 __attribute__((ext_vector_type(2)));
constexpr int BM = 256, BK = 64, HALF = 128, HTB = HALF * BK * 2, STAGE_BYTES = 8 * HTB;
__host__ __device__ __forceinline__ int lds_byte(int r, int c) { const int st = (r >> 4) * 2 + (c >> 5), rr = r & 15, cc = c & 31, ob = rr * 64 + cc * 2; return st * 1024 + (ob ^ (((ob >> 9) & 1) << 5)); }
__host__ __device__ __forceinline__ void stage_rc(int b, int& R, int& C) { const int st = b / 1024, sb = b % 1024, swz = sb ^ (((sb >> 9) & 1) << 5); R = (st >> 1) * 16 + swz / 64; C = (st & 1) * 32 + (swz % 64) / 2; }
__host__ __device__ __forceinline__ int perm32(int rho) { const int n = rho >> 4, i = rho & 15; return 8 * (i >> 2) + 4 * n + (i & 3); }
struct Unit { const char* pA; const char* pB; char* pO; int ldc, act, aux, pm, pn; };
__device__ __forceinline__ unsigned cvt_pk_bf16(float lo, float hi) { typedef __bf16 v2bf __attribute__((ext_vector_type(2))); typedef float v2f __attribute__((ext_vector_type(2)));
    const v2f x = {lo, hi}; const v2bf y = __builtin_convertvector(x, v2bf); return __builtin_bit_cast(unsigned, y); }
__device__ __forceinline__ f32x2 gelu_pk(f32x2 v) {
    const f32x2 av = __builtin_elementwise_abs(v), d = av * 0.2316418882f + 1.0f;
    f32x2 t; t.x = __builtin_amdgcn_rcpf(d.x); t.y = __builtin_amdgcn_rcpf(d.y);
    f32x2 q = t * 0.5307027145f + (-0.7265760135f); q = q * t + 0.7107068705f; q = q * t + (-0.142248368f); q = q * t + 0.127414796f; q = q * t;
    const f32x2 s = (v * v) * (-0.72134752044f);
    f32x2 e; e.x = __builtin_amdgcn_exp2f(s.x); e.y = __builtin_amdgcn_exp2f(s.y);
    const f32x2 m = v * (q * e), r = v - m;
    f32x2 o; o.x = v.x < 0.f ? m.x : r.x; o.y = v.y < 0.f ? m.y : r.y; return o;
}
__device__ __forceinline__ float ub8(unsigned w, int n) { return (float)((w >> (8 * n)) & 0xffu); }
__device__ __forceinline__ float sigm(float x) { return __builtin_amdgcn_rcpf(1.0f + __builtin_amdgcn_exp2f(x * -1.44269504089f)); }
__device__ __forceinline__ int xcd_remap(int L, int nwg) { const int q = nwg / 8, r = nwg % 8, xcd = L % 8, off = L / 8; return (xcd < r ? xcd * (q + 1) : r * (q + 1) + (xcd - r) * q) + off; }

template <class Epi, class Sched, bool ALIGN_EPI, bool SP2>
__device__ __forceinline__ void gemm_phase(PG8_LAS unsigned char* lds, const int K, const Sched& S, const Epi& E) {
    const int tid = threadIdx.x, wid = __builtin_amdgcn_readfirstlane(tid >> 6), lane = tid & 63, wr = wid >> 2, wc = wid & 3, fr = lane & 15, fq = lane >> 4;
    const int nt = K / BK;
    unsigned voffA[2], voffB[2];
#pragma unroll
    for (int i = 0; i < 2; ++i) { int R, C; stage_rc(tid * 16 + i * 8192, R, C); const int Rb = (R & ~31) + perm32(R & 31);
        voffA[i] = (unsigned)(R * K + C) * 2u; voffB[i] = (unsigned)(Rb * K + C) * 2u; }
    const size_t kstep = (size_t)(BK * 2);
    const size_t hstep = (size_t)HALF * K * 2;
    const unsigned ldsw = (unsigned)wid * 1024u;
    const int aoff = lds_byte(wr * 64 + fr, fq * 8), boff = lds_byte(wc * 32 + fr, fq * 8);
#define PG8_SA(b, h) (((b) * 2 + (h)) * HTB)
#define PG8_SB(b, h) ((4 + (b) * 2 + (h)) * HTB)
#define PG8_STAGE(bufoff, gbase, voff) do { _Pragma("unroll") for (int _i = 0; _i < 2; ++_i) \
        __builtin_amdgcn_global_load_lds((const unsigned*)((const char*)(gbase) + (voff)[_i]), (PG8_LAS unsigned*)(lds + (bufoff) + ldsw + _i * 8192), 16, 0, 0); } while (0)
#define PG8_LDA(dst, b, h) do { _Pragma("unroll") for (int m = 0; m < 4; ++m) _Pragma("unroll") for (int k = 0; k < 2; ++k) dst[m][k] = *(const PG8_LAS bf16x8*)(lds + PG8_SA(b, h) + aoff + m * 2048 + k * 1024); } while (0)
#define PG8_LDB(dst, b, h) do { _Pragma("unroll") for (int n = 0; n < 2; ++n) _Pragma("unroll") for (int k = 0; k < 2; ++k) dst[n][k] = *(const PG8_LAS bf16x8*)(lds + PG8_SB(b, h) + boff + n * 2048 + k * 1024); } while (0)
#define PG8_MMA(ai, bj, At, Bt) do { __builtin_amdgcn_s_setprio(1); _Pragma("unroll") for (int m = 0; m < 4; ++m) _Pragma("unroll") for (int n = 0; n < 2; ++n) _Pragma("unroll") for (int k = 0; k < 2; ++k) \
        acc[ai][bj][m][n] = __builtin_amdgcn_mfma_f32_16x16x32_bf16(Bt[n][k], At[m][k], acc[ai][bj][m][n], 0, 0, 0); __builtin_amdgcn_s_setprio(0); } while (0)
#define PG8_WAIT_V(n) asm volatile("s_waitcnt vmcnt(" #n ")" ::: "memory")
#define PG8_WAIT_L(n) asm volatile("s_waitcnt lgkmcnt(" #n ")" ::: "memory")
#define PG8_BAR __builtin_amdgcn_s_barrier()
#define PG8_SCHED __builtin_amdgcn_sched_barrier(0)
    Unit cur, nxt; int ui = 0;
    if (!S.next(0, cur)) return;
    if (MK_STAGGER > 0) { const unsigned long long t0_ = __builtin_amdgcn_s_memrealtime(); const unsigned long long dl_ = (unsigned long long)((blockIdx.x >> 3) & 3) * MK_STAGGER;
        while (__builtin_amdgcn_s_memrealtime() - t0_ < dl_) __builtin_amdgcn_s_sleep(8); }
    f32x4 acc[2][2][4][2];
#pragma unroll
    for (int a = 0; a < 2; ++a)
#pragma unroll
        for (int b = 0; b < 2; ++b)
#pragma unroll
            for (int m = 0; m < 4; ++m)
#pragma unroll
                for (int n = 0; n < 2; ++n) acc[a][b][m][n] = (f32x4){0.f, 0.f, 0.f, 0.f};
    bf16x8 At[4][2], B0[2][2], B1[2][2];
    const char* cA = cur.pA; const char* cB = cur.pB;
    if constexpr (SP2) {
        PG8_STAGE(PG8_SB(0, 0), cB, voffB); PG8_STAGE(PG8_SB(0, 1), cB + hstep, voffB); PG8_STAGE(PG8_SA(0, 0), cA, voffA); PG8_STAGE(PG8_SA(0, 1), cA + hstep, voffA);
        if (wr == 1) PG8_BAR;
        PG8_WAIT_V(2); PG8_BAR;
        PG8_STAGE(PG8_SB(1, 0), cB + kstep, voffB); PG8_STAGE(PG8_SA(1, 0), cA + kstep, voffA); PG8_STAGE(PG8_SB(1, 1), cB + hstep + kstep, voffB);
        PG8_WAIT_V(6); PG8_BAR;
    } else {
        PG8_STAGE(PG8_SB(0, 0), cB, voffB); PG8_STAGE(PG8_SA(0, 0), cA, voffA); PG8_STAGE(PG8_SB(0, 1), cB + hstep, voffB); PG8_STAGE(PG8_SA(0, 1), cA + hstep, voffA);
        if (wr == 1) PG8_BAR;
        PG8_WAIT_V(4); PG8_BAR;
        PG8_STAGE(PG8_SB(1, 0), cB + kstep, voffB); PG8_STAGE(PG8_SA(1, 0), cA + kstep, voffA); PG8_STAGE(PG8_SB(1, 1), cB + hstep + kstep, voffB);
        PG8_WAIT_V(6); PG8_BAR;
    }
    for (;;) {
        const bool has_next = S.next(ui + 1, nxt);
        const char* nA = has_next ? nxt.pA : cA; const char* nB = has_next ? nxt.pB : cB;
        for (int t = 0; t < nt; t += 2) {
            const bool last = (t == nt - 2);
            const char* a1 = cA + (size_t)(t + 1) * kstep;
            const char* a2 = last ? nA : cA + (size_t)(t + 2) * kstep; const char* b2 = last ? nB : cB + (size_t)(t + 2) * kstep;
            const char* a3 = a2 + kstep; const char* b3 = b2 + kstep;
            if constexpr (SP2) {
            PG8_LDB(B0, 0, 0); PG8_LDB(B1, 0, 1); PG8_SCHED; PG8_LDA(At, 0, 0); PG8_STAGE(PG8_SA(1, 1), a1 + hstep, voffA);
            PG8_WAIT_V(8); PG8_WAIT_L(0); PG8_BAR; PG8_MMA(0, 0, At, B0); PG8_MMA(0, 1, At, B1); PG8_BAR; PG8_SCHED;
            PG8_LDA(At, 0, 1); PG8_STAGE(PG8_SB(0, 0), b2, voffB); PG8_STAGE(PG8_SB(0, 1), b2 + hstep, voffB); PG8_STAGE(PG8_SA(0, 0), a2, voffA);
            PG8_WAIT_V(8); PG8_WAIT_L(0); PG8_BAR; PG8_MMA(1, 0, At, B0); PG8_MMA(1, 1, At, B1); PG8_BAR; PG8_SCHED;
            PG8_LDB(B0, 1, 0); PG8_LDB(B1, 1, 1); PG8_SCHED; PG8_LDA(At, 1, 0); PG8_STAGE(PG8_SA(0, 1), a2 + hstep, voffA);
            PG8_WAIT_V(8); PG8_WAIT_L(0); PG8_BAR; PG8_MMA(0, 0, At, B0); PG8_MMA(0, 1, At, B1); PG8_BAR; PG8_SCHED;
            PG8_LDA(At, 1, 1); PG8_STAGE(PG8_SB(1, 0), b3, voffB); PG8_STAGE(PG8_SB(1, 1), b3 + hstep, voffB); PG8_STAGE(PG8_SA(1, 0), a3, voffA);
            PG8_WAIT_V(8); PG8_WAIT_L(0); PG8_BAR; PG8_MMA(1, 0, At, B0); PG8_MMA(1, 1, At, B1); PG8_BAR; PG8_SCHED;
            } else {
            PG8_LDB(B0, 0, 0); PG8_SCHED; PG8_LDA(At, 0, 0); PG8_STAGE(PG8_SA(1, 1), a1 + hstep, voffA);
            PG8_WAIT_L(8); PG8_BAR; PG8_WAIT_L(0); PG8_MMA(0, 0, At, B0); PG8_BAR; PG8_SCHED;
            PG8_LDB(B1, 0, 1); PG8_STAGE(PG8_SB(0, 0), b2, voffB);
            PG8_BAR; PG8_WAIT_L(0); PG8_MMA(0, 1, At, B1); PG8_BAR;
            PG8_LDA(At, 0, 1); PG8_STAGE(PG8_SA(0, 0), a2, voffA);
            PG8_BAR; PG8_WAIT_L(0); PG8_MMA(1, 0, At, B0); PG8_BAR; PG8_SCHED;
            PG8_STAGE(PG8_SB(0, 1), b2 + hstep, voffB);
            PG8_WAIT_V(6); PG8_BAR; PG8_MMA(1, 1, At, B1); PG8_BAR;
            PG8_LDB(B0, 1, 0); PG8_SCHED; PG8_LDA(At, 1, 0); PG8_STAGE(PG8_SA(0, 1), a2 + hstep, voffA);
            PG8_WAIT_L(8); PG8_BAR; PG8_WAIT_L(0); PG8_MMA(0, 0, At, B0); PG8_BAR; PG8_SCHED;
            PG8_LDB(B1, 1, 1); PG8_STAGE(PG8_SB(1, 0), b3, voffB);
            PG8_BAR; PG8_WAIT_L(0); PG8_MMA(0, 1, At, B1); PG8_BAR;
            PG8_LDA(At, 1, 1); PG8_STAGE(PG8_SA(1, 0), a3, voffA);
            PG8_BAR; PG8_WAIT_L(0); PG8_MMA(1, 0, At, B0); PG8_BAR; PG8_SCHED;
            PG8_STAGE(PG8_SB(1, 1), b3 + hstep, voffB);
            PG8_WAIT_V(6); PG8_BAR; PG8_MMA(1, 1, At, B1); PG8_BAR;
            }
        }
        if constexpr (ALIGN_EPI) { if (wr == 0) PG8_BAR; }
        bool keep = false;
        if constexpr (Epi::CHAIN) { E.chain(acc, cur, wr, wc, fr, fq); keep = Epi::KEEP && (cur.aux == 0); } else E(acc, cur, wr, wc, fr, fq);
        if (!has_next) break;
        if (!keep) {
#pragma unroll
        for (int a = 0; a < 2; ++a)
#pragma unroll
            for (int b = 0; b < 2; ++b)
#pragma unroll
                for (int m = 0; m < 4; ++m)
#pragma unroll
                    for (int n = 0; n < 2; ++n) acc[a][b][m][n] = (f32x4){0.f, 0.f, 0.f, 0.f};
        }
        cur = nxt; cA = nA; cB = nB; ++ui;
        if constexpr (ALIGN_EPI) { if (wr == 1) PG8_BAR; }
    }
    PG8_WAIT_V(0);
    if constexpr (!ALIGN_EPI) { if (wr == 0) PG8_BAR; }
    PG8_BAR;
#undef PG8_SA
#undef PG8_SB
#undef PG8_STAGE
#undef PG8_LDA
#undef PG8_LDB
#undef PG8_MMA
#undef PG8_WAIT_V
#undef PG8_WAIT_L
#undef PG8_BAR
#undef PG8_SCHED
}

enum Act { ACT_NONE = 0, ACT_GELU = 1, ACT_SILU = 2, ACT_SIGM = 3, ACT_QSC = 4, ACT_AF32 = 5, ACT_VT = 6 };
struct EpiAct { static constexpr bool CHAIN = false;
    template <int ACT> __device__ __forceinline__ void run(const f32x4 (&acc)[2][2][4][2], const Unit& u, int r0, int c0) const {
        bf16_t* O = (bf16_t*)u.pO; if (ACT == ACT_VT) c0 = (c0 >> 6) * 65536 + (c0 & 63);
#pragma unroll
        for (int ai = 0; ai < 2; ++ai)
#pragma unroll
            for (int m = 0; m < 4; ++m) { bf16_t* rowp = O + (size_t)(r0 + ai * HALF + m * 16) * u.ldc + c0;
#pragma unroll
                for (int bj = 0; bj < 2; ++bj) { f32x4 v0 = acc[ai][bj][m][0], v1 = acc[ai][bj][m][1];
                    if (ACT == ACT_GELU) { f32x2 a = gelu_pk((f32x2){v0[0], v0[1]}), b = gelu_pk((f32x2){v0[2], v0[3]}), c = gelu_pk((f32x2){v1[0], v1[1]}), d = gelu_pk((f32x2){v1[2], v1[3]});
                        v0 = (f32x4){a.x, a.y, b.x, b.y}; v1 = (f32x4){c.x, c.y, d.x, d.y}; }
                    if (ACT == ACT_SILU) {
#pragma unroll
                        for (int j = 0; j < 4; ++j) { v0[j] = v0[j] * sigm(v0[j]); v1[j] = v1[j] * sigm(v1[j]); } }
                    if (ACT == ACT_SIGM) {
#pragma unroll
                        for (int j = 0; j < 4; ++j) { v0[j] = sigm(v0[j]); v1[j] = sigm(v1[j]); } }
                    if (ACT == ACT_QSC) { v0 = v0 * 0.08838834764831845f; v1 = v1 * 0.08838834764831845f; }
                    u32x4 w; w.x = cvt_pk_bf16(v0[0], v0[1]); w.y = cvt_pk_bf16(v0[2], v0[3]); w.z = cvt_pk_bf16(v1[0], v1[1]); w.w = cvt_pk_bf16(v1[2], v1[3]);
                    *(u32x4*)(rowp + (ACT == ACT_VT ? bj * 2 * 65536 : bj * HALF)) = w; } }
    }
    __device__ __forceinline__ void run_gate8(const f32x4 (&acc)[2][2][4][2], const Unit& u, int r0, int c0, float lo) const {
        unsigned char* O = (unsigned char*)u.pO;
#pragma unroll
        for (int ai = 0; ai < 2; ++ai)
#pragma unroll
            for (int m = 0; m < 4; ++m) { unsigned char* rowp = O + (size_t)(r0 + ai * HALF + m * 16) * u.ldc + c0;
#pragma unroll
                for (int bj = 0; bj < 2; ++bj) { u32x2 w = {0u, 0u};
#pragma unroll
                    for (int j = 0; j < 8; ++j) { const float x = j < 4 ? acc[ai][bj][m][0][j] : acc[ai][bj][m][1][j - 4];
                        const float q = fmaxf(__builtin_amdgcn_rcpf(__builtin_amdgcn_exp2f(x) * (1.0f / 255.0f) + (1.0f / 255.0f)), lo);
                        if (j < 4) w.x = __builtin_amdgcn_cvt_pk_u8_f32(q, j, w.x); else w.y = __builtin_amdgcn_cvt_pk_u8_f32(q, j - 4, w.y); }
                    *(u32x2*)(rowp + bj * HALF) = w; } }
    }
    __device__ __forceinline__ void operator()(const f32x4 (&acc)[2][2][4][2], const Unit& u, int wr, int wc, int fr, int fq) const {
        const int r0 = wr * 64 + fr, c0 = wc * 32 + 8 * fq;
        switch (u.act) {
        case ACT_NONE: run<ACT_NONE>(acc, u, r0, c0); break;
        case ACT_GELU: run<ACT_GELU>(acc, u, r0, c0); break;
        case ACT_SILU: run<ACT_SILU>(acc, u, r0, c0); break;
        case ACT_SIGM: run_gate8(acc, u, r0, c0, u.aux ? 1.0f : 0.0f); break;
        case ACT_QSC:  run<ACT_QSC>(acc, u, r0, c0); break;
        case ACT_VT:   run<ACT_VT>(acc, u, r0, c0); break;
        default:
            if (wc == 0) { float* O = (float*)u.pO;
#pragma unroll
                for (int ai = 0; ai < 2; ++ai)
#pragma unroll
                    for (int m = 0; m < 4; ++m) { float* rowp = O + (size_t)(r0 + ai * HALF + m * 16) * u.ldc + 8 * fq;
                        *(f32x4*)rowp = acc[ai][0][m][0]; *(f32x4*)(rowp + 4) = acc[ai][0][m][1]; } }
            break;
        }
    }
};
struct EpiMrg { static constexpr bool CHAIN = true, KEEP = true; const unsigned char* GA; const unsigned char* GB; bf16_t* Y;
    __device__ __forceinline__ void chain(f32x4 (&acc)[2][2][4][2], const Unit& u, int wr, int wc, int fr, int fq) const {
        const size_t o0 = (size_t)(u.pm * BM + wr * 64 + fr) * 1024 + u.pn * BM + wc * 32 + 8 * fq;
        if (u.aux == 0) {
#pragma unroll
            for (int ai = 0; ai < 2; ++ai)
#pragma unroll
                for (int m = 0; m < 4; ++m)
#pragma unroll
                    for (int bj = 0; bj < 2; ++bj) { const size_t o = o0 + (size_t)(ai * HALF + m * 16) * 1024 + bj * HALF;
                        const u32x2 a = *(const u32x2*)(GA + o), b = *(const u32x2*)(GB + o);
                        const float ra[8] = {ub8(a.x, 0), ub8(a.x, 1), ub8(a.x, 2), ub8(a.x, 3),
                                             ub8(a.y, 0), ub8(a.y, 1), ub8(a.y, 2), ub8(a.y, 3)};
                        const float rb[8] = {ub8(b.x, 0), ub8(b.x, 1), ub8(b.x, 2), ub8(b.x, 3),
                                             ub8(b.y, 0), ub8(b.y, 1), ub8(b.y, 2), ub8(b.y, 3)};
#pragma unroll
                        for (int e = 0; e < 8; ++e) { const float r = ra[e] * __builtin_amdgcn_rcpf(rb[e]); if (e < 4) acc[ai][bj][m][0][e] *= r; else acc[ai][bj][m][1][e - 4] *= r; } }
        } else {
#pragma unroll
            for (int ai = 0; ai < 2; ++ai)
#pragma unroll
                for (int m = 0; m < 4; ++m)
#pragma unroll
                    for (int bj = 0; bj < 2; ++bj) { const size_t o = o0 + (size_t)(ai * HALF + m * 16) * 1024 + bj * HALF;
                        const u32x2 g = *(const u32x2*)(GB + o); constexpr float s8 = 1.0f / 255.0f;
                        f32x4 v0 = acc[ai][bj][m][0], v1 = acc[ai][bj][m][1];
                        v0[0] *= ub8(g.x, 0) * s8; v0[1] *= ub8(g.x, 1) * s8; v0[2] *= ub8(g.x, 2) * s8; v0[3] *= ub8(g.x, 3) * s8;
                        v1[0] *= ub8(g.y, 0) * s8; v1[1] *= ub8(g.y, 1) * s8; v1[2] *= ub8(g.y, 2) * s8; v1[3] *= ub8(g.y, 3) * s8;
                        u32x4 w; w.x = cvt_pk_bf16(v0[0], v0[1]); w.y = cvt_pk_bf16(v0[2], v0[3]); w.z = cvt_pk_bf16(v1[0], v1[1]); w.w = cvt_pk_bf16(v1[2], v1[3]);
                        *(u32x4*)(Y + o) = w; }
        }
    }
};
struct EpiRes { const float* X; static constexpr bool CHAIN = false; const float* MOD; float* O; int goff;
    __device__ __forceinline__ void operator()(const f32x4 (&acc)[2][2][4][2], const Unit& u, int wr, int wc, int fr, int fq) const {
        const int cb = u.pn * BM + wc * 32 + 8 * fq; const size_t o0 = (size_t)(u.pm * BM + wr * 64 + fr) * 1024 + cb;
        const float* gp = MOD + ((u.pm * BM) / T) * 6144 + goff + cb;
        f32x4 g[2][2];
#pragma unroll
        for (int bj = 0; bj < 2; ++bj) { g[bj][0] = *(const f32x4*)(gp + bj * HALF); g[bj][1] = *(const f32x4*)(gp + bj * HALF + 4); }
#pragma unroll
        for (int ai = 0; ai < 2; ++ai)
#pragma unroll
            for (int m = 0; m < 4; ++m)
#pragma unroll
                for (int bj = 0; bj < 2; ++bj) { const size_t o = o0 + (size_t)(ai * HALF + m * 16) * 1024 + bj * HALF;
                    const f32x4 x0 = *(const f32x4*)(X + o), x1 = *(const f32x4*)(X + o + 4);
                    *(f32x4*)(O + o) = x0 + g[bj][0] * acc[ai][bj][m][0]; *(f32x4*)(O + o + 4) = x1 + g[bj][1] * acc[ai][bj][m][1]; }
    }
};
struct EpiFin { static constexpr bool CHAIN = true, KEEP = false; const bf16_t* X1; const float* GV2; const float* MOD; const float* FG; float* O; unsigned long long* ROWSS2; unsigned* CNT;
    __device__ __forceinline__ void chain(f32x4 (&acc)[2][2][4][2], const Unit& u, int wr, int wc, int fr, int fq) const {
        const int cb = u.pn * BM + wc * 32 + 8 * fq, r0 = u.pm * BM + wr * 64 + fr; const size_t o0 = (size_t)r0 * 1024 + cb;
        const float* gp = MOD + ((u.pm * BM) / T) * 6144 + 5120 + cb;
        {   f32x4 g[2][2], iv[2][2]; float ssv[8]; const float* vp = GV2 + ((u.pm * BM) / T) * 1024 + cb;
#pragma unroll
            for (int bj = 0; bj < 2; ++bj) { g[bj][0] = *(const f32x4*)(gp + bj * HALF); g[bj][1] = *(const f32x4*)(gp + bj * HALF + 4);
                const f32x4 v0 = *(const f32x4*)(vp + bj * HALF), v1 = *(const f32x4*)(vp + bj * HALF + 4);
#pragma unroll
                for (int e = 0; e < 4; ++e) { iv[bj][0][e] = 1.0f / v0[e]; iv[bj][1][e] = 1.0f / v1[e]; } }
#pragma unroll
            for (int ai = 0; ai < 2; ++ai)
#pragma unroll
                for (int m = 0; m < 4; ++m) { float ss = 0.f;
#pragma unroll
                    for (int bj = 0; bj < 2; ++bj) { const size_t o = o0 + (size_t)(ai * HALF + m * 16) * 1024 + bj * HALF;
                        const u32x4 xr = *(const u32x4*)(X1 + o);
                        const f32x4 xa = {__uint_as_float(xr.x << 16), __uint_as_float(xr.x & 0xffff0000u), __uint_as_float(xr.y << 16), __uint_as_float(xr.y & 0xffff0000u)}, xb = {__uint_as_float(xr.z << 16), __uint_as_float(xr.z & 0xffff0000u), __uint_as_float(xr.w << 16), __uint_as_float(xr.w & 0xffff0000u)};
                        const f32x4 x0 = xa * iv[bj][0] + g[bj][0] * acc[ai][bj][m][0], x1 = xb * iv[bj][1] + g[bj][1] * acc[ai][bj][m][1];
                        acc[ai][bj][m][0] = x0; acc[ai][bj][m][1] = x1;
                        ss += (x0[0] * x0[0] + x0[1] * x0[1]) + (x0[2] * x0[2] + x0[3] * x0[3]) + (x1[0] * x1[0] + x1[1] * x1[1]) + (x1[2] * x1[2] + x1[3] * x1[3]); }
                    ss += __shfl_xor(ss, 16); ss += __shfl_xor(ss, 32); ssv[ai * 4 + m] = ss;
                    asm volatile("" ::: "memory"); }
#pragma unroll
            for (int h = 0; h < 2; ++h) { const int gs = 2 * fq + h; float v = 0.f;
#pragma unroll
                for (int g2 = 0; g2 < 8; ++g2) v = gs == g2 ? ssv[g2] : v;
                atomicAdd(ROWSS2 + r0 + (gs >> 2) * HALF + (gs & 3) * 16, (unsigned long long)(v * 1073741824.0f) + (1ull << 58)); }
        }
        f32x4 fg[2][2];
#pragma unroll
        for (int bj = 0; bj < 2; ++bj) { fg[bj][0] = *(const f32x4*)(FG + cb + bj * HALF); fg[bj][1] = *(const f32x4*)(FG + cb + bj * HALF + 4); }
        unsigned long long tot[2][4];
        for (unsigned spins = 0;; ++spins) { bool ok = true;
#pragma unroll
            for (int ai = 0; ai < 2; ++ai)
#pragma unroll
                for (int m = 0; m < 4; ++m) tot[ai][m] = __hip_atomic_load(ROWSS2 + r0 + ai * HALF + m * 16, __ATOMIC_RELAXED, __HIP_MEMORY_SCOPE_AGENT);
#pragma unroll
            for (int ai = 0; ai < 2; ++ai)
#pragma unroll
                for (int m = 0; m < 4; ++m) ok = ok && ((tot[ai][m] >> 58) >= 16ull);
            if (__builtin_amdgcn_ballot_w64(!ok) == 0ull || spins > (1u << 20)) break;
            __builtin_amdgcn_s_sleep(1); }
#pragma unroll
        for (int ai = 0; ai < 2; ++ai)
#pragma unroll
            for (int m = 0; m < 4; ++m) tot[ai][m] &= ((1ull << 58) - 1ull);
#pragma unroll
        for (int ai = 0; ai < 2; ++ai)
#pragma unroll
            for (int m = 0; m < 4; ++m) {
                const float rs = __builtin_amdgcn_rsqf((float)tot[ai][m] * (1.0f / (1073741824.0f * 1024.0f)) + EPS);
#pragma unroll
                for (int bj = 0; bj < 2; ++bj) { const size_t o = o0 + (size_t)(ai * HALF + m * 16) * 1024 + bj * HALF;
                    *(f32x4*)(O + o) = acc[ai][bj][m][0] * rs * fg[bj][0]; *(f32x4*)(O + o + 4) = acc[ai][bj][m][1] * rs * fg[bj][1]; } }
    }
};
struct EpiSwi { bf16_t* HBp; static constexpr bool CHAIN = false;
    __device__ __forceinline__ void operator()(const f32x4 (&acc)[2][2][4][2], const Unit& u, int wr, int wc, int fr, int fq) const {
        const size_t o0 = (size_t)(u.pm * BM + wr * 64 + fr) * DFF + u.pn * HALF + wc * 32 + 8 * fq;
#pragma unroll
        for (int ai = 0; ai < 2; ++ai)
#pragma unroll
            for (int m = 0; m < 4; ++m) { const f32x4 a0 = acc[ai][0][m][0], a1 = acc[ai][0][m][1], g0 = acc[ai][1][m][0], g1 = acc[ai][1][m][1]; f32x4 v0, v1;
#pragma unroll
                for (int j = 0; j < 4; ++j) { v0[j] = a0[j] * g0[j] * sigm(g0[j]); v1[j] = a1[j] * g1[j] * sigm(g1[j]); }
                u32x4 w; w.x = cvt_pk_bf16(v0[0], v0[1]); w.y = cvt_pk_bf16(v0[2], v0[3]); w.z = cvt_pk_bf16(v1[0], v1[1]); w.w = cvt_pk_bf16(v1[2], v1[3]);
                *(u32x4*)(HBp + o0 + (size_t)(ai * HALF + m * 16) * DFF) = w; }
    }
};

struct EpiRes2 { static constexpr bool CHAIN = false; const float* X; const float* MOD; const float* GV2; bf16_t* X1; bf16_t* A2; unsigned long long* ROWSS;
    __device__ __forceinline__ void operator()(const f32x4 (&acc)[2][2][4][2], const Unit& u, int wr, int wc, int fr, int fq) const {
        const int cb = u.pn * BM + wc * 32 + 8 * fq, bidx = (u.pm * BM) / T; const int r0 = u.pm * BM + wr * 64 + fr; const size_t o0 = (size_t)r0 * 1024 + cb;
        const float* gp = MOD + bidx * 6144 + 2048 + cb; const float* vp = GV2 + bidx * 1024 + cb;
        f32x4 g[2][2], gv[2][2]; float ssv[8];
#pragma unroll
        for (int bj = 0; bj < 2; ++bj) { g[bj][0] = *(const f32x4*)(gp + bj * HALF); g[bj][1] = *(const f32x4*)(gp + bj * HALF + 4); gv[bj][0] = *(const f32x4*)(vp + bj * HALF); gv[bj][1] = *(const f32x4*)(vp + bj * HALF + 4); }
#pragma unroll
        for (int ai = 0; ai < 2; ++ai)
#pragma unroll
            for (int m = 0; m < 4; ++m) { float ss = 0.f;
#pragma unroll
                for (int bj = 0; bj < 2; ++bj) { const size_t o = o0 + (size_t)(ai * HALF + m * 16) * 1024 + bj * HALF;
                    const f32x4 x0 = *(const f32x4*)(X + o) + g[bj][0] * acc[ai][bj][m][0], x1 = *(const f32x4*)(X + o + 4) + g[bj][1] * acc[ai][bj][m][1];
                    ss += (x0[0] * x0[0] + x0[1] * x0[1]) + (x0[2] * x0[2] + x0[3] * x0[3]) + (x1[0] * x1[0] + x1[1] * x1[1]) + (x1[2] * x1[2] + x1[3] * x1[3]);
                    const f32x4 a0 = x0 * gv[bj][0], a1 = x1 * gv[bj][1];
                    u32x4 w; w.x = cvt_pk_bf16(a0[0], a0[1]); w.y = cvt_pk_bf16(a0[2], a0[3]); w.z = cvt_pk_bf16(a1[0], a1[1]); w.w = cvt_pk_bf16(a1[2], a1[3]);
                    *(u32x4*)(A2 + o) = w; }
                ss += __shfl_xor(ss, 16); ss += __shfl_xor(ss, 32); ssv[ai * 4 + m] = ss; }
#pragma unroll
        for (int h = 0; h < 2; ++h) { const int gs = 2 * fq + h; float v = 0.f;
#pragma unroll
            for (int g = 0; g < 8; ++g) v = gs == g ? ssv[g] : v;
            atomicAdd(ROWSS + r0 + (gs >> 2) * HALF + (gs & 3) * 16, (unsigned long long)(v * 1073741824.0f)); }
    }
};
struct EpiSwi2 { static constexpr bool CHAIN = false; bf16_t* HBp; const unsigned long long* ROWSS; const float* CV;
    __device__ __forceinline__ void operator()(const f32x4 (&acc)[2][2][4][2], const Unit& u, int wr, int wc, int fr, int fq) const {
        const int r0 = u.pm * BM + wr * 64 + fr, cc = u.pn * HALF + wc * 32 + 8 * fq, bidx = (u.pm * BM) / T;
        const size_t o0 = (size_t)r0 * DFF + cc;
        const float* cp = CV + bidx * (2 * DFF) + cc;
        const f32x4 ca0 = *(const f32x4*)cp, ca1 = *(const f32x4*)(cp + 4), cg0 = *(const f32x4*)(cp + DFF), cg1 = *(const f32x4*)(cp + DFF + 4);
        float rsv[2][4];
#pragma unroll
        for (int ai = 0; ai < 2; ++ai)
#pragma unroll
            for (int m = 0; m < 4; ++m) rsv[ai][m] = (float)ROWSS[r0 + ai * HALF + m * 16];
#pragma unroll
        for (int ai = 0; ai < 2; ++ai)
#pragma unroll
            for (int m = 0; m < 4; ++m) { const float rs = __builtin_amdgcn_rsqf(rsv[ai][m] * (1.0f / (1073741824.0f * 1024.0f)) + EPS);
                const f32x4 a0 = acc[ai][0][m][0] * rs + ca0, a1 = acc[ai][0][m][1] * rs + ca1, g0 = acc[ai][1][m][0] * rs + cg0, g1 = acc[ai][1][m][1] * rs + cg1; f32x4 v0, v1;
#pragma unroll
                for (int j = 0; j < 4; ++j) { v0[j] = a0[j] * g0[j] * sigm(g0[j]); v1[j] = a1[j] * g1[j] * sigm(g1[j]); }
                u32x4 w; w.x = cvt_pk_bf16(v0[0], v0[1]); w.y = cvt_pk_bf16(v0[2], v0[3]); w.z = cvt_pk_bf16(v1[0], v1[1]); w.w = cvt_pk_bf16(v1[2], v1[3]);
                *(u32x4*)(HBp + o0 + (size_t)(ai * HALF + m * 16) * DFF) = w; }
    }
};
struct OrderGrid { const char* A; const char* Bt; int nM, nN, K, G, c;
    __device__ __forceinline__ bool next(int i, Unit& u) const {
        const int nwg = nM * nN; const long L = (long)i * G + c; if (L >= nwg) return false;
        const int w = xcd_remap((int)L, nwg);
        const int nig = 8 * nN, gid = w / nig, fm = gid * 8, gsz = (nM - fm) < 8 ? (nM - fm) : 8;
        u.pm = fm + ((w % nig) % gsz); u.pn = (w % nig) / gsz;
        u.pA = A + (size_t)u.pm * 256 * K * 2; u.pB = Bt + (size_t)u.pn * 256 * K * 2; u.pO = nullptr; u.ldc = 0; u.act = 0; u.aux = 0; return true;
    }
};
struct OrderMrg { const char* A0; const char* B0; const char* A1; const char* B1; int G, c;
    __device__ __forceinline__ bool next(int i, Unit& u) const {
        constexpr int nM = 128, nN = 4, nwg = nM * nN; const long L = (long)(i >> 1) * G + c; if (L >= nwg) return false;
        const int w = xcd_remap((int)L, nwg);
        const int nig = 8 * nN, gid = w / nig, fm = gid * 8;
        u.pm = fm + ((w % nig) & 7); u.pn = (w % nig) >> 3; u.aux = i & 1;
        u.pA = ((i & 1) ? A1 : A0) + (size_t)u.pm * 256 * 1024 * 2; u.pB = ((i & 1) ? B1 : B0) + (size_t)u.pn * 256 * 1024 * 2; u.pO = nullptr; u.ldc = 0; u.act = 0; return true;
    }
};
struct Order1A { const char* H; const char* WT1A; const char* WTVV; char* Q; char* Kb; char* AFp; char* VVT; int G, c;
    __device__ __forceinline__ bool next(int i, Unit& u) const {
        constexpr int NWG = 1208; const long L = (long)i * G + c; if (L >= NWG) return false;
        int w = xcd_remap((int)L, NWG);
        int tok, col; bool swapped;
        if (w < 640) { const int gid = w / 40, r = w % 40; tok = gid * 8 + (r & 7); col = r >> 3; swapped = false; }
        else if (w < 1152) { w -= 640; const int gid = w / 32, r = w & 31; tok = gid * 8 + (r & 7); col = r >> 3; swapped = true; }
        else if (w < 1176) { w -= 1152; tok = 128 + (w & 7); col = 2 + (w >> 3); swapped = false; }
        else { w -= 1176; tok = 128 + (w & 7); col = w >> 3; swapped = true; }
        u.pm = tok; u.pn = col; u.aux = 0;
        const char* hp = H + (size_t)tok * 256 * 1024 * 2;
        if (swapped) { u.pA = WTVV + (size_t)col * 256 * 1024 * 2; u.pB = hp; u.pO = VVT + ((size_t)(tok * 4) * 65536 + (size_t)(col * 256) * 64) * 2; u.ldc = 64; u.act = ACT_VT; }
        else { u.pA = hp; u.pB = WT1A + (size_t)col * 256 * 1024 * 2;
            if (col < 2) { u.pO = Q + ((size_t)(tok * 256) * QKW + col * 256) * 2; u.ldc = QKW; u.act = ACT_NONE; }
            else if (col < 4) { u.pO = Kb + ((size_t)(tok * 256) * QKW + (col - 2) * 256) * 2; u.ldc = QKW; u.act = ACT_NONE; }
            else { u.pO = AFp + (size_t)(tok * 256) * 32 * 4; u.ldc = 32; u.act = ACT_AF32; } }
        return true;
    }
};
struct Order1B { const char* H; const char* WT1B; const char* WTVA; char* U; char* R; char* GA; char* GB; char* GVT; int G, c;
    __device__ __forceinline__ bool next(int i, Unit& u) const {
        const long L = (long)i * G + c; if (L >= 2560) return false;
        int w = L < 2048 ? xcd_remap((int)L, 2048) : 2048 + xcd_remap((int)L - 2048, 512);
        u.aux = 0;
        if (w < 2048) { const int gid = w >> 7, r = w & 127, tok = gid * 8 + (r & 7), col = r >> 3; u.pm = tok; u.pn = col;
            u.pA = H + (size_t)tok * 256 * 1024 * 2; u.pB = WT1B + (size_t)col * 256 * 1024 * 2; u.ldc = 1024;
            const int seg = col >> 2; const long long dR = R - U, dGA = GA - U, dGB = GB - U;
            const long long dsel = (seg == 1 ? dR : 0ll) + (seg == 2 ? dGA : 0ll) + (seg == 3 ? dGB : 0ll);
            u.act = seg == 0 ? ACT_GELU : seg == 1 ? ACT_SILU : ACT_SIGM;
            const size_t eo = (size_t)(tok * 256) * 1024 + (col & 3) * 256; u.pO = U + dsel + (seg >= 2 ? eo : eo * 2); u.aux = seg == 3 ? 1 : 0; }
        else { w -= 2048; const int gid = w >> 5, r = w & 31, tok = gid * 8 + (r & 7), ch = r >> 3; u.pm = tok; u.pn = ch;
            u.pA = WTVA + (size_t)ch * 256 * 1024 * 2; u.pB = H + (size_t)tok * 256 * 1024 * 2; u.pO = GVT + ((size_t)(ch * 256) * ML + tok * 256) * 2; u.ldc = ML; u.act = ACT_GELU; }
        return true;
    }
};
}

#define LAS __attribute__((address_space(3)))

namespace gla {
typedef short bf16x8 __attribute__((ext_vector_type(8)));
typedef float f32x4 __attribute__((ext_vector_type(4)));
typedef unsigned u32x4 __attribute__((ext_vector_type(4)));
typedef unsigned u32x2 __attribute__((ext_vector_type(2)));
constexpr int PKG_L_BYTES = 41984, PKG_C_BYTES = 17408, OFF_EL = 0, OFF_KS = 1024, OFF_QD = 17408, OFF_AT = 33792;
constexpr int SLOT_BYTES = PKG_L_BYTES + 8192, OFF_V = PKG_L_BYTES;
constexpr size_t WS_PKGC = 487 * MiB, WS_PKGD = 500 * MiB;
static_assert(WS_PKG + (size_t)64 * 64 * PKG_L_BYTES <= WS_OF && WS_PKGC + (size_t)64 * 4 * PKG_C_BYTES <= WS_END, "package regions");
constexpr float LOG2E = 1.44269504088896f;
__device__ __forceinline__ unsigned cvt_pk(float lo, float hi) { typedef __bf16 v2bf __attribute__((ext_vector_type(2))); typedef float v2f __attribute__((ext_vector_type(2)));
    const v2f x = {lo, hi}; const v2bf y = __builtin_convertvector(x, v2bf); return __builtin_bit_cast(unsigned, y); }
__device__ __forceinline__ float bfr(float f) { return __uint_as_float((__float_as_uint(f) + 0x7fffu + ((__float_as_uint(f) >> 16) & 1u)) & 0xffff0000u); }
__device__ __forceinline__ char* pkg_ptr(unsigned char* ws, int seq, int ch) {
    return ch < 4 ? (char*)ws + WS_PKGC + (size_t)(seq * 4 + ch) * PKG_C_BYTES : (char*)ws + WS_PKG + (size_t)(seq * 64 + (ch - 4)) * PKG_L_BYTES;
}
#define GLA_BAR() do { asm volatile("s_waitcnt lgkmcnt(0)" ::: "memory"); __builtin_amdgcn_s_barrier(); asm volatile("" ::: "memory"); } while (0)

__device__ __forceinline__ void prepass_phase(LAS unsigned char* lds, unsigned char* ws, const float* w_af, const float* b_af, const float* w_ab, const float* b_ab, int G, int c) {
    const int tid = threadIdx.x, w = __builtin_amdgcn_readfirstlane(tid >> 6), lane = tid & 63, lc = lane & 15, lg = lane >> 4;
    LAS float* B2 = (LAS float*)lds;
    LAS float* BL = (LAS float*)(lds + 33792);
    LAS unsigned char* QD = lds + 34816;
    LAS unsigned char* KI = lds + 51200;
    LAS unsigned short* KST = (LAS unsigned short*)(lds + 67584);
    LAS float* AFL = (LAS float*)(lds + 83968);
    LAS float* WL = (LAS float*)(lds + 93184);
    const bf16* Qg = (const bf16*)(ws + WS_Q); const bf16* Kg = (const bf16*)(ws + WS_K); const float* AF = (const float*)(ws + WS_AF);
    constexpr int NITEMS = 64 * 68;
    struct In1 { f32x4 araw; float bias; };
    struct In2 { u32x4 k[2]; u32x4 q[2]; };
    auto load1 = [&](int item_, In1& p) { const int item = item_ < NITEMS ? item_ : NITEMS - 1; const int seq = item / 68, ch = item - seq * 68, dir = seq >> 5, b = (seq >> 2) & 7, h = seq & 3;
        const int row0 = ch < 4 ? ML + b * TC + ch * 64 : b * T + (ch - 4) * 64, dk = 16 * w + lc;
        p.bias = (dir ? b_ab : b_af)[h * DK + dk];
        p.araw = *(const f32x4*)(AF + (size_t)row0 * 32 + tid * 4); };
    auto put_af = [&](const In1& p) { float hi[4], lo[4];
#pragma unroll
        for (int j = 0; j < 4; ++j) { hi[j] = bfr(p.araw[j]); lo[j] = bfr(p.araw[j] - hi[j]); }
        u32x2 h, l; h.x = (__float_as_uint(hi[0]) >> 16) | (__float_as_uint(hi[1]) & 0xffff0000u); h.y = (__float_as_uint(hi[2]) >> 16) | (__float_as_uint(hi[3]) & 0xffff0000u);
        l.x = (__float_as_uint(lo[0]) >> 16) | (__float_as_uint(lo[1]) & 0xffff0000u); l.y = (__float_as_uint(lo[2]) >> 16) | (__float_as_uint(lo[3]) & 0xffff0000u);
        LAS unsigned char* rp = (LAS unsigned char*)AFL + (tid >> 3) * 144 + (tid & 7) * 8; *(LAS u32x2*)rp = h; *(LAS u32x2*)(rp + 64) = l; };
    auto load2 = [&](int item_, In2& p) { const int item = item_ < NITEMS ? item_ : NITEMS - 1; const int seq = item / 68, ch = item - seq * 68, b = (seq >> 2) & 7, h = seq & 3;
        const int row0 = ch < 4 ? ML + b * TC + ch * 64 : b * T + (ch - 4) * 64;
        const bf16* qsrc = Qg + (ch < 4 ? (long long)(Kg - Qg) : 0ll);
#pragma unroll
        for (int rep = 0; rep < 2; ++rep) { const int f = w + 8 * rep, it = f >> 2, sidx = f & 3, i = 16 * it + lc;
            const size_t ro = (size_t)(row0 + i) * QKW + h * DK + 32 * sidx + 8 * lg;
            p.k[rep] = *(const u32x4*)(Kg + ro); p.q[rep] = *(const u32x4*)(qsrc + ro); } };
    struct Def { u32x4 aw, k0, k1; char* pq; char* pk; };
    auto flush = [&](const Def& d) { *(u32x4*)(d.pq + OFF_AT + ((w & 3) * 2 + (w >> 2)) * 1024 + lane * 16) = d.aw; *(u32x4*)(d.pk + OFF_KS + (2 * w) * 1024 + lane * 16) = d.k0; *(u32x4*)(d.pk + OFF_KS + (2 * w + 1) * 1024 + lane * 16) = d.k1; };
    auto body = [&](int item_, const In1& c1, const In2& c2, In1& n1, In2& n2, const Def& din, Def& dout) {
        const bool oob = item_ >= NITEMS; const int item = oob ? NITEMS - 1 : item_;
        const int seq = item / 68, ch = item - seq * 68, dir = seq >> 5, hh = seq & 3;
        const bool isctx = ch < 4;
        char* pkr = pkg_ptr(ws, seq, ch); char* dummy = (char*)ws + WS_PKGD;
        char* pk = dummy + (oob ? 0ll : (long long)(pkr - dummy));
        char* pkq = dummy + ((oob || isctx) ? 0ll : (long long)(pkr - dummy));
        {
            const int dk = 16 * w + lc;
            bf16x8 bh, bl;
#pragma unroll
            for (int j = 0; j < 8; ++j) { const float wv = WL[(dir * 16 + ((8 * lg + j) & 15)) * 512 + hh * DK + dk]; const float hi = bfr(wv); const float lo = bfr(wv - hi);
                bh[j] = (short)(__float_as_uint(hi) >> 16); bl[j] = lg < 2 ? (short)(__float_as_uint(lo) >> 16) : (short)0; }
            const float bias = c1.bias;
            float g2[4][4];
#pragma unroll
            for (int tt = 0; tt < 4; ++tt) {
                const bf16x8 af = *(const LAS bf16x8*)((const LAS unsigned char*)AFL + (16 * tt + lc) * 144 + (lg < 2 ? 0 : 64) + (dir * 16 + 8 * (lg & 1)) * 2);
                f32x4 z = (f32x4){0.f, 0.f, 0.f, 0.f};
                z = __builtin_amdgcn_mfma_f32_16x16x32_bf16(af, bh, z, 0, 0, 0);
                z = __builtin_amdgcn_mfma_f32_16x16x32_bf16(af, bl, z, 0, 0, 0);
#pragma unroll
                for (int r = 0; r < 4; ++r) { const float zz = z[r] + bias;
                    const float ls2 = fminf(zz, 0.f) * LOG2E - __builtin_amdgcn_logf(1.0f + __builtin_amdgcn_exp2f(-fabsf(zz) * LOG2E));
                    g2[tt][r] = ls2 * (1.0f / 16.0f); }
            }
            float pre[4][4], tot[4], all[4][4];
#pragma unroll
            for (int tt = 0; tt < 4; ++tt) { pre[tt][0] = g2[tt][0]; pre[tt][1] = pre[tt][0] + g2[tt][1]; pre[tt][2] = pre[tt][1] + g2[tt][2]; pre[tt][3] = pre[tt][2] + g2[tt][3]; tot[tt] = pre[tt][3]; }
#pragma unroll
            for (int tt = 0; tt < 4; ++tt)
#pragma unroll
                for (int q = 0; q < 4; ++q) all[tt][q] = __shfl(tot[tt], lc + 16 * q);
            float run = 0.f, total;
            float offs[4];
#pragma unroll
            for (int tt = 0; tt < 4; ++tt) { offs[tt] = run + (lg > 0 ? all[tt][0] : 0.f) + (lg > 1 ? all[tt][1] : 0.f) + (lg > 2 ? all[tt][2] : 0.f); run += (all[tt][0] + all[tt][1]) + (all[tt][2] + all[tt][3]); }
            total = run;
#pragma unroll
            for (int tt = 0; tt < 4; ++tt)
#pragma unroll
                for (int r = 0; r < 4; ++r) { const float incl = offs[tt] + pre[tt][r]; const float bb = dir ? (total - incl) + g2[tt][r] : incl; B2[(16 * tt + 4 * lg + r) * 132 + dk] = bb; }
            { const float et = __builtin_amdgcn_exp2f(total); BL[dk] = et; ((float*)(pk + OFF_EL))[dk] = et; }
        }
        GLA_BAR();
        load1(item_ + G, n1);
        flush(din);
#pragma unroll
        for (int rep = 0; rep < 2; ++rep) {
            const int f = w + 8 * rep, it = f >> 2, s = f & 3, i = 16 * it + lc, d0 = 32 * s + 4 * lg, d1 = d0 + 16;
            const f32x4 b0 = *(const LAS f32x4*)(B2 + i * 132 + d0), b1 = *(const LAS f32x4*)(B2 + i * 132 + d1), l0 = *(const LAS f32x4*)(BL + d0), l1 = *(const LAS f32x4*)(BL + d1);
            const u32x2 k0 = {c2.k[rep].x, c2.k[rep].y}, k1 = {c2.k[rep].z, c2.k[rep].w};
            float kv[8] = {__uint_as_float(k0.x << 16), __uint_as_float(k0.x & 0xffff0000u), __uint_as_float(k0.y << 16), __uint_as_float(k0.y & 0xffff0000u),
                           __uint_as_float(k1.x << 16), __uint_as_float(k1.x & 0xffff0000u), __uint_as_float(k1.y << 16), __uint_as_float(k1.y & 0xffff0000u)};
            float bb[8] = {b0[0], b0[1], b0[2], b0[3], b1[0], b1[1], b1[2], b1[3]}, ll[8] = {l0[0], l0[1], l0[2], l0[3], l1[0], l1[1], l1[2], l1[3]};
            float ki[8];
#pragma unroll
            for (int e = 0; e < 8; ++e) ki[e] = kv[e] * __builtin_amdgcn_exp2f(-bb[e]);
#pragma unroll
            for (int e = 0; e < 8; e += 2) { const int dk = (e < 4 ? d0 : d1) + (e & 3); const unsigned p = cvt_pk(ki[e] * ll[e], ki[e + 1] * ll[e + 1]);
                KST[dk * 64 + i] = (unsigned short)p; KST[(dk + 1) * 64 + i] = (unsigned short)(p >> 16); }
            {
                const u32x2 q0 = {c2.q[rep].x, c2.q[rep].y}, q1 = {c2.q[rep].z, c2.q[rep].w};
                float qv[8] = {__uint_as_float(q0.x << 16), __uint_as_float(q0.x & 0xffff0000u), __uint_as_float(q0.y << 16), __uint_as_float(q0.y & 0xffff0000u),
                               __uint_as_float(q1.x << 16), __uint_as_float(q1.x & 0xffff0000u), __uint_as_float(q1.y << 16), __uint_as_float(q1.y & 0xffff0000u)};
                float qd[8];
#pragma unroll
                for (int e = 0; e < 8; ++e) qd[e] = qv[e] * __builtin_amdgcn_exp2f(bb[e]);
                u32x4 qw, kw; qw.x = cvt_pk(qd[0], qd[1]); qw.y = cvt_pk(qd[2], qd[3]); qw.z = cvt_pk(qd[4], qd[5]); qw.w = cvt_pk(qd[6], qd[7]);
                kw.x = cvt_pk(ki[0], ki[1]); kw.y = cvt_pk(ki[2], ki[3]); kw.z = cvt_pk(ki[4], ki[5]); kw.w = cvt_pk(ki[6], ki[7]);
                *(LAS u32x4*)(QD + f * 1024 + lane * 16) = qw; *(LAS u32x4*)(KI + f * 1024 + lane * 16) = kw;
                *(u32x4*)(pkq + OFF_QD + f * 1024 + lane * 16) = qw;
            }
        }
        put_af(n1);
        GLA_BAR();
        load2(item_ + G, n2);
        {
            const int s2 = w >> 2, it = w & 3;
            f32x4 d0v = (f32x4){0.f, 0.f, 0.f, 0.f}, d1v = (f32x4){0.f, 0.f, 0.f, 0.f};
#pragma unroll
            for (int s = 0; s < 4; ++s) { const bf16x8 qf = *(const LAS bf16x8*)(QD + (it * 4 + s) * 1024 + lane * 16);
                const bf16x8 ka = *(const LAS bf16x8*)(KI + ((2 * s2) * 4 + s) * 1024 + lane * 16), kb = *(const LAS bf16x8*)(KI + ((2 * s2 + 1) * 4 + s) * 1024 + lane * 16);
                d0v = __builtin_amdgcn_mfma_f32_16x16x32_bf16(ka, qf, d0v, 0, 0, 0); d1v = __builtin_amdgcn_mfma_f32_16x16x32_bf16(kb, qf, d1v, 0, 0, 0); }
            const int i = 16 * it + lc; float a[8];
#pragma unroll
            for (int e = 0; e < 8; ++e) { const int j = 32 * s2 + (e < 4 ? 0 : 16) + 4 * lg + (e & 3); const float v = e < 4 ? d0v[e] : d1v[e - 4]; a[e] = (dir ? (i <= j) : (i >= j)) ? v : 0.f; }
            u32x4 aw; aw.x = cvt_pk(a[0], a[1]); aw.y = cvt_pk(a[2], a[3]); aw.z = cvt_pk(a[4], a[5]); aw.w = cvt_pk(a[6], a[7]);
            dout.aw = aw; dout.pq = pkq; dout.pk = pk;
        }
#pragma unroll
        for (int rep = 0; rep < 2; ++rep) { const int fi = 2 * w + rep, dkt = fi >> 1, sp = fi & 1, dk = 16 * dkt + lc;
            const u32x2 x0 = *(const LAS u32x2*)(KST + dk * 64 + 32 * sp + 4 * lg), x1 = *(const LAS u32x2*)(KST + dk * 64 + 32 * sp + 16 + 4 * lg);
            u32x4 o; o.x = x0.x; o.y = x0.y; o.z = x1.x; o.w = x1.y;
            if (rep == 0) dout.k0 = o; else dout.k1 = o; }
    };
    In1 a1, b1; In2 a2, b2;
    load1(c, a1); load2(c, a2);
    for (int i = tid; i < 2 * 16 * 512 / 4; i += 512) ((LAS f32x4*)WL)[i] = i < 2048 ? ((const f32x4*)w_af)[i] : ((const f32x4*)w_ab)[i - 2048];
    put_af(a1);
    GLA_BAR();
    Def da, db; { char* dummy = (char*)ws + WS_PKGD; da.pq = dummy; da.pk = dummy; da.aw = (u32x4){0u, 0u, 0u, 0u}; da.k0 = da.aw; da.k1 = da.aw; }
    int item = c;
    for (; item + G < NITEMS; item += 2 * G) {
        body(item, a1, a2, b1, b2, da, db);
        body(item + G, b1, b2, a1, a2, db, da);
    }
    if (item < NITEMS) { body(item, a1, a2, b1, b2, da, db); flush(db); }
    else flush(da);
}

__device__ __forceinline__ void scan_phase(LAS unsigned char* lds, unsigned char* ws, int G, int c) {
    const int tid = threadIdx.x, w = __builtin_amdgcn_readfirstlane(tid >> 6), lane = tid & 63, lc = lane & 15, lg = lane >> 4;
    const bf16* VVT = (const bf16*)(ws + WS_VVT);
    const int vc = (G % 8 == 0) ? (c % 8) * (G / 8) + c / 8 : c;
    for (int item = vc; item < 256; item += G) {
        const int seq = item >> 2, vs = item & 3, dir = seq >> 5, b = (seq >> 2) & 7, h = seq & 3;
        bf16* O = (bf16*)(ws + (dir ? WS_OB : WS_OF));
        auto chunk_of = [&](int st) { return st < 4 ? (dir ? 3 - st : st) : 4 + (dir ? 63 - (st - 4) : st - 4); };
        if (w >= 4) {
            const int lw = w - 4;
            auto ptr_of = [&](int st_) { const int st = st_ < 68 ? st_ : 67; return chunk_of(st); };
            auto own_src = [&](int st_, int k) -> const char* { const int ch = ptr_of(st_); const char* pk = pkg_ptr(ws, seq, ch); const int tot = ch < 4 ? 17 : 41, nown = (tot - vs + 3) >> 2;
                const int trow = ch < 4 ? ML + b * TC + ch * 64 : b * T + (ch - 4) * 64;
                const int j = lw + 4 * k;
                if (j < nown) return pk + (vs + 4 * j) * 1024 + lane * 16;
                if (j < nown + 8) return (const char*)(VVT + ((size_t)(trow >> 6) * 1024 + h * DV + vs * 64) * 64 + lane * 8) + (j - nown) * 1024;
                return pk + vs * 1024 + lane * 16; };
            auto own_dst = [&](int st, int k) -> int { const int ch = chunk_of(st); const int tot = ch < 4 ? 17 : 41, nown = (tot - vs + 3) >> 2; const int j = lw + 4 * k;
                return j < nown ? (vs + 4 * j) * 1024 : j < nown + 8 ? OFF_V + (j - nown) * 1024 : vs * 1024; };
            auto rest_piece = [&](int st_, int k) -> int { const int ch = ptr_of(st_); const int tot = ch < 4 ? 17 : 41, nown = (tot - vs + 3) >> 2, nrest = tot - nown; const int j = lw + 4 * k;
                const int jj = j < nrest ? j : 0, i3 = jj % 3; return (jj / 3) * 4 + (i3 < vs ? i3 : i3 + 1); };
            u32x4 oa[5], ob[5], rb[8];
            auto ld_own = [&](int st, u32x4 (&r)[5]) {
#pragma unroll
                for (int k = 0; k < 5; ++k) r[k] = *(const u32x4*)own_src(st, k); };
            auto st_own = [&](int st, const u32x4 (&r)[5]) { if (st >= 68) return; LAS unsigned char* dst = lds + (st % 3) * SLOT_BYTES;
#pragma unroll
                for (int k = 0; k < 5; ++k) *(LAS u32x4*)(dst + own_dst(st, k) + lane * 16) = r[k]; };
            auto ld_rest = [&](int st) { const char* pk = pkg_ptr(ws, seq, ptr_of(st));
#pragma unroll
                for (int k = 0; k < 8; ++k) rb[k] = *(const u32x4*)(pk + rest_piece(st, k) * 1024 + lane * 16); };
            auto st_rest = [&](int st) { if (st >= 68) return; LAS unsigned char* dst = lds + (st % 3) * SLOT_BYTES;
#pragma unroll
                for (int k = 0; k < 8; ++k) *(LAS u32x4*)(dst + rest_piece(st, k) * 1024 + lane * 16) = rb[k]; };
            ld_own(0, oa); ld_own(1, ob); ld_rest(0);
            st_own(0, oa); st_rest(0);
            for (int st = 0; st < 68; st += 2) {
                GLA_BAR();
                ld_rest(st + 1); ld_own(st + 2, oa);
                st_own(st + 1, ob); st_rest(st + 1);
                GLA_BAR();
                ld_rest(st + 2); ld_own(st + 3, ob);
                st_own(st + 2, oa); st_rest(st + 2);
            }
            GLA_BAR();
        } else {
            const int dvb = vs * 64 + 16 * w;
            f32x4 S[8];
#pragma unroll
            for (int t = 0; t < 8; ++t) S[t] = (f32x4){0.f, 0.f, 0.f, 0.f};
#define GLA_FRAG(off) (*(const LAS bf16x8*)(base + (off) + lane * 16))
#define GLA_PIN() __builtin_amdgcn_sched_barrier(0)
            for (int st = 0; st < 68; ++st) {
                GLA_BAR();
                const LAS unsigned char* base = lds + (st % 3) * SLOT_BYTES;
                const int ch = chunk_of(st);
                bf16x8 vf[2];
                {   const LAS unsigned char* vp = base + OFF_V + (16 * w + lc) * 128 + 8 * lg;
                    const u32x2 x0 = *(const LAS u32x2*)vp, x1 = *(const LAS u32x2*)(vp + 32), x2 = *(const LAS u32x2*)(vp + 64), x3 = *(const LAS u32x2*)(vp + 96);
                    u32x4 t0, t1; t0.x = x0.x; t0.y = x0.y; t0.z = x1.x; t0.w = x1.y; t1.x = x2.x; t1.y = x2.y; t1.z = x3.x; t1.w = x3.y; vf[0] = __builtin_bit_cast(bf16x8, t0); vf[1] = __builtin_bit_cast(bf16x8, t1); }
                f32x4 el[8]; bf16x8 ks[8][2];
                if (ch >= 4) {
                    bf16x8 qa[4][6];
#pragma unroll
                    for (int it = 0; it < 4; ++it) {
#pragma unroll
                        for (int s = 0; s < 4; ++s) qa[it][s] = GLA_FRAG(OFF_QD + (it * 4 + s) * 1024);
#pragma unroll
                        for (int s2 = 0; s2 < 2; ++s2) qa[it][4 + s2] = GLA_FRAG(OFF_AT + (it * 2 + s2) * 1024); }
                    GLA_PIN();
                    bf16x8 sa[4];
#pragma unroll
                    for (int s = 0; s < 4; ++s) { u32x4 t; t.x = cvt_pk(S[2 * s][0], S[2 * s][1]); t.y = cvt_pk(S[2 * s][2], S[2 * s][3]); t.z = cvt_pk(S[2 * s + 1][0], S[2 * s + 1][1]); t.w = cvt_pk(S[2 * s + 1][2], S[2 * s + 1][3]); sa[s] = __builtin_bit_cast(bf16x8, t); }
                    const int row0 = b * T + (ch - 4) * 64;
                    f32x4 o[4];
#pragma unroll
                    for (int it = 0; it < 2; ++it) { o[it] = (f32x4){0.f, 0.f, 0.f, 0.f};
#pragma unroll
                        for (int s = 0; s < 4; ++s) o[it] = __builtin_amdgcn_mfma_f32_16x16x32_bf16(sa[s], qa[it][s], o[it], 0, 0, 0);
#pragma unroll
                        for (int s2 = 0; s2 < 2; ++s2) o[it] = __builtin_amdgcn_mfma_f32_16x16x32_bf16(vf[s2], qa[it][4 + s2], o[it], 0, 0, 0); }
                    GLA_PIN();
#pragma unroll
                    for (int t = 0; t < 4; ++t) { el[t] = *(const LAS f32x4*)(base + OFF_EL + (16 * t + 4 * lg) * 4); ks[t][0] = GLA_FRAG(OFF_KS + (t * 2) * 1024); ks[t][1] = GLA_FRAG(OFF_KS + (t * 2 + 1) * 1024); }
                    GLA_PIN();
#pragma unroll
                    for (int it = 2; it < 4; ++it) { o[it] = (f32x4){0.f, 0.f, 0.f, 0.f};
#pragma unroll
                        for (int s = 0; s < 4; ++s) o[it] = __builtin_amdgcn_mfma_f32_16x16x32_bf16(sa[s], qa[it][s], o[it], 0, 0, 0);
#pragma unroll
                        for (int s2 = 0; s2 < 2; ++s2) o[it] = __builtin_amdgcn_mfma_f32_16x16x32_bf16(vf[s2], qa[it][4 + s2], o[it], 0, 0, 0); }
                    GLA_PIN();
#pragma unroll
                    for (int t = 4; t < 8; ++t) { el[t] = *(const LAS f32x4*)(base + OFF_EL + (16 * t + 4 * lg) * 4); ks[t][0] = GLA_FRAG(OFF_KS + (t * 2) * 1024); ks[t][1] = GLA_FRAG(OFF_KS + (t * 2 + 1) * 1024); }
#pragma unroll
                    for (int it = 0; it < 4; ++it) { u32x2 ow; ow.x = cvt_pk(o[it][0], o[it][1]); ow.y = cvt_pk(o[it][2], o[it][3]);
                        *(u32x2*)(O + (size_t)(row0 + 16 * it + lc) * VW + h * DV + dvb + 4 * lg) = ow; }
                    GLA_PIN();
                } else {
#pragma unroll
                    for (int t = 0; t < 8; ++t) { el[t] = *(const LAS f32x4*)(base + OFF_EL + (16 * t + 4 * lg) * 4); ks[t][0] = GLA_FRAG(OFF_KS + (t * 2) * 1024); ks[t][1] = GLA_FRAG(OFF_KS + (t * 2 + 1) * 1024); }
                    GLA_PIN();
                }
#pragma unroll
                for (int t = 0; t < 8; ++t) { S[t] = S[t] * el[t]; S[t] = __builtin_amdgcn_mfma_f32_16x16x32_bf16(ks[t][0], vf[0], S[t], 0, 0, 0); S[t] = __builtin_amdgcn_mfma_f32_16x16x32_bf16(ks[t][1], vf[1], S[t], 0, 0, 0); }
            }
#undef GLA_FRAG
#undef GLA_PIN
            GLA_BAR();
        }
    }
}
}


#define XB_TMO      128
#define XB_XCNT(j)  (256  + 64 * (j))
#define XB_XSUB(j)  (1280 + 64 * (j))
#define XB_XGEN(j)  (2304 + 64 * (j))
#define XB_TOP      3328
#define XB_TOPGEN   3392
#define XCD_BAR_WORDS 3456
#define XB_SPIN_CAP (1u << 18)
__device__ __forceinline__ unsigned xb_ld(unsigned* p)              { return __hip_atomic_load(p, __ATOMIC_RELAXED, __HIP_MEMORY_SCOPE_AGENT); }
__device__ __forceinline__ unsigned xb_add(unsigned* p, unsigned v) { return __hip_atomic_fetch_add(p, v, __ATOMIC_RELAXED, __HIP_MEMORY_SCOPE_AGENT); }
__device__ __forceinline__ unsigned xb_xcc_id() { return (unsigned)__builtin_amdgcn_s_getreg((3 << 11) | 20) & 0xFu; }
#define XB_SPIN(cond, bar) do { unsigned _sp = 0; while (cond) { __builtin_amdgcn_s_sleep(1); \
    if ((++_sp & 255u) == 0u) { if (xb_ld(&(bar)[XB_TMO])) break; if (_sp > XB_SPIN_CAP) { atomicAdd(&(bar)[XB_TMO], 1u); break; } } } } while (0)
struct XcdBarrier { unsigned* bar; unsigned x; volatile LAS unsigned* st; };
__device__ __forceinline__ XcdBarrier xcd_barrier_post(unsigned* bar, volatile LAS unsigned* st) {
    XcdBarrier b; b.bar = bar; b.x = xb_xcc_id(); b.st = st;
    if (threadIdx.x == 0) (void)xb_add(&bar[XB_XCNT(b.x)], 1u);
    return b;
}
__device__ __forceinline__ void xcd_barrier_complete(unsigned* bar, unsigned x, unsigned& nloc, unsigned& nx) {
    const unsigned G = gridDim.x * gridDim.y * gridDim.z;
    unsigned sum, cnt, mine, sp = 0u;
    for (;;) {
        sum = 0u; cnt = 0u; mine = 0u;
#pragma unroll
        for (unsigned j = 0; j < 16; ++j) { const unsigned c = xb_ld(&bar[XB_XCNT(j)]); sum += c; cnt += (c > 0u) ? 1u : 0u; mine = (j == x) ? c : mine; }
        if (sum == G) break;
        __builtin_amdgcn_s_sleep(1);
        if ((++sp & 255u) == 0u) { if (xb_ld(&bar[XB_TMO])) break; if (sp > XB_SPIN_CAP) { atomicAdd(&bar[XB_TMO], 1u); break; } }
    }
    nloc = mine > 0u ? mine : 1u; nx = cnt > 0u ? cnt : 1u;
}
__device__ __forceinline__ void xcd_barrier(const XcdBarrier& b) {
    asm volatile("s_waitcnt vmcnt(0)" ::: "memory");
    __syncthreads();
    if (threadIdx.x == 0) {
        unsigned* bar = b.bar;
        __builtin_amdgcn_s_waitcnt(0);
        unsigned nloc = b.st[0], nx = b.st[1];
        if (nloc == 0u) { xcd_barrier_complete(bar, b.x, nloc, nx); b.st[0] = nloc; b.st[1] = nx; }
        const unsigned old = xb_add(&bar[XB_XSUB(b.x)], 1u);
        const unsigned gen = old / nloc;
        if (old + 1u == (gen + 1u) * nloc) {
            __builtin_amdgcn_fence(__ATOMIC_RELEASE, "agent");
            asm volatile("s_waitcnt vmcnt(0)" ::: "memory");
            const unsigned og = xb_add(&bar[XB_TOP], 1u);
            const unsigned tg = og / nx;
            if (og + 1u == (tg + 1u) * nx) xb_add(&bar[XB_TOPGEN], 1u);
            else XB_SPIN(xb_ld(&bar[XB_TOPGEN]) == tg, bar);
            __builtin_amdgcn_fence(__ATOMIC_ACQUIRE, "agent");
            xb_add(&bar[XB_XGEN(b.x)], 1u);
            asm volatile("s_waitcnt vmcnt(0)" ::: "memory");
        } else {
            XB_SPIN(xb_ld(&bar[XB_XGEN(b.x)]) == gen, bar);
            __builtin_amdgcn_fence(__ATOMIC_ACQUIRE, "agent");
            asm volatile("s_waitcnt vmcnt(0)" ::: "memory");
        }
    }
    __syncthreads();
}

namespace thin {
typedef float f32x4 __attribute__((ext_vector_type(4)));
typedef unsigned u32x4 __attribute__((ext_vector_type(4)));
typedef unsigned u32x2 __attribute__((ext_vector_type(2)));
typedef short bf16x8 __attribute__((ext_vector_type(8)));
using gla::cvt_pk;
__device__ __forceinline__ float lo16(unsigned w) { return __uint_as_float(w << 16); }
__device__ __forceinline__ float hi16(unsigned w) { return __uint_as_float(w & 0xffff0000u); }
__device__ __forceinline__ void tr_item(const float* W, int K, int ldw, int col0, bf16* WT, int mode_, LAS float* scr, int item, int nblk, int lane) {
    const int mode = mode_ & 15; const float wsc = (mode_ & 16) ? -1.44269504089f : (mode_ & 32) ? 0.08838834764831845f : 1.0f;
    const int kb = item / nblk, nb = item % nblk, k0 = 64 * kb, n0 = 32 * nb;
#pragma unroll 8
    for (int i = 0; i < 32; ++i) { const int kk = 2 * i + (lane >> 5); scr[kk * 33 + (lane & 31)] = __builtin_nontemporal_load(&W[(size_t)(k0 + kk) * ldw + col0 + n0 + (lane & 31)]); }
    asm volatile("s_waitcnt lgkmcnt(0)" ::: "memory");
    int r0 = n0;
    if (mode == 1) { const int col = col0 + n0; r0 = col < DFF ? 256 * (col >> 7) + (col & 127) : 256 * ((col - DFF) >> 7) + 128 + ((col - DFF) & 127); }
    const int cch = lane & 7;
#pragma unroll
    for (int j = 0; j < 4; ++j) { const int n = (lane >> 3) + 8 * j; const LAS float* sp = scr + (8 * cch) * 33 + n;
        u32x4 o; o.x = cvt_pk(sp[0 * 33] * wsc, sp[1 * 33] * wsc); o.y = cvt_pk(sp[2 * 33] * wsc, sp[3 * 33] * wsc); o.z = cvt_pk(sp[4 * 33] * wsc, sp[5 * 33] * wsc); o.w = cvt_pk(sp[6 * 33] * wsc, sp[7 * 33] * wsc);
        *(u32x4*)(WT + (size_t)(r0 + (mode == 2 ? pg8::perm32(n) : n)) * K + k0 + 8 * cch) = o; }
    asm volatile("s_waitcnt lgkmcnt(0)" ::: "memory");
}
template <int NR, int NC>
__device__ __forceinline__ void gemv_block(const LAS float* sv, LAS float* red, const float* W, int ldw, int col0, const float* bias, float* out, int ldo) {
    const int tid = threadIdx.x, w = tid >> 6, lane = tid & 63, col = lane % NC, kk = lane / NC;
    float acc[NR];
#pragma unroll
    for (int r = 0; r < NR; ++r) acc[r] = 0.f;
    if (kk < 2) {
#pragma unroll 16
        for (int j = 0; j < 64; ++j) { const int k = 128 * w + 2 * j + kk; const float wv = __builtin_nontemporal_load(&W[(size_t)k * ldw + col0 + col]);
#pragma unroll
            for (int r = 0; r < NR; ++r) acc[r] += sv[r * 1024 + k] * wv; }
    }
#pragma unroll
    for (int r = 0; r < NR; ++r) { const float o = __shfl(acc[r], (lane + NC) & 63); if (lane < NC) red[(w * NR + r) * 32 + col] = acc[r] + o; }
    __syncthreads();
    if (tid < NR * NC) { const int r = tid / NC, cidx = tid % NC; float t = 0.f;
#pragma unroll
        for (int ww = 0; ww < 8; ++ww) t += red[(ww * NR + r) * 32 + cidx];
        out[(size_t)r * ldo + col0 + cidx] = t + (bias ? bias[col0 + cidx] : 0.f); }
    __syncthreads();
}
struct P0Args { const float *c, *cctx, *w_ada, *b_ada, *w_in, *w_ba, *w_bb, *w_out, *w_f1, *w_f2, *w_sp; };
__device__ __forceinline__ void p0_phase(LAS unsigned char* lds, unsigned char* ws, const P0Args& A, int G, int vcu) {
    const int tid = threadIdx.x, w = __builtin_amdgcn_readfirstlane(tid >> 6), lane = tid & 63;
    LAS float* scr = (LAS float*)(lds + w * 8448);
    LAS float* sv = (LAS float*)(lds + 69632);
    LAS float* red = (LAS float*)(lds + 69632 + 36864);
    for (int i = tid; i < 9 * 1024; i += 512) { const int r = i >> 10, k = i & 1023; const float v = r < 8 ? A.c[r * 1024 + k] : A.cctx[k]; sv[i] = v / (1.f + __expf(-v)); }
    __syncthreads();
    for (int cb = vcu; cb < 256; cb += G) gemv_block<9, 24>(sv, red, A.w_ada, 6144, 24 * cb, A.b_ada, (float*)(ws + WS_MOD), 6144);
    const int gw = vcu * 8 + w, NGW = G * 8; int base = 0;
#define TR_JOB(Wp, K_, ldw_, col0_, ncols_, dst_, mode_) do { const int nblk_ = (ncols_) / 32, items_ = ((K_) / 64) * nblk_; \
        for (int it_ = ((gw - base) % NGW + NGW) % NGW; it_ < items_; it_ += NGW) tr_item(Wp, K_, ldw_, col0_, dst_, mode_, scr, it_, nblk_, lane); base = (base + items_) % NGW; } while (0)
    bf16* WT1A = (bf16*)(ws + WS_WT1A); bf16* WT1B = (bf16*)(ws + WS_WT1B);
    TR_JOB(A.w_in, 1024, NIN, C_Q, 512, WT1A, 2 + 32); TR_JOB(A.w_in, 1024, NIN, C_K, 512, WT1A + 512 * 1024, 2); TR_JOB(A.w_in, 1024, NIN, C_AF, 32, WT1A + 1024 * 1024, 0);
    TR_JOB(A.w_in, 1024, NIN, C_VV, 1024, (bf16*)(ws + WS_WTVV), 0); TR_JOB(A.w_in, 1024, NIN, C_VA, 1024, (bf16*)(ws + WS_WTVA), 0);
    TR_JOB(A.w_in, 1024, NIN, C_U, 1024, WT1B, 0); TR_JOB(A.w_in, 1024, NIN, C_R, 1024, WT1B + 1024 * 1024, 0); TR_JOB(A.w_in, 1024, NIN, C_GA, 1024, WT1B + 2048 * 1024, 16); TR_JOB(A.w_in, 1024, NIN, C_GB, 1024, WT1B + 3072 * 1024, 16);
    TR_JOB(A.w_ba, 1024, 1024, 0, 1024, (bf16*)(ws + WS_WTA), 0); TR_JOB(A.w_bb, 1024, 1024, 0, 1024, (bf16*)(ws + WS_WTB), 0); TR_JOB(A.w_out, 1024, 1024, 0, 1024, (bf16*)(ws + WS_WTO), 0);
    TR_JOB(A.w_f1, 1024, 2 * DFF, 0, 2 * DFF, (bf16*)(ws + WS_WTF1), 1);
    TR_JOB(A.w_f2, DFF, 1024, 0, 1024, (bf16*)(ws + WS_WTF2), 0);
#undef TR_JOB
    { u32x4* z = (u32x4*)(WT1A + 1056 * 1024); const u32x4 zero = {0u, 0u, 0u, 0u}; for (int i = vcu * 512 + tid; i < 224 * 1024 / 8; i += G * 512) z[i] = zero; }
    for (int i = vcu * 512 + tid; i < 8 * 8 * 4 * 64; i += G * 512) { const int ln = i & 63, sidx = (i >> 6) & 3, pt = (i >> 8) & 7, g = i >> 11;
        const float* src = A.w_sp + ((size_t)g * 128 + 16 * pt + (ln & 15)) * 128 + 32 * sidx + 8 * (ln >> 4);
        const f32x4 a = *(const f32x4*)src, b = *(const f32x4*)(src + 4);
        u32x4 o; o.x = cvt_pk(a[0], a[1]); o.y = cvt_pk(a[2], a[3]); o.z = cvt_pk(b[0], b[1]); o.w = cvt_pk(b[2], b[3]);
        ((u32x4*)(ws + WS_WSPF))[i] = o; }
    __syncthreads();
}
__device__ __forceinline__ float wsum(float v) {
#pragma unroll
    for (int o = 1; o < 64; o <<= 1) v += __shfl_xor(v, o);
    return v;
}
__device__ __forceinline__ void p1_phase(LAS unsigned char* lds, unsigned char* ws, const float* x, const float* ctx, const float* n1g, const float* n2g, const float* w_f1, int G, int vcu) {
    const int tid = threadIdx.x, w = __builtin_amdgcn_readfirstlane(tid >> 6), lane = tid & 63;
    const float* MOD = (const float*)(ws + WS_MOD); bf16* H = (bf16*)(ws + WS_H);
    const int gw = vcu * 8 + w, NGW = G * 8;
    LAS float* TA = (LAS float*)lds; LAS float* TB = TA + 9 * 1024;
    for (int i = tid; i < 9 * 1024; i += 512) { const int mr = i >> 10, ci = i & 1023; TA[i] = n1g[ci] * (MOD[mr * 6144 + 1024 + ci] + 1.0f); TB[i] = MOD[mr * 6144 + ci]; }
    __syncthreads();
    auto rowp = [&](int row) { return row < ML ? x + (size_t)row * D : ctx + (size_t)(row - ML) * D; };
    auto store_row = [&](const f32x4 (&v)[4], float t, int row) {
        const int mr = row < ML ? row / T : 8; const float rstd = rsqrtf(t * (1.f / D) + EPS);
#pragma unroll
        for (int j = 0; j < 4; ++j) { const int cidx = 4 * lane + 256 * j; const f32x4 ga = *(const LAS f32x4*)(TA + mr * 1024 + cidx), sh = *(const LAS f32x4*)(TB + mr * 1024 + cidx);
            const f32x4 y = v[j] * rstd * ga + sh; u32x2 o; o.x = cvt_pk(y[0], y[1]); o.y = cvt_pk(y[2], y[3]); *(u32x2*)(H + (size_t)row * D + cidx) = o; } };
    auto sumsq = [&](const f32x4 (&v)[4]) { float t = 0.f;
#pragma unroll
        for (int j = 0; j < 4; ++j) t += (v[j][0] * v[j][0] + v[j][1] * v[j][1]) + (v[j][2] * v[j][2] + v[j][3] * v[j][3]);
        return t; };
    if (G == 256) {
        constexpr int NQ = 3, NR = M / 2048, NIT = (NR + NQ - 1) / NQ; static_assert(M % 2048 == 0, "rows per wave");
        f32x4 v[2][NQ][4];
#pragma unroll
        for (int q = 0; q < NQ; ++q) { const float* xr = rowp(gw + q * 2048);
#pragma unroll
            for (int j = 0; j < 4; ++j) v[0][q][j] = __builtin_nontemporal_load((const f32x4*)(xr + 4 * lane + 256 * j)); }
#pragma unroll
        for (int it = 0; it < NIT; ++it) {
            if (it + 1 < NIT) {
#pragma unroll
                for (int q = 0; q < NQ; ++q) if ((it + 1) * NQ + q < NR) { const float* xr = rowp(gw + ((it + 1) * NQ + q) * 2048);
#pragma unroll
                    for (int j = 0; j < 4; ++j) v[(it + 1) & 1][q][j] = __builtin_nontemporal_load((const f32x4*)(xr + 4 * lane + 256 * j)); } }
            float ss[NQ];
#pragma unroll
            for (int q = 0; q < NQ; ++q) ss[q] = (it * NQ + q < NR) ? sumsq(v[it & 1][q]) : 0.f;
#pragma unroll
            for (int o = 1; o < 64; o <<= 1) {
#pragma unroll
                for (int q = 0; q < NQ; ++q) if (it * NQ + q < NR) ss[q] += __shfl_xor(ss[q], o); }
#pragma unroll
            for (int q = 0; q < NQ; ++q) if (it * NQ + q < NR) store_row(v[it & 1][q], ss[q], gw + (it * NQ + q) * 2048);
        }
    } else {
    for (int row0 = gw; row0 < M; row0 += 4 * NGW) {
        f32x4 v[4][4]; float ss[4];
#pragma unroll
        for (int q = 0; q < 4; ++q) { const int row = row0 + q * NGW < M ? row0 + q * NGW : row0; const float* xr = rowp(row);
#pragma unroll
            for (int j = 0; j < 4; ++j) v[q][j] = __builtin_nontemporal_load((const f32x4*)(xr + 4 * lane + 256 * j)); }
#pragma unroll
        for (int q = 0; q < 4; ++q) ss[q] = sumsq(v[q]);
#pragma unroll
        for (int o = 1; o < 64; o <<= 1) {
#pragma unroll
            for (int q = 0; q < 4; ++q) ss[q] += __shfl_xor(ss[q], o); }
#pragma unroll
        for (int q = 0; q < 4; ++q) { const int row = row0 + q * NGW; if (row < M) store_row(v[q], ss[q], row); }
    }
    }
    __syncthreads();
    for (int i = vcu * 512 + tid; i < 8 * 1024; i += G * 512) ((float*)(ws + WS_GV2))[i] = n2g[i & 1023] * (1.f + MOD[(i >> 10) * 6144 + 4096 + (i & 1023)]);
    LAS float* sv = (LAS float*)lds; LAS float* red = (LAS float*)(lds + 32768);
    for (int i = tid; i < 8 * 1024; i += 512) sv[i] = MOD[(i >> 10) * 6144 + 3072 + (i & 1023)];
    __syncthreads();
    for (int cb = vcu; cb < 256; cb += G) gemv_block<8, 22>(sv, red, w_f1, 2 * DFF, 22 * cb, nullptr, (float*)(ws + WS_CV), 2 * DFF);
}
__device__ __forceinline__ void mix_phase(LAS unsigned char* lds, unsigned char* ws, const float* lng, const float* lnb, const float* bsp, const float* gain, int G, int vcu) {
    const int tid = threadIdx.x, w = __builtin_amdgcn_readfirstlane(tid >> 6), lane = tid & 63, lc = lane & 15, lg = lane >> 4;
    const bf16* GVT = (const bf16*)(ws + WS_GVT); bf16* U = (bf16*)(ws + WS_U); const u32x4* WSPF = (const u32x4*)(ws + WS_WSPF);
    LAS float* RS = (LAS float*)lds;
    LAS float* RQ = (LAS float*)(lds + 16384);
    LAS float* MR = (LAS float*)(lds + 32768);
    LAS unsigned char* WB = lds + 36864;
    LAS float* LNG = (LAS float*)(lds + 135168); LAS float* LNB = LNG + 1024; LAS float* BSL = LNB + 1024;
    for (int i = tid; i < 1024; i += 512) { LNG[i] = lng[i]; LNB[i] = lnb[i]; BSL[i] = bsp[i]; }
    for (int ch = vcu; ch < ML / 128; ch += G) {
        const int tok0 = ch * 128;
        {
            const int to = tid & 15, cs = tid >> 4; float sm[8], sq[8];
#pragma unroll
            for (int e = 0; e < 8; ++e) { sm[e] = 0.f; sq[e] = 0.f; }
            const bf16* gp = GVT + (size_t)(cs * 32) * ML + tok0 + 8 * to;
            u32x4 raw[32];
#pragma unroll
            for (int cc = 0; cc < 32; ++cc) raw[cc] = *(const u32x4*)(gp + (size_t)cc * ML);
#pragma unroll
            for (int cc = 0; cc < 32; ++cc) { const unsigned rw[4] = {raw[cc].x, raw[cc].y, raw[cc].z, raw[cc].w};
#pragma unroll
                for (int e = 0; e < 4; ++e) { const float x0 = lo16(rw[e]), x1 = hi16(rw[e]); sm[2 * e] += x0; sq[2 * e] += x0 * x0; sm[2 * e + 1] += x1; sq[2 * e + 1] += x1 * x1; } }
#pragma unroll
            for (int e = 0; e < 8; ++e) { RS[cs * 128 + 8 * to + e] = sm[e]; RQ[cs * 128 + 8 * to + e] = sq[e]; }
        }
        __syncthreads();
        if (tid < 128) { float sx = 0.f, qx = 0.f;
#pragma unroll
            for (int k = 0; k < 32; ++k) { sx += RS[k * 128 + tid]; qx += RQ[k * 128 + tid]; }
            const float mean = sx * (1.f / 1024.f), var = fmaxf(qx * (1.f / 1024.f) - mean * mean, 0.f); MR[2 * tid] = mean; MR[2 * tid + 1] = rsqrtf(var + EPS); }
        __syncthreads();
        struct GIn { u32x4 wq[4]; u32x4 av[4]; u32x4 uq[4]; };
        auto gload = [&](int g_, GIn& x) { const int g = g_ < 8 ? g_ : 7;
#pragma unroll
            for (int k = 0; k < 4; ++k) x.wq[k] = WSPF[g * 2048 + tid + 512 * k];
#pragma unroll
            for (int k = 0; k < 4; ++k) { const int e = tid + 512 * k; x.av[k] = *(const u32x4*)(GVT + (size_t)(g * 128 + (e >> 4)) * ML + tok0 + (e & 15) * 8); }
#pragma unroll
            for (int k = 0; k < 4; ++k) { const int e = tid + 512 * k; x.uq[k] = *(const u32x4*)(U + (size_t)(tok0 + (e >> 4)) * D + g * 128 + (e & 15) * 8); } };
        auto gcomp = [&](int g, const GIn& x, GIn& nx) {
            LAS unsigned char* wb = WB; LAS unsigned char* gt = lds + 102400;
#pragma unroll
            for (int k = 0; k < 4; ++k) *(LAS u32x4*)(wb + (tid + 512 * k) * 16) = x.wq[k];
            LAS unsigned char* ut = lds + ((g & 1) ? 69632 : 0);
#pragma unroll
            for (int k = 0; k < 4; ++k) { const int e = tid + 512 * k, row = e >> 4, cu = e & 15, so = row * 256 + ((cu ^ (row & 15)) << 4); *(LAS u32x4*)(ut + so) = x.uq[k]; *(LAS u32x4*)(gt + so) = x.av[k]; }
            GLA_BAR();
            gload(g + 1, nx);
            const int chn = g * 128 + 16 * w + lc; const float gg = LNG[chn], bb = LNB[chn];
            bf16x8 af[4];
#pragma unroll
            for (int sidx = 0; sidx < 4; ++sidx) { const int q0 = 32 * sidx + 8 * lg; const u32x4 raw = *(const LAS u32x4*)(gt + (16 * w + lc) * 256 + (((4 * sidx + lg) ^ lc) << 4));
                const unsigned rw[4] = {raw.x, raw.y, raw.z, raw.w}; float y[8];
#pragma unroll
                for (int e = 0; e < 4; ++e) { const f32x4 mr = *(const LAS f32x4*)(MR + 2 * (q0 + 2 * e));
                    y[2 * e] = (lo16(rw[e]) - mr[0]) * mr[1] * gg + bb; y[2 * e + 1] = (hi16(rw[e]) - mr[2]) * mr[3] * gg + bb; }
                u32x4 t; t.x = cvt_pk(y[0], y[1]); t.y = cvt_pk(y[2], y[3]); t.z = cvt_pk(y[4], y[5]); t.w = cvt_pk(y[6], y[7]); af[sidx] = __builtin_bit_cast(bf16x8, t); }
#pragma unroll
            for (int pt = 0; pt < 8; ++pt) { f32x4 d = (f32x4){0.f, 0.f, 0.f, 0.f};
#pragma unroll
                for (int sidx = 0; sidx < 4; ++sidx) { const bf16x8 bf = *(const LAS bf16x8*)(wb + ((pt * 4 + sidx) * 64 + lane) * 16); d = __builtin_amdgcn_mfma_f32_16x16x32_bf16(af[sidx], bf, d, 0, 0, 0); }
                const float bs = BSL[g * 128 + 16 * pt + lc];
                LAS u32x2* up = (LAS u32x2*)(ut + (16 * pt + lc) * 256 + (((2 * w + (lg >> 1)) ^ lc) << 4) + (lg & 1) * 8); const u32x2 uv = *up;
                u32x2 o; o.x = cvt_pk(lo16(uv.x) * (d[0] + bs), hi16(uv.x) * (d[1] + bs)); o.y = cvt_pk(lo16(uv.y) * (d[2] + bs), hi16(uv.y) * (d[3] + bs)); *up = o; }
            GLA_BAR();
#pragma unroll
            for (int k = 0; k < 4; ++k) { const int e = tid + 512 * k, row = e >> 4, cu = e & 15;
                *(u32x4*)(U + (size_t)(tok0 + row) * D + g * 128 + cu * 8) = *(const LAS u32x4*)(ut + row * 256 + ((cu ^ (row & 15)) << 4)); } };
        GIn ga, gb;
        gload(0, ga);
        for (int g = 0; g < 8; g += 2) { gcomp(g, ga, gb); gcomp(g + 1, gb, ga); }
        __syncthreads();
    }
    bf16* OF = (bf16*)(ws + WS_OF); const bf16* OB = (const bf16*)(ws + WS_OB); const bf16* R = (const bf16*)(ws + WS_R);
    const int gw = vcu * 8 + w, NGW = G * 8;
    for (int row0 = gw; row0 < ML; row0 += 2 * NGW) {
        u32x4 ra[2][2], rb[2][2], rr[2][2];
#pragma unroll
        for (int q = 0; q < 2; ++q) { const int row = row0 + q * NGW < ML ? row0 + q * NGW : row0; const size_t o = (size_t)row * VW + 16 * lane;
#pragma unroll
            for (int hv = 0; hv < 2; ++hv) { ra[q][hv] = *(const u32x4*)(OF + o + 8 * hv); rb[q][hv] = *(const u32x4*)(OB + o + 8 * hv); rr[q][hv] = *(const u32x4*)(R + o + 8 * hv); } }
#pragma unroll
        for (int q = 0; q < 2; ++q) { const int row = row0 + q * NGW; if (row < ML) { const size_t o = (size_t)row * VW + 16 * lane; float v[16], r[16]; float ss = 0.f;
#pragma unroll
            for (int hv = 0; hv < 2; ++hv) { const u32x4 a = ra[q][hv], b = rb[q][hv], rq = rr[q][hv];
                const unsigned aw[4] = {a.x, a.y, a.z, a.w}, bw[4] = {b.x, b.y, b.z, b.w}, rw[4] = {rq.x, rq.y, rq.z, rq.w};
#pragma unroll
                for (int e = 0; e < 4; ++e) { v[8 * hv + 2 * e] = lo16(aw[e]) + lo16(bw[e]); v[8 * hv + 2 * e + 1] = hi16(aw[e]) + hi16(bw[e]); r[8 * hv + 2 * e] = lo16(rw[e]); r[8 * hv + 2 * e + 1] = hi16(rw[e]); } }
#pragma unroll
            for (int e = 0; e < 16; ++e) ss += v[e] * v[e];
            ss += __shfl_xor(ss, 1); ss += __shfl_xor(ss, 2); ss += __shfl_xor(ss, 4); ss += __shfl_xor(ss, 8);
            const float rstd = rsqrtf(ss * (1.f / DV) + EPS);
#pragma unroll
            for (int hv = 0; hv < 2; ++hv) { const f32x4 g0 = *(const f32x4*)(gain + 16 * lane + 8 * hv), g1 = *(const f32x4*)(gain + 16 * lane + 8 * hv + 4); float y[8];
#pragma unroll
                for (int e = 0; e < 4; ++e) { y[e] = v[8 * hv + e] * rstd * g0[e] * r[8 * hv + e]; y[4 + e] = v[8 * hv + 4 + e] * rstd * g1[e] * r[8 * hv + 4 + e]; }
                u32x4 t; t.x = cvt_pk(y[0], y[1]); t.y = cvt_pk(y[2], y[3]); t.z = cvt_pk(y[4], y[5]); t.w = cvt_pk(y[6], y[7]); *(u32x4*)(OF + o + 8 * hv) = t; } } }
    }
}
__device__ __forceinline__ void fin_phase(float* X, const float* g, int G, int vcu) {
    const int w = threadIdx.x >> 6, lane = threadIdx.x & 63, gw = vcu * 8 + w, NGW = G * 8;
    for (int row = gw; row < ML; row += NGW) { float* xr = X + (size_t)row * D; f32x4 v[4]; float ss = 0.f;
#pragma unroll
        for (int j = 0; j < 4; ++j) { v[j] = *(const f32x4*)(xr + 4 * lane + 256 * j); ss += (v[j][0] * v[j][0] + v[j][1] * v[j][1]) + (v[j][2] * v[j][2] + v[j][3] * v[j][3]); }
        const float rstd = rsqrtf(wsum(ss) * (1.f / D) + EPS);
#pragma unroll
        for (int j = 0; j < 4; ++j) *(f32x4*)(xr + 4 * lane + 256 * j) = v[j] * rstd * *(const f32x4*)(g + 4 * lane + 256 * j); }
}
}

constexpr int NWAVES = 8, LDS_BYTES = 163840;
#ifndef PG8_SP2
#define PG8_SP2 true
#endif
#ifndef PG8_ALIGN
#define PG8_ALIGN true
#endif
enum Phase { PH_P0 = 0, PH_P1 = 1, PH_G1A = 2, PH_PRE = 3, PH_SCAN = 4, PH_G1B = 5, PH_MIX = 6, PH_MRG = 7, PH_WOUT = 8, PH_FF1 = 9, PH_FF2 = 10, PH_END = 11 };
constexpr int CW_FINCNT = 32768;
constexpr int CW_BAR = 4096;
constexpr int MISC_OFF = LDS_BYTES - 256;
struct Args { const float* in[24]; float* out; unsigned char* ws; int ph_lo, ph_hi; };
__global__ void __launch_bounds__(NWAVES * 64, 2) mega_fwd(Args a) {
    extern __shared__ __attribute__((aligned(16))) unsigned char lds_raw[];
    LAS unsigned char* lds = (LAS unsigned char*)lds_raw;
    unsigned char* ws = a.ws;
    const int G = gridDim.x, c = blockIdx.x;
    const int vcu = (G % 8 == 0) ? (c % 8) * (G / 8) + c / 8 : c;
    const char* Hc = (const char*)(ws + WS_H);
    volatile LAS unsigned* MISC = (volatile LAS unsigned*)(lds + MISC_OFF);
    if (threadIdx.x < 64) MISC[threadIdx.x] = 0u;
    __syncthreads();
    XcdBarrier bar; bar.bar = (unsigned*)(ws + WS_CTL) + CW_BAR; bar.x = 0; bar.st = nullptr;
    const bool multi = a.ph_hi - a.ph_lo > 1;
    if (multi) bar = xcd_barrier_post((unsigned*)(ws + WS_CTL) + CW_BAR, MISC + 8);
#define IN(k) (a.ph_lo <= (k) && (k) < a.ph_hi)
#define SEAM(k) do { if (IN(k) && IN((k) + 1)) xcd_barrier(bar); } while (0)
    if (IN(PH_P0)) { thin::P0Args pa{a.in[1], a.in[3], a.in[4], a.in[5], a.in[7], a.in[17], a.in[18], a.in[19], a.in[21], a.in[22], a.in[10]}; thin::p0_phase(lds, ws, pa, G, vcu); }
    SEAM(PH_P0);
    if (IN(PH_P1)) thin::p1_phase(lds, ws, a.in[0], a.in[2], a.in[6], a.in[20], a.in[21], G, vcu);
    SEAM(PH_P1);
    if (IN(PH_G1A)) {
        pg8::Order1A S{Hc, (const char*)(ws + WS_WT1A), (const char*)(ws + WS_WTVV), (char*)(ws + WS_Q), (char*)(ws + WS_K), (char*)(ws + WS_AF), (char*)(ws + WS_VVT), G, c};
        pg8::EpiAct E;
        pg8::gemm_phase<pg8::EpiAct, pg8::Order1A, PG8_ALIGN, PG8_SP2>(lds, 1024, S, E);
    }
    SEAM(PH_G1A);
    if (IN(PH_PRE)) { gla::prepass_phase(lds, ws, a.in[12], a.in[13], a.in[14], a.in[15], G, c); __syncthreads(); }
    SEAM(PH_PRE);
    if (IN(PH_SCAN)) { gla::scan_phase(lds, ws, G, c); __syncthreads(); }
    SEAM(PH_SCAN);
    if (IN(PH_G1B)) {
        pg8::Order1B S{Hc, (const char*)(ws + WS_WT1B), (const char*)(ws + WS_WTVA), (char*)(ws + WS_U), (char*)(ws + WS_R), (char*)a.out, (char*)a.out + (size_t)ML * D, (char*)(ws + WS_GVT), G, c};
        pg8::EpiAct E;
        pg8::gemm_phase<pg8::EpiAct, pg8::Order1B, PG8_ALIGN, PG8_SP2>(lds, 1024, S, E);
    }
    SEAM(PH_G1B);
    if (IN(PH_MIX)) thin::mix_phase(lds, ws, a.in[8], a.in[9], a.in[11], a.in[16], G, vcu);
    SEAM(PH_MIX);
    if (IN(PH_MRG)) {
        pg8::OrderMrg S{(const char*)(ws + WS_U), (const char*)(ws + WS_WTA), (const char*)(ws + WS_OF), (const char*)(ws + WS_WTB), G, c};
        pg8::EpiMrg E{(const unsigned char*)a.out, (const unsigned char*)a.out + (size_t)ML * D, (bf16*)(ws + WS_Y)};
        pg8::gemm_phase<pg8::EpiMrg, pg8::OrderMrg, PG8_ALIGN, PG8_SP2>(lds, 1024, S, E);
    }
    SEAM(PH_MRG);
    if (IN(PH_WOUT)) {
        pg8::OrderGrid S{(const char*)(ws + WS_Y), (const char*)(ws + WS_WTO), 128, 4, 1024, G, c};
        pg8::EpiRes2 E{a.in[0], (const float*)(ws + WS_MOD), (const float*)(ws + WS_GV2), (bf16*)(ws + WS_X1), (bf16*)(ws + WS_A2), (unsigned long long*)(ws + WS_ROWSS)};
        pg8::gemm_phase<pg8::EpiRes2, pg8::OrderGrid, PG8_ALIGN, PG8_SP2>(lds, 1024, S, E);
    }
    SEAM(PH_WOUT);
    if (IN(PH_FF1)) {
        pg8::OrderGrid S{(const char*)(ws + WS_A2), (const char*)(ws + WS_WTF1), 128, 22, 1024, G, c};
        pg8::EpiSwi2 E{(bf16*)(ws + WS_HB), (const unsigned long long*)(ws + WS_ROWSS), (const float*)(ws + WS_CV)};
        pg8::gemm_phase<pg8::EpiSwi2, pg8::OrderGrid, PG8_ALIGN, PG8_SP2>(lds, 1024, S, E);
    }
    SEAM(PH_FF1);
    if (IN(PH_FF2)) {
        pg8::OrderGrid S{(const char*)(ws + WS_HB), (const char*)(ws + WS_WTF2), 128, 4, DFF, G, c};
        pg8::EpiFin E{(const bf16*)(ws + WS_A2), (const float*)(ws + WS_GV2), (const float*)(ws + WS_MOD), a.in[23], a.out, (unsigned long long*)(ws + WS_ROWSS2), (unsigned*)(ws + WS_CTL) + CW_FINCNT};
        pg8::gemm_phase<pg8::EpiFin, pg8::OrderGrid, PG8_ALIGN, PG8_SP2>(lds, DFF, S, E);
    }
#undef IN
#undef SEAM
}
static int g_grid = 0;
static void run_mega(hipStream_t stream, void* const* d_in, void* d_out, void* d_ws, int lo, int hi) {
    Args a{}; for (int i = 0; i < 24; ++i) a.in[i] = (const float*)d_in[i];
    a.out = (float*)d_out; a.ws = (unsigned char*)d_ws; a.ph_lo = lo; a.ph_hi = hi;
    hipLaunchKernelGGL(mega_fwd, dim3(g_grid), dim3(NWAVES * 64), LDS_BYTES, stream, a);
}

template <class Epi, bool DUAL = false>
static void run_gemm(hipStream_t s, const bf16* A, const bf16* Bt, int Mrows, int N, int K, const Epi& e) {
    hipLaunchKernelGGL((nv_gemm<Epi, DUAL>), dim3((N + 63) / 64, Mrows / 64), dim3(256), 0, s, A, Bt, Mrows, N, K, 0, e);
}
static void run_tr(hipStream_t s, const float* W, int K, int ldw, int col0, int ncols, bf16* WT) {
    hipLaunchKernelGGL(nv_transpose, dim3(ncols / 32, K / 32), dim3(256), 0, s, W, K, ldw, col0, ncols, WT);
}

extern "C" void kernel_launch(void* const* d_in, const int* in_sizes, int n_in, void* d_out, int out_size, void* d_ws, size_t ws_size, hipStream_t stream) {
    if (n_in != 24 || out_size != ML * D || ws_size < WS_END) { fprintf(stderr, "kernel_launch: unexpected sizes n_in %d out %d ws %zu\n", n_in, out_size, ws_size); return; }
    const float* x = (const float*)d_in[0]; const float* c = (const float*)d_in[1]; const float* ctx = (const float*)d_in[2]; const float* cctx = (const float*)d_in[3];
    const float* w_ada = (const float*)d_in[4]; const float* b_ada = (const float*)d_in[5]; const float* norm1_g = (const float*)d_in[6]; const float* w_in = (const float*)d_in[7];
    const float* ln_v_g = (const float*)d_in[8]; const float* ln_v_b = (const float*)d_in[9]; const float* w_sp = (const float*)d_in[10]; const float* b_sp = (const float*)d_in[11];
    const float* w_af = (const float*)d_in[12]; const float* b_af = (const float*)d_in[13]; const float* w_ab = (const float*)d_in[14]; const float* b_ab = (const float*)d_in[15];
    const float* gla_g = (const float*)d_in[16]; const float* w_ba = (const float*)d_in[17]; const float* w_bb = (const float*)d_in[18]; const float* w_out = (const float*)d_in[19];
    const float* norm2_g = (const float*)d_in[20]; const float* w_f1 = (const float*)d_in[21]; const float* w_f2 = (const float*)d_in[22]; const float* fin_g = (const float*)d_in[23];
    unsigned char* ws = (unsigned char*)d_ws; float* out = (float*)d_out;
    if (g_grid == 0) {
        int dev = 0, cus = 0, per_cu = 0;
        hipGetDevice(&dev); hipDeviceGetAttribute(&cus, hipDeviceAttributeMultiprocessorCount, dev);
        hipFuncSetAttribute((const void*)mega_fwd, hipFuncAttributeMaxDynamicSharedMemorySize, LDS_BYTES);
        hipOccupancyMaxActiveBlocksPerMultiprocessor(&per_cu, (const void*)mega_fwd, NWAVES * 64, LDS_BYTES);
        (void)hipGetLastError();
        if (per_cu < 1) fprintf(stderr, "kernel_launch: occupancy query says %d blocks/CU\n", per_cu);
        g_grid = cus;
    }
    bf16 *WT1A = (bf16*)(ws + WS_WT1A), *WTVV = (bf16*)(ws + WS_WTVV), *WT1B = (bf16*)(ws + WS_WT1B), *WTVA = (bf16*)(ws + WS_WTVA), *WTA = (bf16*)(ws + WS_WTA), *WTB = (bf16*)(ws + WS_WTB),
         *WTO = (bf16*)(ws + WS_WTO), *WTF1 = (bf16*)(ws + WS_WTF1), *WTF2 = (bf16*)(ws + WS_WTF2);
    float* MOD = (float*)(ws + WS_MOD); float* LNST = (float*)(ws + WS_LNST);
    bf16 *H = (bf16*)(ws + WS_H), *Q = (bf16*)(ws + WS_Q), *Kb = (bf16*)(ws + WS_K), *VVT = (bf16*)(ws + WS_VVT), *OF = (bf16*)(ws + WS_OF), *OB = (bf16*)(ws + WS_OB), *U = (bf16*)(ws + WS_U),
         *GVT = (bf16*)(ws + WS_GVT), *R = (bf16*)(ws + WS_R), *Y = (bf16*)(ws + WS_Y), *A2 = (bf16*)(ws + WS_A2), *HB = (bf16*)(ws + WS_HB);
    float *AF = (float*)(ws + WS_AF), *Y1 = (float*)(ws + WS_Y1), *X1 = (float*)(ws + WS_X1);
    bf16 *GA = (bf16*)d_out, *GB = (bf16*)d_out + (size_t)ML * D;
    hipMemsetAsync(ws + WS_CTL, 0, 1 * MiB, stream);
#ifndef MK_ONE_LAUNCH
#define MK_ONE_LAUNCH 1
#endif
#ifndef MK_REP
#define MK_REP 0
#endif
    if (MK_ONE_LAUNCH) run_mega(stream, d_in, d_out, d_ws, 0, PH_END);
    else for (int p = 0; p < PH_END; ++p) { run_mega(stream, d_in, d_out, d_ws, p, p + 1); if ((MK_REP >> p) & 1) run_mega(stream, d_in, d_out, d_ws, p, p + 1); }
}
```
